# Optimizing an MI355X kernel written in HIP

```python
import math
import jax, jax.numpy as jnp
from jax import lax
import numpy as np

D_MODEL = 1024
BATCH = 4
SEQ = 8192
DEPTH = 1

N_HEADS = 8
N_KV_HEADS = 2
HEAD_DIM = 64
ATTN_WIDTH = N_HEADS * HEAD_DIM
KV_WIDTH = N_KV_HEADS * HEAD_DIM
WINDOW = 128
BLOCK_Q = 128
HYENA_WIDTH = 512
HYENA_ORDER = 2
SHORT_CONV = 3
FILTER_EMB = 33
FILTER_BANDS = (FILTER_EMB - 1) // 2
FILTER_HIDDEN = 64
WINDOW_SHIFT = 0.05
FAST_DECAY_PCT = 0.3
SLOW_DECAY_PCT = 1.5
DECAY_TARGET = 1e-2
N_FILTERS = HYENA_ORDER * 2 * HYENA_WIDTH
N_GROUPS = 8
EXPERTS_PER_GROUP = 8
N_EXPERTS = N_GROUPS * EXPERTS_PER_GROUP
TOP_K = 2
D_EXPERT = 512
MOE_BLOCK = 256
LN_EPS = 1e-5
DN_ALPHA = (2.0 * DEPTH) ** 0.25
DN_BETA = (8.0 * DEPTH) ** -0.25
IN_WIDTH = ATTN_WIDTH + 2 * KV_WIDTH + (HYENA_ORDER + 1) * HYENA_WIDTH + 2 * D_MODEL

kernel_name = "hybrid_hyena_swa_hmoe_deepnorm_encoder"


def layer_norm(x, g, b):
    xf = x.astype(jnp.float32)
    mu = jnp.mean(xf, axis=-1, keepdims=True)
    var = jnp.mean(jnp.square(xf - mu), axis=-1, keepdims=True)
    y = (xf - mu) * lax.rsqrt(var + LN_EPS) * g.astype(jnp.float32) + b.astype(jnp.float32)
    return y.astype(x.dtype)


def windowed_attention(q, k, v, sink):
    B, S = q.shape[0], q.shape[1]
    nb = S // BLOCK_Q
    G = N_HEADS // N_KV_HEADS
    qb = q.reshape(B, nb, BLOCK_Q, N_KV_HEADS, G, HEAD_DIM)
    k = k.reshape(B, S, N_KV_HEADS, HEAD_DIM)
    v = v.reshape(B, S, N_KV_HEADS, HEAD_DIM)

    def band(t):
        tp = jnp.pad(t, ((0, 0), (BLOCK_Q, BLOCK_Q), (0, 0), (0, 0)))
        tp = tp.reshape(B, nb + 2, BLOCK_Q, N_KV_HEADS, HEAD_DIM)
        return jnp.concatenate([tp[:, :-2], tp[:, 1:-1], tp[:, 2:]], axis=2)

    kw, vw = band(k), band(v)
    s = jnp.einsum('bnqkgd,bnjkd->bnkgqj', qb, kw).astype(jnp.float32) * (HEAD_DIM ** -0.5)
    a = jnp.arange(BLOCK_Q)[:, None]
    j = jnp.arange(3 * BLOCK_Q)[None, :]
    rel = j - BLOCK_Q - a
    kpos = jnp.arange(nb)[:, None, None] * BLOCK_Q - BLOCK_Q + j[None]
    valid = (jnp.abs(rel) <= WINDOW)[None] & (kpos >= 0) & (kpos < S)
    slopes = (2.0 ** (-8.0 * jnp.arange(1, N_HEADS + 1, dtype=jnp.float32) / N_HEADS)).reshape(N_KV_HEADS, G)
    alibi = -slopes[:, :, None, None] * jnp.abs(rel).astype(jnp.float32)
    s = jnp.where(valid[None, :, None, None], s + alibi[None, None], -jnp.inf)
    snk = sink.astype(jnp.float32).reshape(N_KV_HEADS, G)[None, None, :, :, None, None]
    m = jnp.maximum(jnp.max(s, axis=-1, keepdims=True), snk)
    p = jnp.exp(s - m)
    p = p / (jnp.sum(p, axis=-1, keepdims=True) + jnp.exp(snk - m))
    o = jnp.einsum('bnkgqj,bnjkd->bnqkgd', p.astype(vw.dtype), vw)
    return o.reshape(B, S, ATTN_WIDTH)


def hyena_filters(L, w1, b1, fr1, w2, b2, fr2, w3, decay):
    f32 = jnp.float32
    t = jnp.linspace(0.0, 1.0, L, dtype=f32)[:, None]
    w = 2.0 * math.pi * jnp.arange(L, dtype=f32)[:, None] / L
    bands = jnp.linspace(1e-4, FILTER_BANDS - 1, FILTER_BANDS, dtype=f32)[None, :]
    z = jnp.concatenate([t, jnp.cos(bands * w), -jnp.sin(bands * w)], axis=-1)
    hdn = jnp.sin(fr1.astype(f32) * (z @ w1.astype(f32) + b1.astype(f32)))
    hdn = jnp.sin(fr2.astype(f32) * (hdn @ w2.astype(f32) + b2.astype(f32)))
    k = hdn @ w3.astype(f32)
    k = k * (jnp.exp(-t * jnp.abs(decay.astype(f32))) + WINDOW_SHIFT)
    k = k.reshape(L, HYENA_ORDER, 2, HYENA_WIDTH)
    k = k / jnp.sum(jnp.abs(k), axis=(0, 2), keepdims=True)
    fwd, bwd = k[:, :, 0], k[:, :, 1]
    return jnp.concatenate([fwd, jnp.zeros_like(fwd[:1]), bwd[:0:-1]], axis=0)


def fft_long_conv(z, kc, skip):
    L = z.shape[1]
    zf = z.astype(jnp.float32)
    y = jnp.fft.irfft(jnp.fft.rfft(zf, n=2 * L, axis=1) * jnp.fft.rfft(kc, axis=0)[None], n=2 * L, axis=1)[:, :L]
    return (y + zf * skip.astype(jnp.float32)).astype(z.dtype)


def hyena_branch(u, conv_w, conv_b, fw1, fb1, ff1, fw2, fb2, ff2, fw3, decay, skip):
    L = u.shape[1]
    u = lax.conv_general_dilated(u, conv_w[:, None, :].astype(u.dtype), (1,),
                                 [(SHORT_CONV // 2, SHORT_CONV // 2)],
                                 dimension_numbers=('NWC', 'WIO', 'NWC'),
                                 feature_group_count=u.shape[-1]) + conv_b
    v, x1, x2 = jnp.split(u, HYENA_ORDER + 1, axis=-1)
    kc = hyena_filters(L, fw1, fb1, ff1, fw2, fb2, ff2, fw3, decay)
    z = v
    for o, gate in enumerate((x1, x2)):
        z = gate * fft_long_conv(z, kc[:, o], skip[o])
    return z


def token_mixer(h, w_in, conv_w, conv_b, fw1, fb1, ff1, fw2, fb2, ff2, fw3, decay, skip,
                w_hy_o, w_attn_o, attn_sink, w_out):
    proj = h @ w_in
    cuts = np.cumsum([ATTN_WIDTH, KV_WIDTH, KV_WIDTH, (HYENA_ORDER + 1) * HYENA_WIDTH, D_MODEL]).tolist()
    q, k, v, hy_u, g_attn, g_hy = jnp.split(proj, cuts, axis=-1)
    attn = windowed_attention(q, k, v, attn_sink) @ w_attn_o
    hy = hyena_branch(hy_u, conv_w, conv_b, fw1, fb1, ff1, fw2, fb2, ff2, fw3, decay, skip) @ w_hy_o
    merged = jax.nn.sigmoid(g_attn) * attn + jax.nn.sigmoid(g_hy) * hy
    return merged @ w_out


def hierarchical_moe(h, wg, bg, we, be, w1, w3, w2):
    B, S, D = h.shape
    T = B * S
    hf = h.reshape(T, D)
    tid = jnp.arange(T)
    gl = (hf @ wg + bg).astype(jnp.float32)
    g = jnp.argmax(gl, axis=-1)
    pg = jax.nn.softmax(gl, axis=-1)[tid, g][:, None]
    el = (hf @ we + be).astype(jnp.float32).reshape(T, N_GROUPS, EXPERTS_PER_GROUP)[tid, g]
    topv, topi = lax.top_k(el, TOP_K)
    wts = (jax.nn.softmax(topv, axis=-1) * pg).reshape(-1)
    eid = (g[:, None] * EXPERTS_PER_GROUP + topi).reshape(-1)
    tok = jnp.repeat(tid, TOP_K)
    M = T * TOP_K
    order = jnp.argsort(eid)
    se, st, sw = eid[order], tok[order], wts[order]
    sizes = jnp.bincount(eid, length=N_EXPERTS)
    offs = jnp.cumsum(sizes) - sizes
    psizes = (sizes + MOE_BLOCK - 1) // MOE_BLOCK * MOE_BLOCK
    pends = jnp.cumsum(psizes)
    poffs = pends - psizes
    dest = poffs[se] + (jnp.arange(M) - offs[se])
    P = M + N_EXPERTS * MOE_BLOCK
    nblk = P // MOE_BLOCK
    buf_tok = jnp.full((P,), T, jnp.int32).at[dest].set(st.astype(jnp.int32))
    buf_w = jnp.zeros((P,), jnp.float32).at[dest].set(sw)
    blk_e = jnp.clip(jnp.searchsorted(pends, jnp.arange(nblk) * MOE_BLOCK, side='right'), 0, N_EXPERTS - 1)
    hpad = jnp.concatenate([hf, jnp.zeros((1, D), hf.dtype)], axis=0)
    xb = hpad[buf_tok].reshape(nblk, MOE_BLOCK, D)

    def expert_block(args):
        xi, e = args
        return (jax.nn.silu(xi @ w1[e]) * (xi @ w3[e])) @ w2[e]

    yb = lax.map(expert_block, (xb, blk_e)).reshape(P, D)
    y = jax.ops.segment_sum(yb * buf_w[:, None].astype(yb.dtype), buf_tok, num_segments=T + 1)[:T]
    return y.reshape(B, S, D)


def encoder_layer(x, c, w_ada, b_ada, w_in, conv_w, conv_b, fw1, fb1, ff1, fw2, fb2, ff2, fw3,
                  decay, skip, w_hy_o, w_attn_o, attn_sink, w_out, ln1_g, ln1_b,
                  rg_w, rg_b, re_w, re_b, ew1, ew3, ew2, ln2_g, ln2_b):
    mod = (jax.nn.silu(c) @ w_ada + b_ada)[:, None, :]
    shift1, scale1, gate1, shift2, scale2, gate2 = jnp.split(mod, 6, axis=-1)
    h = x * (1.0 + scale1) + shift1
    y = token_mixer(h, w_in, conv_w, conv_b, fw1, fb1, ff1, fw2, fb2, ff2, fw3, decay, skip,
                    w_hy_o, w_attn_o, attn_sink, w_out)
    x = layer_norm(DN_ALPHA * x + gate1 * y, ln1_g, ln1_b)
    h = x * (1.0 + scale2) + shift2
    y = hierarchical_moe(h, rg_w, rg_b, re_w, re_b, ew1, ew3, ew2)
    return layer_norm(DN_ALPHA * x + gate2 * y, ln2_g, ln2_b)


def setup_inputs(seed: int = 0) -> dict:
    key = jax.random.key(seed)
    ks = jax.random.split(key, 32)
    f32 = jnp.float32
    nrm = lambda k, shape, scale: jax.random.normal(k, shape, f32) * scale
    Dp, C, D = DEPTH, HYENA_WIDTH, D_MODEL
    col_scale = jnp.concatenate([jnp.ones((ATTN_WIDTH + KV_WIDTH,), f32),
                                 jnp.full((KV_WIDTH + C,), DN_BETA, f32),
                                 jnp.ones((2 * C + 2 * D,), f32)])
    d_min = -math.log(DECAY_TARGET) / SLOW_DECAY_PCT
    d_max = -math.log(DECAY_TARGET) / FAST_DECAY_PCT
    base_decay = jnp.tile(jnp.linspace(d_min, d_max, C, dtype=f32), HYENA_ORDER * 2)
    return {
        "x": nrm(ks[0], (BATCH, SEQ, D), 1.0),
        "c": nrm(ks[1], (BATCH, D), 1.0),
        "w_ada": nrm(ks[2], (Dp, D, 6 * D), D ** -0.5),
        "b_ada": nrm(ks[3], (Dp, 6 * D), 0.02),
        "w_in": nrm(ks[4], (Dp, D, IN_WIDTH), D ** -0.5) * col_scale,
        "conv_w": nrm(ks[5], (Dp, SHORT_CONV, (HYENA_ORDER + 1) * C), SHORT_CONV ** -0.5),
        "conv_b": nrm(ks[6], (Dp, (HYENA_ORDER + 1) * C), 0.02),
        "filt_w1": nrm(ks[7], (Dp, FILTER_EMB, FILTER_HIDDEN), FILTER_EMB ** -0.5),
        "filt_b1": nrm(ks[8], (Dp, FILTER_HIDDEN), 0.1),
        "filt_freq1": 1.0 + nrm(ks[9], (Dp, FILTER_HIDDEN), 0.1),
        "filt_w2": nrm(ks[10], (Dp, FILTER_HIDDEN, FILTER_HIDDEN), FILTER_HIDDEN ** -0.5),
        "filt_b2": nrm(ks[11], (Dp, FILTER_HIDDEN), 0.1),
        "filt_freq2": 1.0 + nrm(ks[12], (Dp, FILTER_HIDDEN), 0.1),
        "filt_w3": nrm(ks[13], (Dp, FILTER_HIDDEN, N_FILTERS), FILTER_HIDDEN ** -0.5),
        "filt_decay": base_decay[None] + nrm(ks[14], (Dp, N_FILTERS), 0.01),
        "hy_skip": nrm(ks[15], (Dp, HYENA_ORDER, C), 0.5),
        "w_hy_o": nrm(ks[16], (Dp, C, D), C ** -0.5 * DN_BETA),
        "w_attn_o": nrm(ks[17], (Dp, ATTN_WIDTH, D), ATTN_WIDTH ** -0.5 * DN_BETA),
        "attn_sink": nrm(ks[18], (Dp, N_HEADS), 0.5),
        "w_out": nrm(ks[19], (Dp, D, D), D ** -0.5 * DN_BETA),
        "ln1_g": 1.0 + nrm(ks[20], (Dp, D), 0.02),
        "ln1_b": nrm(ks[21], (Dp, D), 0.02),
        "router_group_w": nrm(ks[22], (Dp, D, N_GROUPS), D ** -0.5),
        "router_group_b": nrm(ks[23], (Dp, N_GROUPS), 0.01),
        "router_expert_w": nrm(ks[24], (Dp, D, N_EXPERTS), D ** -0.5),
        "router_expert_b": nrm(ks[25], (Dp, N_EXPERTS), 0.01),
        "exp_w1": nrm(ks[26], (Dp, N_EXPERTS, D, D_EXPERT), D ** -0.5),
        "exp_w3": nrm(ks[27], (Dp, N_EXPERTS, D, D_EXPERT), D ** -0.5),
        "exp_w2": nrm(ks[28], (Dp, N_EXPERTS, D_EXPERT, D), D_EXPERT ** -0.5 * DN_BETA),
        "ln2_g": 1.0 + nrm(ks[29], (Dp, D), 0.02),
        "ln2_b": nrm(ks[30], (Dp, D), 0.02),
    }


def reference(x, c, w_ada, b_ada, w_in, conv_w, conv_b, filt_w1, filt_b1, filt_freq1, filt_w2,
              filt_b2, filt_freq2, filt_w3, filt_decay, hy_skip, w_hy_o, w_attn_o, attn_sink,
              w_out, ln1_g, ln1_b, router_group_w, router_group_b, router_expert_w,
              router_expert_b, exp_w1, exp_w3, exp_w2, ln2_g, ln2_b):
    for l in range(DEPTH):
        x = encoder_layer(x, c, w_ada[l], b_ada[l], w_in[l], conv_w[l], conv_b[l], filt_w1[l],
                          filt_b1[l], filt_freq1[l], filt_w2[l], filt_b2[l], filt_freq2[l],
                          filt_w3[l], filt_decay[l], hy_skip[l], w_hy_o[l], w_attn_o[l],
                          attn_sink[l], w_out[l], ln1_g[l], ln1_b[l], router_group_w[l],
                          router_group_b[l], router_expert_w[l], router_expert_b[l],
                          exp_w1[l], exp_w3[l], exp_w2[l], ln2_g[l], ln2_b[l])
    return x
```

```cpp
#include <hip/hip_runtime.h>
#include <cstdio>
#include <cstdint>

#ifndef MK_N_LAUNCHES
#define MK_N_LAUNCHES 12
#endif

#define GAS __attribute__((address_space(1)))
#define LAS __attribute__((address_space(3)))
typedef unsigned short bf16_t;
typedef short bf16x8 __attribute__((ext_vector_type(8)));
typedef float f32x4 __attribute__((ext_vector_type(4)));
typedef float f32x2 __attribute__((ext_vector_type(2)));
typedef unsigned u32x4 __attribute__((ext_vector_type(4)));
typedef unsigned u32x2 __attribute__((ext_vector_type(2)));

constexpr int NB = 4, SEQ = 8192, DM = 1024, T = NB * SEQ;
constexpr int AW = 512, KVW = 128, HW = 512, INW = 4352, N1A = 2816, NHY = 1536;
constexpr int NE = 64, DE = 512, ECAP = 32768;
constexpr int NFILT = 2048, FH = 64, FEMB = 33;
constexpr float LN_EPS = 1e-5f;
constexpr float DN_ALPHA = 1.189207115002721f;
constexpr int NTHREADS = 512, NWAVES = 8;

constexpr size_t MiB = 1u << 20;
constexpr size_t WS_CTL = 0, CTL_ZERO_BYTES = 1 * MiB;
constexpr size_t WS_MODP = 1 * MiB, WS_MOD = 3 * MiB, WS_HDN = 4 * MiB, WS_WRT = 6 * MiB, WS_WIN = 7 * MiB;
constexpr size_t WS_WA = 16 * MiB, WS_WH = 17 * MiB, WS_WO = 18 * MiB, WS_BTOK = 20 * MiB, WS_BW = 28 * MiB;
constexpr size_t WS_HB = 36 * MiB;
constexpr size_t WS_Q = 100 * MiB, WS_K = 132 * MiB, WS_V = 140 * MiB, WS_GA = 148 * MiB, WS_GH = 212 * MiB;
constexpr size_t WS_UT = 276 * MiB, WS_TMP = 276 * MiB;
constexpr size_t WS_ATT = 372 * MiB, WS_HYT = 404 * MiB, WS_HY = 436 * MiB;
constexpr size_t WS_W13 = 100 * MiB, WS_W2 = 228 * MiB, WS_HACT = 292 * MiB, WS_Y2 = 372 * MiB, WS_END = 500 * MiB;
constexpr int CW_BAR = 4096, CW_CNT = 8192;

constexpr int RING_BYTES = 131072, LDSCTL_OFF = RING_BYTES, MISC_OFF = LDSCTL_OFF + 320, TAB_OFF = LDSCTL_OFF + 1024;
constexpr int LDS_BYTES = 163840;

#define LDS_WAIT() asm volatile("s_waitcnt lgkmcnt(0)" ::: "memory")
#define VM_WAIT() asm volatile("s_waitcnt vmcnt(0)" ::: "memory")
__device__ __forceinline__ unsigned f2bf(float f) { unsigned u = __builtin_bit_cast(unsigned, f); return (u + 0x7fffu + ((u >> 16) & 1u)) >> 16; }
__device__ __forceinline__ unsigned pk2(float lo, float hi) { return f2bf(lo) | (f2bf(hi) << 16); }
__device__ __forceinline__ float bf2f(unsigned short b) { return __builtin_bit_cast(float, (unsigned)b << 16); }
__device__ __forceinline__ float bflo(unsigned w) { return __builtin_bit_cast(float, w << 16); }
__device__ __forceinline__ float bfhi(unsigned w) { return __builtin_bit_cast(float, w & 0xffff0000u); }
__device__ __forceinline__ float sigmoidf_(float x) { return 1.0f / (1.0f + __expf(-x)); }
__device__ __forceinline__ float wave_sum(float v) {
#pragma unroll
    for (int o = 1; o < 64; o <<= 1) v += __shfl_xor(v, o);
    return v;
}

namespace pg8 {
constexpr int BM = 256, BK = 64, HALF = 128, HTB = HALF * BK * 2, STAGE_BYTES = 8 * HTB, NXCD = 8, WGM = 8;
__host__ __device__ __forceinline__ int lds_byte(int r, int c) { const int st = (r >> 4) * 2 + (c >> 5), rr = r & 15, cc = c & 31, ob = rr * 64 + cc * 2; return st * 1024 + (ob ^ (((ob >> 9) & 1) << 5)); }
__host__ __device__ __forceinline__ void stage_rc(int b, int& R, int& C) { const int st = b / 1024, sb = b % 1024, swz = sb ^ (((sb >> 9) & 1) << 5); R = (st >> 1) * 16 + swz / 64; C = (st & 1) * 32 + (swz % 64) / 2; }
__host__ __device__ __forceinline__ int perm32(int rho) { const int n = rho >> 4, i = rho & 15; return 8 * (i >> 2) + 4 * n + (i & 3); }

struct Unit { int pm, pn, e, mt; };

struct DenseSched {
    int nM, nN, nwg, G, c, K; const char* Bt;
    __device__ void init(int M, int N, int K_, int G_, int c_, const void* Bt_) { nM = M / BM; nN = N / BM; nwg = nM * nN; G = G_; c = c_; K = K_; Bt = (const char*)Bt_; }
    __device__ bool next(int i, Unit& u) const {
        const long L = (long)i * G + c; if (L >= nwg) return false;
        int wgid = (int)L; { const int q = nwg / NXCD, r = nwg % NXCD, xcd = wgid % NXCD, off = wgid / NXCD; wgid = (xcd < r ? xcd * (q + 1) : r * (q + 1) + (xcd - r) * q) + off; }
        const int nig = WGM * nN, gid = wgid / nig, fm = gid * WGM, gsz = (nM - fm) < WGM ? (nM - fm) : WGM;
        u.pm = fm + ((wgid % nig) % gsz); u.pn = (wgid % nig) / gsz; u.e = 0; u.mt = 0; return true;
    }
    __device__ __forceinline__ unsigned arow(const Unit& u, int r) const { return (unsigned)(u.pm * BM + r); }
    __device__ __forceinline__ const char* bptr(const Unit& u) const { return Bt + (size_t)u.pn * BM * K * 2; }
};

struct MoeSched {
    const LAS int* tab;
    const int* btok;
    const char* Bt; size_t estride; int G, v, K; bool gather;
    __device__ bool next(int i, Unit& u) const {
        const int L = i * G + v; const int tile = L >> 2; if (tile >= tab[64]) return false;
        int e = 0;
        for (int j = 1; j < 64; ++j) e += (tab[j] <= tile) ? 1 : 0;
        u.e = e; u.mt = tile - tab[e]; u.pm = tile; u.pn = L & 3; return true;
    }
    __device__ __forceinline__ unsigned arow(const Unit& u, int r) const {
        if (!gather) return (unsigned)(u.pm * BM + r);
        const int idx = u.mt * BM + r; const int cnt = tab[72 + u.e];
        unsigned tok = 0; if (idx < cnt) tok = (unsigned)btok[(size_t)u.e * ECAP + idx] >> 1;
        return tok;
    }
    __device__ __forceinline__ const char* bptr(const Unit& u) const { return Bt + (size_t)u.e * estride + (size_t)u.pn * BM * K * 2; }
};

template <class Epi, class Sched, bool ALIGN_EPI>
__device__ __forceinline__ void gemm_phase(LAS unsigned char* lds, const void* Abase, const int K, const Sched& S, const Epi& E) {
    const int tid = threadIdx.x, wid = __builtin_amdgcn_readfirstlane(tid >> 6), lane = tid & 63, wr = wid >> 2, wc = wid & 3, fr = lane & 15, fq = lane >> 4;
    const int nt = K / BK;
    int Rr[2], Cc[2]; unsigned voffB[2];
#pragma unroll
    for (int i = 0; i < 2; ++i) { stage_rc(tid * 16 + i * 8192, Rr[i], Cc[i]); const int Rb = Epi::PERM ? ((Rr[i] & ~31) + perm32(Rr[i] & 31)) : Rr[i]; voffB[i] = (unsigned)(Rb * K + Cc[i]) * 2u; }
    const size_t kstep = (size_t)(BK * 2);
    const size_t hstep = (size_t)HALF * K * 2;
    const unsigned ldsw = (unsigned)wid * 1024u;
    const int aoff = lds_byte(wr * 64 + fr, fq * 8), boff = lds_byte(wc * 32 + fr, fq * 8);
#define PG8_SA(b, h) (((b) * 2 + (h)) * HTB)
#define PG8_SB(b, h) ((4 + (b) * 2 + (h)) * HTB)
#define PG8_STAGE(bufoff, gbase, voff) do { _Pragma("unroll") for (int _i = 0; _i < 2; ++_i) \
        __builtin_amdgcn_global_load_lds((const unsigned*)((const char*)(gbase) + (voff)[_i]), (LAS unsigned*)(lds + (bufoff) + ldsw + _i * 8192), 16, 0, 0); } while (0)
#define PG8_LDA(dst, b, h) do { _Pragma("unroll") for (int m = 0; m < 4; ++m) _Pragma("unroll") for (int k = 0; k < 2; ++k) dst[m][k] = *(const LAS bf16x8*)(lds + PG8_SA(b, h) + aoff + m * 2048 + k * 1024); } while (0)
#define PG8_LDB(dst, b, h) do { _Pragma("unroll") for (int n = 0; n < 2; ++n) _Pragma("unroll") for (int k = 0; k < 2; ++k) dst[n][k] = *(const LAS bf16x8*)(lds + PG8_SB(b, h) + boff + n * 2048 + k * 1024); } while (0)
#define PG8_MMA(ai, bj, At, Bt) do { __builtin_amdgcn_s_setprio(1); _Pragma("unroll") for (int m = 0; m < 4; ++m) _Pragma("unroll") for (int n = 0; n < 2; ++n) _Pragma("unroll") for (int k = 0; k < 2; ++k) \
        acc[ai][bj][m][n] = __builtin_amdgcn_mfma_f32_16x16x32_bf16(Bt[n][k], At[m][k], acc[ai][bj][m][n], 0, 0, 0); __builtin_amdgcn_s_setprio(0); } while (0)
#define PG8_WAIT_V(n) asm volatile("s_waitcnt vmcnt(" #n ")" ::: "memory")
#define PG8_WAIT_L(n) asm volatile("s_waitcnt lgkmcnt(" #n ")" ::: "memory")
#define PG8_BAR __builtin_amdgcn_s_barrier()
#define PG8_SCHED __builtin_amdgcn_sched_barrier(0)
    Unit cur, nxt; int ui = 0;
    if (!S.next(0, cur)) return;
    f32x4 acc[2][2][4][2];
#pragma unroll
    for (int a = 0; a < 2; ++a)
#pragma unroll
        for (int b = 0; b < 2; ++b)
#pragma unroll
            for (int m = 0; m < 4; ++m)
#pragma unroll
                for (int n = 0; n < 2; ++n) acc[a][b][m][n] = (f32x4){0.f, 0.f, 0.f, 0.f};
    bf16x8 At[4][2], B0[2][2], B1[2][2];
    unsigned cv0[2], cv1[2], nv0[2], nv1[2];
#pragma unroll
    for (int i = 0; i < 2; ++i) { cv0[i] = (S.arow(cur, Rr[i]) * (unsigned)K + (unsigned)Cc[i]) * 2u; cv1[i] = (S.arow(cur, HALF + Rr[i]) * (unsigned)K + (unsigned)Cc[i]) * 2u; }
    const char* const cA = (const char*)Abase;
    const char* cB = S.bptr(cur);
    PG8_STAGE(PG8_SB(0, 0), cB, voffB); PG8_STAGE(PG8_SB(0, 1), cB + hstep, voffB); PG8_STAGE(PG8_SA(0, 0), cA, cv0); PG8_STAGE(PG8_SA(0, 1), cA, cv1);
    if (wr == 1) PG8_BAR;
    PG8_WAIT_V(2); PG8_BAR;
    PG8_STAGE(PG8_SB(1, 0), cB + kstep, voffB); PG8_STAGE(PG8_SA(1, 0), cA + kstep, cv0); PG8_STAGE(PG8_SB(1, 1), cB + hstep + kstep, voffB);
    PG8_WAIT_V(6); PG8_BAR;
    for (;;) {
        const bool has_next = S.next(ui + 1, nxt);
        const char* nB = has_next ? S.bptr(nxt) : cB;
#pragma unroll
        for (int i = 0; i < 2; ++i) {
            nv0[i] = has_next ? (S.arow(nxt, Rr[i]) * (unsigned)K + (unsigned)Cc[i]) * 2u : cv0[i];
            nv1[i] = has_next ? (S.arow(nxt, HALF + Rr[i]) * (unsigned)K + (unsigned)Cc[i]) * 2u : cv1[i];
        }
        for (int t = 0; t < nt; t += 2) {
            const bool last = (t == nt - 2);
            const char* a1 = cA + (size_t)(t + 1) * kstep;
            const char* a2 = last ? cA : cA + (size_t)(t + 2) * kstep; const char* b2 = last ? nB : cB + (size_t)(t + 2) * kstep;
            const char* a3 = a2 + kstep; const char* b3 = b2 + kstep;
            unsigned x0[2], x1[2];
#pragma unroll
            for (int i = 0; i < 2; ++i) { x0[i] = last ? nv0[i] : cv0[i]; x1[i] = last ? nv1[i] : cv1[i]; }
            PG8_LDB(B0, 0, 0); PG8_LDB(B1, 0, 1); PG8_SCHED; PG8_LDA(At, 0, 0); PG8_STAGE(PG8_SA(1, 1), a1, cv1);
            PG8_WAIT_V(8); PG8_WAIT_L(0); PG8_BAR; PG8_MMA(0, 0, At, B0); PG8_MMA(0, 1, At, B1); PG8_BAR; PG8_SCHED;
            PG8_LDA(At, 0, 1); PG8_STAGE(PG8_SB(0, 0), b2, voffB); PG8_STAGE(PG8_SB(0, 1), b2 + hstep, voffB); PG8_STAGE(PG8_SA(0, 0), a2, x0);
            PG8_WAIT_V(8); PG8_WAIT_L(0); PG8_BAR; PG8_MMA(1, 0, At, B0); PG8_MMA(1, 1, At, B1); PG8_BAR; PG8_SCHED;
            PG8_LDB(B0, 1, 0); PG8_LDB(B1, 1, 1); PG8_SCHED; PG8_LDA(At, 1, 0); PG8_STAGE(PG8_SA(0, 1), a2, x1);
            PG8_WAIT_V(8); PG8_WAIT_L(0); PG8_BAR; PG8_MMA(0, 0, At, B0); PG8_MMA(0, 1, At, B1); PG8_BAR; PG8_SCHED;
            PG8_LDA(At, 1, 1); PG8_STAGE(PG8_SB(1, 0), b3, voffB); PG8_STAGE(PG8_SB(1, 1), b3 + hstep, voffB); PG8_STAGE(PG8_SA(1, 0), a3, x0);
            PG8_WAIT_V(8); PG8_WAIT_L(0); PG8_BAR; PG8_MMA(1, 0, At, B0); PG8_MMA(1, 1, At, B1); PG8_BAR; PG8_SCHED;
        }
        if constexpr (ALIGN_EPI) { if (wr == 0) PG8_BAR; }
        E(acc, cur, wr, wc, fr, fq);
        if (!has_next) break;
#pragma unroll
        for (int a = 0; a < 2; ++a)
#pragma unroll
            for (int b = 0; b < 2; ++b)
#pragma unroll
                for (int m = 0; m < 4; ++m)
#pragma unroll
                    for (int n = 0; n < 2; ++n) acc[a][b][m][n] = (f32x4){0.f, 0.f, 0.f, 0.f};
        cur = nxt; cB = nB; ++ui;
#pragma unroll
        for (int i = 0; i < 2; ++i) { cv0[i] = nv0[i]; cv1[i] = nv1[i]; }
        if constexpr (ALIGN_EPI) { if (wr == 1) PG8_BAR; }
    }
    PG8_WAIT_V(0);
    if constexpr (!ALIGN_EPI) { if (wr == 0) PG8_BAR; }
    PG8_BAR;
#undef PG8_SA
#undef PG8_SB
#undef PG8_STAGE
#undef PG8_LDA
#undef PG8_LDB
#undef PG8_MMA
#undef PG8_WAIT_V
#undef PG8_WAIT_L
#undef PG8_BAR
#undef PG8_SCHED
}

__device__ __forceinline__ u32x4 pack8(const f32x4 v0, const f32x4 v1) { u32x4 w; w.x = pk2(v0[0], v0[1]); w.y = pk2(v0[2], v0[3]); w.z = pk2(v1[0], v1[1]); w.w = pk2(v1[2], v1[3]); return w; }

struct EpiInA {
    static constexpr bool PERM = true;
    bf16_t *Q, *Kb, *Vb, *GA, *GH;
    __device__ __forceinline__ void operator()(const f32x4 (&acc)[2][2][4][2], const Unit& u, int wr, int wc, int fr, int fq) const {
        const int row0 = u.pm * BM + wr * 64 + fr; const int cin = wc * 32 + 8 * fq;
#pragma unroll
        for (int bj = 0; bj < 2; ++bj) {
            bf16_t* base; int ld, col; bool sig = false;
            if (u.pn < 2) { base = Q; ld = AW; col = u.pn * 256 + bj * 128 + cin; }
            else if (u.pn == 2) { base = bj == 0 ? Kb : Vb; ld = KVW; col = cin; }
            else if (u.pn < 7) { base = GA; ld = DM; col = (u.pn - 3) * 256 + bj * 128 + cin; sig = true; }
            else { base = GH; ld = DM; col = (u.pn - 7) * 256 + bj * 128 + cin; sig = true; }
#pragma unroll
            for (int ai = 0; ai < 2; ++ai)
#pragma unroll
                for (int m = 0; m < 4; ++m) {
                    f32x4 v0 = acc[ai][bj][m][0], v1 = acc[ai][bj][m][1];
                    if (sig) {
#pragma unroll
                        for (int j = 0; j < 4; ++j) { v0[j] = sigmoidf_(v0[j]); v1[j] = sigmoidf_(v1[j]); }
                    }
                    *(u32x4*)(base + (size_t)(row0 + ai * HALF + m * 16) * ld + col) = pack8(v0, v1);
                }
        }
    }
};
struct EpiBf16 {
    static constexpr bool PERM = true;
    bf16_t* O; int ldc;
    __device__ __forceinline__ void operator()(const f32x4 (&acc)[2][2][4][2], const Unit& u, int wr, int wc, int fr, int fq) const {
        const int row0 = u.pm * BM + wr * 64 + fr; const int col0 = u.pn * BM + wc * 32 + 8 * fq;
#pragma unroll
        for (int ai = 0; ai < 2; ++ai)
#pragma unroll
            for (int m = 0; m < 4; ++m)
#pragma unroll
                for (int bj = 0; bj < 2; ++bj)
                    *(u32x4*)(O + (size_t)(row0 + ai * HALF + m * 16) * ldc + col0 + bj * HALF) = pack8(acc[ai][bj][m][0], acc[ai][bj][m][1]);
    }
};
template <bool ADD> struct EpiGate {
    static constexpr bool PERM = true;
    const bf16_t* G; const bf16_t* P; bf16_t* O;
    __device__ __forceinline__ void operator()(const f32x4 (&acc)[2][2][4][2], const Unit& u, int wr, int wc, int fr, int fq) const {
        const int row0 = u.pm * BM + wr * 64 + fr; const int col0 = u.pn * BM + wc * 32 + 8 * fq;
#pragma unroll
        for (int ai = 0; ai < 2; ++ai)
#pragma unroll
            for (int m = 0; m < 4; ++m)
#pragma unroll
                for (int bj = 0; bj < 2; ++bj) {
                    const size_t off = (size_t)(row0 + ai * HALF + m * 16) * DM + col0 + bj * HALF;
                    const u32x4 g = *(const u32x4*)(G + off);
                    f32x4 v0 = acc[ai][bj][m][0], v1 = acc[ai][bj][m][1];
                    v0[0] *= bflo(g.x); v0[1] *= bfhi(g.x); v0[2] *= bflo(g.y); v0[3] *= bfhi(g.y);
                    v1[0] *= bflo(g.z); v1[1] *= bfhi(g.z); v1[2] *= bflo(g.w); v1[3] *= bfhi(g.w);
                    if (ADD) { const u32x4 p = *(const u32x4*)(P + off);
                        v0[0] += bflo(p.x); v0[1] += bfhi(p.x); v0[2] += bflo(p.y); v0[3] += bfhi(p.y);
                        v1[0] += bflo(p.z); v1[1] += bfhi(p.z); v1[2] += bflo(p.w); v1[3] += bfhi(p.w); }
                    *(u32x4*)(O + off) = pack8(v0, v1);
                }
    }
};
struct EpiRes {
    static constexpr bool PERM = false;
    const float* X; const float* gate; float* O;
    __device__ __forceinline__ void operator()(const f32x4 (&acc)[2][2][4][2], const Unit& u, int wr, int wc, int fr, int fq) const {
        const int row0 = u.pm * BM + wr * 64 + fr; const int col0 = u.pn * BM + wc * 32 + 4 * fq;
        const int b = (u.pm * BM) / SEQ;
#pragma unroll
        for (int bj = 0; bj < 2; ++bj)
#pragma unroll
            for (int n = 0; n < 2; ++n) {
                const int col = col0 + bj * HALF + n * 16;
                const f32x4 gv = *(const f32x4*)(gate + (size_t)b * 6144 + col);
#pragma unroll
                for (int ai = 0; ai < 2; ++ai)
#pragma unroll
                    for (int m = 0; m < 4; ++m) {
                        const size_t off = (size_t)(row0 + ai * HALF + m * 16) * DM + col;
                        const f32x4 xv = *(const f32x4*)(X + off);
                        *(f32x4*)(O + off) = xv * DN_ALPHA + gv * acc[ai][bj][m][n];
                    }
            }
    }
};
struct EpiSwiGLU {
    static constexpr bool PERM = true;
    bf16_t* H;
    __device__ __forceinline__ void operator()(const f32x4 (&acc)[2][2][4][2], const Unit& u, int wr, int wc, int fr, int fq) const {
        const int row0 = u.pm * BM + wr * 64 + fr; const int col0 = u.pn * HALF + wc * 32 + 8 * fq;
#pragma unroll
        for (int ai = 0; ai < 2; ++ai)
#pragma unroll
            for (int m = 0; m < 4; ++m) {
                f32x4 v0, v1;
#pragma unroll
                for (int j = 0; j < 4; ++j) { const float a0 = acc[ai][0][m][0][j], a1 = acc[ai][0][m][1][j];
                    v0[j] = a0 * sigmoidf_(a0) * acc[ai][1][m][0][j]; v1[j] = a1 * sigmoidf_(a1) * acc[ai][1][m][1][j]; }
                *(u32x4*)(H + (size_t)(row0 + ai * HALF + m * 16) * DE + col0) = pack8(v0, v1);
            }
    }
};
struct EpiScatter {
    static constexpr bool PERM = true;
    bf16_t* Y2; const int* btok; const float* bw; const LAS int* tab;
    __device__ __forceinline__ void operator()(const f32x4 (&acc)[2][2][4][2], const Unit& u, int wr, int wc, int fr, int fq) const {
        const int col0 = u.pn * BM + wc * 32 + 8 * fq; const int cnt = tab[72 + u.e];
#pragma unroll
        for (int ai = 0; ai < 2; ++ai)
#pragma unroll
            for (int m = 0; m < 4; ++m) {
                const int idx = u.mt * BM + ai * HALF + wr * 64 + m * 16 + fr;
                if (idx < cnt) {
                    const int dst = btok[(size_t)u.e * ECAP + idx]; const float w = bw[(size_t)u.e * ECAP + idx];
#pragma unroll
                    for (int bj = 0; bj < 2; ++bj)
                        *(u32x4*)(Y2 + (size_t)dst * DM + col0 + bj * HALF) = pack8(acc[ai][bj][m][0] * w, acc[ai][bj][m][1] * w);
                }
            }
    }
};
}

#define XB_TMO      128
#define XB_XCNT(j)  (256  + 64 * (j))
#define XB_XSUB(j)  (1280 + 64 * (j))
#define XB_XGEN(j)  (2304 + 64 * (j))
#define XB_TOP      3328
#define XB_TOPGEN   3392
#define XCD_BAR_WORDS 3456
#define XB_SPIN_CAP (1u << 22)
__device__ __forceinline__ unsigned xb_ld(unsigned* p)              { return __hip_atomic_load(p, __ATOMIC_RELAXED, __HIP_MEMORY_SCOPE_AGENT); }
__device__ __forceinline__ unsigned xb_add(unsigned* p, unsigned v) { return __hip_atomic_fetch_add(p, v, __ATOMIC_RELAXED, __HIP_MEMORY_SCOPE_AGENT); }
__device__ __forceinline__ unsigned xb_xcc_id() { return (unsigned)__builtin_amdgcn_s_getreg((3 << 11) | 20) & 0xFu; }
#define XB_SPIN(cond, bar) do { unsigned _sp = 0; while (cond) { __builtin_amdgcn_s_sleep(1); \
    if ((++_sp & 255u) == 0u) { if (xb_ld(&(bar)[XB_TMO])) break; if (_sp > XB_SPIN_CAP) { atomicAdd(&(bar)[XB_TMO], 1u); break; } } } } while (0)
struct XcdBarrier { unsigned* bar; unsigned x; volatile LAS unsigned* st; };
__device__ __forceinline__ XcdBarrier xcd_barrier_post(unsigned* bar, volatile LAS unsigned* st) {
    XcdBarrier b; b.bar = bar; b.x = xb_xcc_id(); b.st = st;
    if (threadIdx.x == 0) (void)xb_add(&bar[XB_XCNT(b.x)], 1u);
    return b;
}
__device__ __forceinline__ void xcd_barrier_complete(unsigned* bar, unsigned x, unsigned& nloc, unsigned& nx) {
    const unsigned G = gridDim.x * gridDim.y * gridDim.z;
    unsigned sum, cnt, mine, sp = 0u;
    for (;;) {
        sum = 0u; cnt = 0u; mine = 0u;
#pragma unroll
        for (unsigned j = 0; j < 16; ++j) { const unsigned c = xb_ld(&bar[XB_XCNT(j)]); sum += c; cnt += (c > 0u) ? 1u : 0u; mine = (j == x) ? c : mine; }
        if (sum == G) break;
        __builtin_amdgcn_s_sleep(1);
        if ((++sp & 255u) == 0u) { if (xb_ld(&bar[XB_TMO])) break; if (sp > XB_SPIN_CAP) { atomicAdd(&bar[XB_TMO], 1u); break; } }
    }
    nloc = mine > 0u ? mine : 1u; nx = cnt > 0u ? cnt : 1u;
}
__device__ __forceinline__ void xcd_barrier(const XcdBarrier& b) {
    asm volatile("s_waitcnt vmcnt(0)" ::: "memory");
    __syncthreads();
    if (threadIdx.x == 0) {
        unsigned* bar = b.bar;
        __builtin_amdgcn_s_waitcnt(0);
        unsigned nloc = b.st[0], nx = b.st[1];
        if (nloc == 0u) { xcd_barrier_complete(bar, b.x, nloc, nx); b.st[0] = nloc; b.st[1] = nx; }
        const unsigned old = xb_add(&bar[XB_XSUB(b.x)], 1u);
        const unsigned gen = old / nloc;
        if (old + 1u == (gen + 1u) * nloc) {
            __builtin_amdgcn_fence(__ATOMIC_RELEASE, "agent");
            asm volatile("s_waitcnt vmcnt(0)" ::: "memory");
            const unsigned og = xb_add(&bar[XB_TOP], 1u);
            const unsigned tg = og / nx;
            if (og + 1u == (tg + 1u) * nx) xb_add(&bar[XB_TOPGEN], 1u);
            else XB_SPIN(xb_ld(&bar[XB_TOPGEN]) == tg, bar);
            __builtin_amdgcn_fence(__ATOMIC_ACQUIRE, "agent");
            xb_add(&bar[XB_XGEN(b.x)], 1u);
            asm volatile("s_waitcnt vmcnt(0)" ::: "memory");
        } else {
            XB_SPIN(xb_ld(&bar[XB_XGEN(b.x)]) == gen, bar);
            __builtin_amdgcn_fence(__ATOMIC_ACQUIRE, "agent");
            asm volatile("s_waitcnt vmcnt(0)" ::: "memory");
        }
    }
    __syncthreads();
}

struct Args { const float* in[31]; float* out; unsigned char* ws; int ph_lo, ph_hi; };
struct Frame {
    LAS unsigned char* lds; unsigned char* ws; unsigned* ctl;
    int tid, lane, wave, vcu, G;
    const float* const* in; float* out;
};
enum { I_X = 0, I_C, I_WADA, I_BADA, I_WIN, I_CONVW, I_CONVB, I_FW1, I_FB1, I_FF1, I_FW2, I_FB2, I_FF2, I_FW3, I_DECAY, I_SKIP, I_WHY, I_WATT, I_SINK, I_WOUT,
       I_LN1G, I_LN1B, I_RGW, I_RGB, I_REW, I_REB, I_EW1, I_EW3, I_EW2, I_LN2G, I_LN2B };

__device__ __forceinline__ void transpose_item(const float* W, int K, int N, bf16_t* WT, int ldt, int drow0, LAS float* scr, int kb, int nb, int lane) {
    const int k0 = 64 * kb, n0 = 32 * nb;
#pragma unroll 8
    for (int i = 0; i < 32; ++i) { const int kk = 2 * i + (lane >> 5); scr[kk * 33 + (lane & 31)] = W[(size_t)(k0 + kk) * N + n0 + (lane & 31)]; }
    LDS_WAIT(); asm volatile("" ::: "memory");
    const int c = lane & 7;
#pragma unroll
    for (int j = 0; j < 4; ++j) { const int n = (lane >> 3) + 8 * j; const LAS float* s = scr + (8 * c) * 33 + n;
        u32x4 o; o.x = pk2(s[0 * 33], s[1 * 33]); o.y = pk2(s[2 * 33], s[3 * 33]); o.z = pk2(s[4 * 33], s[5 * 33]); o.w = pk2(s[6 * 33], s[7 * 33]);
        *(u32x4*)(WT + (size_t)(drow0 + n) * ldt + k0 + 8 * c) = o; }
    LDS_WAIT(); asm volatile("" ::: "memory");
}

__device__ __forceinline__ void ph_prep(Frame& F) {
    const float* c = F.in[I_C]; const float* wada = F.in[I_WADA];
    float* modp = (float*)(F.ws + WS_MODP);
    for (int it = blockIdx.x; it < 192; it += F.G) {
        const int kc = it / 12, cg = it % 12, j = cg * 512 + F.tid;
        float a0 = 0.f, a1 = 0.f, a2 = 0.f, a3 = 0.f;
        for (int kk = 0; kk < 64; ++kk) { const int k = kc * 64 + kk; const float w = wada[(size_t)k * 6144 + j];
            const float c0 = c[k], c1 = c[1024 + k], c2 = c[2048 + k], c3 = c[3072 + k];
            a0 += c0 * sigmoidf_(c0) * w; a1 += c1 * sigmoidf_(c1) * w; a2 += c2 * sigmoidf_(c2) * w; a3 += c3 * sigmoidf_(c3) * w; }
        modp[(size_t)(kc * 4 + 0) * 6144 + j] = a0; modp[(size_t)(kc * 4 + 1) * 6144 + j] = a1; modp[(size_t)(kc * 4 + 2) * 6144 + j] = a2; modp[(size_t)(kc * 4 + 3) * 6144 + j] = a3;
    }
    LAS float* scr = (LAS float*)(F.lds + F.wave * 16384);
    const int gw = F.vcu * NWAVES + F.wave, NGW = F.G * NWAVES;
    constexpr int I_IN = 16 * 136, I_A = 8 * 32, I_H = 8 * 32, I_O = 16 * 32;
    for (int it = gw; it < I_IN + I_A + I_H + I_O; it += NGW) {
        int r = it;
        if (r < I_IN) { const int kb = r / 136, nb = r % 136, n0 = nb * 32;
            const int drow = n0 < 768 ? n0 : (n0 < 2304 ? N1A + (n0 - 768) : 768 + (n0 - 2304));
            transpose_item(F.in[I_WIN], DM, INW, (bf16_t*)(F.ws + WS_WIN), DM, drow, scr, kb, nb, F.lane); continue; } r -= I_IN;
        if (r < I_A) { transpose_item(F.in[I_WATT], AW, DM, (bf16_t*)(F.ws + WS_WA), AW, (r % 32) * 32, scr, r / 32, r % 32, F.lane); continue; } r -= I_A;
        if (r < I_H) { transpose_item(F.in[I_WHY], HW, DM, (bf16_t*)(F.ws + WS_WH), HW, (r % 32) * 32, scr, r / 32, r % 32, F.lane); continue; } r -= I_H;
        transpose_item(F.in[I_WOUT], DM, DM, (bf16_t*)(F.ws + WS_WO), DM, (r % 32) * 32, scr, r / 32, r % 32, F.lane);
    }
    {
        const float* w1 = F.in[I_FW1]; const float* b1 = F.in[I_FB1]; const float* f1 = F.in[I_FF1];
        const float* w2 = F.in[I_FW2]; const float* b2 = F.in[I_FB2]; const float* f2 = F.in[I_FF2];
        float* hdn = (float*)(F.ws + WS_HDN);
        const int j = F.lane;
        for (int t = gw; t < SEQ; t += NGW) {
            const float tl = (float)t / (float)(SEQ - 1);
            const float w = 6.283185307179586f * (float)t / (float)SEQ;
            float zi = 0.f;
            if (j == 0) zi = tl;
            else if (j <= 16) { const float band = 1e-4f + (float)(j - 1) * ((15.0f - 1e-4f) / 15.0f); zi = cosf(band * w); }
            else if (j <= 32) { const float band = 1e-4f + (float)(j - 17) * ((15.0f - 1e-4f) / 15.0f); zi = -sinf(band * w); }
            float a = b1[j];
#pragma unroll
            for (int i = 0; i < FEMB; ++i) a += __shfl(zi, i) * w1[i * FH + j];
            const float h1 = sinf(f1[j] * a);
            float a2 = b2[j];
#pragma unroll
            for (int i = 0; i < FH; ++i) a2 += __shfl(h1, i) * w2[i * FH + j];
            hdn[(size_t)t * FH + j] = sinf(f2[j] * a2);
        }
    }
    {
        float* wrt = (float*)(F.ws + WS_WRT); const float* wg = F.in[I_RGW]; const float* we = F.in[I_REW];
        for (int i = blockIdx.x * NTHREADS + F.tid; i < 72 * DM; i += F.G * NTHREADS) { const int o = i / DM, k = i % DM; wrt[i] = o < 8 ? wg[k * 8 + o] : we[k * 64 + (o - 8)]; }
    }
}

__device__ __forceinline__ void ph_hb(Frame& F) {
    const float* modp = (const float*)(F.ws + WS_MODP); const float* bada = F.in[I_BADA];
    float* mod = (float*)(F.ws + WS_MOD);
    for (int i = blockIdx.x * NTHREADS + F.tid; i < NB * 6144; i += F.G * NTHREADS) { const int b = i / 6144, j = i % 6144; float s = bada[j];
        for (int kc = 0; kc < 16; ++kc) s += modp[(size_t)(kc * 4 + b) * 6144 + j];
        mod[i] = s; }
    LAS float* sc = (LAS float*)F.lds; LAS float* sh = sc + DM;
    const float* x = F.in[I_X]; bf16_t* hb = (bf16_t*)(F.ws + WS_HB);
    for (int ch = blockIdx.x; ch < T / 128; ch += F.G) {
        const int b = (ch * 128) / SEQ;
        __syncthreads();
        for (int j = F.tid; j < 2 * DM; j += NTHREADS) { float s = bada[j];
            for (int kc = 0; kc < 16; ++kc) s += modp[(size_t)(kc * 4 + b) * 6144 + j];
            if (j < DM) sh[j] = s; else sc[j - DM] = 1.0f + s; }
        __syncthreads();
        for (int r = F.wave; r < 128; r += NWAVES) {
            const size_t row = (size_t)ch * 128 + r;
            const f32x4* xr = (const f32x4*)(x + row * DM) + F.lane;
            unsigned long long* o8 = (unsigned long long*)(hb + row * DM) + F.lane;
#pragma unroll
            for (int j = 0; j < 4; ++j) { const f32x4 v = xr[64 * j]; const int k = 4 * F.lane + 256 * j;
                const float h0 = v[0] * sc[k] + sh[k], h1 = v[1] * sc[k + 1] + sh[k + 1], h2 = v[2] * sc[k + 2] + sh[k + 2], h3 = v[3] * sc[k + 3] + sh[k + 3];
                o8[64 * j] = (unsigned long long)pk2(h0, h1) | ((unsigned long long)pk2(h2, h3) << 32); }
        }
    }
    __syncthreads();
}

__device__ __forceinline__ void ph_attn(Frame& F) {
    const bf16_t* Q = (const bf16_t*)(F.ws + WS_Q); const bf16_t* Kb = (const bf16_t*)(F.ws + WS_K); const bf16_t* Vb = (const bf16_t*)(F.ws + WS_V);
    bf16_t* O = (bf16_t*)(F.ws + WS_ATT); const float* sink = F.in[I_SINK];
    LAS unsigned* Ks = (LAS unsigned*)F.lds;
    LAS unsigned* Vs = Ks + 384 * 32;
    for (int unit = blockIdx.x; unit < NB * 2 * 64; unit += F.G) {
        const int qb = unit & 63, kvh = (unit >> 6) & 1, b = unit >> 7;
        __syncthreads();
        for (int i = F.tid; i < 384 * 8; i += NTHREADS) {
            const int j = i >> 3, p = i & 7; const int kpos = qb * 128 - 128 + j;
            u32x4 kv = (u32x4){0u, 0u, 0u, 0u}, vv = kv;
            if (kpos >= 0 && kpos < SEQ) { const size_t off = ((size_t)b * SEQ + kpos) * KVW + kvh * 64 + p * 8; kv = *(const u32x4*)(Kb + off); vv = *(const u32x4*)(Vb + off); }
            *(LAS u32x4*)(Ks + j * 32 + p * 4) = kv; *(LAS u32x4*)(Vs + j * 32 + p * 4) = vv;
        }
        __syncthreads();
        const int g = F.tid >> 7, a = F.tid & 127, h = kvh * 4 + g;
        const size_t trow = (size_t)b * SEQ + qb * 128 + a;
        float q[64];
#pragma unroll
        for (int p = 0; p < 8; ++p) { const u32x4 w = *(const u32x4*)(Q + trow * AW + h * 64 + p * 8);
            q[p * 8 + 0] = bflo(w.x); q[p * 8 + 1] = bfhi(w.x); q[p * 8 + 2] = bflo(w.y); q[p * 8 + 3] = bfhi(w.y);
            q[p * 8 + 4] = bflo(w.z); q[p * 8 + 5] = bfhi(w.z); q[p * 8 + 6] = bflo(w.w); q[p * 8 + 7] = bfhi(w.w); }
        const float slope = exp2f(-(float)(h + 1));
        float m = sink[h], l = 1.0f;
        float o[64];
#pragma unroll
        for (int d = 0; d < 64; ++d) o[d] = 0.f;
        for (int j = 0; j < 384; ++j) {
            const int rel = j - 128 - a; const int kpos = qb * 128 - 128 + j;
            const bool valid = (rel >= -128) && (rel <= 128) && (kpos >= 0) && (kpos < SEQ);
            float s = 0.f;
#pragma unroll
            for (int p = 0; p < 8; ++p) { const u32x4 w = *(const LAS u32x4*)(Ks + j * 32 + p * 4);
                s += q[p * 8 + 0] * bflo(w.x) + q[p * 8 + 1] * bfhi(w.x) + q[p * 8 + 2] * bflo(w.y) + q[p * 8 + 3] * bfhi(w.y)
                   + q[p * 8 + 4] * bflo(w.z) + q[p * 8 + 5] * bfhi(w.z) + q[p * 8 + 6] * bflo(w.w) + q[p * 8 + 7] * bfhi(w.w); }
            s = s * 0.125f - slope * fabsf((float)rel);
            if (valid) {
                const float mn = fmaxf(m, s); const float sc = __expf(m - mn); const float pj = __expf(s - mn);
                l = l * sc + pj; m = mn;
#pragma unroll
                for (int p = 0; p < 8; ++p) { const u32x4 w = *(const LAS u32x4*)(Vs + j * 32 + p * 4);
                    o[p * 8 + 0] = o[p * 8 + 0] * sc + pj * bflo(w.x); o[p * 8 + 1] = o[p * 8 + 1] * sc + pj * bfhi(w.x);
                    o[p * 8 + 2] = o[p * 8 + 2] * sc + pj * bflo(w.y); o[p * 8 + 3] = o[p * 8 + 3] * sc + pj * bfhi(w.y);
                    o[p * 8 + 4] = o[p * 8 + 4] * sc + pj * bflo(w.z); o[p * 8 + 5] = o[p * 8 + 5] * sc + pj * bfhi(w.z);
                    o[p * 8 + 6] = o[p * 8 + 6] * sc + pj * bflo(w.w); o[p * 8 + 7] = o[p * 8 + 7] * sc + pj * bfhi(w.w); }
            }
        }
        const float il = 1.0f / l;
#pragma unroll
        for (int p = 0; p < 8; ++p) { u32x4 w; w.x = pk2(o[p * 8 + 0] * il, o[p * 8 + 1] * il); w.y = pk2(o[p * 8 + 2] * il, o[p * 8 + 3] * il);
            w.z = pk2(o[p * 8 + 4] * il, o[p * 8 + 5] * il); w.w = pk2(o[p * 8 + 6] * il, o[p * 8 + 7] * il);
            *(u32x4*)(O + trow * AW + h * 64 + p * 8) = w; }
    }
    __syncthreads();
}

__device__ __forceinline__ float block_sum(Frame& F, float v, LAS float* red) {
    v = wave_sum(v);
    __syncthreads();
    if (F.lane == 0) red[F.wave] = v;
    __syncthreads();
    float s = 0.f;
#pragma unroll
    for (int i = 0; i < NWAVES; ++i) s += red[i];
    return s;
}
__device__ __forceinline__ float shortconv(const bf16_t* row, int t, float w0, float w1, float w2, float bias) {
    const float c = bf2f(row[t]); const float p = t > 0 ? bf2f(row[t - 1]) : 0.f; const float n = t < SEQ - 1 ? bf2f(row[t + 1]) : 0.f;
    return w0 * p + w1 * c + w2 * n + bias;
}
__device__ __forceinline__ void ph_hyena_direct(Frame& F) {
    const bf16_t* UT = (const bf16_t*)(F.ws + WS_UT); bf16_t* HYT = (bf16_t*)(F.ws + WS_HYT);
    const float* hdn = (const float*)(F.ws + WS_HDN); const float* w3 = F.in[I_FW3]; const float* decay = F.in[I_DECAY];
    const float* convw = F.in[I_CONVW]; const float* convb = F.in[I_CONVB]; const float* skip = F.in[I_SKIP];
    LAS float* kc = (LAS float*)F.lds;
    LAS float* z = kc + 16384;
    LAS float* w3s = z + 8192;
    LAS float* red = w3s + 128;
    for (int c = blockIdx.x; c < HW; c += F.G) {
        for (int o = 0; o < 2; ++o) {
            const int colf = o * 1024 + c, colb = o * 1024 + 512 + c;
            __syncthreads();
            if (F.tid < 128) w3s[F.tid] = w3[(size_t)(F.tid & 63) * NFILT + (F.tid < 64 ? colf : colb)];
            if (F.tid == 0) kc[SEQ] = 0.f;
            __syncthreads();
            const float df = fabsf(decay[colf]), db = fabsf(decay[colb]);
            float asum = 0.f;
            for (int i = 0; i < 16; ++i) {
                const int t = F.tid + 512 * i; const f32x4* hr = (const f32x4*)(hdn + (size_t)t * FH);
                float sf = 0.f, sb = 0.f;
#pragma unroll
                for (int k4 = 0; k4 < 16; ++k4) { const f32x4 hv = hr[k4];
                    sf += hv[0] * w3s[k4 * 4] + hv[1] * w3s[k4 * 4 + 1] + hv[2] * w3s[k4 * 4 + 2] + hv[3] * w3s[k4 * 4 + 3];
                    sb += hv[0] * w3s[64 + k4 * 4] + hv[1] * w3s[64 + k4 * 4 + 1] + hv[2] * w3s[64 + k4 * 4 + 2] + hv[3] * w3s[64 + k4 * 4 + 3]; }
                const float tl = (float)t / (float)(SEQ - 1);
                sf *= (__expf(-tl * df) + 0.05f); sb *= (__expf(-tl * db) + 0.05f);
                asum += fabsf(sf) + fabsf(sb);
                kc[t] = sf; if (t > 0) kc[2 * SEQ - t] = sb;
            }
            const float inv = 1.0f / block_sum(F, asum, red);
            for (int i = F.tid; i < 2 * SEQ; i += NTHREADS) kc[i] *= inv;
            const float sk = skip[o * HW + c];
            const int chz = c, chg = (o + 1) * HW + c;
            const float zw0 = convw[chz], zw1 = convw[NHY + chz], zw2 = convw[2 * NHY + chz], zb = convb[chz];
            const float gw0 = convw[chg], gw1 = convw[NHY + chg], gw2 = convw[2 * NHY + chg], gb = convb[chg];
            for (int b = 0; b < NB; ++b) {
                __syncthreads();
                for (int i = 0; i < 16; ++i) { const int t = F.tid + 512 * i;
                    z[t] = (o == 0) ? shortconv(UT + (size_t)chz * T + (size_t)b * SEQ, t, zw0, zw1, zw2, zb) : bf2f(HYT[(size_t)c * T + (size_t)b * SEQ + t]); }
                __syncthreads();
                float acc[16];
#pragma unroll
                for (int i = 0; i < 16; ++i) acc[i] = 0.f;
                for (int s = 0; s < SEQ; ++s) {
                    const float zs = z[s];
#pragma unroll
                    for (int i = 0; i < 16; ++i) acc[i] += zs * kc[(F.tid + 512 * i - s) & (2 * SEQ - 1)];
                }
#pragma unroll
                for (int i = 0; i < 16; ++i) { const int t = F.tid + 512 * i;
                    const float gate = shortconv(UT + (size_t)chg * T + (size_t)b * SEQ, t, gw0, gw1, gw2, gb);
                    const float y = acc[i] + sk * z[t];
                    HYT[(size_t)c * T + (size_t)b * SEQ + t] = (bf16_t)f2bf(gate * y); }
            }
        }
    }
    __syncthreads();
}

__device__ __forceinline__ void ph_hyT(Frame& F) {
    const bf16_t* HYT = (const bf16_t*)(F.ws + WS_HYT); bf16_t* HY = (bf16_t*)(F.ws + WS_HY);
    for (int it = blockIdx.x; it < 8 * (T / 512); it += F.G) {
        const int cb = it & 7, tb = it >> 3; const int t = tb * 512 + F.tid, c0 = cb * 64;
        unsigned w[32];
#pragma unroll
        for (int i = 0; i < 32; ++i) { const unsigned lo = HYT[(size_t)(c0 + 2 * i) * T + t], hi = HYT[(size_t)(c0 + 2 * i + 1) * T + t]; w[i] = lo | (hi << 16); }
#pragma unroll
        for (int i = 0; i < 8; ++i) *(u32x4*)(HY + (size_t)t * HW + c0 + 8 * i) = (u32x4){w[4 * i], w[4 * i + 1], w[4 * i + 2], w[4 * i + 3]};
    }
}

__device__ __forceinline__ void ph_expert_cvt(Frame& F) {
    LAS float* scr = (LAS float*)(F.lds + F.wave * 16384);
    const int gw = F.vcu * NWAVES + F.wave, NGW = F.G * NWAVES;
    bf16_t* W13 = (bf16_t*)(F.ws + WS_W13); bf16_t* W2 = (bf16_t*)(F.ws + WS_W2);
    for (int it = gw; it < NE * 768; it += NGW) {
        const int e = it / 768; int r = it % 768;
        if (r < 512) { const bool is3 = r >= 256; r &= 255; const int kb = r / 16, nb = r % 16, n0 = nb * 32;
            const int drow = (n0 >> 7) * 256 + (is3 ? 128 : 0) + (n0 & 127);
            transpose_item(F.in[is3 ? I_EW3 : I_EW1] + (size_t)e * DM * DE, DM, DE, W13 + (size_t)e * DM * DM, DM, drow, scr, kb, nb, F.lane); }
        else { r -= 512; const int kb = r / 32, nb = r % 32;
            transpose_item(F.in[I_EW2] + (size_t)e * DE * DM, DE, DM, W2 + (size_t)e * DM * DE, DE, nb * 32, scr, kb, nb, F.lane); }
    }
}

__device__ __forceinline__ void ph_ln1_route(Frame& F) {
    float* v = F.out; bf16_t* h2b = (bf16_t*)(F.ws + WS_HB);
    const float* mod = (const float*)(F.ws + WS_MOD); const float* g1 = F.in[I_LN1G]; const float* b1 = F.in[I_LN1B];
    const float* wrt = (const float*)(F.ws + WS_WRT); const float* bg = F.in[I_RGB]; const float* be = F.in[I_REB];
    unsigned* cnt = F.ctl + CW_CNT; int* btok = (int*)(F.ws + WS_BTOK); float* bw = (float*)(F.ws + WS_BW);
    const int gw = F.vcu * NWAVES + F.wave, NGW = F.G * NWAVES;
    for (int row = gw; row < T; row += NGW) {
        const int b = row / SEQ;
        f32x4* xr = (f32x4*)(v + (size_t)row * DM) + F.lane;
        f32x4 x[4]; float s = 0.f;
#pragma unroll
        for (int j = 0; j < 4; ++j) { x[j] = xr[64 * j]; s += (x[j][0] + x[j][1]) + (x[j][2] + x[j][3]); }
        const float mean = wave_sum(s) * (1.f / DM); float s2 = 0.f;
#pragma unroll
        for (int j = 0; j < 4; ++j) { x[j] = x[j] - mean; s2 += (x[j][0] * x[j][0] + x[j][1] * x[j][1]) + (x[j][2] * x[j][2] + x[j][3] * x[j][3]); }
        const float rstd = 1.f / sqrtf(wave_sum(s2) * (1.f / DM) + LN_EPS);
        f32x4 h[4];
        unsigned long long* o8 = (unsigned long long*)(h2b + (size_t)row * DM) + F.lane;
#pragma unroll
        for (int j = 0; j < 4; ++j) { const int k = 4 * F.lane + 256 * j;
            const f32x4 gg = *(const f32x4*)(g1 + k), bb = *(const f32x4*)(b1 + k);
            const f32x4 sh = *(const f32x4*)(mod + (size_t)b * 6144 + 3072 + k), sc = *(const f32x4*)(mod + (size_t)b * 6144 + 4096 + k);
            x[j] = x[j] * rstd * gg + bb; xr[64 * j] = x[j];
            h[j] = x[j] * (sc + 1.0f) + sh;
            o8[64 * j] = (unsigned long long)pk2(h[j][0], h[j][1]) | ((unsigned long long)pk2(h[j][2], h[j][3]) << 32); }
        float gl[8];
#pragma unroll
        for (int o = 0; o < 8; ++o) { float p = 0.f;
#pragma unroll
            for (int j = 0; j < 4; ++j) { const f32x4 w = *(const f32x4*)(wrt + (size_t)o * DM + 4 * F.lane + 256 * j); p += h[j][0] * w[0] + h[j][1] * w[1] + h[j][2] * w[2] + h[j][3] * w[3]; }
            gl[o] = wave_sum(p) + bg[o]; }
        float gmax = gl[0]; int g = 0;
#pragma unroll
        for (int i = 1; i < 8; ++i) if (gl[i] > gmax) { gmax = gl[i]; g = i; }
        float den = 0.f;
#pragma unroll
        for (int i = 0; i < 8; ++i) den += __expf(gl[i] - gmax);
        const float pg = 1.0f / den;
        float el[8];
#pragma unroll
        for (int o = 0; o < 8; ++o) { float p = 0.f; const float* wr_ = wrt + (size_t)(8 + g * 8 + o) * DM;
#pragma unroll
            for (int j = 0; j < 4; ++j) { const f32x4 w = *(const f32x4*)(wr_ + 4 * F.lane + 256 * j); p += h[j][0] * w[0] + h[j][1] * w[1] + h[j][2] * w[2] + h[j][3] * w[3]; }
            el[o] = wave_sum(p) + be[g * 8 + o]; }
        int i1 = 0; float e1 = el[0];
#pragma unroll
        for (int j = 1; j < 8; ++j) if (el[j] > e1) { e1 = el[j]; i1 = j; }
        int i2 = -1; float e2 = -INFINITY;
#pragma unroll
        for (int j = 0; j < 8; ++j) if (j != i1 && (i2 < 0 || el[j] > e2)) { e2 = el[j]; i2 = j; }
        const float r = __expf(e2 - e1); const float wa = pg / (1.0f + r), wb = pg * r / (1.0f + r);
        if (F.lane == 0) {
            const int ea = g * 8 + i1, eb = g * 8 + i2;
            const unsigned ra = atomicAdd(&cnt[ea], 1u); btok[(size_t)ea * ECAP + ra] = row * 2; bw[(size_t)ea * ECAP + ra] = wa;
            const unsigned rb = atomicAdd(&cnt[eb], 1u); btok[(size_t)eb * ECAP + rb] = row * 2 + 1; bw[(size_t)eb * ECAP + rb] = wb;
        }
    }
}

__device__ __forceinline__ void build_moe_tab(Frame& F, LAS int* tab) {
    __syncthreads();
    if (F.tid < 64) tab[72 + F.tid] = (int)__hip_atomic_load(F.ctl + CW_CNT + F.tid, __ATOMIC_RELAXED, __HIP_MEMORY_SCOPE_AGENT);
    __syncthreads();
    if (F.tid == 0) { int s = 0; for (int e = 0; e < 64; ++e) { tab[e] = s; s += (tab[72 + e] + 255) >> 8; } tab[64] = s; }
    __syncthreads();
}

__device__ __forceinline__ void ph_final(Frame& F) {
    float* v = F.out; const bf16_t* y2 = (const bf16_t*)(F.ws + WS_Y2);
    const float* mod = (const float*)(F.ws + WS_MOD); const float* g2 = F.in[I_LN2G]; const float* b2 = F.in[I_LN2B];
    const int gw = F.vcu * NWAVES + F.wave, NGW = F.G * NWAVES;
    for (int row = gw; row < T; row += NGW) {
        const int b = row / SEQ;
        f32x4* xr = (f32x4*)(v + (size_t)row * DM) + F.lane;
        const unsigned long long* ya = (const unsigned long long*)(y2 + (size_t)(2 * row) * DM) + F.lane;
        const unsigned long long* yb = (const unsigned long long*)(y2 + (size_t)(2 * row + 1) * DM) + F.lane;
        f32x4 x[4]; float s = 0.f;
#pragma unroll
        for (int j = 0; j < 4; ++j) { const int k = 4 * F.lane + 256 * j;
            const f32x4 gt = *(const f32x4*)(mod + (size_t)b * 6144 + 5120 + k);
            const unsigned long long a = ya[64 * j], c = yb[64 * j];
            f32x4 y; y[0] = bflo((unsigned)a) + bflo((unsigned)c); y[1] = bfhi((unsigned)a) + bfhi((unsigned)c);
            y[2] = bflo((unsigned)(a >> 32)) + bflo((unsigned)(c >> 32)); y[3] = bfhi((unsigned)(a >> 32)) + bfhi((unsigned)(c >> 32));
            x[j] = xr[64 * j] * DN_ALPHA + gt * y; s += (x[j][0] + x[j][1]) + (x[j][2] + x[j][3]); }
        const float mean = wave_sum(s) * (1.f / DM); float s2 = 0.f;
#pragma unroll
        for (int j = 0; j < 4; ++j) { x[j] = x[j] - mean; s2 += (x[j][0] * x[j][0] + x[j][1] * x[j][1]) + (x[j][2] * x[j][2] + x[j][3] * x[j][3]); }
        const float rstd = 1.f / sqrtf(wave_sum(s2) * (1.f / DM) + LN_EPS);
#pragma unroll
        for (int j = 0; j < 4; ++j) { const int k = 4 * F.lane + 256 * j; xr[64 * j] = x[j] * rstd * *(const f32x4*)(g2 + k) + *(const f32x4*)(b2 + k); }
    }
}

constexpr int N_PHASES = 12;
template <unsigned PH_MASK> __global__ void __launch_bounds__(NTHREADS, 2) mk_fwd(Args args) {
    extern __shared__ __attribute__((aligned(16))) unsigned char lds[];
    Frame F;
    F.lds = (LAS unsigned char*)lds; F.ws = args.ws; F.ctl = (unsigned*)(args.ws + WS_CTL);
    F.tid = threadIdx.x; F.lane = F.tid & 63; F.wave = __builtin_amdgcn_readfirstlane(F.tid >> 6);
    F.G = gridDim.x; { const int bx = blockIdx.x; F.vcu = (F.G % 8 == 0) ? (bx % 8) * (F.G / 8) + bx / 8 : bx; }
    F.in = args.in; F.out = args.out;
    volatile LAS unsigned* MISC = (volatile LAS unsigned*)(F.lds + MISC_OFF);
    for (int u = F.tid; u < (LDS_BYTES - LDSCTL_OFF) / 4; u += NTHREADS) ((LAS unsigned*)(F.lds + LDSCTL_OFF))[u] = 0u;
    __syncthreads();
    const int lo = args.ph_lo, hi = args.ph_hi;
    const bool multi = (hi - lo) > 1;
    XcdBarrier bar; bar.bar = F.ctl + CW_BAR; bar.x = 0; bar.st = nullptr;
    if (multi) bar = xcd_barrier_post(F.ctl + CW_BAR, MISC + 8);
#define IN(k) (((PH_MASK >> (k)) & 1) && lo <= (k) && (k) < hi)
#define SEAM(k) do { if (IN(k) && IN((k) + 1)) xcd_barrier(bar); } while (0)
    LAS unsigned char* ring = F.lds;
    LAS int* tab = (LAS int*)(F.lds + TAB_OFF);
    bf16_t* HB = (bf16_t*)(F.ws + WS_HB);

    if (IN(0)) { ph_prep(F); } SEAM(0);
    if (IN(1)) { ph_hb(F); } SEAM(1);
    if (IN(2)) {
        { pg8::DenseSched S; S.init(T, N1A, DM, F.G, (int)blockIdx.x, F.ws + WS_WIN);
          pg8::EpiInA E{(bf16_t*)(F.ws + WS_Q), (bf16_t*)(F.ws + WS_K), (bf16_t*)(F.ws + WS_V), (bf16_t*)(F.ws + WS_GA), (bf16_t*)(F.ws + WS_GH)};
          pg8::gemm_phase<pg8::EpiInA, pg8::DenseSched, true>(ring, HB, DM, S, E); }
        { pg8::DenseSched S; S.init(NHY, T, DM, F.G, (int)blockIdx.x, HB);
          pg8::EpiBf16 E{(bf16_t*)(F.ws + WS_UT), T};
          pg8::gemm_phase<pg8::EpiBf16, pg8::DenseSched, true>(ring, F.ws + WS_WIN + (size_t)N1A * DM * 2, DM, S, E); }
    } SEAM(2);
    if (IN(3)) { ph_attn(F); ph_hyena_direct(F); } SEAM(3);
    if (IN(4)) { ph_hyT(F); } SEAM(4);
    if (IN(5)) {
        pg8::DenseSched S; S.init(T, DM, AW, F.G, (int)blockIdx.x, F.ws + WS_WA);
        pg8::EpiGate<false> E{(const bf16_t*)(F.ws + WS_GA), nullptr, (bf16_t*)(F.ws + WS_TMP)};
        pg8::gemm_phase<pg8::EpiGate<false>, pg8::DenseSched, true>(ring, F.ws + WS_ATT, AW, S, E);
    } SEAM(5);
    if (IN(6)) {
        pg8::DenseSched S; S.init(T, DM, HW, F.G, (int)blockIdx.x, F.ws + WS_WH);
        pg8::EpiGate<true> E{(const bf16_t*)(F.ws + WS_GH), (const bf16_t*)(F.ws + WS_TMP), HB};
        pg8::gemm_phase<pg8::EpiGate<true>, pg8::DenseSched, true>(ring, F.ws + WS_HY, HW, S, E);
    } SEAM(6);
    if (IN(7)) {
        { pg8::DenseSched S; S.init(T, DM, DM, F.G, (int)blockIdx.x, F.ws + WS_WO);
          pg8::EpiRes E{F.in[I_X], (const float*)(F.ws + WS_MOD) + 2048, F.out};
          pg8::gemm_phase<pg8::EpiRes, pg8::DenseSched, true>(ring, HB, DM, S, E); }
        ph_expert_cvt(F);
    } SEAM(7);
    if (IN(8)) { ph_ln1_route(F); } SEAM(8);
    if (IN(9)) {
        build_moe_tab(F, tab);
        pg8::MoeSched S{tab, (const int*)(F.ws + WS_BTOK), (const char*)(F.ws + WS_W13), (size_t)DM * DM * 2, F.G, F.vcu, DM, true};
        pg8::EpiSwiGLU E{(bf16_t*)(F.ws + WS_HACT)};
        pg8::gemm_phase<pg8::EpiSwiGLU, pg8::MoeSched, true>(ring, HB, DM, S, E);
    } SEAM(9);
    if (IN(10)) {
        build_moe_tab(F, tab);
        pg8::MoeSched S{tab, (const int*)(F.ws + WS_BTOK), (const char*)(F.ws + WS_W2), (size_t)DM * DE * 2, F.G, F.vcu, DE, false};
        pg8::EpiScatter E{(bf16_t*)(F.ws + WS_Y2), (const int*)(F.ws + WS_BTOK), (const float*)(F.ws + WS_BW), tab};
        pg8::gemm_phase<pg8::EpiScatter, pg8::MoeSched, true>(ring, F.ws + WS_HACT, DE, S, E);
    } SEAM(10);
    if (IN(11)) { ph_final(F); }
#undef IN
#undef SEAM
}

extern "C" void kernel_launch(void* const* d_in, const int* in_sizes, int n_in, void* d_out, int out_size, void* d_ws, size_t ws_size, hipStream_t stream) {
    static int grid = 0;
    if (grid == 0) {
        if (n_in != 31 || out_size != T * DM || ws_size < WS_END) { fprintf(stderr, "kernel_launch: unexpected shapes: n_in %d out %d ws %zu (need %zu)\n", n_in, out_size, ws_size, (size_t)WS_END); grid = -1; return; }
        int dev = 0, cus = 0;
        if (hipGetDevice(&dev) != hipSuccess || hipDeviceGetAttribute(&cus, hipDeviceAttributeMultiprocessorCount, dev) != hipSuccess) { grid = -1; return; }
        bool ok = true;
#define SET_ATTR(m) ok = ok && (hipFuncSetAttribute((const void*)mk_fwd<(m)>, hipFuncAttributeMaxDynamicSharedMemorySize, LDS_BYTES) == hipSuccess)
#if MK_N_LAUNCHES == 1
        SET_ATTR(0xFFFu);
#else
        { SET_ATTR(1u << 0); SET_ATTR(1u << 1); SET_ATTR(1u << 2); SET_ATTR(1u << 3); SET_ATTR(1u << 4); SET_ATTR(1u << 5); SET_ATTR(1u << 6); SET_ATTR(1u << 7); SET_ATTR(1u << 8); SET_ATTR(1u << 9); SET_ATTR(1u << 10); SET_ATTR(1u << 11); }
#endif
#undef SET_ATTR
        if (!ok) { fprintf(stderr, "kernel_launch: hipFuncSetAttribute failed\n"); grid = -1; return; }
        (void)hipGetLastError();
        grid = cus;
    }
    if (grid < 0) return;
    if (hipMemsetAsync((char*)d_ws + WS_CTL, 0, CTL_ZERO_BYTES, stream) != hipSuccess) return;
    Args a{};
    for (int i = 0; i < 31; ++i) a.in[i] = (const float*)d_in[i];
    a.out = (float*)d_out; a.ws = (unsigned char*)d_ws;
#if MK_N_LAUNCHES == 1
    a.ph_lo = 0; a.ph_hi = N_PHASES; hipLaunchKernelGGL(mk_fwd<0xFFFu>, dim3(grid), dim3(NTHREADS), LDS_BYTES, stream, a);
#else
    {
#define LAUNCH_PH(p) do { a.ph_lo = (p); a.ph_hi = (p) + 1; hipLaunchKernelGGL(mk_fwd<(1u << (p))>, dim3(grid), dim3(NTHREADS), LDS_BYTES, stream, a); } while (0)
        LAUNCH_PH(0); LAUNCH_PH(1); LAUNCH_PH(2); LAUNCH_PH(3); LAUNCH_PH(4); LAUNCH_PH(5); LAUNCH_PH(6); LAUNCH_PH(7); LAUNCH_PH(8); LAUNCH_PH(9); LAUNCH_PH(10); LAUNCH_PH(11);
#undef LAUNCH_PH
    }
#endif
}
```

```cpp
#include <hip/hip_runtime.h>
#include <cstdio>
#include <cstdint>

#ifndef MK_N_LAUNCHES
#define MK_N_LAUNCHES 1
#endif

#define GAS __attribute__((address_space(1)))
#define LAS __attribute__((address_space(3)))
typedef unsigned short bf16_t;
typedef short bf16x8 __attribute__((ext_vector_type(8)));
typedef float f32x4 __attribute__((ext_vector_type(4)));
typedef float f32x2 __attribute__((ext_vector_type(2)));
typedef unsigned u32x4 __attribute__((ext_vector_type(4)));
typedef unsigned u32x2 __attribute__((ext_vector_type(2)));

constexpr int NB = 4, SEQ = 8192, DM = 1024, T = NB * SEQ;
constexpr int AW = 512, KVW = 128, HW = 512, INW = 4352, N1A = 2816, NHY = 1536;
constexpr int NE = 64, DE = 512, ECAP = 32768;
constexpr int NFILT = 2048, FH = 64, FEMB = 33;
constexpr float LN_EPS = 1e-5f;
constexpr float DN_ALPHA = 1.189207115002721f;
constexpr int NTHREADS = 512, NWAVES = 8;

constexpr size_t MiB = 1u << 20;
constexpr size_t WS_CTL = 0, CTL_ZERO_BYTES = 1 * MiB;
constexpr size_t WS_MODP = 1 * MiB, WS_MOD = 3 * MiB, WS_HDN = 4 * MiB, WS_WRT = 6 * MiB, WS_WIN = 7 * MiB;
constexpr size_t WS_WA = 16 * MiB, WS_WH = 17 * MiB, WS_WO = 18 * MiB, WS_BTOK = 20 * MiB, WS_BW = 28 * MiB;
constexpr size_t WS_HB = 36 * MiB;
constexpr size_t WS_Q = 100 * MiB, WS_K = 132 * MiB, WS_V = 140 * MiB, WS_GA = 148 * MiB, WS_GH = 212 * MiB;
constexpr size_t WS_UT = 276 * MiB, WS_TMP = 276 * MiB;
constexpr size_t WS_ATT = 372 * MiB, WS_HYT = 404 * MiB, WS_HY = 436 * MiB;
constexpr size_t WS_W13 = 100 * MiB, WS_W2 = 228 * MiB, WS_HACT = 292 * MiB, WS_Y2 = 372 * MiB, WS_END = 500 * MiB;
constexpr int CW_BAR = 4096, CW_CNT = 8192;

constexpr int RING_BYTES = 131072, LDSCTL_OFF = RING_BYTES, MISC_OFF = LDSCTL_OFF + 320, TAB_OFF = LDSCTL_OFF + 1024;
constexpr int LDS_BYTES = 163840;

#define LDS_WAIT() asm volatile("s_waitcnt lgkmcnt(0)" ::: "memory")
#define VM_WAIT() asm volatile("s_waitcnt vmcnt(0)" ::: "memory")
__device__ __forceinline__ unsigned f2bf(float f) { unsigned u = __builtin_bit_cast(unsigned, f); return (u + 0x7fffu + ((u >> 16) & 1u)) >> 16; }
__device__ __forceinline__ unsigned pk2(float lo, float hi) { return f2bf(lo) | (f2bf(hi) << 16); }
__device__ __forceinline__ float bf2f(unsigned short b) { return __builtin_bit_cast(float, (unsigned)b << 16); }
__device__ __forceinline__ float bflo(unsigned w) { return __builtin_bit_cast(float, w << 16); }
__device__ __forceinline__ float bfhi(unsigned w) { return __builtin_bit_cast(float, w & 0xffff0000u); }
__device__ __forceinline__ float sigmoidf_(float x) { return 1.0f / (1.0f + __expf(-x)); }
__device__ __forceinline__ float wave_sum(float v) {
#pragma unroll
    for (int o = 1; o < 64; o <<= 1) v += __shfl_xor(v, o);
    return v;
}

namespace pg8 {
constexpr int BM = 256, BK = 64, HALF = 128, HTB = HALF * BK * 2, STAGE_BYTES = 8 * HTB, NXCD = 8, WGM = 8;
__host__ __device__ __forceinline__ int lds_byte(int r, int c) { const int st = (r >> 4) * 2 + (c >> 5), rr = r & 15, cc = c & 31, ob = rr * 64 + cc * 2; return st * 1024 + (ob ^ (((ob >> 9) & 1) << 5)); }
__host__ __device__ __forceinline__ void stage_rc(int b, int& R, int& C) { const int st = b / 1024, sb = b % 1024, swz = sb ^ (((sb >> 9) & 1) << 5); R = (st >> 1) * 16 + swz / 64; C = (st & 1) * 32 + (swz % 64) / 2; }
__host__ __device__ __forceinline__ int perm32(int rho) { const int n = rho >> 4, i = rho & 15; return 8 * (i >> 2) + 4 * n + (i & 3); }

struct Unit { int pm, pn, e, mt; };

struct DenseSched {
    int nM, nN, nwg, G, c, K; const char* Bt;
    __device__ void init(int M, int N, int K_, int G_, int c_, const void* Bt_) { nM = M / BM; nN = N / BM; nwg = nM * nN; G = G_; c = c_; K = K_; Bt = (const char*)Bt_; }
    __device__ bool next(int i, Unit& u) const {
        const long L = (long)i * G + c; if (L >= nwg) return false;
        int wgid = (int)L; { const int q = nwg / NXCD, r = nwg % NXCD, xcd = wgid % NXCD, off = wgid / NXCD; wgid = (xcd < r ? xcd * (q + 1) : r * (q + 1) + (xcd - r) * q) + off; }
        const int nig = WGM * nN, gid = wgid / nig, fm = gid * WGM, gsz = (nM - fm) < WGM ? (nM - fm) : WGM;
        u.pm = fm + ((wgid % nig) % gsz); u.pn = (wgid % nig) / gsz; u.e = 0; u.mt = 0; return true;
    }
    __device__ __forceinline__ unsigned arow(const Unit& u, int r) const { return (unsigned)(u.pm * BM + r); }
    __device__ __forceinline__ const char* bptr(const Unit& u) const { return Bt + (size_t)u.pn * BM * K * 2; }
};

struct MoeSched {
    const LAS int* tab;
    const int* btok;
    const char* Bt; size_t estride; int G, v, K; bool gather;
    __device__ bool next(int i, Unit& u) const {
        const int L = i * G + v; const int tile = L >> 2; if (tile >= tab[64]) return false;
        int e = 0;
        for (int j = 1; j < 64; ++j) e += (tab[j] <= tile) ? 1 : 0;
        u.e = e; u.mt = tile - tab[e]; u.pm = tile; u.pn = L & 3; return true;
    }
    __device__ __forceinline__ unsigned arow(const Unit& u, int r) const {
        if (!gather) return (unsigned)(u.pm * BM + r);
        const int idx = u.mt * BM + r; const int cnt = tab[72 + u.e];
        unsigned tok = 0; if (idx < cnt) tok = (unsigned)btok[(size_t)u.e * ECAP + idx] >> 1;
        return tok;
    }
    __device__ __forceinline__ const char* bptr(const Unit& u) const { return Bt + (size_t)u.e * estride + (size_t)u.pn * BM * K * 2; }
};

template <class Epi, class Sched, bool ALIGN_EPI>
__device__ __forceinline__ void gemm_phase(LAS unsigned char* lds, const void* Abase, const int K, const Sched& S, const Epi& E) {
    const int tid = threadIdx.x, wid = __builtin_amdgcn_readfirstlane(tid >> 6), lane = tid & 63, wr = wid >> 2, wc = wid & 3, fr = lane & 15, fq = lane >> 4;
    const int nt = K / BK;
    int Rr[2], Cc[2]; unsigned voffB[2];
#pragma unroll
    for (int i = 0; i < 2; ++i) { stage_rc(tid * 16 + i * 8192, Rr[i], Cc[i]); const int Rb = Epi::PERM ? ((Rr[i] & ~31) + perm32(Rr[i] & 31)) : Rr[i]; voffB[i] = (unsigned)(Rb * K + Cc[i]) * 2u; }
    const size_t kstep = (size_t)(BK * 2);
    const size_t hstep = (size_t)HALF * K * 2;
    const unsigned ldsw = (unsigned)wid * 1024u;
    const int aoff = lds_byte(wr * 64 + fr, fq * 8), boff = lds_byte(wc * 32 + fr, fq * 8);
#define PG8_SA(b, h) (((b) * 2 + (h)) * HTB)
#define PG8_SB(b, h) ((4 + (b) * 2 + (h)) * HTB)
#define PG8_STAGE(bufoff, gbase, voff) do { _Pragma("unroll") for (int _i = 0; _i < 2; ++_i) \
        __builtin_amdgcn_global_load_lds((const unsigned*)((const char*)(gbase) + (voff)[_i]), (LAS unsigned*)(lds + (bufoff) + ldsw + _i * 8192), 16, 0, 0); } while (0)
#define PG8_LDA(dst, b, h) do { _Pragma("unroll") for (int m = 0; m < 4; ++m) _Pragma("unroll") for (int k = 0; k < 2; ++k) dst[m][k] = *(const LAS bf16x8*)(lds + PG8_SA(b, h) + aoff + m * 2048 + k * 1024); } while (0)
#define PG8_LDB(dst, b, h) do { _Pragma("unroll") for (int n = 0; n < 2; ++n) _Pragma("unroll") for (int k = 0; k < 2; ++k) dst[n][k] = *(const LAS bf16x8*)(lds + PG8_SB(b, h) + boff + n * 2048 + k * 1024); } while (0)
#define PG8_MMA(ai, bj, At, Bt) do { __builtin_amdgcn_s_setprio(1); _Pragma("unroll") for (int m = 0; m < 4; ++m) _Pragma("unroll") for (int n = 0; n < 2; ++n) _Pragma("unroll") for (int k = 0; k < 2; ++k) \
        acc[ai][bj][m][n] = __builtin_amdgcn_mfma_f32_16x16x32_bf16(Bt[n][k], At[m][k], acc[ai][bj][m][n], 0, 0, 0); __builtin_amdgcn_s_setprio(0); } while (0)
#define PG8_WAIT_V(n) asm volatile("s_waitcnt vmcnt(" #n ")" ::: "memory")
#define PG8_WAIT_L(n) asm volatile("s_waitcnt lgkmcnt(" #n ")" ::: "memory")
#define PG8_BAR __builtin_amdgcn_s_barrier()
#define PG8_SCHED __builtin_amdgcn_sched_barrier(0)
    Unit cur, nxt; int ui = 0;
    if (!S.next(0, cur)) return;
    f32x4 acc[2][2][4][2];
#pragma unroll
    for (int a = 0; a < 2; ++a)
#pragma unroll
        for (int b = 0; b < 2; ++b)
#pragma unroll
            for (int m = 0; m < 4; ++m)
#pragma unroll
                for (int n = 0; n < 2; ++n) acc[a][b][m][n] = (f32x4){0.f, 0.f, 0.f, 0.f};
    bf16x8 At[4][2], B0[2][2], B1[2][2];
    unsigned cv0[2], cv1[2], nv0[2], nv1[2];
#pragma unroll
    for (int i = 0; i < 2; ++i) { cv0[i] = (S.arow(cur, Rr[i]) * (unsigned)K + (unsigned)Cc[i]) * 2u; cv1[i] = (S.arow(cur, HALF + Rr[i]) * (unsigned)K + (unsigned)Cc[i]) * 2u; }
    const char* const cA = (const char*)Abase;
    const char* cB = S.bptr(cur);
    PG8_STAGE(PG8_SB(0, 0), cB, voffB); PG8_STAGE(PG8_SB(0, 1), cB + hstep, voffB); PG8_STAGE(PG8_SA(0, 0), cA, cv0); PG8_STAGE(PG8_SA(0, 1), cA, cv1);
    if (wr == 1) PG8_BAR;
    PG8_WAIT_V(2); PG8_BAR;
    PG8_STAGE(PG8_SB(1, 0), cB + kstep, voffB); PG8_STAGE(PG8_SA(1, 0), cA + kstep, cv0); PG8_STAGE(PG8_SB(1, 1), cB + hstep + kstep, voffB);
    PG8_WAIT_V(6); PG8_BAR;
    for (;;) {
        const bool has_next = S.next(ui + 1, nxt);
        const char* nB = has_next ? S.bptr(nxt) : cB;
#pragma unroll
        for (int i = 0; i < 2; ++i) {
            nv0[i] = has_next ? (S.arow(nxt, Rr[i]) * (unsigned)K + (unsigned)Cc[i]) * 2u : cv0[i];
            nv1[i] = has_next ? (S.arow(nxt, HALF + Rr[i]) * (unsigned)K + (unsigned)Cc[i]) * 2u : cv1[i];
        }
        for (int t = 0; t < nt; t += 2) {
            const bool last = (t == nt - 2);
            const char* a1 = cA + (size_t)(t + 1) * kstep;
            const char* a2 = last ? cA : cA + (size_t)(t + 2) * kstep; const char* b2 = last ? nB : cB + (size_t)(t + 2) * kstep;
            const char* a3 = a2 + kstep; const char* b3 = b2 + kstep;
            unsigned x0[2], x1[2];
#pragma unroll
            for (int i = 0; i < 2; ++i) { x0[i] = last ? nv0[i] : cv0[i]; x1[i] = last ? nv1[i] : cv1[i]; }
            PG8_LDB(B0, 0, 0); PG8_LDB(B1, 0, 1); PG8_SCHED; PG8_LDA(At, 0, 0); PG8_STAGE(PG8_SA(1, 1), a1, cv1);
            PG8_WAIT_V(8); PG8_WAIT_L(0); PG8_BAR; PG8_MMA(0, 0, At, B0); PG8_MMA(0, 1, At, B1); PG8_BAR; PG8_SCHED;
            PG8_LDA(At, 0, 1); PG8_STAGE(PG8_SB(0, 0), b2, voffB); PG8_STAGE(PG8_SB(0, 1), b2 + hstep, voffB); PG8_STAGE(PG8_SA(0, 0), a2, x0);
            PG8_WAIT_V(8); PG8_WAIT_L(0); PG8_BAR; PG8_MMA(1, 0, At, B0); PG8_MMA(1, 1, At, B1); PG8_BAR; PG8_SCHED;
            PG8_LDB(B0, 1, 0); PG8_LDB(B1, 1, 1); PG8_SCHED; PG8_LDA(At, 1, 0); PG8_STAGE(PG8_SA(0, 1), a2, x1);
            PG8_WAIT_V(8); PG8_WAIT_L(0); PG8_BAR; PG8_MMA(0, 0, At, B0); PG8_MMA(0, 1, At, B1); PG8_BAR; PG8_SCHED;
            PG8_LDA(At, 1, 1); PG8_STAGE(PG8_SB(1, 0), b3, voffB); PG8_STAGE(PG8_SB(1, 1), b3 + hstep, voffB); PG8_STAGE(PG8_SA(1, 0), a3, x0);
            PG8_WAIT_V(8); PG8_WAIT_L(0); PG8_BAR; PG8_MMA(1, 0, At, B0); PG8_MMA(1, 1, At, B1); PG8_BAR; PG8_SCHED;
        }
        if constexpr (ALIGN_EPI) { if (wr == 0) PG8_BAR; }
        E(acc, cur, wr, wc, fr, fq);
        if (!has_next) break;
#pragma unroll
        for (int a = 0; a < 2; ++a)
#pragma unroll
            for (int b = 0; b < 2; ++b)
#pragma unroll
                for (int m = 0; m < 4; ++m)
#pragma unroll
                    for (int n = 0; n < 2; ++n) acc[a][b][m][n] = (f32x4){0.f, 0.f, 0.f, 0.f};
        cur = nxt; cB = nB; ++ui;
#pragma unroll
        for (int i = 0; i < 2; ++i) { cv0[i] = nv0[i]; cv1[i] = nv1[i]; }
        if constexpr (ALIGN_EPI) { if (wr == 1) PG8_BAR; }
    }
    PG8_WAIT_V(0);
    if constexpr (!ALIGN_EPI) { if (wr == 0) PG8_BAR; }
    PG8_BAR;
#undef PG8_SA
#undef PG8_SB
#undef PG8_STAGE
#undef PG8_LDA
#undef PG8_LDB
#undef PG8_MMA
#undef PG8_WAIT_V
#undef PG8_WAIT_L
#undef PG8_BAR
#undef PG8_SCHED
}

__device__ __forceinline__ u32x4 pack8(const f32x4 v0, const f32x4 v1) { u32x4 w; w.x = pk2(v0[0], v0[1]); w.y = pk2(v0[2], v0[3]); w.z = pk2(v1[0], v1[1]); w.w = pk2(v1[2], v1[3]); return w; }

struct EpiInA {
    static constexpr bool PERM = true;
    bf16_t *Q, *Kb, *Vb, *GA, *GH;
    __device__ __forceinline__ void operator()(const f32x4 (&acc)[2][2][4][2], const Unit& u, int wr, int wc, int fr, int fq) const {
        const int row0 = u.pm * BM + wr * 64 + fr; const int cin = wc * 32 + 8 * fq;
#pragma unroll
        for (int bj = 0; bj < 2; ++bj) {
            bf16_t* base; int ld, col; bool sig = false;
            if (u.pn < 2) { base = Q; ld = AW; col = u.pn * 256 + bj * 128 + cin; }
            else if (u.pn == 2) { base = bj == 0 ? Kb : Vb; ld = KVW; col = cin; }
            else if (u.pn < 7) { base = GA; ld = DM; col = (u.pn - 3) * 256 + bj * 128 + cin; sig = true; }
            else { base = GH; ld = DM; col = (u.pn - 7) * 256 + bj * 128 + cin; sig = true; }
#pragma unroll
            for (int ai = 0; ai < 2; ++ai)
#pragma unroll
                for (int m = 0; m < 4; ++m) {
                    f32x4 v0 = acc[ai][bj][m][0], v1 = acc[ai][bj][m][1];
                    if (sig) {
#pragma unroll
                        for (int j = 0; j < 4; ++j) { v0[j] = sigmoidf_(v0[j]); v1[j] = sigmoidf_(v1[j]); }
                    }
                    *(u32x4*)(base + (size_t)(row0 + ai * HALF + m * 16) * ld + col) = pack8(v0, v1);
                }
        }
    }
};
struct EpiBf16 {
    static constexpr bool PERM = true;
    bf16_t* O; int ldc;
    __device__ __forceinline__ void operator()(const f32x4 (&acc)[2][2][4][2], const Unit& u, int wr, int wc, int fr, int fq) const {
        const int row0 = u.pm * BM + wr * 64 + fr; const int col0 = u.pn * BM + wc * 32 + 8 * fq;
#pragma unroll
        for (int ai = 0; ai < 2; ++ai)
#pragma unroll
            for (int m = 0; m < 4; ++m)
#pragma unroll
                for (int bj = 0; bj < 2; ++bj)
                    *(u32x4*)(O + (size_t)(row0 + ai * HALF + m * 16) * ldc + col0 + bj * HALF) = pack8(acc[ai][bj][m][0], acc[ai][bj][m][1]);
    }
};
template <bool ADD> struct EpiGate {
    static constexpr bool PERM = true;
    const bf16_t* G; const bf16_t* P; bf16_t* O;
    __device__ __forceinline__ void operator()(const f32x4 (&acc)[2][2][4][2], const Unit& u, int wr, int wc, int fr, int fq) const {
        const int row0 = u.pm * BM + wr * 64 + fr; const int col0 = u.pn * BM + wc * 32 + 8 * fq;
#pragma unroll
        for (int ai = 0; ai < 2; ++ai)
#pragma unroll
            for (int m = 0; m < 4; ++m)
#pragma unroll
                for (int bj = 0; bj < 2; ++bj) {
                    const size_t off = (size_t)(row0 + ai * HALF + m * 16) * DM + col0 + bj * HALF;
                    const u32x4 g = *(const u32x4*)(G + off);
                    f32x4 v0 = acc[ai][bj][m][0], v1 = acc[ai][bj][m][1];
                    v0[0] *= bflo(g.x); v0[1] *= bfhi(g.x); v0[2] *= bflo(g.y); v0[3] *= bfhi(g.y);
                    v1[0] *= bflo(g.z); v1[1] *= bfhi(g.z); v1[2] *= bflo(g.w); v1[3] *= bfhi(g.w);
                    if (ADD) { const u32x4 p = *(const u32x4*)(P + off);
                        v0[0] += bflo(p.x); v0[1] += bfhi(p.x); v0[2] += bflo(p.y); v0[3] += bfhi(p.y);
                        v1[0] += bflo(p.z); v1[1] += bfhi(p.z); v1[2] += bflo(p.w); v1[3] += bfhi(p.w); }
                    *(u32x4*)(O + off) = pack8(v0, v1);
                }
    }
};
struct EpiRes {
    static constexpr bool PERM = false;
    const float* X; const float* gate; float* O;
    __device__ __forceinline__ void operator()(const f32x4 (&acc)[2][2][4][2], const Unit& u, int wr, int wc, int fr, int fq) const {
        const int row0 = u.pm * BM + wr * 64 + fr; const int col0 = u.pn * BM + wc * 32 + 4 * fq;
        const int b = (u.pm * BM) / SEQ;
#pragma unroll
        for (int bj = 0; bj < 2; ++bj)
#pragma unroll
            for (int n = 0; n < 2; ++n) {
                const int col = col0 + bj * HALF + n * 16;
                const f32x4 gv = *(const f32x4*)(gate + (size_t)b * 6144 + col);
#pragma unroll
                for (int ai = 0; ai < 2; ++ai)
#pragma unroll
                    for (int m = 0; m < 4; ++m) {
                        const size_t off = (size_t)(row0 + ai * HALF + m * 16) * DM + col;
                        const f32x4 xv = *(const f32x4*)(X + off);
                        *(f32x4*)(O + off) = xv * DN_ALPHA + gv * acc[ai][bj][m][n];
                    }
            }
    }
};
struct EpiSwiGLU {
    static constexpr bool PERM = true;
    bf16_t* H;
    __device__ __forceinline__ void operator()(const f32x4 (&acc)[2][2][4][2], const Unit& u, int wr, int wc, int fr, int fq) const {
        const int row0 = u.pm * BM + wr * 64 + fr; const int col0 = u.pn * HALF + wc * 32 + 8 * fq;
#pragma unroll
        for (int ai = 0; ai < 2; ++ai)
#pragma unroll
            for (int m = 0; m < 4; ++m) {
                f32x4 v0, v1;
#pragma unroll
                for (int j = 0; j < 4; ++j) { const float a0 = acc[ai][0][m][0][j], a1 = acc[ai][0][m][1][j];
                    v0[j] = a0 * sigmoidf_(a0) * acc[ai][1][m][0][j]; v1[j] = a1 * sigmoidf_(a1) * acc[ai][1][m][1][j]; }
                *(u32x4*)(H + (size_t)(row0 + ai * HALF + m * 16) * DE + col0) = pack8(v0, v1);
            }
    }
};
struct EpiScatter {
    static constexpr bool PERM = true;
    bf16_t* Y2; const int* btok; const float* bw; const LAS int* tab;
    __device__ __forceinline__ void operator()(const f32x4 (&acc)[2][2][4][2], const Unit& u, int wr, int wc, int fr, int fq) const {
        const int col0 = u.pn * BM + wc * 32 + 8 * fq; const int cnt = tab[72 + u.e];
#pragma unroll
        for (int ai = 0; ai < 2; ++ai)
#pragma unroll
            for (int m = 0; m < 4; ++m) {
                const int idx = u.mt * BM + ai * HALF + wr * 64 + m * 16 + fr;
                if (idx < cnt) {
                    const int dst = btok[(size_t)u.e * ECAP + idx]; const float w = bw[(size_t)u.e * ECAP + idx];
#pragma unroll
                    for (int bj = 0; bj < 2; ++bj)
                        *(u32x4*)(Y2 + (size_t)dst * DM + col0 + bj * HALF) = pack8(acc[ai][bj][m][0] * w, acc[ai][bj][m][1] * w);
                }
            }
    }
};
}

#define XB_TMO      128
#define XB_XCNT(j)  (256  + 64 * (j))
#define XB_XSUB(j)  (1280 + 64 * (j))
#define XB_XGEN(j)  (2304 + 64 * (j))
#define XB_TOP      3328
#define XB_TOPGEN   3392
#define XCD_BAR_WORDS 3456
#define XB_SPIN_CAP (1u << 22)
__device__ __forceinline__ unsigned xb_ld(unsigned* p)              { return __hip_atomic_load(p, __ATOMIC_RELAXED, __HIP_MEMORY_SCOPE_AGENT); }
__device__ __forceinline__ unsigned xb_add(unsigned* p, unsigned v) { return __hip_atomic_fetch_add(p, v, __ATOMIC_RELAXED, __HIP_MEMORY_SCOPE_AGENT); }
__device__ __forceinline__ unsigned xb_xcc_id() { return (unsigned)__builtin_amdgcn_s_getreg((3 << 11) | 20) & 0xFu; }
#define XB_SPIN(cond, bar) do { unsigned _sp = 0; while (cond) { __builtin_amdgcn_s_sleep(1); \
    if ((++_sp & 255u) == 0u) { if (xb_ld(&(bar)[XB_TMO])) break; if (_sp > XB_SPIN_CAP) { atomicAdd(&(bar)[XB_TMO], 1u); break; } } } } while (0)
__device__ __forceinline__ void xcd_barrier_post(unsigned* bar) { if (threadIdx.x == 0) (void)xb_add(&bar[XB_XCNT(xb_xcc_id())], 1u); }
__device__ __forceinline__ void xcd_barrier_complete(unsigned* bar, unsigned x, unsigned& nloc, unsigned& nx) {
    const unsigned G = gridDim.x * gridDim.y * gridDim.z;
    unsigned sum, cnt, mine, sp = 0u;
    for (;;) {
        sum = 0u; cnt = 0u; mine = 0u;
#pragma unroll
        for (unsigned j = 0; j < 16; ++j) { const unsigned c = xb_ld(&bar[XB_XCNT(j)]); sum += c; cnt += (c > 0u) ? 1u : 0u; mine = (j == x) ? c : mine; }
        if (sum == G) break;
        __builtin_amdgcn_s_sleep(1);
        if ((++sp & 255u) == 0u) { if (xb_ld(&bar[XB_TMO])) break; if (sp > XB_SPIN_CAP) { atomicAdd(&bar[XB_TMO], 1u); break; } }
    }
    nloc = mine > 0u ? mine : 1u; nx = cnt > 0u ? cnt : 1u;
}
__device__ __forceinline__ void xcd_barrier(unsigned* bar, volatile LAS unsigned* st) {
    asm volatile("s_waitcnt vmcnt(0)" ::: "memory");
    __syncthreads();
    if (threadIdx.x == 0) {
        const unsigned x = xb_xcc_id();
        __builtin_amdgcn_s_waitcnt(0);
        unsigned nloc = st[0], nx = st[1];
        if (nloc == 0u) { xcd_barrier_complete(bar, x, nloc, nx); st[0] = nloc; st[1] = nx; }
        const unsigned old = xb_add(&bar[XB_XSUB(x)], 1u);
        const unsigned gen = old / nloc;
        if (old + 1u == (gen + 1u) * nloc) {
            __builtin_amdgcn_fence(__ATOMIC_RELEASE, "agent");
            asm volatile("s_waitcnt vmcnt(0)" ::: "memory");
            const unsigned og = xb_add(&bar[XB_TOP], 1u);
            const unsigned tg = og / nx;
            if (og + 1u == (tg + 1u) * nx) xb_add(&bar[XB_TOPGEN], 1u);
            else XB_SPIN(xb_ld(&bar[XB_TOPGEN]) == tg, bar);
            __builtin_amdgcn_fence(__ATOMIC_ACQUIRE, "agent");
            xb_add(&bar[XB_XGEN(x)], 1u);
            asm volatile("s_waitcnt vmcnt(0)" ::: "memory");
        } else {
            XB_SPIN(xb_ld(&bar[XB_XGEN(x)]) == gen, bar);
            __builtin_amdgcn_fence(__ATOMIC_ACQUIRE, "agent");
            asm volatile("s_waitcnt vmcnt(0)" ::: "memory");
        }
    }
    __syncthreads();
}

struct Args { const float* in[31]; float* out; unsigned char* ws; int ph_lo, ph_hi; };
struct Frame {
    LAS unsigned char* lds; unsigned char* ws; unsigned* ctl;
    int tid, lane, wave, vcu, G;
    const float* const* in; float* out;
};
enum { I_X = 0, I_C, I_WADA, I_BADA, I_WIN, I_CONVW, I_CONVB, I_FW1, I_FB1, I_FF1, I_FW2, I_FB2, I_FF2, I_FW3, I_DECAY, I_SKIP, I_WHY, I_WATT, I_SINK, I_WOUT,
       I_LN1G, I_LN1B, I_RGW, I_RGB, I_REW, I_REB, I_EW1, I_EW3, I_EW2, I_LN2G, I_LN2B };

__device__ __forceinline__ void transpose_item(const float* W, int K, int N, bf16_t* WT, int ldt, int drow0, LAS float* scr, int kb, int nb, int lane) {
    const int k0 = 64 * kb, n0 = 32 * nb;
#pragma unroll 8
    for (int i = 0; i < 32; ++i) { const int kk = 2 * i + (lane >> 5); scr[kk * 33 + (lane & 31)] = W[(size_t)(k0 + kk) * N + n0 + (lane & 31)]; }
    LDS_WAIT(); asm volatile("" ::: "memory");
    const int c = lane & 7;
#pragma unroll
    for (int j = 0; j < 4; ++j) { const int n = (lane >> 3) + 8 * j; const LAS float* s = scr + (8 * c) * 33 + n;
        u32x4 o; o.x = pk2(s[0 * 33], s[1 * 33]); o.y = pk2(s[2 * 33], s[3 * 33]); o.z = pk2(s[4 * 33], s[5 * 33]); o.w = pk2(s[6 * 33], s[7 * 33]);
        *(u32x4*)(WT + (size_t)(drow0 + n) * ldt + k0 + 8 * c) = o; }
    LDS_WAIT(); asm volatile("" ::: "memory");
}

__device__ __forceinline__ void ph_prep(Frame& F) {
    const float* c = F.in[I_C]; const float* wada = F.in[I_WADA];
    float* modp = (float*)(F.ws + WS_MODP);
    for (int it = blockIdx.x; it < 192; it += F.G) {
        const int kc = it / 12, cg = it % 12, j = cg * 512 + F.tid;
        float a0 = 0.f, a1 = 0.f, a2 = 0.f, a3 = 0.f;
        for (int kk = 0; kk < 64; ++kk) { const int k = kc * 64 + kk; const float w = wada[(size_t)k * 6144 + j];
            const float c0 = c[k], c1 = c[1024 + k], c2 = c[2048 + k], c3 = c[3072 + k];
            a0 += c0 * sigmoidf_(c0) * w; a1 += c1 * sigmoidf_(c1) * w; a2 += c2 * sigmoidf_(c2) * w; a3 += c3 * sigmoidf_(c3) * w; }
        modp[(size_t)(kc * 4 + 0) * 6144 + j] = a0; modp[(size_t)(kc * 4 + 1) * 6144 + j] = a1; modp[(size_t)(kc * 4 + 2) * 6144 + j] = a2; modp[(size_t)(kc * 4 + 3) * 6144 + j] = a3;
    }
    LAS float* scr = (LAS float*)(F.lds + F.wave * 16384);
    const int gw = F.vcu * NWAVES + F.wave, NGW = F.G * NWAVES;
    constexpr int I_IN = 16 * 136, I_A = 8 * 32, I_H = 8 * 32, I_O = 16 * 32;
    for (int it = gw; it < I_IN + I_A + I_H + I_O; it += NGW) {
        int r = it;
        if (r < I_IN) { const int kb = r / 136, nb = r % 136, n0 = nb * 32;
            const int drow = n0 < 768 ? n0 : (n0 < 2304 ? N1A + (n0 - 768) : 768 + (n0 - 2304));
            transpose_item(F.in[I_WIN], DM, INW, (bf16_t*)(F.ws + WS_WIN), DM, drow, scr, kb, nb, F.lane); continue; } r -= I_IN;
        if (r < I_A) { transpose_item(F.in[I_WATT], AW, DM, (bf16_t*)(F.ws + WS_WA), AW, (r % 32) * 32, scr, r / 32, r % 32, F.lane); continue; } r -= I_A;
        if (r < I_H) { transpose_item(F.in[I_WHY], HW, DM, (bf16_t*)(F.ws + WS_WH), HW, (r % 32) * 32, scr, r / 32, r % 32, F.lane); continue; } r -= I_H;
        transpose_item(F.in[I_WOUT], DM, DM, (bf16_t*)(F.ws + WS_WO), DM, (r % 32) * 32, scr, r / 32, r % 32, F.lane);
    }
    {
        const float* w1 = F.in[I_FW1]; const float* b1 = F.in[I_FB1]; const float* f1 = F.in[I_FF1];
        const float* w2 = F.in[I_FW2]; const float* b2 = F.in[I_FB2]; const float* f2 = F.in[I_FF2];
        float* hdn = (float*)(F.ws + WS_HDN);
        const int j = F.lane;
        for (int t = gw; t < SEQ; t += NGW) {
            const float tl = (float)t / (float)(SEQ - 1);
            const float w = 6.283185307179586f * (float)t / (float)SEQ;
            float zi = 0.f;
            if (j == 0) zi = tl;
            else if (j <= 16) { const float band = 1e-4f + (float)(j - 1) * ((15.0f - 1e-4f) / 15.0f); zi = cosf(band * w); }
            else if (j <= 32) { const float band = 1e-4f + (float)(j - 17) * ((15.0f - 1e-4f) / 15.0f); zi = -sinf(band * w); }
            float a = b1[j];
#pragma unroll
            for (int i = 0; i < FEMB; ++i) a += __shfl(zi, i) * w1[i * FH + j];
            const float h1 = sinf(f1[j] * a);
            float a2 = b2[j];
#pragma unroll
            for (int i = 0; i < FH; ++i) a2 += __shfl(h1, i) * w2[i * FH + j];
            hdn[(size_t)t * FH + j] = sinf(f2[j] * a2);
        }
    }
    {
        float* wrt = (float*)(F.ws + WS_WRT); const float* wg = F.in[I_RGW]; const float* we = F.in[I_REW];
        for (int i = blockIdx.x * NTHREADS + F.tid; i < 72 * DM; i += F.G * NTHREADS) { const int o = i / DM, k = i % DM; wrt[i] = o < 8 ? wg[k * 8 + o] : we[k * 64 + (o - 8)]; }
    }
}

__device__ __forceinline__ void ph_hb(Frame& F) {
    const float* modp = (const float*)(F.ws + WS_MODP); const float* bada = F.in[I_BADA];
    float* mod = (float*)(F.ws + WS_MOD);
    for (int i = blockIdx.x * NTHREADS + F.tid; i < NB * 6144; i += F.G * NTHREADS) { const int b = i / 6144, j = i % 6144; float s = bada[j];
        for (int kc = 0; kc < 16; ++kc) s += modp[(size_t)(kc * 4 + b) * 6144 + j];
        mod[i] = s; }
    LAS float* sc = (LAS float*)F.lds; LAS float* sh = sc + DM;
    const float* x = F.in[I_X]; bf16_t* hb = (bf16_t*)(F.ws + WS_HB);
    for (int ch = blockIdx.x; ch < T / 128; ch += F.G) {
        const int b = (ch * 128) / SEQ;
        __syncthreads();
        for (int j = F.tid; j < 2 * DM; j += NTHREADS) { float s = bada[j];
            for (int kc = 0; kc < 16; ++kc) s += modp[(size_t)(kc * 4 + b) * 6144 + j];
            if (j < DM) sh[j] = s; else sc[j - DM] = 1.0f + s; }
        __syncthreads();
        for (int r = F.wave; r < 128; r += NWAVES) {
            const size_t row = (size_t)ch * 128 + r;
            const f32x4* xr = (const f32x4*)(x + row * DM) + F.lane;
            unsigned long long* o8 = (unsigned long long*)(hb + row * DM) + F.lane;
#pragma unroll
            for (int j = 0; j < 4; ++j) { const f32x4 v = xr[64 * j]; const int k = 4 * F.lane + 256 * j;
                const float h0 = v[0] * sc[k] + sh[k], h1 = v[1] * sc[k + 1] + sh[k + 1], h2 = v[2] * sc[k + 2] + sh[k + 2], h3 = v[3] * sc[k + 3] + sh[k + 3];
                o8[64 * j] = (unsigned long long)pk2(h0, h1) | ((unsigned long long)pk2(h2, h3) << 32); }
        }
    }
    __syncthreads();
}

__device__ __forceinline__ void ph_attn(Frame& F) {
    const bf16_t* Q = (const bf16_t*)(F.ws + WS_Q); const bf16_t* Kb = (const bf16_t*)(F.ws + WS_K); const bf16_t* Vb = (const bf16_t*)(F.ws + WS_V);
    bf16_t* O = (bf16_t*)(F.ws + WS_ATT); const float* sink = F.in[I_SINK];
    LAS unsigned* Ks = (LAS unsigned*)F.lds;
    LAS unsigned* Vs = Ks + 384 * 32;
    for (int unit = blockIdx.x; unit < NB * 2 * 64; unit += F.G) {
        const int qb = unit & 63, kvh = (unit >> 6) & 1, b = unit >> 7;
        __syncthreads();
        for (int i = F.tid; i < 384 * 8; i += NTHREADS) {
            const int j = i >> 3, p = i & 7; const int kpos = qb * 128 - 128 + j;
            u32x4 kv = (u32x4){0u, 0u, 0u, 0u}, vv = kv;
            if (kpos >= 0 && kpos < SEQ) { const size_t off = ((size_t)b * SEQ + kpos) * KVW + kvh * 64 + p * 8; kv = *(const u32x4*)(Kb + off); vv = *(const u32x4*)(Vb + off); }
            *(LAS u32x4*)(Ks + j * 32 + p * 4) = kv; *(LAS u32x4*)(Vs + j * 32 + p * 4) = vv;
        }
        __syncthreads();
        const int g = F.tid >> 7, a = F.tid & 127, h = kvh * 4 + g;
        const size_t trow = (size_t)b * SEQ + qb * 128 + a;
        float q[64];
#pragma unroll
        for (int p = 0; p < 8; ++p) { const u32x4 w = *(const u32x4*)(Q + trow * AW + h * 64 + p * 8);
            q[p * 8 + 0] = bflo(w.x); q[p * 8 + 1] = bfhi(w.x); q[p * 8 + 2] = bflo(w.y); q[p * 8 + 3] = bfhi(w.y);
            q[p * 8 + 4] = bflo(w.z); q[p * 8 + 5] = bfhi(w.z); q[p * 8 + 6] = bflo(w.w); q[p * 8 + 7] = bfhi(w.w); }
        const float slope = exp2f(-(float)(h + 1));
        float m = sink[h], l = 1.0f;
        float o[64];
#pragma unroll
        for (int d = 0; d < 64; ++d) o[d] = 0.f;
        for (int j = 0; j < 384; ++j) {
            const int rel = j - 128 - a; const int kpos = qb * 128 - 128 + j;
            const bool valid = (rel >= -128) && (rel <= 128) && (kpos >= 0) && (kpos < SEQ);
            float s = 0.f;
#pragma unroll
            for (int p = 0; p < 8; ++p) { const u32x4 w = *(const LAS u32x4*)(Ks + j * 32 + p * 4);
                s += q[p * 8 + 0] * bflo(w.x) + q[p * 8 + 1] * bfhi(w.x) + q[p * 8 + 2] * bflo(w.y) + q[p * 8 + 3] * bfhi(w.y)
                   + q[p * 8 + 4] * bflo(w.z) + q[p * 8 + 5] * bfhi(w.z) + q[p * 8 + 6] * bflo(w.w) + q[p * 8 + 7] * bfhi(w.w); }
            s = s * 0.125f - slope * fabsf((float)rel);
            if (valid) {
                const float mn = fmaxf(m, s); const float sc = __expf(m - mn); const float pj = __expf(s - mn);
                l = l * sc + pj; m = mn;
#pragma unroll
                for (int p = 0; p < 8; ++p) { const u32x4 w = *(const LAS u32x4*)(Vs + j * 32 + p * 4);
                    o[p * 8 + 0] = o[p * 8 + 0] * sc + pj * bflo(w.x); o[p * 8 + 1] = o[p * 8 + 1] * sc + pj * bfhi(w.x);
                    o[p * 8 + 2] = o[p * 8 + 2] * sc + pj * bflo(w.y); o[p * 8 + 3] = o[p * 8 + 3] * sc + pj * bfhi(w.y);
                    o[p * 8 + 4] = o[p * 8 + 4] * sc + pj * bflo(w.z); o[p * 8 + 5] = o[p * 8 + 5] * sc + pj * bfhi(w.z);
                    o[p * 8 + 6] = o[p * 8 + 6] * sc + pj * bflo(w.w); o[p * 8 + 7] = o[p * 8 + 7] * sc + pj * bfhi(w.w); }
            }
        }
        const float il = 1.0f / l;
#pragma unroll
        for (int p = 0; p < 8; ++p) { u32x4 w; w.x = pk2(o[p * 8 + 0] * il, o[p * 8 + 1] * il); w.y = pk2(o[p * 8 + 2] * il, o[p * 8 + 3] * il);
            w.z = pk2(o[p * 8 + 4] * il, o[p * 8 + 5] * il); w.w = pk2(o[p * 8 + 6] * il, o[p * 8 + 7] * il);
            *(u32x4*)(O + trow * AW + h * 64 + p * 8) = w; }
    }
    __syncthreads();
}

__device__ __forceinline__ float block_sum(Frame& F, float v, LAS float* red) {
    v = wave_sum(v);
    __syncthreads();
    if (F.lane == 0) red[F.wave] = v;
    __syncthreads();
    float s = 0.f;
#pragma unroll
    for (int i = 0; i < NWAVES; ++i) s += red[i];
    return s;
}
__device__ __forceinline__ float shortconv(const bf16_t* row, int t, float w0, float w1, float w2, float bias) {
    const float c = bf2f(row[t]); const float p = t > 0 ? bf2f(row[t - 1]) : 0.f; const float n = t < SEQ - 1 ? bf2f(row[t + 1]) : 0.f;
    return w0 * p + w1 * c + w2 * n + bias;
}
__device__ __forceinline__ void ph_hyena_direct(Frame& F) {
    const bf16_t* UT = (const bf16_t*)(F.ws + WS_UT); bf16_t* HYT = (bf16_t*)(F.ws + WS_HYT);
    const float* hdn = (const float*)(F.ws + WS_HDN); const float* w3 = F.in[I_FW3]; const float* decay = F.in[I_DECAY];
    const float* convw = F.in[I_CONVW]; const float* convb = F.in[I_CONVB]; const float* skip = F.in[I_SKIP];
    LAS float* kc = (LAS float*)F.lds;
    LAS float* z = kc + 16384;
    LAS float* w3s = z + 8192;
    LAS float* red = w3s + 128;
    for (int c = blockIdx.x; c < HW; c += F.G) {
        for (int o = 0; o < 2; ++o) {
            const int colf = o * 1024 + c, colb = o * 1024 + 512 + c;
            __syncthreads();
            if (F.tid < 128) w3s[F.tid] = w3[(size_t)(F.tid & 63) * NFILT + (F.tid < 64 ? colf : colb)];
            if (F.tid == 0) kc[SEQ] = 0.f;
            __syncthreads();
            const float df = fabsf(decay[colf]), db = fabsf(decay[colb]);
            float asum = 0.f;
            for (int i = 0; i < 16; ++i) {
                const int t = F.tid + 512 * i; const f32x4* hr = (const f32x4*)(hdn + (size_t)t * FH);
                float sf = 0.f, sb = 0.f;
#pragma unroll
                for (int k4 = 0; k4 < 16; ++k4) { const f32x4 hv = hr[k4];
                    sf += hv[0] * w3s[k4 * 4] + hv[1] * w3s[k4 * 4 + 1] + hv[2] * w3s[k4 * 4 + 2] + hv[3] * w3s[k4 * 4 + 3];
                    sb += hv[0] * w3s[64 + k4 * 4] + hv[1] * w3s[64 + k4 * 4 + 1] + hv[2] * w3s[64 + k4 * 4 + 2] + hv[3] * w3s[64 + k4 * 4 + 3]; }
                const float tl = (float)t / (float)(SEQ - 1);
                sf *= (__expf(-tl * df) + 0.05f); sb *= (__expf(-tl * db) + 0.05f);
                asum += fabsf(sf) + fabsf(sb);
                kc[t] = sf; if (t > 0) kc[2 * SEQ - t] = sb;
            }
            const float inv = 1.0f / block_sum(F, asum, red);
            for (int i = F.tid; i < 2 * SEQ; i += NTHREADS) kc[i] *= inv;
            const float sk = skip[o * HW + c];
            const int chz = c, chg = (o + 1) * HW + c;
            const float zw0 = convw[chz], zw1 = convw[NHY + chz], zw2 = convw[2 * NHY + chz], zb = convb[chz];
            const float gw0 = convw[chg], gw1 = convw[NHY + chg], gw2 = convw[2 * NHY + chg], gb = convb[chg];
            for (int b = 0; b < NB; ++b) {
                __syncthreads();
                for (int i = 0; i < 16; ++i) { const int t = F.tid + 512 * i;
                    z[t] = (o == 0) ? shortconv(UT + (size_t)chz * T + (size_t)b * SEQ, t, zw0, zw1, zw2, zb) : bf2f(HYT[(size_t)c * T + (size_t)b * SEQ + t]); }
                __syncthreads();
                float acc[16];
#pragma unroll
                for (int i = 0; i < 16; ++i) acc[i] = 0.f;
                for (int s = 0; s < SEQ; ++s) {
                    const float zs = z[s];
#pragma unroll
                    for (int i = 0; i < 16; ++i) acc[i] += zs * kc[(F.tid + 512 * i - s) & (2 * SEQ - 1)];
                }
#pragma unroll
                for (int i = 0; i < 16; ++i) { const int t = F.tid + 512 * i;
                    const float gate = shortconv(UT + (size_t)chg * T + (size_t)b * SEQ, t, gw0, gw1, gw2, gb);
                    const float y = acc[i] + sk * z[t];
                    HYT[(size_t)c * T + (size_t)b * SEQ + t] = (bf16_t)f2bf(gate * y); }
            }
        }
    }
    __syncthreads();
}

__device__ __forceinline__ void ph_hyT(Frame& F) {
    const bf16_t* HYT = (const bf16_t*)(F.ws + WS_HYT); bf16_t* HY = (bf16_t*)(F.ws + WS_HY);
    for (int it = blockIdx.x; it < 8 * (T / 512); it += F.G) {
        const int cb = it & 7, tb = it >> 3; const int t = tb * 512 + F.tid, c0 = cb * 64;
        unsigned w[32];
#pragma unroll
        for (int i = 0; i < 32; ++i) { const unsigned lo = HYT[(size_t)(c0 + 2 * i) * T + t], hi = HYT[(size_t)(c0 + 2 * i + 1) * T + t]; w[i] = lo | (hi << 16); }
#pragma unroll
        for (int i = 0; i < 8; ++i) *(u32x4*)(HY + (size_t)t * HW + c0 + 8 * i) = (u32x4){w[4 * i], w[4 * i + 1], w[4 * i + 2], w[4 * i + 3]};
    }
}

__device__ __forceinline__ void ph_expert_cvt(Frame& F) {
    LAS float* scr = (LAS float*)(F.lds + F.wave * 16384);
    const int gw = F.vcu * NWAVES + F.wave, NGW = F.G * NWAVES;
    bf16_t* W13 = (bf16_t*)(F.ws + WS_W13); bf16_t* W2 = (bf16_t*)(F.ws + WS_W2);
    for (int it = gw; it < NE * 768; it += NGW) {
        const int e = it / 768; int r = it % 768;
        if (r < 512) { const bool is3 = r >= 256; r &= 255; const int kb = r / 16, nb = r % 16, n0 = nb * 32;
            const int drow = (n0 >> 7) * 256 + (is3 ? 128 : 0) + (n0 & 127);
            transpose_item(F.in[is3 ? I_EW3 : I_EW1] + (size_t)e * DM * DE, DM, DE, W13 + (size_t)e * DM * DM, DM, drow, scr, kb, nb, F.lane); }
        else { r -= 512; const int kb = r / 32, nb = r % 32;
            transpose_item(F.in[I_EW2] + (size_t)e * DE * DM, DE, DM, W2 + (size_t)e * DM * DE, DE, nb * 32, scr, kb, nb, F.lane); }
    }
}

__device__ __forceinline__ void ph_ln1_route(Frame& F) {
    float* v = F.out; bf16_t* h2b = (bf16_t*)(F.ws + WS_HB);
    const float* mod = (const float*)(F.ws + WS_MOD); const float* g1 = F.in[I_LN1G]; const float* b1 = F.in[I_LN1B];
    const float* wrt = (const float*)(F.ws + WS_WRT); const float* bg = F.in[I_RGB]; const float* be = F.in[I_REB];
    unsigned* cnt = F.ctl + CW_CNT; int* btok = (int*)(F.ws + WS_BTOK); float* bw = (float*)(F.ws + WS_BW);
    const int gw = F.vcu * NWAVES + F.wave, NGW = F.G * NWAVES;
    for (int row = gw; row < T; row += NGW) {
        const int b = row / SEQ;
        f32x4* xr = (f32x4*)(v + (size_t)row * DM) + F.lane;
        f32x4 x[4]; float s = 0.f;
#pragma unroll
        for (int j = 0; j < 4; ++j) { x[j] = xr[64 * j]; s += (x[j][0] + x[j][1]) + (x[j][2] + x[j][3]); }
        const float mean = wave_sum(s) * (1.f / DM); float s2 = 0.f;
#pragma unroll
        for (int j = 0; j < 4; ++j) { x[j] = x[j] - mean; s2 += (x[j][0] * x[j][0] + x[j][1] * x[j][1]) + (x[j][2] * x[j][2] + x[j][3] * x[j][3]); }
        const float rstd = 1.f / sqrtf(wave_sum(s2) * (1.f / DM) + LN_EPS);
        f32x4 h[4];
        unsigned long long* o8 = (unsigned long long*)(h2b + (size_t)row * DM) + F.lane;
#pragma unroll
        for (int j = 0; j < 4; ++j) { const int k = 4 * F.lane + 256 * j;
            const f32x4 gg = *(const f32x4*)(g1 + k), bb = *(const f32x4*)(b1 + k);
            const f32x4 sh = *(const f32x4*)(mod + (size_t)b * 6144 + 3072 + k), sc = *(const f32x4*)(mod + (size_t)b * 6144 + 4096 + k);
            x[j] = x[j] * rstd * gg + bb; xr[64 * j] = x[j];
            h[j] = x[j] * (sc + 1.0f) + sh;
            o8[64 * j] = (unsigned long long)pk2(h[j][0], h[j][1]) | ((unsigned long long)pk2(h[j][2], h[j][3]) << 32); }
        float gl[8];
#pragma unroll
        for (int o = 0; o < 8; ++o) { float p = 0.f;
#pragma unroll
            for (int j = 0; j < 4; ++j) { const f32x4 w = *(const f32x4*)(wrt + (size_t)o * DM + 4 * F.lane + 256 * j); p += h[j][0] * w[0] + h[j][1] * w[1] + h[j][2] * w[2] + h[j][3] * w[3]; }
            gl[o] = wave_sum(p) + bg[o]; }
        float gmax = gl[0]; int g = 0;
#pragma unroll
        for (int i = 1; i < 8; ++i) if (gl[i] > gmax) { gmax = gl[i]; g = i; }
        float den = 0.f;
#pragma unroll
        for (int i = 0; i < 8; ++i) den += __expf(gl[i] - gmax);
        const float pg = 1.0f / den;
        float el[8];
#pragma unroll
        for (int o = 0; o < 8; ++o) { float p = 0.f; const float* wr_ = wrt + (size_t)(8 + g * 8 + o) * DM;
#pragma unroll
            for (int j = 0; j < 4; ++j) { const f32x4 w = *(const f32x4*)(wr_ + 4 * F.lane + 256 * j); p += h[j][0] * w[0] + h[j][1] * w[1] + h[j][2] * w[2] + h[j][3] * w[3]; }
            el[o] = wave_sum(p) + be[g * 8 + o]; }
        int i1 = 0; float e1 = el[0];
#pragma unroll
        for (int j = 1; j < 8; ++j) if (el[j] > e1) { e1 = el[j]; i1 = j; }
        int i2 = -1; float e2 = -INFINITY;
#pragma unroll
        for (int j = 0; j < 8; ++j) if (j != i1 && (i2 < 0 || el[j] > e2)) { e2 = el[j]; i2 = j; }
        const float r = __expf(e2 - e1); const float wa = pg / (1.0f + r), wb = pg * r / (1.0f + r);
        if (F.lane == 0) {
            const int ea = g * 8 + i1, eb = g * 8 + i2;
            const unsigned ra = atomicAdd(&cnt[ea], 1u); btok[(size_t)ea * ECAP + ra] = row * 2; bw[(size_t)ea * ECAP + ra] = wa;
            const unsigned rb = atomicAdd(&cnt[eb], 1u); btok[(size_t)eb * ECAP + rb] = row * 2 + 1; bw[(size_t)eb * ECAP + rb] = wb;
        }
    }
}

__device__ __forceinline__ void build_moe_tab(Frame& F, LAS int* tab) {
    __syncthreads();
    if (F.tid < 64) tab[72 + F.tid] = (int)__hip_atomic_load(F.ctl + CW_CNT + F.tid, __ATOMIC_RELAXED, __HIP_MEMORY_SCOPE_AGENT);
    __syncthreads();
    if (F.tid == 0) { int s = 0; for (int e = 0; e < 64; ++e) { tab[e] = s; s += (tab[72 + e] + 255) >> 8; } tab[64] = s; }
    __syncthreads();
}

__device__ __forceinline__ void ph_final(Frame& F) {
    float* v = F.out; const bf16_t* y2 = (const bf16_t*)(F.ws + WS_Y2);
    const float* mod = (const float*)(F.ws + WS_MOD); const float* g2 = F.in[I_LN2G]; const float* b2 = F.in[I_LN2B];
    const int gw = F.vcu * NWAVES + F.wave, NGW = F.G * NWAVES;
    for (int row = gw; row < T; row += NGW) {
        const int b = row / SEQ;
        f32x4* xr = (f32x4*)(v + (size_t)row * DM) + F.lane;
        const unsigned long long* ya = (const unsigned long long*)(y2 + (size_t)(2 * row) * DM) + F.lane;
        const unsigned long long* yb = (const unsigned long long*)(y2 + (size_t)(2 * row + 1) * DM) + F.lane;
        f32x4 x[4]; float s = 0.f;
#pragma unroll
        for (int j = 0; j < 4; ++j) { const int k = 4 * F.lane + 256 * j;
            const f32x4 gt = *(const f32x4*)(mod + (size_t)b * 6144 + 5120 + k);
            const unsigned long long a = ya[64 * j], c = yb[64 * j];
            f32x4 y; y[0] = bflo((unsigned)a) + bflo((unsigned)c); y[1] = bfhi((unsigned)a) + bfhi((unsigned)c);
            y[2] = bflo((unsigned)(a >> 32)) + bflo((unsigned)(c >> 32)); y[3] = bfhi((unsigned)(a >> 32)) + bfhi((unsigned)(c >> 32));
            x[j] = xr[64 * j] * DN_ALPHA + gt * y; s += (x[j][0] + x[j][1]) + (x[j][2] + x[j][3]); }
        const float mean = wave_sum(s) * (1.f / DM); float s2 = 0.f;
#pragma unroll
        for (int j = 0; j < 4; ++j) { x[j] = x[j] - mean; s2 += (x[j][0] * x[j][0] + x[j][1] * x[j][1]) + (x[j][2] * x[j][2] + x[j][3] * x[j][3]); }
        const float rstd = 1.f / sqrtf(wave_sum(s2) * (1.f / DM) + LN_EPS);
#pragma unroll
        for (int j = 0; j < 4; ++j) { const int k = 4 * F.lane + 256 * j; xr[64 * j] = x[j] * rstd * *(const f32x4*)(g2 + k) + *(const f32x4*)(b2 + k); }
    }
}

constexpr int N_PHASES = 12;
__device__ __forceinline__ Frame make_frame(const Args& args, unsigned char* lds) {
    Frame F;
    F.lds = (LAS unsigned char*)lds; F.ws = args.ws; F.ctl = (unsigned*)(args.ws + WS_CTL);
    F.tid = threadIdx.x; F.lane = F.tid & 63; F.wave = __builtin_amdgcn_readfirstlane(F.tid >> 6);
    F.G = gridDim.x; { const int bx = blockIdx.x; F.vcu = (F.G % 8 == 0) ? (bx % 8) * (F.G / 8) + bx / 8 : bx; }
    F.in = args.in; F.out = args.out;
    return F;
}
template <unsigned PH_MASK> __global__ void __launch_bounds__(NTHREADS, 2) mk_fwd(Args args) {
    extern __shared__ __attribute__((aligned(16))) unsigned char lds[];
    for (int u = threadIdx.x; u < (LDS_BYTES - LDSCTL_OFF) / 4; u += NTHREADS) ((LAS unsigned*)((LAS unsigned char*)lds + LDSCTL_OFF))[u] = 0u;
    __syncthreads();
    constexpr bool multi = (PH_MASK & (PH_MASK - 1u)) != 0u;
    if (multi) xcd_barrier_post((unsigned*)(args.ws + WS_CTL) + CW_BAR);
#define IN(k) ((PH_MASK >> (k)) & 1u)
#define SEAM(k) do { if (IN(k) && IN((k) + 1)) xcd_barrier((unsigned*)(args.ws + WS_CTL) + CW_BAR, (volatile LAS unsigned*)((LAS unsigned char*)lds + MISC_OFF) + 8); } while (0)
#define RING ((LAS unsigned char*)lds)
#define TAB ((LAS int*)((LAS unsigned char*)lds + TAB_OFF))

    if (IN(0)) { Frame F = make_frame(args, lds); ph_prep(F); } SEAM(0);
    if (IN(1)) { Frame F = make_frame(args, lds); ph_hb(F); } SEAM(1);
    if (IN(2)) {
        { pg8::DenseSched S; S.init(T, N1A, DM, gridDim.x, (int)blockIdx.x, args.ws + WS_WIN);
          pg8::EpiInA E{(bf16_t*)(args.ws + WS_Q), (bf16_t*)(args.ws + WS_K), (bf16_t*)(args.ws + WS_V), (bf16_t*)(args.ws + WS_GA), (bf16_t*)(args.ws + WS_GH)};
          pg8::gemm_phase<pg8::EpiInA, pg8::DenseSched, true>(RING, args.ws + WS_HB, DM, S, E); }
        { pg8::DenseSched S; S.init(NHY, T, DM, gridDim.x, (int)blockIdx.x, args.ws + WS_HB);
          pg8::EpiBf16 E{(bf16_t*)(args.ws + WS_UT), T};
          pg8::gemm_phase<pg8::EpiBf16, pg8::DenseSched, true>(RING, args.ws + WS_WIN + (size_t)N1A * DM * 2, DM, S, E); }
    } SEAM(2);
    if (IN(3)) { Frame F = make_frame(args, lds); ph_attn(F); ph_hyena_direct(F); } SEAM(3);
    if (IN(4)) { Frame F = make_frame(args, lds); ph_hyT(F); } SEAM(4);
    if (IN(5)) {
        pg8::DenseSched S; S.init(T, DM, AW, gridDim.x, (int)blockIdx.x, args.ws + WS_WA);
        pg8::EpiGate<false> E{(const bf16_t*)(args.ws + WS_GA), nullptr, (bf16_t*)(args.ws + WS_TMP)};
        pg8::gemm_phase<pg8::EpiGate<false>, pg8::DenseSched, true>(RING, args.ws + WS_ATT, AW, S, E);
    } SEAM(5);
    if (IN(6)) {
        pg8::DenseSched S; S.init(T, DM, HW, gridDim.x, (int)blockIdx.x, args.ws + WS_WH);
        pg8::EpiGate<true> E{(const bf16_t*)(args.ws + WS_GH), (const bf16_t*)(args.ws + WS_TMP), (bf16_t*)(args.ws + WS_HB)};
        pg8::gemm_phase<pg8::EpiGate<true>, pg8::DenseSched, true>(RING, args.ws + WS_HY, HW, S, E);
    } SEAM(6);
    if (IN(7)) {
        { pg8::DenseSched S; S.init(T, DM, DM, gridDim.x, (int)blockIdx.x, args.ws + WS_WO);
          pg8::EpiRes E{args.in[I_X], (const float*)(args.ws + WS_MOD) + 2048, args.out};
          pg8::gemm_phase<pg8::EpiRes, pg8::DenseSched, true>(RING, args.ws + WS_HB, DM, S, E); }
        { Frame F = make_frame(args, lds); ph_expert_cvt(F); }
    } SEAM(7);
    if (IN(8)) { Frame F = make_frame(args, lds); ph_ln1_route(F); } SEAM(8);
    if (IN(9)) {
        { Frame F = make_frame(args, lds); build_moe_tab(F, TAB); }
        const int G = gridDim.x, bx = blockIdx.x, vcu = (G % 8 == 0) ? (bx % 8) * (G / 8) + bx / 8 : bx;
        pg8::MoeSched S{TAB, (const int*)(args.ws + WS_BTOK), (const char*)(args.ws + WS_W13), (size_t)DM * DM * 2, G, vcu, DM, true};
        pg8::EpiSwiGLU E{(bf16_t*)(args.ws + WS_HACT)};
        pg8::gemm_phase<pg8::EpiSwiGLU, pg8::MoeSched, true>(RING, args.ws + WS_HB, DM, S, E);
    } SEAM(9);
    if (IN(10)) {
        { Frame F = make_frame(args, lds); build_moe_tab(F, TAB); }
        const int G = gridDim.x, bx = blockIdx.x, vcu = (G % 8 == 0) ? (bx % 8) * (G / 8) + bx / 8 : bx;
        pg8::MoeSched S{TAB, (const int*)(args.ws + WS_BTOK), (const char*)(args.ws + WS_W2), (size_t)DM * DE * 2, G, vcu, DE, false};
        pg8::EpiScatter E{(bf16_t*)(args.ws + WS_Y2), (const int*)(args.ws + WS_BTOK), (const float*)(args.ws + WS_BW), TAB};
        pg8::gemm_phase<pg8::EpiScatter, pg8::MoeSched, true>(RING, args.ws + WS_HACT, DE, S, E);
    } SEAM(10);
    if (IN(11)) { Frame F = make_frame(args, lds); ph_final(F); }
#undef IN
#undef SEAM
#undef RING
#undef TAB
}

extern "C" void kernel_launch(void* const* d_in, const int* in_sizes, int n_in, void* d_out, int out_size, void* d_ws, size_t ws_size, hipStream_t stream) {
    static int grid = 0;
    if (grid == 0) {
        if (n_in != 31 || out_size != T * DM || ws_size < WS_END) { fprintf(stderr, "kernel_launch: unexpected shapes: n_in %d out %d ws %zu (need %zu)\n", n_in, out_size, ws_size, (size_t)WS_END); grid = -1; return; }
        int dev = 0, cus = 0;
        if (hipGetDevice(&dev) != hipSuccess || hipDeviceGetAttribute(&cus, hipDeviceAttributeMultiprocessorCount, dev) != hipSuccess) { grid = -1; return; }
        bool ok = true;
#define SET_ATTR(m) ok = ok && (hipFuncSetAttribute((const void*)mk_fwd<(m)>, hipFuncAttributeMaxDynamicSharedMemorySize, LDS_BYTES) == hipSuccess)
#if MK_N_LAUNCHES == 1
        SET_ATTR(0xFFFu);
#else
        { SET_ATTR(1u << 0); SET_ATTR(1u << 1); SET_ATTR(1u << 2); SET_ATTR(1u << 3); SET_ATTR(1u << 4); SET_ATTR(1u << 5); SET_ATTR(1u << 6); SET_ATTR(1u << 7); SET_ATTR(1u << 8); SET_ATTR(1u << 9); SET_ATTR(1u << 10); SET_ATTR(1u << 11); }
#endif
#undef SET_ATTR
        if (!ok) { fprintf(stderr, "kernel_launch: hipFuncSetAttribute failed\n"); grid = -1; return; }
        (void)hipGetLastError();
        grid = cus;
    }
    if (grid < 0) return;
    if (hipMemsetAsync((char*)d_ws + WS_CTL, 0, CTL_ZERO_BYTES, stream) != hipSuccess) return;
    Args a{};
    for (int i = 0; i < 31; ++i) a.in[i] = (const float*)d_in[i];
    a.out = (float*)d_out; a.ws = (unsigned char*)d_ws;
#if MK_N_LAUNCHES == 1
    a.ph_lo = 0; a.ph_hi = N_PHASES; hipLaunchKernelGGL(mk_fwd<0xFFFu>, dim3(grid), dim3(NTHREADS), LDS_BYTES, stream, a);
#else
    {
#define LAUNCH_PH(p) do { a.ph_lo = (p); a.ph_hi = (p) + 1; hipLaunchKernelGGL(mk_fwd<(1u << (p))>, dim3(grid), dim3(NTHREADS), LDS_BYTES, stream, a); } while (0)
        LAUNCH_PH(0); LAUNCH_PH(1); LAUNCH_PH(2); LAUNCH_PH(3); LAUNCH_PH(4); LAUNCH_PH(5); LAUNCH_PH(6); LAUNCH_PH(7); LAUNCH_PH(8); LAUNCH_PH(9); LAUNCH_PH(10); LAUNCH_PH(11);
#undef LAUNCH_PH
    }
#endif
}
```

```cpp
#include <hip/hip_runtime.h>
#include <cstdio>
#include <cstdint>

#ifndef FUSED_MASK
#define FUSED_MASK 0xFFFu
#endif
#ifndef MK_N_LAUNCHES
#define MK_N_LAUNCHES 1
#endif

#define GAS __attribute__((address_space(1)))
#define LAS __attribute__((address_space(3)))
typedef unsigned short bf16_t;
typedef short bf16x8 __attribute__((ext_vector_type(8)));
typedef float f32x4 __attribute__((ext_vector_type(4)));
typedef float f32x2 __attribute__((ext_vector_type(2)));
typedef unsigned u32x4 __attribute__((ext_vector_type(4)));
typedef unsigned u32x2 __attribute__((ext_vector_type(2)));

constexpr int NB = 4, SEQ = 8192, DM = 1024, T = NB * SEQ;
constexpr int AW = 512, KVW = 128, HW = 512, INW = 4352, N1A = 2816, NHY = 1536;
constexpr int NE = 64, DE = 512, ECAP = 32768;
constexpr int NFILT = 2048, FH = 64, FEMB = 33;
constexpr float LN_EPS = 1e-5f;
constexpr float DN_ALPHA = 1.189207115002721f;
constexpr int NTHREADS = 512, NWAVES = 8;

constexpr size_t MiB = 1u << 20;
constexpr size_t WS_CTL = 0, CTL_ZERO_BYTES = 1 * MiB;
constexpr size_t WS_MODP = 1 * MiB, WS_MOD = 3 * MiB, WS_HDN = 4 * MiB, WS_WRT = 6 * MiB, WS_WIN = 7 * MiB;
constexpr size_t WS_WA = 16 * MiB, WS_WH = 17 * MiB, WS_WO = 18 * MiB, WS_BTOK = 20 * MiB, WS_BW = 28 * MiB;
constexpr size_t WS_HB = 36 * MiB;
constexpr size_t WS_Q = 100 * MiB, WS_K = 132 * MiB, WS_V = 140 * MiB, WS_GA = 148 * MiB, WS_GH = 212 * MiB;
constexpr size_t WS_UT = 276 * MiB, WS_TMP = 276 * MiB;
constexpr size_t WS_ATT = 372 * MiB, WS_HYT = 404 * MiB, WS_HY = 436 * MiB;
constexpr size_t WS_W13 = 100 * MiB, WS_W2 = 228 * MiB, WS_HACT = 292 * MiB, WS_Y2 = 372 * MiB, WS_END = 500 * MiB;
constexpr size_t WS_FTAB = 15 * MiB + 524288;
constexpr size_t WS_TWT = 15 * MiB + 524288 + 73728;
constexpr size_t WS_KHAT = 36 * MiB;
constexpr size_t WS_GT = 436 * MiB;
constexpr size_t WS_KRAW = 468 * MiB;
constexpr size_t WS_KPART = 6 * MiB + 524288;  constexpr size_t WS_HDNB = WS_HDN;
constexpr int CW_BAR = 4096, CW_CNT = 8192;

constexpr int RING_BYTES = 131072, LDS_BYTES = 163840, LDSCTL_OFF = LDS_BYTES - 2048, MISC_OFF = LDSCTL_OFF + 320, TAB_OFF = LDSCTL_OFF + 1024;

#define LDS_WAIT() asm volatile("s_waitcnt lgkmcnt(0)" ::: "memory")
#define VM_WAIT() asm volatile("s_waitcnt vmcnt(0)" ::: "memory")
__device__ __forceinline__ unsigned f2bf(float f) { unsigned u = __builtin_bit_cast(unsigned, f); return (u + 0x7fffu + ((u >> 16) & 1u)) >> 16; }
__device__ __forceinline__ unsigned pk2(float lo, float hi) { return f2bf(lo) | (f2bf(hi) << 16); }
__device__ __forceinline__ float bf2f(unsigned short b) { return __builtin_bit_cast(float, (unsigned)b << 16); }
__device__ __forceinline__ float bflo(unsigned w) { return __builtin_bit_cast(float, w << 16); }
__device__ __forceinline__ float bfhi(unsigned w) { return __builtin_bit_cast(float, w & 0xffff0000u); }
__device__ __forceinline__ float sigmoidf_(float x) { return 1.0f / (1.0f + __expf(-x)); }
__device__ __forceinline__ float wave_sum(float v) {
#pragma unroll
    for (int o = 1; o < 64; o <<= 1) v += __shfl_xor(v, o);
    return v;
}

namespace pg8 {
constexpr int BM = 256, BK = 64, HALF = 128, HTB = HALF * BK * 2, STAGE_BYTES = 8 * HTB, NXCD = 8, WGM = 8;
__host__ __device__ __forceinline__ int lds_byte(int r, int c) { const int st = (r >> 4) * 2 + (c >> 5), rr = r & 15, cc = c & 31, ob = rr * 64 + cc * 2; return st * 1024 + (ob ^ (((ob >> 9) & 1) << 5)); }
__host__ __device__ __forceinline__ void stage_rc(int b, int& R, int& C) { const int st = b / 1024, sb = b % 1024, swz = sb ^ (((sb >> 9) & 1) << 5); R = (st >> 1) * 16 + swz / 64; C = (st & 1) * 32 + (swz % 64) / 2; }
__host__ __device__ __forceinline__ int perm32(int rho) { const int n = rho >> 4, i = rho & 15; return 8 * (i >> 2) + 4 * n + (i & 3); }

struct Unit { int pm, pn, e, mt; };

struct DenseSched {
    int nM, nN, nwg, G, c, K; const char* Bt;
    __device__ void init(int M, int N, int K_, int G_, int c_, const void* Bt_) { nM = M / BM; nN = N / BM; nwg = nM * nN; G = G_; c = c_; K = K_; Bt = (const char*)Bt_; }
    __device__ bool next(int i, Unit& u) const {
        const long L = (long)i * G + c; if (L >= nwg) return false;
        int wgid = (int)L; { const int q = nwg / NXCD, r = nwg % NXCD, xcd = wgid % NXCD, off = wgid / NXCD; wgid = (xcd < r ? xcd * (q + 1) : r * (q + 1) + (xcd - r) * q) + off; }
        const int nig = WGM * nN, gid = wgid / nig, fm = gid * WGM, gsz = (nM - fm) < WGM ? (nM - fm) : WGM;
        u.pm = fm + ((wgid % nig) % gsz); u.pn = (wgid % nig) / gsz; u.e = 0; u.mt = 0; return true;
    }
    __device__ __forceinline__ unsigned arow(const Unit& u, int r) const { return (unsigned)(u.pm * BM + r); }
    __device__ __forceinline__ const char* bptr(const Unit& u) const { return Bt + (size_t)u.pn * BM * K * 2; }
};

struct MoeSched {
    const LAS int* tab;
    const int* btok;
    const char* Bt; size_t estride; int G, v, K; bool gather;
    __device__ bool next(int i, Unit& u) const {
        const int L = i * G + v; const int tile = L >> 2; if (tile >= tab[64]) return false;
        int e = 0;
        for (int j = 1; j < 64; ++j) e += (tab[j] <= tile) ? 1 : 0;
        u.e = e; u.mt = tile - tab[e]; u.pm = tile; u.pn = L & 3; return true;
    }
    __device__ __forceinline__ unsigned arow(const Unit& u, int r) const {
        if (!gather) return (unsigned)(u.pm * BM + r);
        const int idx = u.mt * BM + r; const int cnt = tab[72 + u.e];
        unsigned tok = 0; if (idx < cnt) tok = (unsigned)btok[(size_t)u.e * ECAP + idx] >> 1;
        return tok;
    }
    __device__ __forceinline__ const char* bptr(const Unit& u) const { return Bt + (size_t)u.e * estride + (size_t)u.pn * BM * K * 2; }
};

template <class Epi, class Sched, bool ALIGN_EPI>
__device__ __forceinline__ void gemm_phase(LAS unsigned char* lds, const void* Abase, const int K, const Sched& S, const Epi& E) {
    int tid = threadIdx.x; asm volatile("" : "+v"(tid));
    const int wid = __builtin_amdgcn_readfirstlane(tid >> 6), lane = tid & 63, wr = wid >> 2, wc = wid & 3, fr = lane & 15, fq = lane >> 4;
    const int nt = K / BK;
    int Rr[2], Cc[2]; unsigned voffB[2];
#pragma unroll
    for (int i = 0; i < 2; ++i) { stage_rc(tid * 16 + i * 8192, Rr[i], Cc[i]); const int Rb = Epi::PERM ? ((Rr[i] & ~31) + perm32(Rr[i] & 31)) : Rr[i]; voffB[i] = (unsigned)(Rb * K + Cc[i]) * 2u; }
    const size_t kstep = (size_t)(BK * 2);
    const size_t hstep = (size_t)HALF * K * 2;
    const unsigned ldsw = (unsigned)wid * 1024u;
    const int aoff = lds_byte(wr * 64 + fr, fq * 8), boff = lds_byte(wc * 32 + fr, fq * 8);
#define PG8_SA(b, h) (((b) * 2 + (h)) * HTB)
#define PG8_SB(b, h) ((4 + (b) * 2 + (h)) * HTB)
#define PG8_STAGE(bufoff, gbase, voff) do { _Pragma("unroll") for (int _i = 0; _i < 2; ++_i) \
        __builtin_amdgcn_global_load_lds((const unsigned*)((const char*)(gbase) + (voff)[_i]), (LAS unsigned*)(lds + (bufoff) + ldsw + _i * 8192), 16, 0, 0); } while (0)
#define PG8_LDA(dst, b, h) do { _Pragma("unroll") for (int m = 0; m < 4; ++m) _Pragma("unroll") for (int k = 0; k < 2; ++k) dst[m][k] = *(const LAS bf16x8*)(lds + PG8_SA(b, h) + aoff + m * 2048 + k * 1024); } while (0)
#define PG8_LDB(dst, b, h) do { _Pragma("unroll") for (int n = 0; n < 2; ++n) _Pragma("unroll") for (int k = 0; k < 2; ++k) dst[n][k] = *(const LAS bf16x8*)(lds + PG8_SB(b, h) + boff + n * 2048 + k * 1024); } while (0)
#define PG8_MMA(ai, bj, At, Bt) do { __builtin_amdgcn_s_setprio(1); _Pragma("unroll") for (int m = 0; m < 4; ++m) _Pragma("unroll") for (int n = 0; n < 2; ++n) _Pragma("unroll") for (int k = 0; k < 2; ++k) \
        acc[ai][bj][m][n] = __builtin_amdgcn_mfma_f32_16x16x32_bf16(Bt[n][k], At[m][k], acc[ai][bj][m][n], 0, 0, 0); __builtin_amdgcn_s_setprio(0); } while (0)
#define PG8_WAIT_V(n) asm volatile("s_waitcnt vmcnt(" #n ")" ::: "memory")
#define PG8_WAIT_L(n) asm volatile("s_waitcnt lgkmcnt(" #n ")" ::: "memory")
#define PG8_BAR __builtin_amdgcn_s_barrier()
#define PG8_SCHED __builtin_amdgcn_sched_barrier(0)
    Unit cur, nxt; int ui = 0;
    if (!S.next(0, cur)) return;
    f32x4 acc[2][2][4][2];
#pragma unroll
    for (int a = 0; a < 2; ++a)
#pragma unroll
        for (int b = 0; b < 2; ++b)
#pragma unroll
            for (int m = 0; m < 4; ++m)
#pragma unroll
                for (int n = 0; n < 2; ++n) acc[a][b][m][n] = (f32x4){0.f, 0.f, 0.f, 0.f};
    bf16x8 At[4][2], B0[2][2], B1[2][2];
    unsigned cv0[2], cv1[2], nv0[2], nv1[2];
#pragma unroll
    for (int i = 0; i < 2; ++i) { cv0[i] = (S.arow(cur, Rr[i]) * (unsigned)K + (unsigned)Cc[i]) * 2u; cv1[i] = (S.arow(cur, HALF + Rr[i]) * (unsigned)K + (unsigned)Cc[i]) * 2u; }
    const char* const cA = (const char*)Abase;
    const char* cB = S.bptr(cur);
    PG8_STAGE(PG8_SB(0, 0), cB, voffB); PG8_STAGE(PG8_SB(0, 1), cB + hstep, voffB); PG8_STAGE(PG8_SA(0, 0), cA, cv0); PG8_STAGE(PG8_SA(0, 1), cA, cv1);
    if (wr == 1) PG8_BAR;
    PG8_WAIT_V(2); PG8_BAR;
    PG8_STAGE(PG8_SB(1, 0), cB + kstep, voffB); PG8_STAGE(PG8_SA(1, 0), cA + kstep, cv0); PG8_STAGE(PG8_SB(1, 1), cB + hstep + kstep, voffB);
    PG8_WAIT_V(6); PG8_BAR;
    for (;;) {
        const bool has_next = S.next(ui + 1, nxt);
        const char* nB = has_next ? S.bptr(nxt) : cB;
#pragma unroll
        for (int i = 0; i < 2; ++i) {
            nv0[i] = has_next ? (S.arow(nxt, Rr[i]) * (unsigned)K + (unsigned)Cc[i]) * 2u : cv0[i];
            nv1[i] = has_next ? (S.arow(nxt, HALF + Rr[i]) * (unsigned)K + (unsigned)Cc[i]) * 2u : cv1[i];
        }
        for (int t = 0; t < nt; t += 2) {
            const bool last = (t == nt - 2);
            const char* a1 = cA + (size_t)(t + 1) * kstep;
            const char* a2 = last ? cA : cA + (size_t)(t + 2) * kstep; const char* b2 = last ? nB : cB + (size_t)(t + 2) * kstep;
            const char* a3 = a2 + kstep; const char* b3 = b2 + kstep;
            unsigned x0[2], x1[2];
#pragma unroll
            for (int i = 0; i < 2; ++i) { x0[i] = last ? nv0[i] : cv0[i]; x1[i] = last ? nv1[i] : cv1[i]; }
            PG8_LDB(B0, 0, 0); PG8_LDB(B1, 0, 1); PG8_SCHED; PG8_LDA(At, 0, 0); PG8_STAGE(PG8_SA(1, 1), a1, cv1);
            PG8_WAIT_V(8); PG8_WAIT_L(0); PG8_BAR; PG8_MMA(0, 0, At, B0); PG8_MMA(0, 1, At, B1); PG8_BAR; PG8_SCHED;
            PG8_LDA(At, 0, 1); PG8_STAGE(PG8_SB(0, 0), b2, voffB); PG8_STAGE(PG8_SB(0, 1), b2 + hstep, voffB); PG8_STAGE(PG8_SA(0, 0), a2, x0);
            PG8_WAIT_V(8); PG8_WAIT_L(0); PG8_BAR; PG8_MMA(1, 0, At, B0); PG8_MMA(1, 1, At, B1); PG8_BAR; PG8_SCHED;
            PG8_LDB(B0, 1, 0); PG8_LDB(B1, 1, 1); PG8_SCHED; PG8_LDA(At, 1, 0); PG8_STAGE(PG8_SA(0, 1), a2, x1);
            PG8_WAIT_V(8); PG8_WAIT_L(0); PG8_BAR; PG8_MMA(0, 0, At, B0); PG8_MMA(0, 1, At, B1); PG8_BAR; PG8_SCHED;
            PG8_LDA(At, 1, 1); PG8_STAGE(PG8_SB(1, 0), b3, voffB); PG8_STAGE(PG8_SB(1, 1), b3 + hstep, voffB); PG8_STAGE(PG8_SA(1, 0), a3, x0);
            PG8_WAIT_V(8); PG8_WAIT_L(0); PG8_BAR; PG8_MMA(1, 0, At, B0); PG8_MMA(1, 1, At, B1); PG8_BAR; PG8_SCHED;
        }
        if constexpr (ALIGN_EPI) { if (wr == 0) PG8_BAR; }
        E(acc, cur, wr, wc, fr, fq);
        if (!has_next) break;
#pragma unroll
        for (int a = 0; a < 2; ++a)
#pragma unroll
            for (int b = 0; b < 2; ++b)
#pragma unroll
                for (int m = 0; m < 4; ++m)
#pragma unroll
                    for (int n = 0; n < 2; ++n) acc[a][b][m][n] = (f32x4){0.f, 0.f, 0.f, 0.f};
        cur = nxt; cB = nB; ++ui;
#pragma unroll
        for (int i = 0; i < 2; ++i) { cv0[i] = nv0[i]; cv1[i] = nv1[i]; }
        if constexpr (ALIGN_EPI) { if (wr == 1) PG8_BAR; }
    }
    PG8_WAIT_V(0);
    if constexpr (!ALIGN_EPI) { if (wr == 0) PG8_BAR; }
    PG8_BAR;
#undef PG8_SA
#undef PG8_SB
#undef PG8_STAGE
#undef PG8_LDA
#undef PG8_LDB
#undef PG8_MMA
#undef PG8_WAIT_V
#undef PG8_WAIT_L
#undef PG8_BAR
#undef PG8_SCHED
}

__device__ __forceinline__ u32x4 pack8(const f32x4 v0, const f32x4 v1) { u32x4 w; w.x = pk2(v0[0], v0[1]); w.y = pk2(v0[2], v0[3]); w.z = pk2(v1[0], v1[1]); w.w = pk2(v1[2], v1[3]); return w; }

struct EpiInA {
    static constexpr bool PERM = true;
    bf16_t *Q, *Kb, *Vb, *GA, *GH;
    __device__ __forceinline__ void operator()(const f32x4 (&acc)[2][2][4][2], const Unit& u, int wr, int wc, int fr, int fq) const {
        const int row0 = u.pm * BM + wr * 64 + fr; const int cin = wc * 32 + 8 * fq;
#pragma unroll
        for (int bj = 0; bj < 2; ++bj) {
            bf16_t* base; int ld, col; bool sig = false;
            if (u.pn < 2) { base = Q; ld = AW; col = u.pn * 256 + bj * 128 + cin; }
            else if (u.pn == 2) { base = bj == 0 ? Kb : Vb; ld = KVW; col = cin; }
            else if (u.pn < 7) { base = GA; ld = DM; col = (u.pn - 3) * 256 + bj * 128 + cin; sig = true; }
            else { base = GH; ld = DM; col = (u.pn - 7) * 256 + bj * 128 + cin; sig = true; }
#pragma unroll
            for (int ai = 0; ai < 2; ++ai)
#pragma unroll
                for (int m = 0; m < 4; ++m) {
                    f32x4 v0 = acc[ai][bj][m][0], v1 = acc[ai][bj][m][1];
                    if (sig) {
#pragma unroll
                        for (int j = 0; j < 4; ++j) { v0[j] = sigmoidf_(v0[j]); v1[j] = sigmoidf_(v1[j]); }
                    }
                    *(u32x4*)(base + (size_t)(row0 + ai * HALF + m * 16) * ld + col) = pack8(v0, v1);
                }
        }
    }
};
struct EpiBf16 {
    static constexpr bool PERM = true;
    bf16_t* O; int ldc;
    __device__ __forceinline__ void operator()(const f32x4 (&acc)[2][2][4][2], const Unit& u, int wr, int wc, int fr, int fq) const {
        const int row0 = u.pm * BM + wr * 64 + fr; const int col0 = u.pn * BM + wc * 32 + 8 * fq;
#pragma unroll
        for (int ai = 0; ai < 2; ++ai)
#pragma unroll
            for (int m = 0; m < 4; ++m)
#pragma unroll
                for (int bj = 0; bj < 2; ++bj)
                    *(u32x4*)(O + (size_t)(row0 + ai * HALF + m * 16) * ldc + col0 + bj * HALF) = pack8(acc[ai][bj][m][0], acc[ai][bj][m][1]);
    }
};
template <bool ADD> struct EpiGate {
    static constexpr bool PERM = true;
    const bf16_t* G; const bf16_t* P; bf16_t* O;
    __device__ __forceinline__ void operator()(const f32x4 (&acc)[2][2][4][2], const Unit& u, int wr, int wc, int fr, int fq) const {
        const int row0 = u.pm * BM + wr * 64 + fr; const int col0 = u.pn * BM + wc * 32 + 8 * fq;
#pragma unroll
        for (int ai = 0; ai < 2; ++ai)
#pragma unroll
            for (int m = 0; m < 4; ++m)
#pragma unroll
                for (int bj = 0; bj < 2; ++bj) {
                    const size_t off = (size_t)(row0 + ai * HALF + m * 16) * DM + col0 + bj * HALF;
                    const u32x4 g = *(const u32x4*)(G + off);
                    f32x4 v0 = acc[ai][bj][m][0], v1 = acc[ai][bj][m][1];
                    v0[0] *= bflo(g.x); v0[1] *= bfhi(g.x); v0[2] *= bflo(g.y); v0[3] *= bfhi(g.y);
                    v1[0] *= bflo(g.z); v1[1] *= bfhi(g.z); v1[2] *= bflo(g.w); v1[3] *= bfhi(g.w);
                    if (ADD) { const u32x4 p = *(const u32x4*)(P + off);
                        v0[0] += bflo(p.x); v0[1] += bfhi(p.x); v0[2] += bflo(p.y); v0[3] += bfhi(p.y);
                        v1[0] += bflo(p.z); v1[1] += bfhi(p.z); v1[2] += bflo(p.w); v1[3] += bfhi(p.w); }
                    *(u32x4*)(O + off) = pack8(v0, v1);
                }
    }
};
struct EpiRes {
    static constexpr bool PERM = false;
    const float* X; const float* gate; float* O;
    __device__ __forceinline__ void operator()(const f32x4 (&acc)[2][2][4][2], const Unit& u, int wr, int wc, int fr, int fq) const {
        const int row0 = u.pm * BM + wr * 64 + fr; const int col0 = u.pn * BM + wc * 32 + 4 * fq;
        const int b = (u.pm * BM) / SEQ;
#pragma unroll
        for (int bj = 0; bj < 2; ++bj)
#pragma unroll
            for (int n = 0; n < 2; ++n) {
                const int col = col0 + bj * HALF + n * 16;
                const f32x4 gv = *(const f32x4*)(gate + (size_t)b * 6144 + col);
#pragma unroll
                for (int ai = 0; ai < 2; ++ai)
#pragma unroll
                    for (int m = 0; m < 4; ++m) {
                        const size_t off = (size_t)(row0 + ai * HALF + m * 16) * DM + col;
                        const f32x4 xv = *(const f32x4*)(X + off);
                        *(f32x4*)(O + off) = xv * DN_ALPHA + gv * acc[ai][bj][m][n];
                    }
            }
    }
};
struct EpiSwiGLU {
    static constexpr bool PERM = true;
    bf16_t* H;
    __device__ __forceinline__ void operator()(const f32x4 (&acc)[2][2][4][2], const Unit& u, int wr, int wc, int fr, int fq) const {
        const int row0 = u.pm * BM + wr * 64 + fr; const int col0 = u.pn * HALF + wc * 32 + 8 * fq;
#pragma unroll
        for (int ai = 0; ai < 2; ++ai)
#pragma unroll
            for (int m = 0; m < 4; ++m) {
                f32x4 v0, v1;
#pragma unroll
                for (int j = 0; j < 4; ++j) { const float a0 = acc[ai][0][m][0][j], a1 = acc[ai][0][m][1][j];
                    v0[j] = a0 * sigmoidf_(a0) * acc[ai][1][m][0][j]; v1[j] = a1 * sigmoidf_(a1) * acc[ai][1][m][1][j]; }
                *(u32x4*)(H + (size_t)(row0 + ai * HALF + m * 16) * DE + col0) = pack8(v0, v1);
            }
    }
};
struct EpiScatter {
    static constexpr bool PERM = true;
    bf16_t* Y2; const int* btok; const float* bw; const LAS int* tab;
    __device__ __forceinline__ void operator()(const f32x4 (&acc)[2][2][4][2], const Unit& u, int wr, int wc, int fr, int fq) const {
        const int col0 = u.pn * BM + wc * 32 + 8 * fq; const int cnt = tab[72 + u.e];
#pragma unroll
        for (int ai = 0; ai < 2; ++ai)
#pragma unroll
            for (int m = 0; m < 4; ++m) {
                const int idx = u.mt * BM + ai * HALF + wr * 64 + m * 16 + fr;
                if (idx < cnt) {
                    const int dst = btok[(size_t)u.e * ECAP + idx]; const float w = bw[(size_t)u.e * ECAP + idx];
#pragma unroll
                    for (int bj = 0; bj < 2; ++bj)
                        *(u32x4*)(Y2 + (size_t)dst * DM + col0 + bj * HALF) = pack8(acc[ai][bj][m][0] * w, acc[ai][bj][m][1] * w);
                }
            }
    }
};
}

#define XB_TMO      128
#define XB_XCNT(j)  (256  + 64 * (j))
#define XB_XSUB(j)  (1280 + 64 * (j))
#define XB_XGEN(j)  (2304 + 64 * (j))
#define XB_TOP      3328
#define XB_TOPGEN   3392
#define XCD_BAR_WORDS 3456
#define XB_SPIN_CAP (1u << 22)
__device__ __forceinline__ unsigned xb_ld(unsigned* p)              { return __hip_atomic_load(p, __ATOMIC_RELAXED, __HIP_MEMORY_SCOPE_AGENT); }
__device__ __forceinline__ unsigned xb_add(unsigned* p, unsigned v) { return __hip_atomic_fetch_add(p, v, __ATOMIC_RELAXED, __HIP_MEMORY_SCOPE_AGENT); }
__device__ __forceinline__ unsigned xb_xcc_id() { return (unsigned)__builtin_amdgcn_s_getreg((3 << 11) | 20) & 0xFu; }
#define XB_SPIN(cond, bar) do { unsigned _sp = 0; while (cond) { __builtin_amdgcn_s_sleep(1); \
    if ((++_sp & 255u) == 0u) { if (xb_ld(&(bar)[XB_TMO])) break; if (_sp > XB_SPIN_CAP) { atomicAdd(&(bar)[XB_TMO], 1u); break; } } } } while (0)
__device__ __forceinline__ void xcd_barrier_post(unsigned* bar) { if (threadIdx.x == 0) (void)xb_add(&bar[XB_XCNT(xb_xcc_id())], 1u); }
__device__ __forceinline__ void xcd_barrier_complete(unsigned* bar, unsigned x, unsigned& nloc, unsigned& nx) {
    const unsigned G = gridDim.x * gridDim.y * gridDim.z;
    unsigned sum, cnt, mine, sp = 0u;
    for (;;) {
        sum = 0u; cnt = 0u; mine = 0u;
#pragma unroll
        for (unsigned j = 0; j < 16; ++j) { const unsigned c = xb_ld(&bar[XB_XCNT(j)]); sum += c; cnt += (c > 0u) ? 1u : 0u; mine = (j == x) ? c : mine; }
        if (sum == G) break;
        __builtin_amdgcn_s_sleep(1);
        if ((++sp & 255u) == 0u) { if (xb_ld(&bar[XB_TMO])) break; if (sp > XB_SPIN_CAP) { atomicAdd(&bar[XB_TMO], 1u); break; } }
    }
    nloc = mine > 0u ? mine : 1u; nx = cnt > 0u ? cnt : 1u;
}
__device__ __forceinline__ void xcd_barrier(unsigned* bar, volatile LAS unsigned* st) {
    asm volatile("s_waitcnt vmcnt(0)" ::: "memory");
    __syncthreads();
    if (threadIdx.x == 0) {
        const unsigned x = xb_xcc_id();
        __builtin_amdgcn_s_waitcnt(0);
        unsigned nloc = st[0], nx = st[1];
        if (nloc == 0u) { xcd_barrier_complete(bar, x, nloc, nx); st[0] = nloc; st[1] = nx; }
        const unsigned old = xb_add(&bar[XB_XSUB(x)], 1u);
        const unsigned gen = old / nloc;
        if (old + 1u == (gen + 1u) * nloc) {
            __builtin_amdgcn_fence(__ATOMIC_RELEASE, "agent");
            asm volatile("s_waitcnt vmcnt(0)" ::: "memory");
            const unsigned og = xb_add(&bar[XB_TOP], 1u);
            const unsigned tg = og / nx;
            if (og + 1u == (tg + 1u) * nx) xb_add(&bar[XB_TOPGEN], 1u);
            else XB_SPIN(xb_ld(&bar[XB_TOPGEN]) == tg, bar);
            __builtin_amdgcn_fence(__ATOMIC_ACQUIRE, "agent");
            xb_add(&bar[XB_XGEN(x)], 1u);
            asm volatile("s_waitcnt vmcnt(0)" ::: "memory");
        } else {
            XB_SPIN(xb_ld(&bar[XB_XGEN(x)]) == gen, bar);
            __builtin_amdgcn_fence(__ATOMIC_ACQUIRE, "agent");
            asm volatile("s_waitcnt vmcnt(0)" ::: "memory");
        }
    }
    __syncthreads();
}

struct Args { const float* in[31]; float* out; unsigned char* ws; int ph_lo, ph_hi; };
struct Frame {
    LAS unsigned char* lds; unsigned char* ws; unsigned* ctl;
    int tid, lane, wave, vcu, G;
    const float* const* in; float* out;
};
enum { I_X = 0, I_C, I_WADA, I_BADA, I_WIN, I_CONVW, I_CONVB, I_FW1, I_FB1, I_FF1, I_FW2, I_FB2, I_FF2, I_FW3, I_DECAY, I_SKIP, I_WHY, I_WATT, I_SINK, I_WOUT,
       I_LN1G, I_LN1B, I_RGW, I_RGB, I_REW, I_REB, I_EW1, I_EW3, I_EW2, I_LN2G, I_LN2B };

__device__ __forceinline__ void transpose_item(const float* W, int K, int N, bf16_t* WT, int ldt, int drow0, LAS float* scr, int kb, int nb, int lane) {
    const int k0 = 64 * kb, n0 = 32 * nb;
#pragma unroll 8
    for (int i = 0; i < 32; ++i) { const int kk = 2 * i + (lane >> 5); scr[kk * 33 + (lane & 31)] = W[(size_t)(k0 + kk) * N + n0 + (lane & 31)]; }
    LDS_WAIT(); asm volatile("" ::: "memory");
    const int c = lane & 7;
#pragma unroll
    for (int j = 0; j < 4; ++j) { const int n = (lane >> 3) + 8 * j; const LAS float* s = scr + (8 * c) * 33 + n;
        u32x4 o; o.x = pk2(s[0 * 33], s[1 * 33]); o.y = pk2(s[2 * 33], s[3 * 33]); o.z = pk2(s[4 * 33], s[5 * 33]); o.w = pk2(s[6 * 33], s[7 * 33]);
        *(u32x4*)(WT + (size_t)(drow0 + n) * ldt + k0 + 8 * c) = o; }
    LDS_WAIT(); asm volatile("" ::: "memory");
}

__device__ __forceinline__ void ph_prep(Frame& F) {
    const float* c = F.in[I_C]; const float* wada = F.in[I_WADA];
    float* modp = (float*)(F.ws + WS_MODP);
    for (int it = blockIdx.x; it < 192; it += F.G) {
        const int kc = it / 12, cg = it % 12, j = cg * 512 + F.tid;
        float a0 = 0.f, a1 = 0.f, a2 = 0.f, a3 = 0.f;
        for (int kk = 0; kk < 64; ++kk) { const int k = kc * 64 + kk; const float w = wada[(size_t)k * 6144 + j];
            const float c0 = c[k], c1 = c[1024 + k], c2 = c[2048 + k], c3 = c[3072 + k];
            a0 += c0 * sigmoidf_(c0) * w; a1 += c1 * sigmoidf_(c1) * w; a2 += c2 * sigmoidf_(c2) * w; a3 += c3 * sigmoidf_(c3) * w; }
        modp[(size_t)(kc * 4 + 0) * 6144 + j] = a0; modp[(size_t)(kc * 4 + 1) * 6144 + j] = a1; modp[(size_t)(kc * 4 + 2) * 6144 + j] = a2; modp[(size_t)(kc * 4 + 3) * 6144 + j] = a3;
    }
    LAS float* scr = (LAS float*)(F.lds + F.wave * 16384);
    const int gw = F.vcu * NWAVES + F.wave, NGW = F.G * NWAVES;
    constexpr int I_IN = 16 * 136, I_A = 8 * 32, I_H = 8 * 32, I_O = 16 * 32;
    for (int it = gw; it < I_IN + I_A + I_H + I_O; it += NGW) {
        int r = it;
        if (r < I_IN) { const int kb = r / 136, nb = r % 136, n0 = nb * 32;
            const int drow = n0 < 768 ? n0 : (n0 < 2304 ? N1A + (n0 - 768) : 768 + (n0 - 2304));
            transpose_item(F.in[I_WIN], DM, INW, (bf16_t*)(F.ws + WS_WIN), DM, drow, scr, kb, nb, F.lane); continue; } r -= I_IN;
        if (r < I_A) { transpose_item(F.in[I_WATT], AW, DM, (bf16_t*)(F.ws + WS_WA), AW, (r % 32) * 32, scr, r / 32, r % 32, F.lane); continue; } r -= I_A;
        if (r < I_H) { transpose_item(F.in[I_WHY], HW, DM, (bf16_t*)(F.ws + WS_WH), HW, (r % 32) * 32, scr, r / 32, r % 32, F.lane); continue; } r -= I_H;
        transpose_item(F.in[I_WOUT], DM, DM, (bf16_t*)(F.ws + WS_WO), DM, (r % 32) * 32, scr, r / 32, r % 32, F.lane);
    }
    {
        const float* w1 = F.in[I_FW1]; const float* b1 = F.in[I_FB1]; const float* f1 = F.in[I_FF1];
        const float* w2 = F.in[I_FW2]; const float* b2 = F.in[I_FB2]; const float* f2 = F.in[I_FF2];
        const int j = F.lane;
        for (int t = gw; t < SEQ; t += NGW) {
            const float tl = (float)t / (float)(SEQ - 1);
            const float w = 6.283185307179586f * (float)t / (float)SEQ;
            float zi = 0.f;
            if (j == 0) zi = tl;
            else if (j <= 16) { const float band = 1e-4f + (float)(j - 1) * ((15.0f - 1e-4f) / 15.0f); zi = cosf(band * w); }
            else if (j <= 32) { const float band = 1e-4f + (float)(j - 17) * ((15.0f - 1e-4f) / 15.0f); zi = -sinf(band * w); }
            float a = b1[j];
#pragma unroll
            for (int i = 0; i < FEMB; ++i) a += __shfl(zi, i) * w1[i * FH + j];
            const float h1 = sinf(f1[j] * a);
            float a2 = b2[j];
#pragma unroll
            for (int i = 0; i < FH; ++i) a2 += __shfl(h1, i) * w2[i * FH + j];
            ((bf16_t*)(F.ws + WS_HDNB))[(size_t)t * FH + j] = (bf16_t)f2bf(sinf(f2[j] * a2));
        }
    }
    {
        bf16_t* ftab = (bf16_t*)(F.ws + WS_FTAB); float* twt = (float*)(F.ws + WS_TWT);
        for (int i = blockIdx.x * NTHREADS + F.tid; i < 2 * 128 * 128; i += F.G * NTHREADS) {
            const int t = i >> 14, row = (i >> 7) & 127, q = i & 127;
            const int q15 = q & 15, h = q15 >> 3, j = q15 & 7; const int nat = (q & ~15) + 8 * (j >> 2) + 4 * h + (j & 3);
            const int e = (row * nat) & 127; const float x = (float)e * (2.0f / 128.0f);
            const float v = t == 0 ? cospif(x) : -sinpif(x);
            ftab[(size_t)t * (128 * 136) + row * 136 + q] = (bf16_t)f2bf(v);
        }
        for (int i = blockIdx.x * NTHREADS + F.tid; i < 16 * 64 * 16; i += F.G * NTHREADS) {
            const int r = i & 15, l = (i >> 4) & 63, ab = i >> 10, al = ab >> 2, be = ab & 3;
            const int e = ((32 * al + ((r & 3) + 8 * (r >> 2) + 4 * (l >> 5))) * (32 * be + (l & 31))) & 16383; const float x = (float)e * (2.0f / 16384.0f);
            twt[2 * i] = cospif(x); twt[2 * i + 1] = -sinpif(x);
        }
    }
    {
        float* wrt = (float*)(F.ws + WS_WRT); const float* wg = F.in[I_RGW]; const float* we = F.in[I_REW];
        for (int i = blockIdx.x * NTHREADS + F.tid; i < 72 * DM; i += F.G * NTHREADS) { const int o = i / DM, k = i % DM; wrt[i] = o < 8 ? wg[k * 8 + o] : we[k * 64 + (o - 8)]; }
    }
}


__device__ __forceinline__ void ph_taps(Frame& F) {
    typedef float f32x16 __attribute__((ext_vector_type(16)));
    const bf16_t* hb = (const bf16_t*)(F.ws + WS_HDNB); const float* w3 = F.in[I_FW3]; const float* decay = F.in[I_DECAY];
    bf16_t* kraw = (bf16_t*)(F.ws + WS_KRAW); float* kpart = (float*)(F.ws + WS_KPART);
    const int lane = F.lane, lr = lane & 31, lh = lane >> 5;
    for (int it = blockIdx.x; it < 256; it += F.G) {
        const int g = it & 63, tq = it >> 6;
        bf16x8 aW[4];
#pragma unroll
        for (int s = 0; s < 4; ++s) { unsigned pk[4];
#pragma unroll
            for (int j2 = 0; j2 < 4; ++j2) { const int k = 16 * s + 8 * lh + 2 * j2; pk[j2] = pk2(w3[(size_t)k * NFILT + 32 * g + lr], w3[(size_t)(k + 1) * NFILT + 32 * g + lr]); }
            aW[s] = __builtin_bit_cast(bf16x8, (u32x4){pk[0], pk[1], pk[2], pk[3]}); }
        float dcy[16], asum[16];
#pragma unroll
        for (int r = 0; r < 16; ++r) { dcy[r] = fabsf(decay[32 * g + (r & 3) + 8 * (r >> 2) + 4 * lh]); asum[r] = 0.f; }
#pragma unroll 1
        for (int tt = 0; tt < 8; ++tt) {
            const int t = 2048 * tq + 32 * (F.wave * 8 + tt) + lr;
            f32x16 acc;
#pragma unroll
            for (int r = 0; r < 16; ++r) acc[r] = 0.f;
#pragma unroll
            for (int s = 0; s < 4; ++s) { const bf16x8 bH = *(const bf16x8*)(hb + (size_t)t * FH + 16 * s + 8 * lh); acc = __builtin_amdgcn_mfma_f32_32x32x16_bf16(aW[s], bH, acc, 0, 0, 0); }
            const float tl = (float)t / (float)(SEQ - 1);
#pragma unroll
            for (int r = 0; r < 16; ++r) { const float v = acc[r] * (__expf(-tl * dcy[r]) + 0.05f); asum[r] += fabsf(v);
                kraw[(size_t)(32 * g + (r & 3) + 8 * (r >> 2) + 4 * lh) * SEQ + t] = (bf16_t)f2bf(v); }
        }
#pragma unroll
        for (int r = 0; r < 16; ++r) { float v = asum[r];
#pragma unroll
            for (int o = 1; o < 32; o <<= 1) v += __shfl_xor(v, o);
            if (lr == 0) kpart[(size_t)(32 * g + (r & 3) + 8 * (r >> 2) + 4 * lh) * 32 + tq * 8 + F.wave] = v; }
    }
}

__device__ __forceinline__ void ph_hb(Frame& F) {
    const float* modp = (const float*)(F.ws + WS_MODP); const float* bada = F.in[I_BADA];
    float* mod = (float*)(F.ws + WS_MOD);
    for (int i = blockIdx.x * NTHREADS + F.tid; i < NB * 6144; i += F.G * NTHREADS) { const int b = i / 6144, j = i % 6144; float s = bada[j];
        for (int kc = 0; kc < 16; ++kc) s += modp[(size_t)(kc * 4 + b) * 6144 + j];
        mod[i] = s; }
    LAS float* sc = (LAS float*)F.lds; LAS float* sh = sc + DM;
    const float* x = F.in[I_X]; bf16_t* hb = (bf16_t*)(F.ws + WS_HB);
    for (int ch = blockIdx.x; ch < T / 128; ch += F.G) {
        const int b = (ch * 128) / SEQ;
        __syncthreads();
        for (int j = F.tid; j < 2 * DM; j += NTHREADS) { float s = bada[j];
            for (int kc = 0; kc < 16; ++kc) s += modp[(size_t)(kc * 4 + b) * 6144 + j];
            if (j < DM) sh[j] = s; else sc[j - DM] = 1.0f + s; }
        __syncthreads();
        for (int r = F.wave; r < 128; r += NWAVES) {
            const size_t row = (size_t)ch * 128 + r;
            const f32x4* xr = (const f32x4*)(x + row * DM) + F.lane;
            unsigned long long* o8 = (unsigned long long*)(hb + row * DM) + F.lane;
#pragma unroll
            for (int j = 0; j < 4; ++j) { const f32x4 v = xr[64 * j]; const int k = 4 * F.lane + 256 * j;
                const float h0 = v[0] * sc[k] + sh[k], h1 = v[1] * sc[k + 1] + sh[k + 1], h2 = v[2] * sc[k + 2] + sh[k + 2], h3 = v[3] * sc[k + 3] + sh[k + 3];
                o8[64 * j] = (unsigned long long)pk2(h0, h1) | ((unsigned long long)pk2(h2, h3) << 32); }
        }
    }
    __syncthreads();
}

__device__ __forceinline__ void ph_attn(Frame& F) {
    const bf16_t* Q = (const bf16_t*)(F.ws + WS_Q); const bf16_t* Kb = (const bf16_t*)(F.ws + WS_K); const bf16_t* Vb = (const bf16_t*)(F.ws + WS_V);
    bf16_t* O = (bf16_t*)(F.ws + WS_ATT); const float* sink = F.in[I_SINK];
    LAS unsigned* Ks = (LAS unsigned*)F.lds;
    LAS unsigned* Vs = Ks + 384 * 32;
    for (int unit = blockIdx.x; unit < NB * 2 * 64; unit += F.G) {
        const int qb = unit & 63, kvh = (unit >> 6) & 1, b = unit >> 7;
        __syncthreads();
        for (int i = F.tid; i < 384 * 8; i += NTHREADS) {
            const int j = i >> 3, p = i & 7; const int kpos = qb * 128 - 128 + j;
            u32x4 kv = (u32x4){0u, 0u, 0u, 0u}, vv = kv;
            if (kpos >= 0 && kpos < SEQ) { const size_t off = ((size_t)b * SEQ + kpos) * KVW + kvh * 64 + p * 8; kv = *(const u32x4*)(Kb + off); vv = *(const u32x4*)(Vb + off); }
            *(LAS u32x4*)(Ks + j * 32 + p * 4) = kv; *(LAS u32x4*)(Vs + j * 32 + p * 4) = vv;
        }
        __syncthreads();
        const int g = F.tid >> 7, a = F.tid & 127, h = kvh * 4 + g;
        const size_t trow = (size_t)b * SEQ + qb * 128 + a;
        float q[64];
#pragma unroll
        for (int p = 0; p < 8; ++p) { const u32x4 w = *(const u32x4*)(Q + trow * AW + h * 64 + p * 8);
            q[p * 8 + 0] = bflo(w.x); q[p * 8 + 1] = bfhi(w.x); q[p * 8 + 2] = bflo(w.y); q[p * 8 + 3] = bfhi(w.y);
            q[p * 8 + 4] = bflo(w.z); q[p * 8 + 5] = bfhi(w.z); q[p * 8 + 6] = bflo(w.w); q[p * 8 + 7] = bfhi(w.w); }
        const float slope = exp2f(-(float)(h + 1));
        float m = sink[h], l = 1.0f;
        float o[64];
#pragma unroll
        for (int d = 0; d < 64; ++d) o[d] = 0.f;
        for (int j = 0; j < 384; ++j) {
            const int rel = j - 128 - a; const int kpos = qb * 128 - 128 + j;
            const bool valid = (rel >= -128) && (rel <= 128) && (kpos >= 0) && (kpos < SEQ);
            float s = 0.f;
#pragma unroll
            for (int p = 0; p < 8; ++p) { const u32x4 w = *(const LAS u32x4*)(Ks + j * 32 + p * 4);
                s += q[p * 8 + 0] * bflo(w.x) + q[p * 8 + 1] * bfhi(w.x) + q[p * 8 + 2] * bflo(w.y) + q[p * 8 + 3] * bfhi(w.y)
                   + q[p * 8 + 4] * bflo(w.z) + q[p * 8 + 5] * bfhi(w.z) + q[p * 8 + 6] * bflo(w.w) + q[p * 8 + 7] * bfhi(w.w); }
            s = s * 0.125f - slope * fabsf((float)rel);
            if (valid) {
                const float mn = fmaxf(m, s); const float sc = __expf(m - mn); const float pj = __expf(s - mn);
                l = l * sc + pj; m = mn;
#pragma unroll
                for (int p = 0; p < 8; ++p) { const u32x4 w = *(const LAS u32x4*)(Vs + j * 32 + p * 4);
                    o[p * 8 + 0] = o[p * 8 + 0] * sc + pj * bflo(w.x); o[p * 8 + 1] = o[p * 8 + 1] * sc + pj * bfhi(w.x);
                    o[p * 8 + 2] = o[p * 8 + 2] * sc + pj * bflo(w.y); o[p * 8 + 3] = o[p * 8 + 3] * sc + pj * bfhi(w.y);
                    o[p * 8 + 4] = o[p * 8 + 4] * sc + pj * bflo(w.z); o[p * 8 + 5] = o[p * 8 + 5] * sc + pj * bfhi(w.z);
                    o[p * 8 + 6] = o[p * 8 + 6] * sc + pj * bflo(w.w); o[p * 8 + 7] = o[p * 8 + 7] * sc + pj * bfhi(w.w); }
            }
        }
        const float il = 1.0f / l;
#pragma unroll
        for (int p = 0; p < 8; ++p) { u32x4 w; w.x = pk2(o[p * 8 + 0] * il, o[p * 8 + 1] * il); w.y = pk2(o[p * 8 + 2] * il, o[p * 8 + 3] * il);
            w.z = pk2(o[p * 8 + 4] * il, o[p * 8 + 5] * il); w.w = pk2(o[p * 8 + 6] * il, o[p * 8 + 7] * il);
            *(u32x4*)(O + trow * AW + h * 64 + p * 8) = w; }
    }
    __syncthreads();
}

__device__ __forceinline__ float block_sum(Frame& F, float v, LAS float* red) {
    v = wave_sum(v);
    __syncthreads();
    if (F.lane == 0) red[F.wave] = v;
    __syncthreads();
    float s = 0.f;
#pragma unroll
    for (int i = 0; i < NWAVES; ++i) s += red[i];
    return s;
}
__device__ __forceinline__ float shortconv(const bf16_t* row, int t, float w0, float w1, float w2, float bias) {
    const float c = bf2f(row[t]); const float p = t > 0 ? bf2f(row[t - 1]) : 0.f; const float n = t < SEQ - 1 ? bf2f(row[t + 1]) : 0.f;
    return w0 * p + w1 * c + w2 * n + bias;
}
__device__ __forceinline__ void ph_hyena_direct(Frame& F) {
    const bf16_t* UT = (const bf16_t*)(F.ws + WS_UT); bf16_t* HYT = (bf16_t*)(F.ws + WS_HYT);
    const float* hdn = (const float*)(F.ws + WS_HDN); const float* w3 = F.in[I_FW3]; const float* decay = F.in[I_DECAY];
    const float* convw = F.in[I_CONVW]; const float* convb = F.in[I_CONVB]; const float* skip = F.in[I_SKIP];
    LAS float* kc = (LAS float*)F.lds;
    LAS float* z = kc + 16384;
    LAS float* w3s = z + 8192;
    LAS float* red = w3s + 128;
    for (int c = blockIdx.x; c < HW; c += F.G) {
        for (int o = 0; o < 2; ++o) {
            const int colf = o * 1024 + c, colb = o * 1024 + 512 + c;
            __syncthreads();
            if (F.tid < 128) w3s[F.tid] = w3[(size_t)(F.tid & 63) * NFILT + (F.tid < 64 ? colf : colb)];
            if (F.tid == 0) kc[SEQ] = 0.f;
            __syncthreads();
            const float df = fabsf(decay[colf]), db = fabsf(decay[colb]);
            float asum = 0.f;
            for (int i = 0; i < 16; ++i) {
                const int t = F.tid + 512 * i; const f32x4* hr = (const f32x4*)(hdn + (size_t)t * FH);
                float sf = 0.f, sb = 0.f;
#pragma unroll
                for (int k4 = 0; k4 < 16; ++k4) { const f32x4 hv = hr[k4];
                    sf += hv[0] * w3s[k4 * 4] + hv[1] * w3s[k4 * 4 + 1] + hv[2] * w3s[k4 * 4 + 2] + hv[3] * w3s[k4 * 4 + 3];
                    sb += hv[0] * w3s[64 + k4 * 4] + hv[1] * w3s[64 + k4 * 4 + 1] + hv[2] * w3s[64 + k4 * 4 + 2] + hv[3] * w3s[64 + k4 * 4 + 3]; }
                const float tl = (float)t / (float)(SEQ - 1);
                sf *= (__expf(-tl * df) + 0.05f); sb *= (__expf(-tl * db) + 0.05f);
                asum += fabsf(sf) + fabsf(sb);
                kc[t] = sf; if (t > 0) kc[2 * SEQ - t] = sb;
            }
            const float inv = 1.0f / block_sum(F, asum, red);
            for (int i = F.tid; i < 2 * SEQ; i += NTHREADS) kc[i] *= inv;
            const float sk = skip[o * HW + c];
            const int chz = c, chg = (o + 1) * HW + c;
            const float zw0 = convw[chz], zw1 = convw[NHY + chz], zw2 = convw[2 * NHY + chz], zb = convb[chz];
            const float gw0 = convw[chg], gw1 = convw[NHY + chg], gw2 = convw[2 * NHY + chg], gb = convb[chg];
            for (int b = 0; b < NB; ++b) {
                __syncthreads();
                for (int i = 0; i < 16; ++i) { const int t = F.tid + 512 * i;
                    z[t] = (o == 0) ? shortconv(UT + (size_t)chz * T + (size_t)b * SEQ, t, zw0, zw1, zw2, zb) : bf2f(HYT[(size_t)c * T + (size_t)b * SEQ + t]); }
                __syncthreads();
                float acc[16];
#pragma unroll
                for (int i = 0; i < 16; ++i) acc[i] = 0.f;
                for (int s = 0; s < SEQ; ++s) {
                    const float zs = z[s];
#pragma unroll
                    for (int i = 0; i < 16; ++i) acc[i] += zs * kc[(F.tid + 512 * i - s) & (2 * SEQ - 1)];
                }
#pragma unroll
                for (int i = 0; i < 16; ++i) { const int t = F.tid + 512 * i;
                    const float gate = shortconv(UT + (size_t)chg * T + (size_t)b * SEQ, t, gw0, gw1, gw2, gb);
                    const float y = acc[i] + sk * z[t];
                    HYT[(size_t)c * T + (size_t)b * SEQ + t] = (bf16_t)f2bf(gate * y); }
            }
        }
    }
    __syncthreads();
}


namespace hy {
typedef float f32x16 __attribute__((ext_vector_type(16)));
typedef __bf16 bf16x2_t __attribute__((ext_vector_type(2)));
constexpr int ROWB = 272, TABB = 128 * ROWB, DROWB = 528, FT_OFF = 0, X_OFF = 2 * TABB, SP_OFF = 4 * TABB;
#define HY_SBAR() do { asm volatile("" ::: "memory"); __builtin_amdgcn_sched_barrier(0); } while (0)
#define MFMA32(a, b, c) __builtin_amdgcn_mfma_f32_32x32x16_bf16((a), (b), (c), 0, 0, 0)
__device__ __forceinline__ int crow(int r, int h) { return (r & 3) + 8 * (r >> 2) + 4 * h; }
__device__ __forceinline__ int q16(int c) { return 8 * ((c >> 2) & 1) + 4 * (c >> 3) + (c & 3); }
__device__ __forceinline__ int kstore(int k) { return (k & ~15) + q16(k & 15); }
__device__ __forceinline__ unsigned cvtpk(float lo, float hi) { f32x2 v = {lo, hi}; bf16x2_t b = __builtin_convertvector(v, bf16x2_t); return __builtin_bit_cast(unsigned, b); }
__device__ __forceinline__ bf16x8 neg8(bf16x8 v) { u32x4 u = __builtin_bit_cast(u32x4, v); u.x ^= 0x80008000u; u.y ^= 0x80008000u; u.z ^= 0x80008000u; u.w ^= 0x80008000u; return __builtin_bit_cast(bf16x8, u); }
template <int S> __device__ __forceinline__ bf16x8 pack_step(const f32x16& x) {
    u32x4 p; p.x = cvtpk(x[8 * S], x[8 * S + 1]); p.y = cvtpk(x[8 * S + 2], x[8 * S + 3]); p.z = cvtpk(x[8 * S + 4], x[8 * S + 5]); p.w = cvtpk(x[8 * S + 6], x[8 * S + 7]);
    return __builtin_bit_cast(bf16x8, p);
}
__device__ __forceinline__ bf16x8 ffrag(LAS const unsigned char* ft, int t, int rb, int s, int lr, int lh) {
    return *(LAS const bf16x8*)(ft + (lr * ROWB + lh * 16) + (t * TABB + rb * 32 * ROWB + 32 * s)); }
__device__ __forceinline__ bf16x8 xfrag(LAS const unsigned char* img, int rb, int cs, int lr, int lh) {
    return *(LAS const bf16x8*)(img + (lr * ROWB + lh * 16) + (rb * 32 * ROWB + 16 * cs)); }
__device__ __forceinline__ bf16x8 dfrag(LAS const unsigned char* img, int rb, int cs, int lr, int lh) {
    return *(LAS const bf16x8*)(img + (lr * DROWB + lh * 16) + (rb * 32 * DROWB + 16 * cs)); }
__device__ __forceinline__ void zero16(f32x16& x) {
#pragma unroll
    for (int r = 0; r < 16; ++r) x[r] = 0.f; }
template <bool CONJ> __device__ __forceinline__ void cmul_tile(f32x16& xr, f32x16& xi, const float* w  ) {
#pragma unroll
    for (int r8 = 0; r8 < 4; ++r8) {
        const f32x4 t0 = *(const f32x4*)(w + 8 * r8), t1 = *(const f32x4*)(w + 8 * r8 + 4);
#pragma unroll
        for (int u = 0; u < 4; ++u) { const int r = 4 * r8 + u; const float wr = u < 2 ? t0[2 * u] : t1[2 * u - 4], wi0 = u < 2 ? t0[2 * u + 1] : t1[2 * u - 3]; const float wi = CONJ ? -wi0 : wi0;
            const float a = xr[r], b = xi[r]; xr[r] = a * wr - b * wi; xi[r] = a * wi + b * wr; }
        asm volatile("" ::: "memory");
    }
}
template <bool CPLX, int NK>
__device__ __forceinline__ void s1_tw(LAS const unsigned char* ft, LAS const unsigned char* img, const float* twt, int J, int lane, bf16x8 (&bAr)[8], bf16x8 (&bAi)[8]) {
    const int lr = lane & 31, lh = lane >> 5;
#pragma unroll
    for (int hf = 0; hf < 2; ++hf) {
        f32x16 Ar[2], Ai[2];
#pragma unroll
        for (int i = 0; i < 2; ++i) { zero16(Ar[i]); zero16(Ai[i]); }
#pragma unroll
        for (int s = 0; s < NK; ++s) {
            const bf16x8 bFr = ffrag(ft, 0, J, s, lr, lh), bFi = ffrag(ft, 1, J, s, lr, lh), bnFi = neg8(bFi);
#pragma unroll
            for (int i = 0; i < 2; ++i) {
                const bf16x8 aXr = xfrag(img, 2 * hf + i, 2 * s, lr, lh);
                Ar[i] = MFMA32(aXr, bFr, Ar[i]); Ai[i] = MFMA32(aXr, bFi, Ai[i]);
                if (CPLX) { const bf16x8 aXi = xfrag(img, 2 * hf + i, 8 + 2 * s, lr, lh); Ar[i] = MFMA32(aXi, bnFi, Ar[i]); Ai[i] = MFMA32(aXi, bFr, Ai[i]); }
            }
            HY_SBAR();
        }
#pragma unroll
        for (int i = 0; i < 2; ++i) { const int ig = 2 * hf + i;
            cmul_tile<false>(Ar[i], Ai[i], twt + ((size_t)((ig * 4 + J) * 64 + lane)) * 32);
            bAr[2 * ig] = pack_step<0>(Ar[i]); bAr[2 * ig + 1] = pack_step<1>(Ar[i]); bAi[2 * ig] = pack_step<0>(Ai[i]); bAi[2 * ig + 1] = pack_step<1>(Ai[i]);
            HY_SBAR();
        }
    }
}
__device__ __forceinline__ void s3_half(LAS const unsigned char* ft, const bf16x8 (&bAr)[8], const bf16x8 (&bAi)[8], int Ih, int lane, f32x16 (&Zr)[2], f32x16 (&Zi)[2]) {
    const int lr = lane & 31, lh = lane >> 5;
#pragma unroll
    for (int I = 0; I < 2; ++I) { zero16(Zr[I]); zero16(Zi[I]); }
#pragma unroll
    for (int s = 0; s < 8; ++s) {
        const bf16x8 bnAi = neg8(bAi[s]);
#pragma unroll
        for (int I = 0; I < 2; ++I) {
            const bf16x8 aFr = ffrag(ft, 0, 2 * Ih + I, s, lr, lh), aFi = ffrag(ft, 1, 2 * Ih + I, s, lr, lh);
            Zr[I] = MFMA32(aFr, bAr[s], Zr[I]); Zr[I] = MFMA32(aFi, bnAi, Zr[I]);
            Zi[I] = MFMA32(aFi, bAr[s], Zi[I]); Zi[I] = MFMA32(aFr, bAi[s], Zi[I]);
        }
        HY_SBAR();
    }
}
__device__ __forceinline__ void fwd_filter(LAS const unsigned char* ft, LAS const unsigned char* img, const float* twt, int J, int lane, float scl, float sk, float* kh  ) {
    bf16x8 bAr[8], bAi[8];
    s1_tw<false, 8>(ft, img, twt, J, lane, bAr, bAi);
#pragma unroll
    for (int Ih = 0; Ih < 2; ++Ih) {
        f32x16 Zr[2], Zi[2];
        s3_half(ft, bAr, bAi, Ih, lane, Zr, Zi);
#pragma unroll
        for (int I = 0; I < 2; ++I) { float* dst = kh + ((size_t)((2 * Ih + I) * 64 + lane)) * 32;
#pragma unroll
            for (int r4 = 0; r4 < 8; ++r4) *(f32x4*)(dst + 4 * r4) = (f32x4){Zr[I][2 * r4] * scl + sk, Zi[I][2 * r4] * scl, Zr[I][2 * r4 + 1] * scl + sk, Zi[I][2 * r4 + 1] * scl}; }
        HY_SBAR();
    }
}
__device__ __forceinline__ void s3_filt_i1(LAS const unsigned char* ft, const float* khat  , const float* twt, int J, int lane, const bf16x8 (&bAr)[8], const bf16x8 (&bAi)[8], u32x2 (&dpk)[4][2][4]) {
    const int lr = lane & 31, lh = lane >> 5;
    bf16x8 aYr[8], aYi[8];
#pragma unroll
    for (int Ih = 0; Ih < 2; ++Ih) {
        f32x16 Zr[2], Zi[2];
        s3_half(ft, bAr, bAi, Ih, lane, Zr, Zi);
#pragma unroll
        for (int I = 0; I < 2; ++I) { const int Ig = 2 * Ih + I;
            cmul_tile<false>(Zr[I], Zi[I], khat + ((size_t)(Ig * 64 + lane)) * 32);
            aYr[2 * Ig] = pack_step<0>(Zr[I]); aYr[2 * Ig + 1] = pack_step<1>(Zr[I]); aYi[2 * Ig] = pack_step<0>(Zi[I]); aYi[2 * Ig + 1] = pack_step<1>(Zi[I]);
            HY_SBAR();
        }
    }
#pragma unroll
    for (int ch = 0; ch < 2; ++ch) {
        f32x16 Cr[2], Ci[2];
#pragma unroll
        for (int c = 0; c < 2; ++c) { zero16(Cr[c]); zero16(Ci[c]); }
#pragma unroll
        for (int s = 0; s < 8; ++s) {
            const bf16x8 anYr = neg8(aYr[s]);
#pragma unroll
            for (int c = 0; c < 2; ++c) {
                const bf16x8 bFr = ffrag(ft, 0, 2 * ch + c, s, lr, lh), bFi = ffrag(ft, 1, 2 * ch + c, s, lr, lh);
                Cr[c] = MFMA32(aYr[s], bFr, Cr[c]); Cr[c] = MFMA32(aYi[s], bFi, Cr[c]);
                Ci[c] = MFMA32(anYr, bFi, Ci[c]); Ci[c] = MFMA32(aYi[s], bFr, Ci[c]);
            }
            HY_SBAR();
        }
#pragma unroll
        for (int c = 0; c < 2; ++c) { const int cg = 2 * ch + c;
            cmul_tile<true>(Cr[c], Ci[c], twt + ((size_t)((J * 4 + cg) * 64 + lane)) * 32);
#pragma unroll
            for (int g = 0; g < 4; ++g) {
                dpk[cg][0][g] = (u32x2){cvtpk(Cr[c][4 * g], Cr[c][4 * g + 1]), cvtpk(Cr[c][4 * g + 2], Cr[c][4 * g + 3])};
                dpk[cg][1][g] = (u32x2){cvtpk(Ci[c][4 * g], Ci[c][4 * g + 1]), cvtpk(Ci[c][4 * g + 2], Ci[c][4 * g + 3])};
            }
            HY_SBAR();
        }
    }
}
__device__ __forceinline__ void write_D(LAS unsigned char* dimg, const u32x2 (&dpk)[4][2][4], int J, int lane) {
    const int lr = lane & 31, lh = lane >> 5;
    LAS unsigned char* base = dimg + lr * DROWB + lh * 16 + J * 64;
#pragma unroll
    for (int c = 0; c < 4; ++c)
#pragma unroll
        for (int g = 0; g < 4; ++g) {
            *(LAS u32x2*)(base + c * 32 * DROWB + 32 * (g >> 1) + 8 * (g & 1)) = dpk[c][0][g];
            *(LAS u32x2*)(base + c * 32 * DROWB + 256 + 32 * (g >> 1) + 8 * (g & 1)) = dpk[c][1][g]; }
}
__device__ __forceinline__ void i3_wave(LAS const unsigned char* ft, LAS const unsigned char* dimg, int a, int c, int lane, f32x16& yr, f32x16& yi) {
    const int lr = lane & 31, lh = lane >> 5;
    zero16(yr); zero16(yi);
#pragma unroll
    for (int s = 0; s < 8; ++s) {
        const bf16x8 aFr = ffrag(ft, 0, a, s, lr, lh), aFi = ffrag(ft, 1, a, s, lr, lh), anFi = neg8(aFi);
        const bf16x8 bDr = dfrag(dimg, c, 2 * s, lr, lh), bDi = dfrag(dimg, c, 16 + 2 * s, lr, lh);
        yr = MFMA32(aFr, bDr, yr); yr = MFMA32(aFi, bDi, yr);
        yi = MFMA32(aFr, bDi, yi); yi = MFMA32(anFi, bDr, yi);
        HY_SBAR();
    }
}
__device__ __forceinline__ int img_off(int n2, int ks) { return n2 * ROWB + ks * 2; }
}

__device__ __forceinline__ void ph_hyena_fft(Frame& F) {
    using namespace hy;
    const bf16_t* UT = (const bf16_t*)(F.ws + WS_UT); bf16_t* HYT = (bf16_t*)(F.ws + WS_HYT);
    const float* hdn = (const float*)(F.ws + WS_HDN); const float* w3 = F.in[I_FW3]; const float* decay = F.in[I_DECAY];
    const float* convw = F.in[I_CONVW]; const float* convb = F.in[I_CONVB]; const float* skip = F.in[I_SKIP];
    const float* twt = (const float*)(F.ws + WS_TWT);
    float* khat = (float*)(F.ws + WS_KHAT + (size_t)blockIdx.x * 262144);
    bf16_t* gt = (bf16_t*)(F.ws + WS_GT + (size_t)blockIdx.x * 131072);
    LAS unsigned char* ft = F.lds + FT_OFF; LAS unsigned char* xr = F.lds + X_OFF;
    LAS float* w3s = (LAS float*)(F.lds + SP_OFF);
    LAS float* red = w3s + 256;
    const int wid = F.wave;
#define HY_IDS int tid = F.tid; asm volatile("" : "+v"(tid)); const int lane = tid & 63, lr = lane & 31, lh = lane >> 5; (void)lr; (void)lh; (void)lane;
    __syncthreads();
    { const u32x4* src = (const u32x4*)(F.ws + WS_FTAB);
      for (int i = F.tid; i < 2 * TABB / 16; i += NTHREADS) *(LAS u32x4*)(ft + i * 16) = src[i]; }
    for (int c = blockIdx.x; c < HW; c += F.G) {
        __syncthreads();
        { HY_IDS
#pragma unroll 1
        for (int i = 0; i < 8; ++i) {
            const int ci = tid + 512 * i; const int od = ci >> 10, t0 = (ci & 1023) * 8, o = od >> 1, dir = od & 1;
            const bf16_t* krow = (const bf16_t*)(F.ws + WS_KRAW) + (size_t)(o * 1024 + dir * 512 + c) * SEQ;
            const u32x4 w = *(const u32x4*)(krow + t0);
            const unsigned short e[8] = {(unsigned short)w.x, (unsigned short)(w.x >> 16), (unsigned short)w.y, (unsigned short)(w.y >> 16), (unsigned short)w.z, (unsigned short)(w.z >> 16), (unsigned short)w.w, (unsigned short)(w.w >> 16)};
            LAS unsigned char* img = xr + o * TABB;
#pragma unroll
            for (int j = 0; j < 8; ++j) { const int t = t0 + j; int n = dir ? 2 * SEQ - t : t; unsigned short v = e[j];
                if (dir && t == 0) { n = SEQ; v = 0; }
                *(LAS bf16_t*)(img + img_off(n & 127, kstore(n >> 7))) = v; }
        }
        }
        __syncthreads();
        { HY_IDS
            const int o = wid >> 2, J = wid & 3;
            float nsum = 0.f;
            { const float* kp = (const float*)(F.ws + WS_KPART);
              for (int i = 0; i < 32; ++i) nsum += kp[(size_t)(o * 1024 + c) * 32 + i] + kp[(size_t)(o * 1024 + 512 + c) * 32 + i]; }
            const float scl = 1.0f / (nsum * (float)(2 * SEQ)), sk = skip[o * HW + c] * (1.0f / (float)(2 * SEQ));
            fwd_filter(ft, xr + o * TABB, twt, J, lane, scl, sk, khat + (size_t)((o * 4 + J) * 4) * 64 * 32);
        }
        __syncthreads();
        for (int rd = 0; rd < 8; ++rd) { HY_IDS
            {
#pragma unroll
                for (int half = 0; half < 2; ++half) {
                    const int blk = 2 * rd + half, g = blk >> 3, b = (blk >> 1) & 3, a = blk & 1; const int chg = (g + 1) * HW + c;
                    const bf16_t* row = UT + (size_t)chg * T + (size_t)b * SEQ;
                    const int t0 = 4096 * a + 8 * tid;
                    const u32x4 w = *(const u32x4*)(row + t0);
                    float u[10];
                    u[1] = bflo(w.x); u[2] = bfhi(w.x); u[3] = bflo(w.y); u[4] = bfhi(w.y); u[5] = bflo(w.z); u[6] = bfhi(w.z); u[7] = bflo(w.w); u[8] = bfhi(w.w);
                    u[0] = t0 > 0 ? bf2f(row[t0 - 1]) : 0.f; u[9] = t0 + 8 < SEQ ? bf2f(row[t0 + 8]) : 0.f;
                    const float w0 = convw[chg], w1 = convw[NHY + chg], w2 = convw[2 * NHY + chg], bb = convb[chg];
                    float v[8];
#pragma unroll
                    for (int i = 0; i < 8; ++i) v[i] = w0 * u[i] + w1 * u[i + 1] + w2 * u[i + 2] + bb;
                    *(LAS u32x4*)(xr + half * 8192 + tid * 16) = (u32x4){pk2(v[0], v[1]), pk2(v[2], v[3]), pk2(v[4], v[5]), pk2(v[6], v[7])};
                }
            }
            __syncthreads();
            {
                const int half = tid >> 8, c4 = (tid >> 6) & 3; const int blk = 2 * rd + half;
                LAS const bf16_t* st = (LAS const bf16_t*)(xr + half * 8192);
                unsigned pk[8];
#pragma unroll
                for (int r2 = 0; r2 < 8; ++r2) { const unsigned lo = st[crow(2 * r2, lh) * 128 + 32 * c4 + lr], hi = st[crow(2 * r2 + 1, lh) * 128 + 32 * c4 + lr]; pk[r2] = lo | (hi << 16); }
                bf16_t* dst = gt + ((size_t)((blk * 4 + c4) * 64 + lane)) * 16;
                *(u32x4*)dst = (u32x4){pk[0], pk[1], pk[2], pk[3]}; *(u32x4*)(dst + 8) = (u32x4){pk[4], pk[5], pk[6], pk[7]};
            }
            __syncthreads();
        }
        u32x2 z1p[2][2][4];
        const int p = wid >> 2, J = wid & 3, ta = wid >> 2, tc = wid & 3;
        for (int o = 0; o < 2; ++o) {
            { HY_IDS
            if (o == 0) {
                const float w0 = convw[c], w1 = convw[NHY + c], w2 = convw[2 * NHY + c], bb = convb[c];
#pragma unroll 1
                for (int i = 0; i < 8; ++i) {
                    const int ci = tid + 512 * i; const int b = ci >> 10, t0 = (ci & 1023) * 8;
                    const bf16_t* row = UT + (size_t)c * T + (size_t)b * SEQ;
                    const u32x4 w = *(const u32x4*)(row + t0);
                    float u[10];
                    u[1] = bflo(w.x); u[2] = bfhi(w.x); u[3] = bflo(w.y); u[4] = bfhi(w.y); u[5] = bflo(w.z); u[6] = bfhi(w.z); u[7] = bflo(w.w); u[8] = bfhi(w.w);
                    u[0] = t0 > 0 ? bf2f(row[t0 - 1]) : 0.f; u[9] = t0 + 8 < SEQ ? bf2f(row[t0 + 8]) : 0.f;
                    const int n1 = t0 >> 7, n2 = t0 & 127; const int ks = kstore(n1) + 64 * (b & 1);
                    LAS unsigned char* img = xr + (b >> 1) * TABB;
#pragma unroll
                    for (int j = 0; j < 8; ++j) *(LAS bf16_t*)(img + img_off(n2 + j, ks)) = (bf16_t)f2bf(w0 * u[j] + w1 * u[j + 1] + w2 * u[j + 2] + bb);
                }
            } else {
#pragma unroll
                for (int q = 0; q < 2; ++q) { LAS unsigned char* img = xr + q * TABB + (32 * tc + lr) * ROWB + lh * 16 + ta * 64;
#pragma unroll
                    for (int g = 0; g < 4; ++g) {
                        *(LAS u32x2*)(img + 32 * (g >> 1) + 8 * (g & 1)) = z1p[q][0][g];
                        *(LAS u32x2*)(img + 128 + 32 * (g >> 1) + 8 * (g & 1)) = z1p[q][1][g]; } }
            }
            }
            __syncthreads();
            u32x2 dpk[4][2][4];
            { HY_IDS
                bf16x8 bAr[8], bAi[8];
                s1_tw<true, 4>(ft, xr + p * TABB, twt, J, lane, bAr, bAi);
                __syncthreads();
                s3_filt_i1(ft, khat + (size_t)((o * 4 + J) * 4) * 64 * 32, twt, J, lane, bAr, bAi, dpk);
            }
#pragma unroll 1
            for (int q = 0; q < 2; ++q) { HY_IDS
                if (p == q) write_D(xr, dpk, J, lane);
                __syncthreads();
                f32x16 yr, yi;
                i3_wave(ft, xr, ta, tc, lane, yr, yi);
                const bf16_t* g0 = gt + ((size_t)((((o * 4 + 2 * q) * 2 + ta) * 4 + tc) * 64 + lane)) * 16;
                const bf16_t* g1 = gt + ((size_t)((((o * 4 + 2 * q + 1) * 2 + ta) * 4 + tc) * 64 + lane)) * 16;
                const u32x4 ga = *(const u32x4*)g0, gb = *(const u32x4*)(g0 + 8), gc = *(const u32x4*)g1, gd = *(const u32x4*)(g1 + 8);
                const unsigned gre[8] = {ga.x, ga.y, ga.z, ga.w, gb.x, gb.y, gb.z, gb.w}, gim[8] = {gc.x, gc.y, gc.z, gc.w, gd.x, gd.y, gd.z, gd.w};
#pragma unroll
                for (int r2 = 0; r2 < 8; ++r2) { yr[2 * r2] *= bflo(gre[r2]); yr[2 * r2 + 1] *= bfhi(gre[r2]); yi[2 * r2] *= bflo(gim[r2]); yi[2 * r2 + 1] *= bfhi(gim[r2]); }
                {
#pragma unroll
                    for (int g = 0; g < 4; ++g) { z1p[q][0][g] = (u32x2){cvtpk(yr[4 * g], yr[4 * g + 1]), cvtpk(yr[4 * g + 2], yr[4 * g + 3])};
                                                  z1p[q][1][g] = (u32x2){cvtpk(yi[4 * g], yi[4 * g + 1]), cvtpk(yi[4 * g + 2], yi[4 * g + 3])}; }
                }
                if (o == 1) {
                    bf16_t* o0 = HYT + (size_t)c * T + (size_t)(2 * q) * SEQ + 32 * tc + lr; bf16_t* o1 = o0 + SEQ;
#pragma unroll
                    for (int r = 0; r < 16; ++r) { const int n1 = 32 * ta + crow(r, lh); o0[128 * n1] = (bf16_t)f2bf(yr[r]); o1[128 * n1] = (bf16_t)f2bf(yi[r]); }
                }
                __syncthreads();
            }
        }
    }
    __syncthreads();
#undef HY_IDS
}

__device__ __forceinline__ void ph_hyT(Frame& F) {
    const bf16_t* HYT = (const bf16_t*)(F.ws + WS_HYT); bf16_t* HY = (bf16_t*)(F.ws + WS_HY);
    for (int it = blockIdx.x; it < 8 * (T / 512); it += F.G) {
        const int cb = it & 7, tb = it >> 3; const int t = tb * 512 + F.tid, c0 = cb * 64;
        unsigned w[32];
#pragma unroll
        for (int i = 0; i < 32; ++i) { const unsigned lo = HYT[(size_t)(c0 + 2 * i) * T + t], hi = HYT[(size_t)(c0 + 2 * i + 1) * T + t]; w[i] = lo | (hi << 16); }
#pragma unroll
        for (int i = 0; i < 8; ++i) *(u32x4*)(HY + (size_t)t * HW + c0 + 8 * i) = (u32x4){w[4 * i], w[4 * i + 1], w[4 * i + 2], w[4 * i + 3]};
    }
}

__device__ __forceinline__ void ph_expert_cvt(Frame& F) {
    LAS float* scr = (LAS float*)(F.lds + F.wave * 16384);
    const int gw = F.vcu * NWAVES + F.wave, NGW = F.G * NWAVES;
    bf16_t* W13 = (bf16_t*)(F.ws + WS_W13); bf16_t* W2 = (bf16_t*)(F.ws + WS_W2);
    for (int it = gw; it < NE * 768; it += NGW) {
        const int e = it / 768; int r = it % 768;
        if (r < 512) { const bool is3 = r >= 256; r &= 255; const int kb = r / 16, nb = r % 16, n0 = nb * 32;
            const int drow = (n0 >> 7) * 256 + (is3 ? 128 : 0) + (n0 & 127);
            transpose_item(F.in[is3 ? I_EW3 : I_EW1] + (size_t)e * DM * DE, DM, DE, W13 + (size_t)e * DM * DM, DM, drow, scr, kb, nb, F.lane); }
        else { r -= 512; const int kb = r / 32, nb = r % 32;
            transpose_item(F.in[I_EW2] + (size_t)e * DE * DM, DE, DM, W2 + (size_t)e * DM * DE, DE, nb * 32, scr, kb, nb, F.lane); }
    }
}

__device__ __forceinline__ void ph_ln1_route(Frame& F) {
    float* v = F.out; bf16_t* h2b = (bf16_t*)(F.ws + WS_HB);
    const float* mod = (const float*)(F.ws + WS_MOD); const float* g1 = F.in[I_LN1G]; const float* b1 = F.in[I_LN1B];
    const float* wrt = (const float*)(F.ws + WS_WRT); const float* bg = F.in[I_RGB]; const float* be = F.in[I_REB];
    unsigned* cnt = F.ctl + CW_CNT; int* btok = (int*)(F.ws + WS_BTOK); float* bw = (float*)(F.ws + WS_BW);
    const int gw = F.vcu * NWAVES + F.wave, NGW = F.G * NWAVES;
    for (int row = gw; row < T; row += NGW) {
        const int b = row / SEQ;
        f32x4* xr = (f32x4*)(v + (size_t)row * DM) + F.lane;
        f32x4 x[4]; float s = 0.f;
#pragma unroll
        for (int j = 0; j < 4; ++j) { x[j] = xr[64 * j]; s += (x[j][0] + x[j][1]) + (x[j][2] + x[j][3]); }
        const float mean = wave_sum(s) * (1.f / DM); float s2 = 0.f;
#pragma unroll
        for (int j = 0; j < 4; ++j) { x[j] = x[j] - mean; s2 += (x[j][0] * x[j][0] + x[j][1] * x[j][1]) + (x[j][2] * x[j][2] + x[j][3] * x[j][3]); }
        const float rstd = 1.f / sqrtf(wave_sum(s2) * (1.f / DM) + LN_EPS);
        f32x4 h[4];
        unsigned long long* o8 = (unsigned long long*)(h2b + (size_t)row * DM) + F.lane;
#pragma unroll
        for (int j = 0; j < 4; ++j) { const int k = 4 * F.lane + 256 * j;
            const f32x4 gg = *(const f32x4*)(g1 + k), bb = *(const f32x4*)(b1 + k);
            const f32x4 sh = *(const f32x4*)(mod + (size_t)b * 6144 + 3072 + k), sc = *(const f32x4*)(mod + (size_t)b * 6144 + 4096 + k);
            x[j] = x[j] * rstd * gg + bb; xr[64 * j] = x[j];
            h[j] = x[j] * (sc + 1.0f) + sh;
            o8[64 * j] = (unsigned long long)pk2(h[j][0], h[j][1]) | ((unsigned long long)pk2(h[j][2], h[j][3]) << 32); }
        float gl[8];
#pragma unroll
        for (int o = 0; o < 8; ++o) { float p = 0.f;
#pragma unroll
            for (int j = 0; j < 4; ++j) { const f32x4 w = *(const f32x4*)(wrt + (size_t)o * DM + 4 * F.lane + 256 * j); p += h[j][0] * w[0] + h[j][1] * w[1] + h[j][2] * w[2] + h[j][3] * w[3]; }
            gl[o] = wave_sum(p) + bg[o]; }
        float gmax = gl[0]; int g = 0;
#pragma unroll
        for (int i = 1; i < 8; ++i) if (gl[i] > gmax) { gmax = gl[i]; g = i; }
        float den = 0.f;
#pragma unroll
        for (int i = 0; i < 8; ++i) den += __expf(gl[i] - gmax);
        const float pg = 1.0f / den;
        float el[8];
#pragma unroll
        for (int o = 0; o < 8; ++o) { float p = 0.f; const float* wr_ = wrt + (size_t)(8 + g * 8 + o) * DM;
#pragma unroll
            for (int j = 0; j < 4; ++j) { const f32x4 w = *(const f32x4*)(wr_ + 4 * F.lane + 256 * j); p += h[j][0] * w[0] + h[j][1] * w[1] + h[j][2] * w[2] + h[j][3] * w[3]; }
            el[o] = wave_sum(p) + be[g * 8 + o]; }
        int i1 = 0; float e1 = el[0];
#pragma unroll
        for (int j = 1; j < 8; ++j) if (el[j] > e1) { e1 = el[j]; i1 = j; }
        int i2 = -1; float e2 = -INFINITY;
#pragma unroll
        for (int j = 0; j < 8; ++j) if (j != i1 && (i2 < 0 || el[j] > e2)) { e2 = el[j]; i2 = j; }
        const float r = __expf(e2 - e1); const float wa = pg / (1.0f + r), wb = pg * r / (1.0f + r);
        if (F.lane == 0) {
            const int ea = g * 8 + i1, eb = g * 8 + i2;
            const unsigned ra = atomicAdd(&cnt[ea], 1u); btok[(size_t)ea * ECAP + ra] = row * 2; bw[(size_t)ea * ECAP + ra] = wa;
            const unsigned rb = atomicAdd(&cnt[eb], 1u); btok[(size_t)eb * ECAP + rb] = row * 2 + 1; bw[(size_t)eb * ECAP + rb] = wb;
        }
    }
}

__device__ __forceinline__ void build_moe_tab(Frame& F, LAS int* tab) {
    __syncthreads();
    if (F.tid < 64) tab[72 + F.tid] = (int)__hip_atomic_load(F.ctl + CW_CNT + F.tid, __ATOMIC_RELAXED, __HIP_MEMORY_SCOPE_AGENT);
    __syncthreads();
    if (F.tid == 0) { int s = 0; for (int e = 0; e < 64; ++e) { tab[e] = s; s += (tab[72 + e] + 255) >> 8; } tab[64] = s; }
    __syncthreads();
}

__device__ __forceinline__ void ph_final(Frame& F) {
    float* v = F.out; const bf16_t* y2 = (const bf16_t*)(F.ws + WS_Y2);
    const float* mod = (const float*)(F.ws + WS_MOD); const float* g2 = F.in[I_LN2G]; const float* b2 = F.in[I_LN2B];
    const int gw = F.vcu * NWAVES + F.wave, NGW = F.G * NWAVES;
    for (int row = gw; row < T; row += NGW) {
        const int b = row / SEQ;
        f32x4* xr = (f32x4*)(v + (size_t)row * DM) + F.lane;
        const unsigned long long* ya = (const unsigned long long*)(y2 + (size_t)(2 * row) * DM) + F.lane;
        const unsigned long long* yb = (const unsigned long long*)(y2 + (size_t)(2 * row + 1) * DM) + F.lane;
        f32x4 x[4]; float s = 0.f;
#pragma unroll
        for (int j = 0; j < 4; ++j) { const int k = 4 * F.lane + 256 * j;
            const f32x4 gt = *(const f32x4*)(mod + (size_t)b * 6144 + 5120 + k);
            const unsigned long long a = ya[64 * j], c = yb[64 * j];
            f32x4 y; y[0] = bflo((unsigned)a) + bflo((unsigned)c); y[1] = bfhi((unsigned)a) + bfhi((unsigned)c);
            y[2] = bflo((unsigned)(a >> 32)) + bflo((unsigned)(c >> 32)); y[3] = bfhi((unsigned)(a >> 32)) + bfhi((unsigned)(c >> 32));
            x[j] = xr[64 * j] * DN_ALPHA + gt * y; s += (x[j][0] + x[j][1]) + (x[j][2] + x[j][3]); }
        const float mean = wave_sum(s) * (1.f / DM); float s2 = 0.f;
#pragma unroll
        for (int j = 0; j < 4; ++j) { x[j] = x[j] - mean; s2 += (x[j][0] * x[j][0] + x[j][1] * x[j][1]) + (x[j][2] * x[j][2] + x[j][3] * x[j][3]); }
        const float rstd = 1.f / sqrtf(wave_sum(s2) * (1.f / DM) + LN_EPS);
#pragma unroll
        for (int j = 0; j < 4; ++j) { const int k = 4 * F.lane + 256 * j; xr[64 * j] = x[j] * rstd * *(const f32x4*)(g2 + k) + *(const f32x4*)(b2 + k); }
    }
}

constexpr int N_PHASES = 12;
__device__ __forceinline__ Frame make_frame(const Args& args, unsigned char* lds) {
    Frame F;
    F.lds = (LAS unsigned char*)lds; F.ws = args.ws; F.ctl = (unsigned*)(args.ws + WS_CTL);
    F.tid = threadIdx.x; F.lane = F.tid & 63; F.wave = __builtin_amdgcn_readfirstlane(F.tid >> 6);
    F.G = gridDim.x; { const int bx = blockIdx.x; F.vcu = (F.G % 8 == 0) ? (bx % 8) * (F.G / 8) + bx / 8 : bx; }
    F.in = args.in; F.out = args.out;
    return F;
}
template <unsigned PH_MASK> __global__ void __launch_bounds__(NTHREADS, 2) mk_fwd(Args args) {
    extern __shared__ __attribute__((aligned(16))) unsigned char lds[];
    for (int u = threadIdx.x; u < (LDS_BYTES - LDSCTL_OFF) / 4; u += NTHREADS) ((LAS unsigned*)((LAS unsigned char*)lds + LDSCTL_OFF))[u] = 0u;
    __syncthreads();
    constexpr bool multi = (PH_MASK & (PH_MASK - 1u)) != 0u;
    if (multi) xcd_barrier_post((unsigned*)(args.ws + WS_CTL) + CW_BAR);
#define IN(k) ((PH_MASK >> (k)) & 1u)
#define SEAM(k) do { if (IN(k) && IN((k) + 1)) xcd_barrier((unsigned*)(args.ws + WS_CTL) + CW_BAR, (volatile LAS unsigned*)((LAS unsigned char*)lds + MISC_OFF) + 8); } while (0)
#define RING ((LAS unsigned char*)lds)
#define TAB ((LAS int*)((LAS unsigned char*)lds + TAB_OFF))

    if (IN(0)) { Frame F = make_frame(args, lds); ph_prep(F); } SEAM(0);
    if (IN(1)) { Frame F = make_frame(args, lds); ph_taps(F); ph_hb(F); } SEAM(1);
    if (IN(2)) {
        { pg8::DenseSched S; S.init(T, N1A, DM, gridDim.x, (int)blockIdx.x, args.ws + WS_WIN);
          pg8::EpiInA E{(bf16_t*)(args.ws + WS_Q), (bf16_t*)(args.ws + WS_K), (bf16_t*)(args.ws + WS_V), (bf16_t*)(args.ws + WS_GA), (bf16_t*)(args.ws + WS_GH)};
          pg8::gemm_phase<pg8::EpiInA, pg8::DenseSched, true>(RING, args.ws + WS_HB, DM, S, E); }
        { pg8::DenseSched S; S.init(NHY, T, DM, gridDim.x, (int)blockIdx.x, args.ws + WS_HB);
          pg8::EpiBf16 E{(bf16_t*)(args.ws + WS_UT), T};
          pg8::gemm_phase<pg8::EpiBf16, pg8::DenseSched, true>(RING, args.ws + WS_WIN + (size_t)N1A * DM * 2, DM, S, E); }
    } SEAM(2);
    if (IN(3)) { Frame F = make_frame(args, lds); ph_attn(F); ph_hyena_fft(F); } SEAM(3);
    if (IN(4)) { Frame F = make_frame(args, lds); ph_hyT(F); } SEAM(4);
    if (IN(5)) {
        pg8::DenseSched S; S.init(T, DM, AW, gridDim.x, (int)blockIdx.x, args.ws + WS_WA);
        pg8::EpiGate<false> E{(const bf16_t*)(args.ws + WS_GA), nullptr, (bf16_t*)(args.ws + WS_TMP)};
        pg8::gemm_phase<pg8::EpiGate<false>, pg8::DenseSched, true>(RING, args.ws + WS_ATT, AW, S, E);
    } SEAM(5);
    if (IN(6)) {
        pg8::DenseSched S; S.init(T, DM, HW, gridDim.x, (int)blockIdx.x, args.ws + WS_WH);
        pg8::EpiGate<true> E{(const bf16_t*)(args.ws + WS_GH), (const bf16_t*)(args.ws + WS_TMP), (bf16_t*)(args.ws + WS_HB)};
        pg8::gemm_phase<pg8::EpiGate<true>, pg8::DenseSched, true>(RING, args.ws + WS_HY, HW, S, E);
    } SEAM(6);
    if (IN(7)) {
        { pg8::DenseSched S; S.init(T, DM, DM, gridDim.x, (int)blockIdx.x, args.ws + WS_WO);
          pg8::EpiRes E{args.in[I_X], (const float*)(args.ws + WS_MOD) + 2048, args.out};
          pg8::gemm_phase<pg8::EpiRes, pg8::DenseSched, true>(RING, args.ws + WS_HB, DM, S, E); }
        { Frame F = make_frame(args, lds); ph_expert_cvt(F); }
    } SEAM(7);
    if (IN(8)) { Frame F = make_frame(args, lds); ph_ln1_route(F); } SEAM(8);
    if (IN(9)) {
        { Frame F = make_frame(args, lds); build_moe_tab(F, TAB); }
        const int G = gridDim.x, bx = blockIdx.x, vcu = (G % 8 == 0) ? (bx % 8) * (G / 8) + bx / 8 : bx;
        pg8::MoeSched S{TAB, (const int*)(args.ws + WS_BTOK), (const char*)(args.ws + WS_W13), (size_t)DM * DM * 2, G, vcu, DM, true};
        pg8::EpiSwiGLU E{(bf16_t*)(args.ws + WS_HACT)};
        pg8::gemm_phase<pg8::EpiSwiGLU, pg8::MoeSched, true>(RING, args.ws + WS_HB, DM, S, E);
    } SEAM(9);
    if (IN(10)) {
        { Frame F = make_frame(args, lds); build_moe_tab(F, TAB); }
        const int G = gridDim.x, bx = blockIdx.x, vcu = (G % 8 == 0) ? (bx % 8) * (G / 8) + bx / 8 : bx;
        pg8::MoeSched S{TAB, (const int*)(args.ws + WS_BTOK), (const char*)(args.ws + WS_W2), (size_t)DM * DE * 2, G, vcu, DE, false};
        pg8::EpiScatter E{(bf16_t*)(args.ws + WS_Y2), (const int*)(args.ws + WS_BTOK), (const float*)(args.ws + WS_BW), TAB};
        pg8::gemm_phase<pg8::EpiScatter, pg8::MoeSched, true>(RING, args.ws + WS_HACT, DE, S, E);
    } SEAM(10);
    if (IN(11)) { Frame F = make_frame(args, lds); ph_final(F); }
#undef IN
#undef SEAM
#undef RING
#undef TAB
}

extern "C" void kernel_launch(void* const* d_in, const int* in_sizes, int n_in, void* d_out, int out_size, void* d_ws, size_t ws_size, hipStream_t stream) {
    static int grid = 0;
    if (grid == 0) {
        if (n_in != 31 || out_size != T * DM || ws_size < WS_END) { fprintf(stderr, "kernel_launch: unexpected shapes: n_in %d out %d ws %zu (need %zu)\n", n_in, out_size, ws_size, (size_t)WS_END); grid = -1; return; }
        int dev = 0, cus = 0;
        if (hipGetDevice(&dev) != hipSuccess || hipDeviceGetAttribute(&cus, hipDeviceAttributeMultiprocessorCount, dev) != hipSuccess) { grid = -1; return; }
        bool ok = true;
#define SET_ATTR(m) ok = ok && (hipFuncSetAttribute((const void*)mk_fwd<(m)>, hipFuncAttributeMaxDynamicSharedMemorySize, LDS_BYTES) == hipSuccess)
#if MK_N_LAUNCHES == 1
        SET_ATTR(FUSED_MASK);
#else
        { SET_ATTR(1u << 0); SET_ATTR(1u << 1); SET_ATTR(1u << 2); SET_ATTR(1u << 3); SET_ATTR(1u << 4); SET_ATTR(1u << 5); SET_ATTR(1u << 6); SET_ATTR(1u << 7); SET_ATTR(1u << 8); SET_ATTR(1u << 9); SET_ATTR(1u << 10); SET_ATTR(1u << 11); }
#endif
#undef SET_ATTR
        if (!ok) { fprintf(stderr, "kernel_launch: hipFuncSetAttribute failed\n"); grid = -1; return; }
        (void)hipGetLastError();
        grid = cus;
    }
    if (grid < 0) return;
    if (hipMemsetAsync((char*)d_ws + WS_CTL, 0, CTL_ZERO_BYTES, stream) != hipSuccess) return;
    Args a{};
    for (int i = 0; i < 31; ++i) a.in[i] = (const float*)d_in[i];
    a.out = (float*)d_out; a.ws = (unsigned char*)d_ws;
#if MK_N_LAUNCHES == 1
    a.ph_lo = 0; a.ph_hi = N_PHASES; hipLaunchKernelGGL(mk_fwd<FUSED_MASK>, dim3(grid), dim3(NTHREADS), LDS_BYTES, stream, a);
#else
    {
#define LAUNCH_PH(p) do { a.ph_lo = (p); a.ph_hi = (p) + 1; hipLaunchKernelGGL(mk_fwd<(1u << (p))>, dim3(grid), dim3(NTHREADS), LDS_BYTES, stream, a); } while (0)
        LAUNCH_PH(0); LAUNCH_PH(1); LAUNCH_PH(2); LAUNCH_PH(3); LAUNCH_PH(4); LAUNCH_PH(5); LAUNCH_PH(6); LAUNCH_PH(7); LAUNCH_PH(8); LAUNCH_PH(9); LAUNCH_PH(10); LAUNCH_PH(11);
#undef LAUNCH_PH
    }
#endif
}
```

```cpp
#include <hip/hip_runtime.h>
#include <cstdio>
#include <cstdint>

#ifndef FUSED_MASK
#define FUSED_MASK 0xFFFu
#endif
#ifndef MK_N_LAUNCHES
#define MK_N_LAUNCHES 1
#endif

#define GAS __attribute__((address_space(1)))
#define LAS __attribute__((address_space(3)))
typedef unsigned short bf16_t;
typedef short bf16x8 __attribute__((ext_vector_type(8)));
typedef float f32x4 __attribute__((ext_vector_type(4)));
typedef float f32x2 __attribute__((ext_vector_type(2)));
typedef unsigned u32x4 __attribute__((ext_vector_type(4)));
typedef unsigned u32x2 __attribute__((ext_vector_type(2)));

constexpr int NB = 4, SEQ = 8192, DM = 1024, T = NB * SEQ;
constexpr int AW = 512, KVW = 128, HW = 512, INW = 4352, N1A = 2816, NHY = 1536;
constexpr int NE = 64, DE = 512, ECAP = 32768;
constexpr int NFILT = 2048, FH = 64, FEMB = 33;
constexpr float LN_EPS = 1e-5f;
constexpr float DN_ALPHA = 1.189207115002721f;
constexpr int NTHREADS = 512, NWAVES = 8;

constexpr size_t MiB = 1u << 20;
constexpr size_t WS_CTL = 0, CTL_ZERO_BYTES = 1 * MiB;
constexpr size_t WS_MODP = 1 * MiB, WS_MOD = 3 * MiB, WS_HDN = 4 * MiB, WS_WRT = 6 * MiB, WS_WIN = 7 * MiB;
constexpr size_t WS_WA = 16 * MiB, WS_WH = 17 * MiB, WS_WO = 18 * MiB, WS_BTOK = 20 * MiB, WS_BW = 28 * MiB;
constexpr size_t WS_HB = 36 * MiB;
constexpr size_t WS_Q = 100 * MiB, WS_K = 132 * MiB, WS_V = 140 * MiB, WS_GA = 148 * MiB, WS_GH = 212 * MiB;
constexpr size_t WS_UT = 276 * MiB, WS_TMP = 276 * MiB;
constexpr size_t WS_ATT = 372 * MiB, WS_HYT = 404 * MiB, WS_HY = 436 * MiB;
constexpr size_t WS_W13 = 100 * MiB, WS_W2 = 228 * MiB, WS_HACT = 292 * MiB, WS_Y2 = 372 * MiB, WS_END = 500 * MiB;
constexpr size_t WS_FTAB = 15 * MiB + 524288;
constexpr size_t WS_TWT = 15 * MiB + 524288 + 73728;
constexpr size_t WS_KHAT = 36 * MiB;
constexpr size_t WS_GT = 436 * MiB;
constexpr size_t WS_KRAW = 468 * MiB;
constexpr size_t WS_KPART = 6 * MiB + 524288;  constexpr size_t WS_HDNB = WS_HDN;
constexpr int CW_BAR = 4096, CW_CNT = 8192;

constexpr int RING_BYTES = 131072, LDS_BYTES = 163840, LDSCTL_OFF = LDS_BYTES - 2048, MISC_OFF = LDSCTL_OFF + 320, TAB_OFF = LDSCTL_OFF + 1024;

#define LDS_WAIT() asm volatile("s_waitcnt lgkmcnt(0)" ::: "memory")
#define VM_WAIT() asm volatile("s_waitcnt vmcnt(0)" ::: "memory")
__device__ __forceinline__ unsigned f2bf(float f) { unsigned u = __builtin_bit_cast(unsigned, f); return (u + 0x7fffu + ((u >> 16) & 1u)) >> 16; }
__device__ __forceinline__ unsigned pk2(float lo, float hi) { return f2bf(lo) | (f2bf(hi) << 16); }
__device__ __forceinline__ float bf2f(unsigned short b) { return __builtin_bit_cast(float, (unsigned)b << 16); }
__device__ __forceinline__ float bflo(unsigned w) { return __builtin_bit_cast(float, w << 16); }
__device__ __forceinline__ float bfhi(unsigned w) { return __builtin_bit_cast(float, w & 0xffff0000u); }
__device__ __forceinline__ float sigmoidf_(float x) { return 1.0f / (1.0f + __expf(-x)); }
__device__ __forceinline__ float wave_sum(float v) {
#pragma unroll
    for (int o = 1; o < 64; o <<= 1) v += __shfl_xor(v, o);
    return v;
}

namespace pg8 {
constexpr int BM = 256, BK = 64, HALF = 128, HTB = HALF * BK * 2, STAGE_BYTES = 8 * HTB, NXCD = 8, WGM = 8;
__host__ __device__ __forceinline__ int lds_byte(int r, int c) { const int st = (r >> 4) * 2 + (c >> 5), rr = r & 15, cc = c & 31, ob = rr * 64 + cc * 2; return st * 1024 + (ob ^ (((ob >> 9) & 1) << 5)); }
__host__ __device__ __forceinline__ void stage_rc(int b, int& R, int& C) { const int st = b / 1024, sb = b % 1024, swz = sb ^ (((sb >> 9) & 1) << 5); R = (st >> 1) * 16 + swz / 64; C = (st & 1) * 32 + (swz % 64) / 2; }
__host__ __device__ __forceinline__ int perm32(int rho) { const int n = rho >> 4, i = rho & 15; return 8 * (i >> 2) + 4 * n + (i & 3); }

struct Unit { int pm, pn, e, mt; };

struct DenseSched {
    int nM, nN, nwg, G, c, K; const char* Bt;
    __device__ void init(int M, int N, int K_, int G_, int c_, const void* Bt_) { nM = M / BM; nN = N / BM; nwg = nM * nN; G = G_; c = c_; K = K_; Bt = (const char*)Bt_; }
    __device__ bool next(int i, Unit& u) const {
        const long L = (long)i * G + c; if (L >= nwg) return false;
        int wgid = (int)L; { const int q = nwg / NXCD, r = nwg % NXCD, xcd = wgid % NXCD, off = wgid / NXCD; wgid = (xcd < r ? xcd * (q + 1) : r * (q + 1) + (xcd - r) * q) + off; }
        const int nig = WGM * nN, gid = wgid / nig, fm = gid * WGM, gsz = (nM - fm) < WGM ? (nM - fm) : WGM;
        u.pm = fm + ((wgid % nig) % gsz); u.pn = (wgid % nig) / gsz; u.e = 0; u.mt = 0; return true;
    }
    __device__ __forceinline__ unsigned arow(const Unit& u, int r) const { return (unsigned)(u.pm * BM + r); }
    __device__ __forceinline__ const char* bptr(const Unit& u) const { return Bt + (size_t)u.pn * BM * K * 2; }
};

struct MoeSched {
    const LAS int* tab;
    const int* btok;
    const char* Bt; size_t estride; int G, v, K; bool gather;
    __device__ bool next(int i, Unit& u) const {
        const int L = i * G + v; const int tile = L >> 2; if (tile >= tab[64]) return false;
        int e = 0;
        for (int j = 1; j < 64; ++j) e += (tab[j] <= tile) ? 1 : 0;
        u.e = e; u.mt = tile - tab[e]; u.pm = tile; u.pn = L & 3; return true;
    }
    __device__ __forceinline__ unsigned arow(const Unit& u, int r) const {
        if (!gather) return (unsigned)(u.pm * BM + r);
        const int idx = u.mt * BM + r; const int cnt = tab[72 + u.e];
        unsigned tok = 0; if (idx < cnt) tok = (unsigned)btok[(size_t)u.e * ECAP + idx] >> 1;
        return tok;
    }
    __device__ __forceinline__ const char* bptr(const Unit& u) const { return Bt + (size_t)u.e * estride + (size_t)u.pn * BM * K * 2; }
};

template <class Epi, class Sched, bool ALIGN_EPI>
__device__ __forceinline__ void gemm_phase(LAS unsigned char* lds, const void* Abase, const int K, const Sched& S, const Epi& E) {
    int tid = threadIdx.x; asm volatile("" : "+v"(tid));
    const int wid = __builtin_amdgcn_readfirstlane(tid >> 6), lane = tid & 63, wr = wid >> 2, wc = wid & 3, fr = lane & 15, fq = lane >> 4;
    const int nt = K / BK;
    int Rr[2], Cc[2]; unsigned voffB[2];
#pragma unroll
    for (int i = 0; i < 2; ++i) { stage_rc(tid * 16 + i * 8192, Rr[i], Cc[i]); const int Rb = Epi::PERM ? ((Rr[i] & ~31) + perm32(Rr[i] & 31)) : Rr[i]; voffB[i] = (unsigned)(Rb * K + Cc[i]) * 2u; }
    const size_t kstep = (size_t)(BK * 2);
    const size_t hstep = (size_t)HALF * K * 2;
    const unsigned ldsw = (unsigned)wid * 1024u;
    const int aoff = lds_byte(wr * 64 + fr, fq * 8), boff = lds_byte(wc * 32 + fr, fq * 8);
#define PG8_SA(b, h) (((b) * 2 + (h)) * HTB)
#define PG8_SB(b, h) ((4 + (b) * 2 + (h)) * HTB)
#define PG8_STAGE(bufoff, gbase, voff) do { _Pragma("unroll") for (int _i = 0; _i < 2; ++_i) \
        __builtin_amdgcn_global_load_lds((const unsigned*)((const char*)(gbase) + (voff)[_i]), (LAS unsigned*)(lds + (bufoff) + ldsw + _i * 8192), 16, 0, 0); } while (0)
#define PG8_LDA(dst, b, h) do { _Pragma("unroll") for (int m = 0; m < 4; ++m) _Pragma("unroll") for (int k = 0; k < 2; ++k) dst[m][k] = *(const LAS bf16x8*)(lds + PG8_SA(b, h) + aoff + m * 2048 + k * 1024); } while (0)
#define PG8_LDB(dst, b, h) do { _Pragma("unroll") for (int n = 0; n < 2; ++n) _Pragma("unroll") for (int k = 0; k < 2; ++k) dst[n][k] = *(const LAS bf16x8*)(lds + PG8_SB(b, h) + boff + n * 2048 + k * 1024); } while (0)
#define PG8_MMA(ai, bj, At, Bt) do { __builtin_amdgcn_s_setprio(1); _Pragma("unroll") for (int m = 0; m < 4; ++m) _Pragma("unroll") for (int n = 0; n < 2; ++n) _Pragma("unroll") for (int k = 0; k < 2; ++k) \
        acc[ai][bj][m][n] = __builtin_amdgcn_mfma_f32_16x16x32_bf16(Bt[n][k], At[m][k], acc[ai][bj][m][n], 0, 0, 0); __builtin_amdgcn_s_setprio(0); } while (0)
#define PG8_WAIT_V(n) asm volatile("s_waitcnt vmcnt(" #n ")" ::: "memory")
#define PG8_WAIT_L(n) asm volatile("s_waitcnt lgkmcnt(" #n ")" ::: "memory")
#define PG8_BAR __builtin_amdgcn_s_barrier()
#define PG8_SCHED __builtin_amdgcn_sched_barrier(0)
    Unit cur, nxt; int ui = 0;
    if (!S.next(0, cur)) return;
    f32x4 acc[2][2][4][2];
#pragma unroll
    for (int a = 0; a < 2; ++a)
#pragma unroll
        for (int b = 0; b < 2; ++b)
#pragma unroll
            for (int m = 0; m < 4; ++m)
#pragma unroll
                for (int n = 0; n < 2; ++n) acc[a][b][m][n] = (f32x4){0.f, 0.f, 0.f, 0.f};
    bf16x8 At[4][2], B0[2][2], B1[2][2];
    unsigned cv0[2], cv1[2], nv0[2], nv1[2];
#pragma unroll
    for (int i = 0; i < 2; ++i) { cv0[i] = (S.arow(cur, Rr[i]) * (unsigned)K + (unsigned)Cc[i]) * 2u; cv1[i] = (S.arow(cur, HALF + Rr[i]) * (unsigned)K + (unsigned)Cc[i]) * 2u; }
    const char* const cA = (const char*)Abase;
    const char* cB = S.bptr(cur);
    PG8_STAGE(PG8_SB(0, 0), cB, voffB); PG8_STAGE(PG8_SB(0, 1), cB + hstep, voffB); PG8_STAGE(PG8_SA(0, 0), cA, cv0); PG8_STAGE(PG8_SA(0, 1), cA, cv1);
    if (wr == 1) PG8_BAR;
    PG8_WAIT_V(2); PG8_BAR;
    PG8_STAGE(PG8_SB(1, 0), cB + kstep, voffB); PG8_STAGE(PG8_SA(1, 0), cA + kstep, cv0); PG8_STAGE(PG8_SB(1, 1), cB + hstep + kstep, voffB);
    PG8_WAIT_V(6); PG8_BAR;
    for (;;) {
        const bool has_next = S.next(ui + 1, nxt);
        const char* nB = has_next ? S.bptr(nxt) : cB;
#pragma unroll
        for (int i = 0; i < 2; ++i) {
            nv0[i] = has_next ? (S.arow(nxt, Rr[i]) * (unsigned)K + (unsigned)Cc[i]) * 2u : cv0[i];
            nv1[i] = has_next ? (S.arow(nxt, HALF + Rr[i]) * (unsigned)K + (unsigned)Cc[i]) * 2u : cv1[i];
        }
        for (int t = 0; t < nt; t += 2) {
            const bool last = (t == nt - 2);
            const char* a1 = cA + (size_t)(t + 1) * kstep;
            const char* a2 = last ? cA : cA + (size_t)(t + 2) * kstep; const char* b2 = last ? nB : cB + (size_t)(t + 2) * kstep;
            const char* a3 = a2 + kstep; const char* b3 = b2 + kstep;
            unsigned x0[2], x1[2];
#pragma unroll
            for (int i = 0; i < 2; ++i) { x0[i] = last ? nv0[i] : cv0[i]; x1[i] = last ? nv1[i] : cv1[i]; }
            PG8_LDB(B0, 0, 0); PG8_LDB(B1, 0, 1); PG8_SCHED; PG8_LDA(At, 0, 0); PG8_STAGE(PG8_SA(1, 1), a1, cv1);
            PG8_WAIT_V(8); PG8_WAIT_L(0); PG8_BAR; PG8_MMA(0, 0, At, B0); PG8_MMA(0, 1, At, B1); PG8_BAR; PG8_SCHED;
            PG8_LDA(At, 0, 1); PG8_STAGE(PG8_SB(0, 0), b2, voffB); PG8_STAGE(PG8_SB(0, 1), b2 + hstep, voffB); PG8_STAGE(PG8_SA(0, 0), a2, x0);
            PG8_WAIT_V(8); PG8_WAIT_L(0); PG8_BAR; PG8_MMA(1, 0, At, B0); PG8_MMA(1, 1, At, B1); PG8_BAR; PG8_SCHED;
            PG8_LDB(B0, 1, 0); PG8_LDB(B1, 1, 1); PG8_SCHED; PG8_LDA(At, 1, 0); PG8_STAGE(PG8_SA(0, 1), a2, x1);
            PG8_WAIT_V(8); PG8_WAIT_L(0); PG8_BAR; PG8_MMA(0, 0, At, B0); PG8_MMA(0, 1, At, B1); PG8_BAR; PG8_SCHED;
            PG8_LDA(At, 1, 1); PG8_STAGE(PG8_SB(1, 0), b3, voffB); PG8_STAGE(PG8_SB(1, 1), b3 + hstep, voffB); PG8_STAGE(PG8_SA(1, 0), a3, x0);
            PG8_WAIT_V(8); PG8_WAIT_L(0); PG8_BAR; PG8_MMA(1, 0, At, B0); PG8_MMA(1, 1, At, B1); PG8_BAR; PG8_SCHED;
        }
        if constexpr (ALIGN_EPI) { if (wr == 0) PG8_BAR; }
        E(acc, cur, wr, wc, fr, fq);
        if (!has_next) break;
#pragma unroll
        for (int a = 0; a < 2; ++a)
#pragma unroll
            for (int b = 0; b < 2; ++b)
#pragma unroll
                for (int m = 0; m < 4; ++m)
#pragma unroll
                    for (int n = 0; n < 2; ++n) acc[a][b][m][n] = (f32x4){0.f, 0.f, 0.f, 0.f};
        cur = nxt; cB = nB; ++ui;
#pragma unroll
        for (int i = 0; i < 2; ++i) { cv0[i] = nv0[i]; cv1[i] = nv1[i]; }
        if constexpr (ALIGN_EPI) { if (wr == 1) PG8_BAR; }
    }
    PG8_WAIT_V(0);
    if constexpr (!ALIGN_EPI) { if (wr == 0) PG8_BAR; }
    PG8_BAR;
#undef PG8_SA
#undef PG8_SB
#undef PG8_STAGE
#undef PG8_LDA
#undef PG8_LDB
#undef PG8_MMA
#undef PG8_WAIT_V
#undef PG8_WAIT_L
#undef PG8_BAR
#undef PG8_SCHED
}

__device__ __forceinline__ u32x4 pack8(const f32x4 v0, const f32x4 v1) { u32x4 w; w.x = pk2(v0[0], v0[1]); w.y = pk2(v0[2], v0[3]); w.z = pk2(v1[0], v1[1]); w.w = pk2(v1[2], v1[3]); return w; }

struct EpiInA {
    static constexpr bool PERM = true;
    bf16_t *Q, *Kb, *Vb, *GA, *GH;
    __device__ __forceinline__ void operator()(const f32x4 (&acc)[2][2][4][2], const Unit& u, int wr, int wc, int fr, int fq) const {
        const int row0 = u.pm * BM + wr * 64 + fr; const int cin = wc * 32 + 8 * fq;
#pragma unroll
        for (int bj = 0; bj < 2; ++bj) {
            bf16_t* base; int ld, col; bool sig = false;
            if (u.pn < 2) { base = Q; ld = AW; col = u.pn * 256 + bj * 128 + cin; }
            else if (u.pn == 2) { base = bj == 0 ? Kb : Vb; ld = KVW; col = cin; }
            else if (u.pn < 7) { base = GA; ld = DM; col = (u.pn - 3) * 256 + bj * 128 + cin; sig = true; }
            else { base = GH; ld = DM; col = (u.pn - 7) * 256 + bj * 128 + cin; sig = true; }
#pragma unroll
            for (int ai = 0; ai < 2; ++ai)
#pragma unroll
                for (int m = 0; m < 4; ++m) {
                    f32x4 v0 = acc[ai][bj][m][0], v1 = acc[ai][bj][m][1];
                    if (sig) {
#pragma unroll
                        for (int j = 0; j < 4; ++j) { v0[j] = sigmoidf_(v0[j]); v1[j] = sigmoidf_(v1[j]); }
                    }
                    *(u32x4*)(base + (size_t)(row0 + ai * HALF + m * 16) * ld + col) = pack8(v0, v1);
                }
        }
    }
};
struct EpiBf16 {
    static constexpr bool PERM = true;
    bf16_t* O; int ldc;
    __device__ __forceinline__ void operator()(const f32x4 (&acc)[2][2][4][2], const Unit& u, int wr, int wc, int fr, int fq) const {
        const int row0 = u.pm * BM + wr * 64 + fr; const int col0 = u.pn * BM + wc * 32 + 8 * fq;
#pragma unroll
        for (int ai = 0; ai < 2; ++ai)
#pragma unroll
            for (int m = 0; m < 4; ++m)
#pragma unroll
                for (int bj = 0; bj < 2; ++bj)
                    *(u32x4*)(O + (size_t)(row0 + ai * HALF + m * 16) * ldc + col0 + bj * HALF) = pack8(acc[ai][bj][m][0], acc[ai][bj][m][1]);
    }
};
template <bool ADD> struct EpiGate {
    static constexpr bool PERM = true;
    const bf16_t* G; const bf16_t* P; bf16_t* O;
    __device__ __forceinline__ void operator()(const f32x4 (&acc)[2][2][4][2], const Unit& u, int wr, int wc, int fr, int fq) const {
        const int row0 = u.pm * BM + wr * 64 + fr; const int col0 = u.pn * BM + wc * 32 + 8 * fq;
#pragma unroll
        for (int ai = 0; ai < 2; ++ai)
#pragma unroll
            for (int m = 0; m < 4; ++m)
#pragma unroll
                for (int bj = 0; bj < 2; ++bj) {
                    const size_t off = (size_t)(row0 + ai * HALF + m * 16) * DM + col0 + bj * HALF;
                    const u32x4 g = *(const u32x4*)(G + off);
                    f32x4 v0 = acc[ai][bj][m][0], v1 = acc[ai][bj][m][1];
                    v0[0] *= bflo(g.x); v0[1] *= bfhi(g.x); v0[2] *= bflo(g.y); v0[3] *= bfhi(g.y);
                    v1[0] *= bflo(g.z); v1[1] *= bfhi(g.z); v1[2] *= bflo(g.w); v1[3] *= bfhi(g.w);
                    if (ADD) { const u32x4 p = *(const u32x4*)(P + off);
                        v0[0] += bflo(p.x); v0[1] += bfhi(p.x); v0[2] += bflo(p.y); v0[3] += bfhi(p.y);
                        v1[0] += bflo(p.z); v1[1] += bfhi(p.z); v1[2] += bflo(p.w); v1[3] += bfhi(p.w); }
                    *(u32x4*)(O + off) = pack8(v0, v1);
                }
    }
};
struct EpiRes {
    static constexpr bool PERM = false;
    const float* X; const float* gate; float* O;
    __device__ __forceinline__ void operator()(const f32x4 (&acc)[2][2][4][2], const Unit& u, int wr, int wc, int fr, int fq) const {
        const int row0 = u.pm * BM + wr * 64 + fr; const int col0 = u.pn * BM + wc * 32 + 4 * fq;
        const int b = (u.pm * BM) / SEQ;
#pragma unroll
        for (int bj = 0; bj < 2; ++bj)
#pragma unroll
            for (int n = 0; n < 2; ++n) {
                const int col = col0 + bj * HALF + n * 16;
                const f32x4 gv = *(const f32x4*)(gate + (size_t)b * 6144 + col);
#pragma unroll
                for (int ai = 0; ai < 2; ++ai)
#pragma unroll
                    for (int m = 0; m < 4; ++m) {
                        const size_t off = (size_t)(row0 + ai * HALF + m * 16) * DM + col;
                        const f32x4 xv = *(const f32x4*)(X + off);
                        *(f32x4*)(O + off) = xv * DN_ALPHA + gv * acc[ai][bj][m][n];
                    }
            }
    }
};
struct EpiSwiGLU {
    static constexpr bool PERM = true;
    bf16_t* H;
    __device__ __forceinline__ void operator()(const f32x4 (&acc)[2][2][4][2], const Unit& u, int wr, int wc, int fr, int fq) const {
        const int row0 = u.pm * BM + wr * 64 + fr; const int col0 = u.pn * HALF + wc * 32 + 8 * fq;
#pragma unroll
        for (int ai = 0; ai < 2; ++ai)
#pragma unroll
            for (int m = 0; m < 4; ++m) {
                f32x4 v0, v1;
#pragma unroll
                for (int j = 0; j < 4; ++j) { const float a0 = acc[ai][0][m][0][j], a1 = acc[ai][0][m][1][j];
                    v0[j] = a0 * sigmoidf_(a0) * acc[ai][1][m][0][j]; v1[j] = a1 * sigmoidf_(a1) * acc[ai][1][m][1][j]; }
                *(u32x4*)(H + (size_t)(row0 + ai * HALF + m * 16) * DE + col0) = pack8(v0, v1);
            }
    }
};
struct EpiScatter {
    static constexpr bool PERM = true;
    bf16_t* Y2; const int* btok; const float* bw; const LAS int* tab;
    __device__ __forceinline__ void operator()(const f32x4 (&acc)[2][2][4][2], const Unit& u, int wr, int wc, int fr, int fq) const {
        const int col0 = u.pn * BM + wc * 32 + 8 * fq; const int cnt = tab[72 + u.e];
#pragma unroll
        for (int ai = 0; ai < 2; ++ai)
#pragma unroll
            for (int m = 0; m < 4; ++m) {
                const int idx = u.mt * BM + ai * HALF + wr * 64 + m * 16 + fr;
                if (idx < cnt) {
                    const int dst = btok[(size_t)u.e * ECAP + idx]; const float w = bw[(size_t)u.e * ECAP + idx];
#pragma unroll
                    for (int bj = 0; bj < 2; ++bj)
                        *(u32x4*)(Y2 + (size_t)dst * DM + col0 + bj * HALF) = pack8(acc[ai][bj][m][0] * w, acc[ai][bj][m][1] * w);
                }
            }
    }
};
}

#define XB_TMO      128
#define XB_XCNT(j)  (256  + 64 * (j))
#define XB_XSUB(j)  (1280 + 64 * (j))
#define XB_XGEN(j)  (2304 + 64 * (j))
#define XB_TOP      3328
#define XB_TOPGEN   3392
#define XCD_BAR_WORDS 3456
#define XB_SPIN_CAP (1u << 22)
__device__ __forceinline__ unsigned xb_ld(unsigned* p)              { return __hip_atomic_load(p, __ATOMIC_RELAXED, __HIP_MEMORY_SCOPE_AGENT); }
__device__ __forceinline__ unsigned xb_add(unsigned* p, unsigned v) { return __hip_atomic_fetch_add(p, v, __ATOMIC_RELAXED, __HIP_MEMORY_SCOPE_AGENT); }
__device__ __forceinline__ unsigned xb_xcc_id() { return (unsigned)__builtin_amdgcn_s_getreg((3 << 11) | 20) & 0xFu; }
#define XB_SPIN(cond, bar) do { unsigned _sp = 0; while (cond) { __builtin_amdgcn_s_sleep(1); \
    if ((++_sp & 255u) == 0u) { if (xb_ld(&(bar)[XB_TMO])) break; if (_sp > XB_SPIN_CAP) { atomicAdd(&(bar)[XB_TMO], 1u); break; } } } } while (0)
__device__ __forceinline__ void xcd_barrier_post(unsigned* bar) { if (threadIdx.x == 0) (void)xb_add(&bar[XB_XCNT(xb_xcc_id())], 1u); }
__device__ __forceinline__ void xcd_barrier_complete(unsigned* bar, unsigned x, unsigned& nloc, unsigned& nx) {
    const unsigned G = gridDim.x * gridDim.y * gridDim.z;
    unsigned sum, cnt, mine, sp = 0u;
    for (;;) {
        sum = 0u; cnt = 0u; mine = 0u;
#pragma unroll
        for (unsigned j = 0; j < 16; ++j) { const unsigned c = xb_ld(&bar[XB_XCNT(j)]); sum += c; cnt += (c > 0u) ? 1u : 0u; mine = (j == x) ? c : mine; }
        if (sum == G) break;
        __builtin_amdgcn_s_sleep(1);
        if ((++sp & 255u) == 0u) { if (xb_ld(&bar[XB_TMO])) break; if (sp > XB_SPIN_CAP) { atomicAdd(&bar[XB_TMO], 1u); break; } }
    }
    nloc = mine > 0u ? mine : 1u; nx = cnt > 0u ? cnt : 1u;
}
__device__ __forceinline__ void xcd_barrier(unsigned* bar, volatile LAS unsigned* st) {
    asm volatile("s_waitcnt vmcnt(0)" ::: "memory");
    __syncthreads();
    if (threadIdx.x == 0) {
        const unsigned x = xb_xcc_id();
        __builtin_amdgcn_s_waitcnt(0);
        unsigned nloc = st[0], nx = st[1];
        if (nloc == 0u) { xcd_barrier_complete(bar, x, nloc, nx); st[0] = nloc; st[1] = nx; }
        const unsigned old = xb_add(&bar[XB_XSUB(x)], 1u);
        const unsigned gen = old / nloc;
        if (old + 1u == (gen + 1u) * nloc) {
            __builtin_amdgcn_fence(__ATOMIC_RELEASE, "agent");
            asm volatile("s_waitcnt vmcnt(0)" ::: "memory");
            const unsigned og = xb_add(&bar[XB_TOP], 1u);
            const unsigned tg = og / nx;
            if (og + 1u == (tg + 1u) * nx) xb_add(&bar[XB_TOPGEN], 1u);
            else XB_SPIN(xb_ld(&bar[XB_TOPGEN]) == tg, bar);
            __builtin_amdgcn_fence(__ATOMIC_ACQUIRE, "agent");
            xb_add(&bar[XB_XGEN(x)], 1u);
            asm volatile("s_waitcnt vmcnt(0)" ::: "memory");
        } else {
            XB_SPIN(xb_ld(&bar[XB_XGEN(x)]) == gen, bar);
            __builtin_amdgcn_fence(__ATOMIC_ACQUIRE, "agent");
            asm volatile("s_waitcnt vmcnt(0)" ::: "memory");
        }
    }
    __syncthreads();
}

struct Args { const float* in[31]; float* out; unsigned char* ws; int ph_lo, ph_hi; };
struct Frame {
    LAS unsigned char* lds; unsigned char* ws; unsigned* ctl;
    int tid, lane, wave, vcu, G;
    const float* const* in; float* out;
};
enum { I_X = 0, I_C, I_WADA, I_BADA, I_WIN, I_CONVW, I_CONVB, I_FW1, I_FB1, I_FF1, I_FW2, I_FB2, I_FF2, I_FW3, I_DECAY, I_SKIP, I_WHY, I_WATT, I_SINK, I_WOUT,
       I_LN1G, I_LN1B, I_RGW, I_RGB, I_REW, I_REB, I_EW1, I_EW3, I_EW2, I_LN2G, I_LN2B };

__device__ __forceinline__ void transpose_item(const float* W, int K, int N, bf16_t* WT, int ldt, int drow0, LAS float* scr, int kb, int nb, int lane) {
    const int k0 = 64 * kb, n0 = 32 * nb;
#pragma unroll 8
    for (int i = 0; i < 32; ++i) { const int kk = 2 * i + (lane >> 5); scr[kk * 33 + (lane & 31)] = W[(size_t)(k0 + kk) * N + n0 + (lane & 31)]; }
    LDS_WAIT(); asm volatile("" ::: "memory");
    const int c = lane & 7;
#pragma unroll
    for (int j = 0; j < 4; ++j) { const int n = (lane >> 3) + 8 * j; const LAS float* s = scr + (8 * c) * 33 + n;
        u32x4 o; o.x = pk2(s[0 * 33], s[1 * 33]); o.y = pk2(s[2 * 33], s[3 * 33]); o.z = pk2(s[4 * 33], s[5 * 33]); o.w = pk2(s[6 * 33], s[7 * 33]);
        *(u32x4*)(WT + (size_t)(drow0 + n) * ldt + k0 + 8 * c) = o; }
    LDS_WAIT(); asm volatile("" ::: "memory");
}

__device__ __forceinline__ void ph_prep(Frame& F) {
    const float* c = F.in[I_C]; const float* wada = F.in[I_WADA];
    float* modp = (float*)(F.ws + WS_MODP);
    for (int it = blockIdx.x; it < 192; it += F.G) {
        const int kc = it / 12, cg = it % 12, j = cg * 512 + F.tid;
        float a0 = 0.f, a1 = 0.f, a2 = 0.f, a3 = 0.f;
        for (int kk = 0; kk < 64; ++kk) { const int k = kc * 64 + kk; const float w = wada[(size_t)k * 6144 + j];
            const float c0 = c[k], c1 = c[1024 + k], c2 = c[2048 + k], c3 = c[3072 + k];
            a0 += c0 * sigmoidf_(c0) * w; a1 += c1 * sigmoidf_(c1) * w; a2 += c2 * sigmoidf_(c2) * w; a3 += c3 * sigmoidf_(c3) * w; }
        modp[(size_t)(kc * 4 + 0) * 6144 + j] = a0; modp[(size_t)(kc * 4 + 1) * 6144 + j] = a1; modp[(size_t)(kc * 4 + 2) * 6144 + j] = a2; modp[(size_t)(kc * 4 + 3) * 6144 + j] = a3;
    }
    LAS float* scr = (LAS float*)(F.lds + F.wave * 16384);
    const int gw = F.vcu * NWAVES + F.wave, NGW = F.G * NWAVES;
    constexpr int I_IN = 16 * 136, I_A = 8 * 32, I_H = 8 * 32, I_O = 16 * 32;
    for (int it = gw; it < I_IN + I_A + I_H + I_O; it += NGW) {
        int r = it;
        if (r < I_IN) { const int kb = r / 136, nb = r % 136, n0 = nb * 32;
            const int drow = n0 < 768 ? n0 : (n0 < 2304 ? N1A + (n0 - 768) : 768 + (n0 - 2304));
            transpose_item(F.in[I_WIN], DM, INW, (bf16_t*)(F.ws + WS_WIN), DM, drow, scr, kb, nb, F.lane); continue; } r -= I_IN;
        if (r < I_A) { transpose_item(F.in[I_WATT], AW, DM, (bf16_t*)(F.ws + WS_WA), AW, (r % 32) * 32, scr, r / 32, r % 32, F.lane); continue; } r -= I_A;
        if (r < I_H) { transpose_item(F.in[I_WHY], HW, DM, (bf16_t*)(F.ws + WS_WH), HW, (r % 32) * 32, scr, r / 32, r % 32, F.lane); continue; } r -= I_H;
        transpose_item(F.in[I_WOUT], DM, DM, (bf16_t*)(F.ws + WS_WO), DM, (r % 32) * 32, scr, r / 32, r % 32, F.lane);
    }
    {
        const float* w1 = F.in[I_FW1]; const float* b1 = F.in[I_FB1]; const float* f1 = F.in[I_FF1];
        const float* w2 = F.in[I_FW2]; const float* b2 = F.in[I_FB2]; const float* f2 = F.in[I_FF2];
        const int j = F.lane;
        for (int t = gw; t < SEQ; t += NGW) {
            const float tl = (float)t / (float)(SEQ - 1);
            const float w = 6.283185307179586f * (float)t / (float)SEQ;
            float zi = 0.f;
            if (j == 0) zi = tl;
            else if (j <= 16) { const float band = 1e-4f + (float)(j - 1) * ((15.0f - 1e-4f) / 15.0f); zi = cosf(band * w); }
            else if (j <= 32) { const float band = 1e-4f + (float)(j - 17) * ((15.0f - 1e-4f) / 15.0f); zi = -sinf(band * w); }
            float a = b1[j];
#pragma unroll
            for (int i = 0; i < FEMB; ++i) a += __shfl(zi, i) * w1[i * FH + j];
            const float h1 = sinf(f1[j] * a);
            float a2 = b2[j];
#pragma unroll
            for (int i = 0; i < FH; ++i) a2 += __shfl(h1, i) * w2[i * FH + j];
            ((bf16_t*)(F.ws + WS_HDNB))[(size_t)t * FH + j] = (bf16_t)f2bf(sinf(f2[j] * a2));
        }
    }
    {
        bf16_t* ftab = (bf16_t*)(F.ws + WS_FTAB); float* twt = (float*)(F.ws + WS_TWT);
        for (int i = blockIdx.x * NTHREADS + F.tid; i < 2 * 128 * 128; i += F.G * NTHREADS) {
            const int t = i >> 14, row = (i >> 7) & 127, q = i & 127;
            const int q15 = q & 15, h = q15 >> 3, j = q15 & 7; const int nat = (q & ~15) + 8 * (j >> 2) + 4 * h + (j & 3);
            const int e = (row * nat) & 127; const float x = (float)e * (2.0f / 128.0f);
            const float v = t == 0 ? cospif(x) : -sinpif(x);
            ftab[(size_t)t * (128 * 136) + row * 136 + q] = (bf16_t)f2bf(v);
        }
        for (int i = blockIdx.x * NTHREADS + F.tid; i < 16 * 64 * 16; i += F.G * NTHREADS) {
            const int r = i & 15, l = (i >> 4) & 63, ab = i >> 10, al = ab >> 2, be = ab & 3;
            const int e = ((32 * al + ((r & 3) + 8 * (r >> 2) + 4 * (l >> 5))) * (32 * be + (l & 31))) & 16383; const float x = (float)e * (2.0f / 16384.0f);
            twt[2 * i] = cospif(x); twt[2 * i + 1] = -sinpif(x);
        }
    }
    {
        float* wrt = (float*)(F.ws + WS_WRT); const float* wg = F.in[I_RGW]; const float* we = F.in[I_REW];
        for (int i = blockIdx.x * NTHREADS + F.tid; i < 72 * DM; i += F.G * NTHREADS) { const int o = i / DM, k = i % DM; wrt[i] = o < 8 ? wg[k * 8 + o] : we[k * 64 + (o - 8)]; }
    }
}


__device__ __forceinline__ void ph_taps(Frame& F) {
    typedef float f32x16 __attribute__((ext_vector_type(16)));
    const bf16_t* hb = (const bf16_t*)(F.ws + WS_HDNB); const float* w3 = F.in[I_FW3]; const float* decay = F.in[I_DECAY];
    bf16_t* kraw = (bf16_t*)(F.ws + WS_KRAW); float* kpart = (float*)(F.ws + WS_KPART);
    const int lane = F.lane, lr = lane & 31, lh = lane >> 5;
    for (int it = blockIdx.x; it < 256; it += F.G) {
        const int g = it & 63, tq = it >> 6;
        bf16x8 aW[4];
#pragma unroll
        for (int s = 0; s < 4; ++s) { unsigned pk[4];
#pragma unroll
            for (int j2 = 0; j2 < 4; ++j2) { const int k = 16 * s + 8 * lh + 2 * j2; pk[j2] = pk2(w3[(size_t)k * NFILT + 32 * g + lr], w3[(size_t)(k + 1) * NFILT + 32 * g + lr]); }
            aW[s] = __builtin_bit_cast(bf16x8, (u32x4){pk[0], pk[1], pk[2], pk[3]}); }
        float dcy[16], asum[16];
#pragma unroll
        for (int r = 0; r < 16; ++r) { dcy[r] = fabsf(decay[32 * g + (r & 3) + 8 * (r >> 2) + 4 * lh]); asum[r] = 0.f; }
#pragma unroll 1
        for (int tt = 0; tt < 8; ++tt) {
            const int t = 2048 * tq + 32 * (F.wave * 8 + tt) + lr;
            f32x16 acc;
#pragma unroll
            for (int r = 0; r < 16; ++r) acc[r] = 0.f;
#pragma unroll
            for (int s = 0; s < 4; ++s) { const bf16x8 bH = *(const bf16x8*)(hb + (size_t)t * FH + 16 * s + 8 * lh); acc = __builtin_amdgcn_mfma_f32_32x32x16_bf16(aW[s], bH, acc, 0, 0, 0); }
            const float tl = (float)t / (float)(SEQ - 1);
#pragma unroll
            for (int r = 0; r < 16; ++r) { const float v = acc[r] * (__expf(-tl * dcy[r]) + 0.05f); asum[r] += fabsf(v);
                kraw[(size_t)(32 * g + (r & 3) + 8 * (r >> 2) + 4 * lh) * SEQ + t] = (bf16_t)f2bf(v); }
        }
#pragma unroll
        for (int r = 0; r < 16; ++r) { float v = asum[r];
#pragma unroll
            for (int o = 1; o < 32; o <<= 1) v += __shfl_xor(v, o);
            if (lr == 0) kpart[(size_t)(32 * g + (r & 3) + 8 * (r >> 2) + 4 * lh) * 32 + tq * 8 + F.wave] = v; }
    }
}

__device__ __forceinline__ void ph_hb(Frame& F) {
    const float* modp = (const float*)(F.ws + WS_MODP); const float* bada = F.in[I_BADA];
    float* mod = (float*)(F.ws + WS_MOD);
    for (int i = blockIdx.x * NTHREADS + F.tid; i < NB * 6144; i += F.G * NTHREADS) { const int b = i / 6144, j = i % 6144; float s = bada[j];
        for (int kc = 0; kc < 16; ++kc) s += modp[(size_t)(kc * 4 + b) * 6144 + j];
        mod[i] = s; }
    LAS float* sc = (LAS float*)F.lds; LAS float* sh = sc + DM;
    const float* x = F.in[I_X]; bf16_t* hb = (bf16_t*)(F.ws + WS_HB);
    for (int ch = blockIdx.x; ch < T / 128; ch += F.G) {
        const int b = (ch * 128) / SEQ;
        __syncthreads();
        for (int j = F.tid; j < 2 * DM; j += NTHREADS) { float s = bada[j];
            for (int kc = 0; kc < 16; ++kc) s += modp[(size_t)(kc * 4 + b) * 6144 + j];
            if (j < DM) sh[j] = s; else sc[j - DM] = 1.0f + s; }
        __syncthreads();
        for (int r = F.wave; r < 128; r += NWAVES) {
            const size_t row = (size_t)ch * 128 + r;
            const f32x4* xr = (const f32x4*)(x + row * DM) + F.lane;
            unsigned long long* o8 = (unsigned long long*)(hb + row * DM) + F.lane;
#pragma unroll
            for (int j = 0; j < 4; ++j) { const f32x4 v = xr[64 * j]; const int k = 4 * F.lane + 256 * j;
                const float h0 = v[0] * sc[k] + sh[k], h1 = v[1] * sc[k + 1] + sh[k + 1], h2 = v[2] * sc[k + 2] + sh[k + 2], h3 = v[3] * sc[k + 3] + sh[k + 3];
                o8[64 * j] = (unsigned long long)pk2(h0, h1) | ((unsigned long long)pk2(h2, h3) << 32); }
        }
    }
    __syncthreads();
}

namespace at {
typedef float f32x16 __attribute__((ext_vector_type(16)));
typedef __bf16 bf16x2_t __attribute__((ext_vector_type(2)));
constexpr int KROWB = 144, VROWB = 784, K_OFF = 0, V_OFF = 384 * KROWB;
__device__ __forceinline__ unsigned cvtpk(float lo, float hi) { f32x2 v = {lo, hi}; bf16x2_t b = __builtin_convertvector(v, bf16x2_t); return __builtin_bit_cast(unsigned, b); }
template <int S> __device__ __forceinline__ bf16x8 pack_step(const f32x16& x) {
    u32x4 p; p.x = cvtpk(x[8 * S], x[8 * S + 1]); p.y = cvtpk(x[8 * S + 2], x[8 * S + 3]); p.z = cvtpk(x[8 * S + 4], x[8 * S + 5]); p.w = cvtpk(x[8 * S + 6], x[8 * S + 7]);
    return __builtin_bit_cast(bf16x8, p);
}
__device__ __forceinline__ int kst(int k) { const int c = k & 15; return (k & ~15) + 8 * ((c >> 2) & 1) + 4 * (c >> 3) + (c & 3); }
}
__device__ __forceinline__ void ph_attn(Frame& F) {
    using namespace at;
    const bf16_t* Q = (const bf16_t*)(F.ws + WS_Q); const bf16_t* Kb = (const bf16_t*)(F.ws + WS_K); const bf16_t* Vb = (const bf16_t*)(F.ws + WS_V);
    bf16_t* O = (bf16_t*)(F.ws + WS_ATT); const float* sink = F.in[I_SINK];
    LAS unsigned char* Ks = F.lds + K_OFF; LAS unsigned char* Vs = F.lds + V_OFF;
    const int wid = F.wave;
    constexpr float LOG2E = 1.4426950408889634f;
    for (int unit = blockIdx.x; unit < NB * 2 * 64; unit += F.G) {
        const int qb = unit & 63, kvh = (unit >> 6) & 1, b = unit >> 7;
        int tid = F.tid; asm volatile("" : "+v"(tid));
        const int lane = tid & 63, lr = lane & 31, lh = lane >> 5;
        __syncthreads();
#pragma unroll 1
        for (int i = 0; i < 6; ++i) {
            const int ci = tid + 512 * i, j = ci >> 3, p = ci & 7; const int kpos = qb * 128 - 128 + j;
            u32x4 kv = (u32x4){0u, 0u, 0u, 0u}, vv = kv;
            if (kpos >= 0 && kpos < SEQ) { const size_t off = ((size_t)b * SEQ + kpos) * KVW + kvh * 64 + p * 8; kv = *(const u32x4*)(Kb + off); vv = *(const u32x4*)(Vb + off); }
            *(LAS u32x4*)(Ks + j * KROWB + p * 16) = kv;
            LAS unsigned char* vp = Vs + (p * 8) * VROWB + kst(j) * 2;
            *(LAS bf16_t*)(vp) = (bf16_t)vv.x; *(LAS bf16_t*)(vp + VROWB) = (bf16_t)(vv.x >> 16);
            *(LAS bf16_t*)(vp + 2 * VROWB) = (bf16_t)vv.y; *(LAS bf16_t*)(vp + 3 * VROWB) = (bf16_t)(vv.y >> 16);
            *(LAS bf16_t*)(vp + 4 * VROWB) = (bf16_t)vv.z; *(LAS bf16_t*)(vp + 5 * VROWB) = (bf16_t)(vv.z >> 16);
            *(LAS bf16_t*)(vp + 6 * VROWB) = (bf16_t)vv.w; *(LAS bf16_t*)(vp + 7 * VROWB) = (bf16_t)(vv.w >> 16);
        }
        __syncthreads();
        const int g = wid >> 1, h = kvh * 4 + g, uh = wid & 1;
        const float slope2 = exp2f(-(float)(h + 1)) * LOG2E, c1 = 0.125f * LOG2E, m0 = sink[h] * LOG2E;
        const float d0 = (float)(4 * lh - lr);
#pragma unroll 1
        for (int ut = 0; ut < 2; ++ut) {
            const int u = 2 * uh + ut; const size_t trow = (size_t)b * SEQ + qb * 128 + 32 * u + lr;
            bf16x8 qf[4];
#pragma unroll
            for (int s4 = 0; s4 < 4; ++s4) qf[s4] = *(const bf16x8*)(Q + trow * AW + h * 64 + 16 * s4 + 8 * lh);
            f32x16 Ot[2];
#pragma unroll
            for (int r = 0; r < 16; ++r) { Ot[0][r] = 0.f; Ot[1][r] = 0.f; }
            float m = m0, l = lh == 0 ? 1.0f : 0.0f;
            int kt0 = u, kt1 = u + 8; if (qb == 0 && kt0 < 4) kt0 = 4; if (qb == 63 && kt1 > 7) kt1 = 7;
#pragma unroll 1
            for (int kt = kt0; kt <= kt1; ++kt) {
                f32x16 St;
#pragma unroll
                for (int r = 0; r < 16; ++r) St[r] = 0.f;
                LAS const unsigned char* kp = Ks + (32 * kt + lr) * KROWB + lh * 16;
#pragma unroll
                for (int s4 = 0; s4 < 4; ++s4) St = __builtin_amdgcn_mfma_f32_32x32x16_bf16(*(LAS const bf16x8*)(kp + 32 * s4), qf[s4], St, 0, 0, 0);
                const float base = (float)(32 * (kt - u) - 128) + d0; const bool edge = (kt == u) || (kt == u + 8);
                float tmax = -INFINITY;
#pragma unroll
                for (int r = 0; r < 16; ++r) { const float rel = fabsf(base + (float)((r & 3) + 8 * (r >> 2)));
                    float sv = St[r] * c1 - slope2 * rel; if (edge && rel > 128.0f) sv = -INFINITY; St[r] = sv; tmax = fmaxf(tmax, sv); }
                tmax = fmaxf(tmax, __shfl_xor(tmax, 32));
                const float mn = fmaxf(m, tmax), scl = exp2f(m - mn); m = mn; l *= scl;
#pragma unroll
                for (int r = 0; r < 16; ++r) { Ot[0][r] *= scl; Ot[1][r] *= scl; }
#pragma unroll
                for (int r = 0; r < 16; ++r) { const float p = exp2f(St[r] - mn); l += p; St[r] = p; }
                const bf16x8 pf0 = pack_step<0>(St), pf1 = pack_step<1>(St);
                LAS const unsigned char* vp = Vs + lr * VROWB + (32 * kt + 8 * lh) * 2;
#pragma unroll
                for (int dt = 0; dt < 2; ++dt) {
                    Ot[dt] = __builtin_amdgcn_mfma_f32_32x32x16_bf16(*(LAS const bf16x8*)(vp + dt * 32 * VROWB), pf0, Ot[dt], 0, 0, 0);
                    Ot[dt] = __builtin_amdgcn_mfma_f32_32x32x16_bf16(*(LAS const bf16x8*)(vp + dt * 32 * VROWB + 32), pf1, Ot[dt], 0, 0, 0);
                }
            }
            l += __shfl_xor(l, 32);
            const float il = 1.0f / l;
            bf16_t* op = O + trow * AW + h * 64 + 4 * lh;
#pragma unroll
            for (int dt = 0; dt < 2; ++dt)
#pragma unroll
                for (int gq = 0; gq < 4; ++gq)
                    *(u32x2*)(op + 32 * dt + 8 * gq) = (u32x2){cvtpk(Ot[dt][4 * gq] * il, Ot[dt][4 * gq + 1] * il), cvtpk(Ot[dt][4 * gq + 2] * il, Ot[dt][4 * gq + 3] * il)};
        }
    }
    __syncthreads();
}

__device__ __forceinline__ float block_sum(Frame& F, float v, LAS float* red) {
    v = wave_sum(v);
    __syncthreads();
    if (F.lane == 0) red[F.wave] = v;
    __syncthreads();
    float s = 0.f;
#pragma unroll
    for (int i = 0; i < NWAVES; ++i) s += red[i];
    return s;
}

namespace hy {
typedef float f32x16 __attribute__((ext_vector_type(16)));
typedef __bf16 bf16x2_t __attribute__((ext_vector_type(2)));
constexpr int ROWB = 272, TABB = 128 * ROWB, DROWB = 528, FT_OFF = 0, X_OFF = 2 * TABB, SP_OFF = 4 * TABB;
#define HY_SBAR() do { asm volatile("" ::: "memory"); __builtin_amdgcn_sched_barrier(0); } while (0)
#define MFMA32(a, b, c) __builtin_amdgcn_mfma_f32_32x32x16_bf16((a), (b), (c), 0, 0, 0)
__device__ __forceinline__ int crow(int r, int h) { return (r & 3) + 8 * (r >> 2) + 4 * h; }
__device__ __forceinline__ int q16(int c) { return 8 * ((c >> 2) & 1) + 4 * (c >> 3) + (c & 3); }
__device__ __forceinline__ int kstore(int k) { return (k & ~15) + q16(k & 15); }
__device__ __forceinline__ unsigned cvtpk(float lo, float hi) { f32x2 v = {lo, hi}; bf16x2_t b = __builtin_convertvector(v, bf16x2_t); return __builtin_bit_cast(unsigned, b); }
__device__ __forceinline__ bf16x8 neg8(bf16x8 v) { u32x4 u = __builtin_bit_cast(u32x4, v); u.x ^= 0x80008000u; u.y ^= 0x80008000u; u.z ^= 0x80008000u; u.w ^= 0x80008000u; return __builtin_bit_cast(bf16x8, u); }
template <int S> __device__ __forceinline__ bf16x8 pack_step(const f32x16& x) {
    u32x4 p; p.x = cvtpk(x[8 * S], x[8 * S + 1]); p.y = cvtpk(x[8 * S + 2], x[8 * S + 3]); p.z = cvtpk(x[8 * S + 4], x[8 * S + 5]); p.w = cvtpk(x[8 * S + 6], x[8 * S + 7]);
    return __builtin_bit_cast(bf16x8, p);
}
__device__ __forceinline__ bf16x8 ffrag(LAS const unsigned char* ft, int t, int rb, int s, int lr, int lh) {
    return *(LAS const bf16x8*)(ft + (lr * ROWB + lh * 16) + (t * TABB + rb * 32 * ROWB + 32 * s)); }
__device__ __forceinline__ bf16x8 xfrag(LAS const unsigned char* img, int rb, int cs, int lr, int lh) {
    return *(LAS const bf16x8*)(img + (lr * ROWB + lh * 16) + (rb * 32 * ROWB + 16 * cs)); }
__device__ __forceinline__ bf16x8 dfrag(LAS const unsigned char* img, int rb, int cs, int lr, int lh) {
    return *(LAS const bf16x8*)(img + (lr * DROWB + lh * 16) + (rb * 32 * DROWB + 16 * cs)); }
__device__ __forceinline__ void zero16(f32x16& x) {
#pragma unroll
    for (int r = 0; r < 16; ++r) x[r] = 0.f; }
template <bool CONJ> __device__ __forceinline__ void cmul_tile(f32x16& xr, f32x16& xi, const float* w  ) {
#pragma unroll
    for (int r8 = 0; r8 < 4; ++r8) {
        const f32x4 t0 = *(const f32x4*)(w + 8 * r8), t1 = *(const f32x4*)(w + 8 * r8 + 4);
#pragma unroll
        for (int u = 0; u < 4; ++u) { const int r = 4 * r8 + u; const float wr = u < 2 ? t0[2 * u] : t1[2 * u - 4], wi0 = u < 2 ? t0[2 * u + 1] : t1[2 * u - 3]; const float wi = CONJ ? -wi0 : wi0;
            const float a = xr[r], b = xi[r]; xr[r] = a * wr - b * wi; xi[r] = a * wi + b * wr; }
        asm volatile("" ::: "memory");
    }
}
template <bool CPLX, int NK>
__device__ __forceinline__ void s1_tw(LAS const unsigned char* ft, LAS const unsigned char* img, const float* twt, int J, int lane, bf16x8 (&bAr)[8], bf16x8 (&bAi)[8]) {
    const int lr = lane & 31, lh = lane >> 5;
#pragma unroll
    for (int hf = 0; hf < 2; ++hf) {
        f32x16 Ar[2], Ai[2];
#pragma unroll
        for (int i = 0; i < 2; ++i) { zero16(Ar[i]); zero16(Ai[i]); }
#pragma unroll
        for (int s = 0; s < NK; ++s) {
            const bf16x8 bFr = ffrag(ft, 0, J, s, lr, lh), bFi = ffrag(ft, 1, J, s, lr, lh), bnFi = neg8(bFi);
#pragma unroll
            for (int i = 0; i < 2; ++i) {
                const bf16x8 aXr = xfrag(img, 2 * hf + i, 2 * s, lr, lh);
                Ar[i] = MFMA32(aXr, bFr, Ar[i]); Ai[i] = MFMA32(aXr, bFi, Ai[i]);
                if (CPLX) { const bf16x8 aXi = xfrag(img, 2 * hf + i, 8 + 2 * s, lr, lh); Ar[i] = MFMA32(aXi, bnFi, Ar[i]); Ai[i] = MFMA32(aXi, bFr, Ai[i]); }
            }
            HY_SBAR();
        }
#pragma unroll
        for (int i = 0; i < 2; ++i) { const int ig = 2 * hf + i;
            cmul_tile<false>(Ar[i], Ai[i], twt + ((size_t)((ig * 4 + J) * 64 + lane)) * 32);
            bAr[2 * ig] = pack_step<0>(Ar[i]); bAr[2 * ig + 1] = pack_step<1>(Ar[i]); bAi[2 * ig] = pack_step<0>(Ai[i]); bAi[2 * ig + 1] = pack_step<1>(Ai[i]);
            HY_SBAR();
        }
    }
}
__device__ __forceinline__ void s3_half(LAS const unsigned char* ft, const bf16x8 (&bAr)[8], const bf16x8 (&bAi)[8], int Ih, int lane, f32x16 (&Zr)[2], f32x16 (&Zi)[2]) {
    const int lr = lane & 31, lh = lane >> 5;
#pragma unroll
    for (int I = 0; I < 2; ++I) { zero16(Zr[I]); zero16(Zi[I]); }
#pragma unroll
    for (int s = 0; s < 8; ++s) {
        const bf16x8 bnAi = neg8(bAi[s]);
#pragma unroll
        for (int I = 0; I < 2; ++I) {
            const bf16x8 aFr = ffrag(ft, 0, 2 * Ih + I, s, lr, lh), aFi = ffrag(ft, 1, 2 * Ih + I, s, lr, lh);
            Zr[I] = MFMA32(aFr, bAr[s], Zr[I]); Zr[I] = MFMA32(aFi, bnAi, Zr[I]);
            Zi[I] = MFMA32(aFi, bAr[s], Zi[I]); Zi[I] = MFMA32(aFr, bAi[s], Zi[I]);
        }
        HY_SBAR();
    }
}
__device__ __forceinline__ void fwd_filter(LAS const unsigned char* ft, LAS const unsigned char* img, const float* twt, int J, int lane, float scl, float sk, float* kh  ) {
    bf16x8 bAr[8], bAi[8];
    s1_tw<false, 8>(ft, img, twt, J, lane, bAr, bAi);
#pragma unroll
    for (int Ih = 0; Ih < 2; ++Ih) {
        f32x16 Zr[2], Zi[2];
        s3_half(ft, bAr, bAi, Ih, lane, Zr, Zi);
#pragma unroll
        for (int I = 0; I < 2; ++I) { float* dst = kh + ((size_t)((2 * Ih + I) * 64 + lane)) * 32;
#pragma unroll
            for (int r4 = 0; r4 < 8; ++r4) *(f32x4*)(dst + 4 * r4) = (f32x4){Zr[I][2 * r4] * scl + sk, Zi[I][2 * r4] * scl, Zr[I][2 * r4 + 1] * scl + sk, Zi[I][2 * r4 + 1] * scl}; }
        HY_SBAR();
    }
}
__device__ __forceinline__ void s3_filt_i1(LAS const unsigned char* ft, const float* khat  , const float* twt, int J, int lane, const bf16x8 (&bAr)[8], const bf16x8 (&bAi)[8], u32x2 (&dpk)[4][2][4]) {
    const int lr = lane & 31, lh = lane >> 5;
    bf16x8 aYr[8], aYi[8];
#pragma unroll
    for (int Ih = 0; Ih < 2; ++Ih) {
        f32x16 Zr[2], Zi[2];
        s3_half(ft, bAr, bAi, Ih, lane, Zr, Zi);
#pragma unroll
        for (int I = 0; I < 2; ++I) { const int Ig = 2 * Ih + I;
            cmul_tile<false>(Zr[I], Zi[I], khat + ((size_t)(Ig * 64 + lane)) * 32);
            aYr[2 * Ig] = pack_step<0>(Zr[I]); aYr[2 * Ig + 1] = pack_step<1>(Zr[I]); aYi[2 * Ig] = pack_step<0>(Zi[I]); aYi[2 * Ig + 1] = pack_step<1>(Zi[I]);
            HY_SBAR();
        }
    }
#pragma unroll
    for (int ch = 0; ch < 2; ++ch) {
        f32x16 Cr[2], Ci[2];
#pragma unroll
        for (int c = 0; c < 2; ++c) { zero16(Cr[c]); zero16(Ci[c]); }
#pragma unroll
        for (int s = 0; s < 8; ++s) {
            const bf16x8 anYr = neg8(aYr[s]);
#pragma unroll
            for (int c = 0; c < 2; ++c) {
                const bf16x8 bFr = ffrag(ft, 0, 2 * ch + c, s, lr, lh), bFi = ffrag(ft, 1, 2 * ch + c, s, lr, lh);
                Cr[c] = MFMA32(aYr[s], bFr, Cr[c]); Cr[c] = MFMA32(aYi[s], bFi, Cr[c]);
                Ci[c] = MFMA32(anYr, bFi, Ci[c]); Ci[c] = MFMA32(aYi[s], bFr, Ci[c]);
            }
            HY_SBAR();
        }
#pragma unroll
        for (int c = 0; c < 2; ++c) { const int cg = 2 * ch + c;
            cmul_tile<true>(Cr[c], Ci[c], twt + ((size_t)((J * 4 + cg) * 64 + lane)) * 32);
#pragma unroll
            for (int g = 0; g < 4; ++g) {
                dpk[cg][0][g] = (u32x2){cvtpk(Cr[c][4 * g], Cr[c][4 * g + 1]), cvtpk(Cr[c][4 * g + 2], Cr[c][4 * g + 3])};
                dpk[cg][1][g] = (u32x2){cvtpk(Ci[c][4 * g], Ci[c][4 * g + 1]), cvtpk(Ci[c][4 * g + 2], Ci[c][4 * g + 3])};
            }
            HY_SBAR();
        }
    }
}
__device__ __forceinline__ void write_D(LAS unsigned char* dimg, const u32x2 (&dpk)[4][2][4], int J, int lane) {
    const int lr = lane & 31, lh = lane >> 5;
    LAS unsigned char* base = dimg + lr * DROWB + lh * 16 + J * 64;
#pragma unroll
    for (int c = 0; c < 4; ++c)
#pragma unroll
        for (int g = 0; g < 4; ++g) {
            *(LAS u32x2*)(base + c * 32 * DROWB + 32 * (g >> 1) + 8 * (g & 1)) = dpk[c][0][g];
            *(LAS u32x2*)(base + c * 32 * DROWB + 256 + 32 * (g >> 1) + 8 * (g & 1)) = dpk[c][1][g]; }
}
__device__ __forceinline__ void i3_wave(LAS const unsigned char* ft, LAS const unsigned char* dimg, int a, int c, int lane, f32x16& yr, f32x16& yi) {
    const int lr = lane & 31, lh = lane >> 5;
    zero16(yr); zero16(yi);
#pragma unroll
    for (int s = 0; s < 8; ++s) {
        const bf16x8 aFr = ffrag(ft, 0, a, s, lr, lh), aFi = ffrag(ft, 1, a, s, lr, lh), anFi = neg8(aFi);
        const bf16x8 bDr = dfrag(dimg, c, 2 * s, lr, lh), bDi = dfrag(dimg, c, 16 + 2 * s, lr, lh);
        yr = MFMA32(aFr, bDr, yr); yr = MFMA32(aFi, bDi, yr);
        yi = MFMA32(aFr, bDi, yi); yi = MFMA32(anFi, bDr, yi);
        HY_SBAR();
    }
}
__device__ __forceinline__ int img_off(int n2, int ks) { return n2 * ROWB + ks * 2; }
}

__device__ __forceinline__ void ph_hyena_fft(Frame& F) {
    using namespace hy;
    const bf16_t* UT = (const bf16_t*)(F.ws + WS_UT); bf16_t* HYT = (bf16_t*)(F.ws + WS_HYT);
    const float* hdn = (const float*)(F.ws + WS_HDN); const float* w3 = F.in[I_FW3]; const float* decay = F.in[I_DECAY];
    const float* convw = F.in[I_CONVW]; const float* convb = F.in[I_CONVB]; const float* skip = F.in[I_SKIP];
    const float* twt = (const float*)(F.ws + WS_TWT);
    float* khat = (float*)(F.ws + WS_KHAT + (size_t)blockIdx.x * 262144);
    bf16_t* gt = (bf16_t*)(F.ws + WS_GT + (size_t)blockIdx.x * 131072);
    LAS unsigned char* ft = F.lds + FT_OFF; LAS unsigned char* xr = F.lds + X_OFF;
    LAS float* w3s = (LAS float*)(F.lds + SP_OFF);
    LAS float* red = w3s + 256;
    const int wid = F.wave;
#define HY_IDS int tid = F.tid; asm volatile("" : "+v"(tid)); const int lane = tid & 63, lr = lane & 31, lh = lane >> 5; (void)lr; (void)lh; (void)lane;
    __syncthreads();
    { const u32x4* src = (const u32x4*)(F.ws + WS_FTAB);
      for (int i = F.tid; i < 2 * TABB / 16; i += NTHREADS) *(LAS u32x4*)(ft + i * 16) = src[i]; }
    for (int c = blockIdx.x; c < HW; c += F.G) {
        __syncthreads();
        { HY_IDS
#pragma unroll 1
        for (int i = 0; i < 8; ++i) {
            const int ci = tid + 512 * i; const int od = ci >> 10, t0 = (ci & 1023) * 8, o = od >> 1, dir = od & 1;
            const bf16_t* krow = (const bf16_t*)(F.ws + WS_KRAW) + (size_t)(o * 1024 + dir * 512 + c) * SEQ;
            const u32x4 w = *(const u32x4*)(krow + t0);
            const unsigned short e[8] = {(unsigned short)w.x, (unsigned short)(w.x >> 16), (unsigned short)w.y, (unsigned short)(w.y >> 16), (unsigned short)w.z, (unsigned short)(w.z >> 16), (unsigned short)w.w, (unsigned short)(w.w >> 16)};
            LAS unsigned char* img = xr + o * TABB;
#pragma unroll
            for (int j = 0; j < 8; ++j) { const int t = t0 + j; int n = dir ? 2 * SEQ - t : t; unsigned short v = e[j];
                if (dir && t == 0) { n = SEQ; v = 0; }
                *(LAS bf16_t*)(img + img_off(n & 127, kstore(n >> 7))) = v; }
        }
        }
        __syncthreads();
        { HY_IDS
            const int o = wid >> 2, J = wid & 3;
            float nsum = 0.f;
            { const float* kp = (const float*)(F.ws + WS_KPART);
              for (int i = 0; i < 32; ++i) nsum += kp[(size_t)(o * 1024 + c) * 32 + i] + kp[(size_t)(o * 1024 + 512 + c) * 32 + i]; }
            const float scl = 1.0f / (nsum * (float)(2 * SEQ)), sk = skip[o * HW + c] * (1.0f / (float)(2 * SEQ));
            fwd_filter(ft, xr + o * TABB, twt, J, lane, scl, sk, khat + (size_t)((o * 4 + J) * 4) * 64 * 32);
        }
        __syncthreads();
        for (int rd = 0; rd < 8; ++rd) { HY_IDS
            {
#pragma unroll
                for (int half = 0; half < 2; ++half) {
                    const int blk = 2 * rd + half, g = blk >> 3, b = (blk >> 1) & 3, a = blk & 1; const int chg = (g + 1) * HW + c;
                    const bf16_t* row = UT + (size_t)chg * T + (size_t)b * SEQ;
                    const int t0 = 4096 * a + 8 * tid;
                    const u32x4 w = *(const u32x4*)(row + t0);
                    float u[10];
                    u[1] = bflo(w.x); u[2] = bfhi(w.x); u[3] = bflo(w.y); u[4] = bfhi(w.y); u[5] = bflo(w.z); u[6] = bfhi(w.z); u[7] = bflo(w.w); u[8] = bfhi(w.w);
                    u[0] = t0 > 0 ? bf2f(row[t0 - 1]) : 0.f; u[9] = t0 + 8 < SEQ ? bf2f(row[t0 + 8]) : 0.f;
                    const float w0 = convw[chg], w1 = convw[NHY + chg], w2 = convw[2 * NHY + chg], bb = convb[chg];
                    float v[8];
#pragma unroll
                    for (int i = 0; i < 8; ++i) v[i] = w0 * u[i] + w1 * u[i + 1] + w2 * u[i + 2] + bb;
                    *(LAS u32x4*)(xr + half * 8192 + tid * 16) = (u32x4){pk2(v[0], v[1]), pk2(v[2], v[3]), pk2(v[4], v[5]), pk2(v[6], v[7])};
                }
            }
            __syncthreads();
            {
                const int half = tid >> 8, c4 = (tid >> 6) & 3; const int blk = 2 * rd + half;
                LAS const bf16_t* st = (LAS const bf16_t*)(xr + half * 8192);
                unsigned pk[8];
#pragma unroll
                for (int r2 = 0; r2 < 8; ++r2) { const unsigned lo = st[crow(2 * r2, lh) * 128 + 32 * c4 + lr], hi = st[crow(2 * r2 + 1, lh) * 128 + 32 * c4 + lr]; pk[r2] = lo | (hi << 16); }
                bf16_t* dst = gt + ((size_t)((blk * 4 + c4) * 64 + lane)) * 16;
                *(u32x4*)dst = (u32x4){pk[0], pk[1], pk[2], pk[3]}; *(u32x4*)(dst + 8) = (u32x4){pk[4], pk[5], pk[6], pk[7]};
            }
            __syncthreads();
        }
        u32x2 z1p[2][2][4];
        const int p = wid >> 2, J = wid & 3, ta = wid >> 2, tc = wid & 3;
        for (int o = 0; o < 2; ++o) {
            { HY_IDS
            if (o == 0) {
                const float w0 = convw[c], w1 = convw[NHY + c], w2 = convw[2 * NHY + c], bb = convb[c];
#pragma unroll 1
                for (int i = 0; i < 8; ++i) {
                    const int ci = tid + 512 * i; const int b = ci >> 10, t0 = (ci & 1023) * 8;
                    const bf16_t* row = UT + (size_t)c * T + (size_t)b * SEQ;
                    const u32x4 w = *(const u32x4*)(row + t0);
                    float u[10];
                    u[1] = bflo(w.x); u[2] = bfhi(w.x); u[3] = bflo(w.y); u[4] = bfhi(w.y); u[5] = bflo(w.z); u[6] = bfhi(w.z); u[7] = bflo(w.w); u[8] = bfhi(w.w);
                    u[0] = t0 > 0 ? bf2f(row[t0 - 1]) : 0.f; u[9] = t0 + 8 < SEQ ? bf2f(row[t0 + 8]) : 0.f;
                    const int n1 = t0 >> 7, n2 = t0 & 127; const int ks = kstore(n1) + 64 * (b & 1);
                    LAS unsigned char* img = xr + (b >> 1) * TABB;
#pragma unroll
                    for (int j = 0; j < 8; ++j) *(LAS bf16_t*)(img + img_off(n2 + j, ks)) = (bf16_t)f2bf(w0 * u[j] + w1 * u[j + 1] + w2 * u[j + 2] + bb);
                }
            } else {
#pragma unroll
                for (int q = 0; q < 2; ++q) { LAS unsigned char* img = xr + q * TABB + (32 * tc + lr) * ROWB + lh * 16 + ta * 64;
#pragma unroll
                    for (int g = 0; g < 4; ++g) {
                        *(LAS u32x2*)(img + 32 * (g >> 1) + 8 * (g & 1)) = z1p[q][0][g];
                        *(LAS u32x2*)(img + 128 + 32 * (g >> 1) + 8 * (g & 1)) = z1p[q][1][g]; } }
            }
            }
            __syncthreads();
            u32x2 dpk[4][2][4];
            { HY_IDS
                bf16x8 bAr[8], bAi[8];
                s1_tw<true, 4>(ft, xr + p * TABB, twt, J, lane, bAr, bAi);
                __syncthreads();
                s3_filt_i1(ft, khat + (size_t)((o * 4 + J) * 4) * 64 * 32, twt, J, lane, bAr, bAi, dpk);
            }
#pragma unroll 1
            for (int q = 0; q < 2; ++q) { HY_IDS
                if (p == q) write_D(xr, dpk, J, lane);
                __syncthreads();
                f32x16 yr, yi;
                i3_wave(ft, xr, ta, tc, lane, yr, yi);
                const bf16_t* g0 = gt + ((size_t)((((o * 4 + 2 * q) * 2 + ta) * 4 + tc) * 64 + lane)) * 16;
                const bf16_t* g1 = gt + ((size_t)((((o * 4 + 2 * q + 1) * 2 + ta) * 4 + tc) * 64 + lane)) * 16;
                const u32x4 ga = *(const u32x4*)g0, gb = *(const u32x4*)(g0 + 8), gc = *(const u32x4*)g1, gd = *(const u32x4*)(g1 + 8);
                const unsigned gre[8] = {ga.x, ga.y, ga.z, ga.w, gb.x, gb.y, gb.z, gb.w}, gim[8] = {gc.x, gc.y, gc.z, gc.w, gd.x, gd.y, gd.z, gd.w};
#pragma unroll
                for (int r2 = 0; r2 < 8; ++r2) { yr[2 * r2] *= bflo(gre[r2]); yr[2 * r2 + 1] *= bfhi(gre[r2]); yi[2 * r2] *= bflo(gim[r2]); yi[2 * r2 + 1] *= bfhi(gim[r2]); }
                {
#pragma unroll
                    for (int g = 0; g < 4; ++g) { z1p[q][0][g] = (u32x2){cvtpk(yr[4 * g], yr[4 * g + 1]), cvtpk(yr[4 * g + 2], yr[4 * g + 3])};
                                                  z1p[q][1][g] = (u32x2){cvtpk(yi[4 * g], yi[4 * g + 1]), cvtpk(yi[4 * g + 2], yi[4 * g + 3])}; }
                }
                if (o == 1) {
                    bf16_t* o0 = HYT + (size_t)c * T + (size_t)(2 * q) * SEQ + 32 * tc + lr; bf16_t* o1 = o0 + SEQ;
#pragma unroll
                    for (int r = 0; r < 16; ++r) { const int n1 = 32 * ta + crow(r, lh); o0[128 * n1] = (bf16_t)f2bf(yr[r]); o1[128 * n1] = (bf16_t)f2bf(yi[r]); }
                }
                __syncthreads();
            }
        }
    }
    __syncthreads();
#undef HY_IDS
}

__device__ __forceinline__ void ph_hyT(Frame& F) {
    const bf16_t* HYT = (const bf16_t*)(F.ws + WS_HYT); bf16_t* HY = (bf16_t*)(F.ws + WS_HY);
    for (int it = blockIdx.x; it < 8 * (T / 512); it += F.G) {
        const int cb = it & 7, tb = it >> 3; const int t = tb * 512 + F.tid, c0 = cb * 64;
        unsigned w[32];
#pragma unroll
        for (int i = 0; i < 32; ++i) { const unsigned lo = HYT[(size_t)(c0 + 2 * i) * T + t], hi = HYT[(size_t)(c0 + 2 * i + 1) * T + t]; w[i] = lo | (hi << 16); }
#pragma unroll
        for (int i = 0; i < 8; ++i) *(u32x4*)(HY + (size_t)t * HW + c0 + 8 * i) = (u32x4){w[4 * i], w[4 * i + 1], w[4 * i + 2], w[4 * i + 3]};
    }
}

__device__ __forceinline__ void ph_expert_cvt(Frame& F) {
    LAS float* scr = (LAS float*)(F.lds + F.wave * 16384);
    const int gw = F.vcu * NWAVES + F.wave, NGW = F.G * NWAVES;
    bf16_t* W13 = (bf16_t*)(F.ws + WS_W13); bf16_t* W2 = (bf16_t*)(F.ws + WS_W2);
    for (int it = gw; it < NE * 768; it += NGW) {
        const int e = it / 768; int r = it % 768;
        if (r < 512) { const bool is3 = r >= 256; r &= 255; const int kb = r / 16, nb = r % 16, n0 = nb * 32;
            const int drow = (n0 >> 7) * 256 + (is3 ? 128 : 0) + (n0 & 127);
            transpose_item(F.in[is3 ? I_EW3 : I_EW1] + (size_t)e * DM * DE, DM, DE, W13 + (size_t)e * DM * DM, DM, drow, scr, kb, nb, F.lane); }
        else { r -= 512; const int kb = r / 32, nb = r % 32;
            transpose_item(F.in[I_EW2] + (size_t)e * DE * DM, DE, DM, W2 + (size_t)e * DM * DE, DE, nb * 32, scr, kb, nb, F.lane); }
    }
}

__device__ __forceinline__ void ph_ln1_route(Frame& F) {
    float* v = F.out; bf16_t* h2b = (bf16_t*)(F.ws + WS_HB);
    const float* mod = (const float*)(F.ws + WS_MOD); const float* g1 = F.in[I_LN1G]; const float* b1 = F.in[I_LN1B];
    const float* wrt = (const float*)(F.ws + WS_WRT); const float* bg = F.in[I_RGB]; const float* be = F.in[I_REB];
    unsigned* cnt = F.ctl + CW_CNT; int* btok = (int*)(F.ws + WS_BTOK); float* bw = (float*)(F.ws + WS_BW);
    const int gw = F.vcu * NWAVES + F.wave, NGW = F.G * NWAVES;
    for (int row = gw; row < T; row += NGW) {
        const int b = row / SEQ;
        f32x4* xr = (f32x4*)(v + (size_t)row * DM) + F.lane;
        f32x4 x[4]; float s = 0.f;
#pragma unroll
        for (int j = 0; j < 4; ++j) { x[j] = xr[64 * j]; s += (x[j][0] + x[j][1]) + (x[j][2] + x[j][3]); }
        const float mean = wave_sum(s) * (1.f / DM); float s2 = 0.f;
#pragma unroll
        for (int j = 0; j < 4; ++j) { x[j] = x[j] - mean; s2 += (x[j][0] * x[j][0] + x[j][1] * x[j][1]) + (x[j][2] * x[j][2] + x[j][3] * x[j][3]); }
        const float rstd = 1.f / sqrtf(wave_sum(s2) * (1.f / DM) + LN_EPS);
        f32x4 h[4];
        unsigned long long* o8 = (unsigned long long*)(h2b + (size_t)row * DM) + F.lane;
#pragma unroll
        for (int j = 0; j < 4; ++j) { const int k = 4 * F.lane + 256 * j;
            const f32x4 gg = *(const f32x4*)(g1 + k), bb = *(const f32x4*)(b1 + k);
            const f32x4 sh = *(const f32x4*)(mod + (size_t)b * 6144 + 3072 + k), sc = *(const f32x4*)(mod + (size_t)b * 6144 + 4096 + k);
            x[j] = x[j] * rstd * gg + bb; xr[64 * j] = x[j];
            h[j] = x[j] * (sc + 1.0f) + sh;
            o8[64 * j] = (unsigned long long)pk2(h[j][0], h[j][1]) | ((unsigned long long)pk2(h[j][2], h[j][3]) << 32); }
        float gl[8];
#pragma unroll
        for (int o = 0; o < 8; ++o) { float p = 0.f;
#pragma unroll
            for (int j = 0; j < 4; ++j) { const f32x4 w = *(const f32x4*)(wrt + (size_t)o * DM + 4 * F.lane + 256 * j); p += h[j][0] * w[0] + h[j][1] * w[1] + h[j][2] * w[2] + h[j][3] * w[3]; }
            gl[o] = wave_sum(p) + bg[o]; }
        float gmax = gl[0]; int g = 0;
#pragma unroll
        for (int i = 1; i < 8; ++i) if (gl[i] > gmax) { gmax = gl[i]; g = i; }
        float den = 0.f;
#pragma unroll
        for (int i = 0; i < 8; ++i) den += __expf(gl[i] - gmax);
        const float pg = 1.0f / den;
        float el[8];
#pragma unroll
        for (int o = 0; o < 8; ++o) { float p = 0.f; const float* wr_ = wrt + (size_t)(8 + g * 8 + o) * DM;
#pragma unroll
            for (int j = 0; j < 4; ++j) { const f32x4 w = *(const f32x4*)(wr_ + 4 * F.lane + 256 * j); p += h[j][0] * w[0] + h[j][1] * w[1] + h[j][2] * w[2] + h[j][3] * w[3]; }
            el[o] = wave_sum(p) + be[g * 8 + o]; }
        int i1 = 0; float e1 = el[0];
#pragma unroll
        for (int j = 1; j < 8; ++j) if (el[j] > e1) { e1 = el[j]; i1 = j; }
        int i2 = -1; float e2 = -INFINITY;
#pragma unroll
        for (int j = 0; j < 8; ++j) if (j != i1 && (i2 < 0 || el[j] > e2)) { e2 = el[j]; i2 = j; }
        const float r = __expf(e2 - e1); const float wa = pg / (1.0f + r), wb = pg * r / (1.0f + r);
        if (F.lane == 0) {
            const int ea = g * 8 + i1, eb = g * 8 + i2;
            const unsigned ra = atomicAdd(&cnt[ea], 1u); btok[(size_t)ea * ECAP + ra] = row * 2; bw[(size_t)ea * ECAP + ra] = wa;
            const unsigned rb = atomicAdd(&cnt[eb], 1u); btok[(size_t)eb * ECAP + rb] = row * 2 + 1; bw[(size_t)eb * ECAP + rb] = wb;
        }
    }
}

__device__ __forceinline__ void build_moe_tab(Frame& F, LAS int* tab) {
    __syncthreads();
    if (F.tid < 64) tab[72 + F.tid] = (int)__hip_atomic_load(F.ctl + CW_CNT + F.tid, __ATOMIC_RELAXED, __HIP_MEMORY_SCOPE_AGENT);
    __syncthreads();
    if (F.tid == 0) { int s = 0; for (int e = 0; e < 64; ++e) { tab[e] = s; s += (tab[72 + e] + 255) >> 8; } tab[64] = s; }
    __syncthreads();
}

__device__ __forceinline__ void ph_final(Frame& F) {
    float* v = F.out; const bf16_t* y2 = (const bf16_t*)(F.ws + WS_Y2);
    const float* mod = (const float*)(F.ws + WS_MOD); const float* g2 = F.in[I_LN2G]; const float* b2 = F.in[I_LN2B];
    const int gw = F.vcu * NWAVES + F.wave, NGW = F.G * NWAVES;
    for (int row = gw; row < T; row += NGW) {
        const int b = row / SEQ;
        f32x4* xr = (f32x4*)(v + (size_t)row * DM) + F.lane;
        const unsigned long long* ya = (const unsigned long long*)(y2 + (size_t)(2 * row) * DM) + F.lane;
        const unsigned long long* yb = (const unsigned long long*)(y2 + (size_t)(2 * row + 1) * DM) + F.lane;
        f32x4 x[4]; float s = 0.f;
#pragma unroll
        for (int j = 0; j < 4; ++j) { const int k = 4 * F.lane + 256 * j;
            const f32x4 gt = *(const f32x4*)(mod + (size_t)b * 6144 + 5120 + k);
            const unsigned long long a = ya[64 * j], c = yb[64 * j];
            f32x4 y; y[0] = bflo((unsigned)a) + bflo((unsigned)c); y[1] = bfhi((unsigned)a) + bfhi((unsigned)c);
            y[2] = bflo((unsigned)(a >> 32)) + bflo((unsigned)(c >> 32)); y[3] = bfhi((unsigned)(a >> 32)) + bfhi((unsigned)(c >> 32));
            x[j] = xr[64 * j] * DN_ALPHA + gt * y; s += (x[j][0] + x[j][1]) + (x[j][2] + x[j][3]); }
        const float mean = wave_sum(s) * (1.f / DM); float s2 = 0.f;
#pragma unroll
        for (int j = 0; j < 4; ++j) { x[j] = x[j] - mean; s2 += (x[j][0] * x[j][0] + x[j][1] * x[j][1]) + (x[j][2] * x[j][2] + x[j][3] * x[j][3]); }
        const float rstd = 1.f / sqrtf(wave_sum(s2) * (1.f / DM) + LN_EPS);
#pragma unroll
        for (int j = 0; j < 4; ++j) { const int k = 4 * F.lane + 256 * j; xr[64 * j] = x[j] * rstd * *(const f32x4*)(g2 + k) + *(const f32x4*)(b2 + k); }
    }
}

constexpr int N_PHASES = 12;
__device__ __forceinline__ Frame make_frame(const Args& args, unsigned char* lds) {
    Frame F;
    F.lds = (LAS unsigned char*)lds; F.ws = args.ws; F.ctl = (unsigned*)(args.ws + WS_CTL);
    F.tid = threadIdx.x; F.lane = F.tid & 63; F.wave = __builtin_amdgcn_readfirstlane(F.tid >> 6);
    F.G = gridDim.x; { const int bx = blockIdx.x; F.vcu = (F.G % 8 == 0) ? (bx % 8) * (F.G / 8) + bx / 8 : bx; }
    F.in = args.in; F.out = args.out;
    return F;
}
template <unsigned PH_MASK> __global__ void __launch_bounds__(NTHREADS, 2) mk_fwd(Args args) {
    extern __shared__ __attribute__((aligned(16))) unsigned char lds[];
    for (int u = threadIdx.x; u < (LDS_BYTES - LDSCTL_OFF) / 4; u += NTHREADS) ((LAS unsigned*)((LAS unsigned char*)lds + LDSCTL_OFF))[u] = 0u;
    __syncthreads();
    constexpr bool multi = (PH_MASK & (PH_MASK - 1u)) != 0u;
    if (multi) xcd_barrier_post((unsigned*)(args.ws + WS_CTL) + CW_BAR);
#define IN(k) ((PH_MASK >> (k)) & 1u)
#define SEAM(k) do { if (IN(k) && IN((k) + 1)) xcd_barrier((unsigned*)(args.ws + WS_CTL) + CW_BAR, (volatile LAS unsigned*)((LAS unsigned char*)lds + MISC_OFF) + 8); } while (0)
#define RING ((LAS unsigned char*)lds)
#define TAB ((LAS int*)((LAS unsigned char*)lds + TAB_OFF))

    if (IN(0)) { Frame F = make_frame(args, lds); ph_prep(F); } SEAM(0);
    if (IN(1)) { Frame F = make_frame(args, lds); ph_taps(F); ph_hb(F); } SEAM(1);
    if (IN(2)) {
        { pg8::DenseSched S; S.init(T, N1A, DM, gridDim.x, (int)blockIdx.x, args.ws + WS_WIN);
          pg8::EpiInA E{(bf16_t*)(args.ws + WS_Q), (bf16_t*)(args.ws + WS_K), (bf16_t*)(args.ws + WS_V), (bf16_t*)(args.ws + WS_GA), (bf16_t*)(args.ws + WS_GH)};
          pg8::gemm_phase<pg8::EpiInA, pg8::DenseSched, true>(RING, args.ws + WS_HB, DM, S, E); }
        { pg8::DenseSched S; S.init(NHY, T, DM, gridDim.x, (int)blockIdx.x, args.ws + WS_HB);
          pg8::EpiBf16 E{(bf16_t*)(args.ws + WS_UT), T};
          pg8::gemm_phase<pg8::EpiBf16, pg8::DenseSched, true>(RING, args.ws + WS_WIN + (size_t)N1A * DM * 2, DM, S, E); }
    } SEAM(2);
    if (IN(3)) { Frame F = make_frame(args, lds); ph_attn(F); ph_hyena_fft(F); } SEAM(3);
    if (IN(4)) { Frame F = make_frame(args, lds); ph_hyT(F); } SEAM(4);
    if (IN(5)) {
        pg8::DenseSched S; S.init(T, DM, AW, gridDim.x, (int)blockIdx.x, args.ws + WS_WA);
        pg8::EpiGate<false> E{(const bf16_t*)(args.ws + WS_GA), nullptr, (bf16_t*)(args.ws + WS_TMP)};
        pg8::gemm_phase<pg8::EpiGate<false>, pg8::DenseSched, true>(RING, args.ws + WS_ATT, AW, S, E);
    } SEAM(5);
    if (IN(6)) {
        pg8::DenseSched S; S.init(T, DM, HW, gridDim.x, (int)blockIdx.x, args.ws + WS_WH);
        pg8::EpiGate<true> E{(const bf16_t*)(args.ws + WS_GH), (const bf16_t*)(args.ws + WS_TMP), (bf16_t*)(args.ws + WS_HB)};
        pg8::gemm_phase<pg8::EpiGate<true>, pg8::DenseSched, true>(RING, args.ws + WS_HY, HW, S, E);
    } SEAM(6);
    if (IN(7)) {
        { pg8::DenseSched S; S.init(T, DM, DM, gridDim.x, (int)blockIdx.x, args.ws + WS_WO);
          pg8::EpiRes E{args.in[I_X], (const float*)(args.ws + WS_MOD) + 2048, args.out};
          pg8::gemm_phase<pg8::EpiRes, pg8::DenseSched, true>(RING, args.ws + WS_HB, DM, S, E); }
        { Frame F = make_frame(args, lds); ph_expert_cvt(F); }
    } SEAM(7);
    if (IN(8)) { Frame F = make_frame(args, lds); ph_ln1_route(F); } SEAM(8);
    if (IN(9)) {
        { Frame F = make_frame(args, lds); build_moe_tab(F, TAB); }
        const int G = gridDim.x, bx = blockIdx.x, vcu = (G % 8 == 0) ? (bx % 8) * (G / 8) + bx / 8 : bx;
        pg8::MoeSched S{TAB, (const int*)(args.ws + WS_BTOK), (const char*)(args.ws + WS_W13), (size_t)DM * DM * 2, G, vcu, DM, true};
        pg8::EpiSwiGLU E{(bf16_t*)(args.ws + WS_HACT)};
        pg8::gemm_phase<pg8::EpiSwiGLU, pg8::MoeSched, true>(RING, args.ws + WS_HB, DM, S, E);
    } SEAM(9);
    if (IN(10)) {
        { Frame F = make_frame(args, lds); build_moe_tab(F, TAB); }
        const int G = gridDim.x, bx = blockIdx.x, vcu = (G % 8 == 0) ? (bx % 8) * (G / 8) + bx / 8 : bx;
        pg8::MoeSched S{TAB, (const int*)(args.ws + WS_BTOK), (const char*)(args.ws + WS_W2), (size_t)DM * DE * 2, G, vcu, DE, false};
        pg8::EpiScatter E{(bf16_t*)(args.ws + WS_Y2), (const int*)(args.ws + WS_BTOK), (const float*)(args.ws + WS_BW), TAB};
        pg8::gemm_phase<pg8::EpiScatter, pg8::MoeSched, true>(RING, args.ws + WS_HACT, DE, S, E);
    } SEAM(10);
    if (IN(11)) { Frame F = make_frame(args, lds); ph_final(F); }
#undef IN
#undef SEAM
#undef RING
#undef TAB
}

extern "C" void kernel_launch(void* const* d_in, const int* in_sizes, int n_in, void* d_out, int out_size, void* d_ws, size_t ws_size, hipStream_t stream) {
    static int grid = 0;
    if (grid == 0) {
        if (n_in != 31 || out_size != T * DM || ws_size < WS_END) { fprintf(stderr, "kernel_launch: unexpected shapes: n_in %d out %d ws %zu (need %zu)\n", n_in, out_size, ws_size, (size_t)WS_END); grid = -1; return; }
        int dev = 0, cus = 0;
        if (hipGetDevice(&dev) != hipSuccess || hipDeviceGetAttribute(&cus, hipDeviceAttributeMultiprocessorCount, dev) != hipSuccess) { grid = -1; return; }
        bool ok = true;
#define SET_ATTR(m) ok = ok && (hipFuncSetAttribute((const void*)mk_fwd<(m)>, hipFuncAttributeMaxDynamicSharedMemorySize, LDS_BYTES) == hipSuccess)
#if MK_N_LAUNCHES == 1
        SET_ATTR(FUSED_MASK);
#else
        { SET_ATTR(1u << 0); SET_ATTR(1u << 1); SET_ATTR(1u << 2); SET_ATTR(1u << 3); SET_ATTR(1u << 4); SET_ATTR(1u << 5); SET_ATTR(1u << 6); SET_ATTR(1u << 7); SET_ATTR(1u << 8); SET_ATTR(1u << 9); SET_ATTR(1u << 10); SET_ATTR(1u << 11); }
#endif
#undef SET_ATTR
        if (!ok) { fprintf(stderr, "kernel_launch: hipFuncSetAttribute failed\n"); grid = -1; return; }
        (void)hipGetLastError();
        grid = cus;
    }
    if (grid < 0) return;
    if (hipMemsetAsync((char*)d_ws + WS_CTL, 0, CTL_ZERO_BYTES, stream) != hipSuccess) return;
    Args a{};
    for (int i = 0; i < 31; ++i) a.in[i] = (const float*)d_in[i];
    a.out = (float*)d_out; a.ws = (unsigned char*)d_ws;
#if MK_N_LAUNCHES == 1
    a.ph_lo = 0; a.ph_hi = N_PHASES; hipLaunchKernelGGL(mk_fwd<FUSED_MASK>, dim3(grid), dim3(NTHREADS), LDS_BYTES, stream, a);
#else
    {
#define LAUNCH_PH(p) do { a.ph_lo = (p); a.ph_hi = (p) + 1; hipLaunchKernelGGL(mk_fwd<(1u << (p))>, dim3(grid), dim3(NTHREADS), LDS_BYTES, stream, a); } while (0)
        LAUNCH_PH(0); LAUNCH_PH(1); LAUNCH_PH(2); LAUNCH_PH(3); LAUNCH_PH(4); LAUNCH_PH(5); LAUNCH_PH(6); LAUNCH_PH(7); LAUNCH_PH(8); LAUNCH_PH(9); LAUNCH_PH(10); LAUNCH_PH(11);
#undef LAUNCH_PH
    }
#endif
}
```

```cpp
#include <hip/hip_runtime.h>
#include <cstdio>
#include <cstdint>

#ifndef PROBE_DBL
#define PROBE_DBL 0u
#endif
#ifndef PROBE_SUB
#define PROBE_SUB 0u
#endif
#ifndef FUSED_MASK
#define FUSED_MASK 0xFFFu
#endif
#ifndef MK_N_LAUNCHES
#define MK_N_LAUNCHES 1
#endif

#define GAS __attribute__((address_space(1)))
#define LAS __attribute__((address_space(3)))
typedef unsigned short bf16_t;
typedef short bf16x8 __attribute__((ext_vector_type(8)));
typedef float f32x4 __attribute__((ext_vector_type(4)));
typedef float f32x2 __attribute__((ext_vector_type(2)));
typedef unsigned u32x4 __attribute__((ext_vector_type(4)));
typedef unsigned u32x2 __attribute__((ext_vector_type(2)));

constexpr int NB = 4, SEQ = 8192, DM = 1024, T = NB * SEQ;
constexpr int AW = 512, KVW = 128, HW = 512, INW = 4352, N1A = 2816, NHY = 1536;
constexpr int NE = 64, DE = 512, ECAP = 32768;
constexpr int NFILT = 2048, FH = 64, FEMB = 33;
constexpr float LN_EPS = 1e-5f;
constexpr float DN_ALPHA = 1.189207115002721f;
constexpr int NTHREADS = 512, NWAVES = 8;

constexpr size_t MiB = 1u << 20;
constexpr size_t WS_CTL = 0, CTL_ZERO_BYTES = 1 * MiB;
constexpr size_t WS_MODP = 1 * MiB, WS_MOD = 3 * MiB, WS_HDN = 4 * MiB, WS_WRT = 6 * MiB, WS_WIN = 7 * MiB;
constexpr size_t WS_WAH = 16 * MiB, WS_WO = 18 * MiB, WS_BTOK = 20 * MiB, WS_BW = 28 * MiB;
constexpr size_t WS_HB = 36 * MiB;
constexpr size_t WS_Q = 100 * MiB, WS_K = 132 * MiB, WS_V = 140 * MiB, WS_GA = 148 * MiB, WS_GH = 212 * MiB;
constexpr size_t WS_UT = 276 * MiB, WS_TMP = 276 * MiB;
constexpr size_t WS_AH = 372 * MiB;
constexpr size_t WS_HYT = 500 * MiB;
constexpr size_t WS_W13 = 100 * MiB, WS_W2 = 228 * MiB, WS_HACT = 292 * MiB, WS_Y2 = 372 * MiB, WS_END = 532 * MiB;
constexpr size_t WS_FTAB = 15 * MiB + 524288;
constexpr size_t WS_TWT = 15 * MiB + 524288 + 73728;
constexpr size_t WS_KHAT = 36 * MiB;
constexpr size_t WS_GT = 436 * MiB;
constexpr size_t WS_KRAW = 468 * MiB;
constexpr size_t WS_KPART = 6 * MiB + 524288;  constexpr size_t WS_HDNB = WS_HDN;
constexpr int CW_BAR = 4096, CW_CNT = 8192;

constexpr int RING_BYTES = 131072, LDS_BYTES = 163840, LDSCTL_OFF = LDS_BYTES - 2048, MISC_OFF = LDSCTL_OFF + 320, TAB_OFF = LDSCTL_OFF + 1024;

#define LDS_WAIT() asm volatile("s_waitcnt lgkmcnt(0)" ::: "memory")
#define VM_WAIT() asm volatile("s_waitcnt vmcnt(0)" ::: "memory")
__device__ __forceinline__ unsigned f2bf(float f) { unsigned u = __builtin_bit_cast(unsigned, f); return (u + 0x7fffu + ((u >> 16) & 1u)) >> 16; }
__device__ __forceinline__ unsigned pk2(float lo, float hi) { return f2bf(lo) | (f2bf(hi) << 16); }
__device__ __forceinline__ float bf2f(unsigned short b) { return __builtin_bit_cast(float, (unsigned)b << 16); }
__device__ __forceinline__ float bflo(unsigned w) { return __builtin_bit_cast(float, w << 16); }
__device__ __forceinline__ float bfhi(unsigned w) { return __builtin_bit_cast(float, w & 0xffff0000u); }
__device__ __forceinline__ float sigmoidf_(float x) { return 1.0f / (1.0f + __expf(-x)); }
__device__ __forceinline__ float wave_sum(float v) {
#pragma unroll
    for (int o = 1; o < 64; o <<= 1) v += __shfl_xor(v, o);
    return v;
}

namespace pg8 {
constexpr int BM = 256, BK = 64, HALF = 128, HTB = HALF * BK * 2, STAGE_BYTES = 8 * HTB, NXCD = 8, WGM = 8;
__host__ __device__ __forceinline__ int lds_byte(int r, int c) { const int st = (r >> 4) * 2 + (c >> 5), rr = r & 15, cc = c & 31, ob = rr * 64 + cc * 2; return st * 1024 + (ob ^ (((ob >> 9) & 1) << 5)); }
__host__ __device__ __forceinline__ void stage_rc(int b, int& R, int& C) { const int st = b / 1024, sb = b % 1024, swz = sb ^ (((sb >> 9) & 1) << 5); R = (st >> 1) * 16 + swz / 64; C = (st & 1) * 32 + (swz % 64) / 2; }
__host__ __device__ __forceinline__ int perm32(int rho) { const int n = rho >> 4, i = rho & 15; return 8 * (i >> 2) + 4 * n + (i & 3); }

struct Unit { int pm, pn, e, mt; };

struct DenseSched {
    static constexpr bool GATHER = false;
    int nM, nN, nwg, G, c, K; const char* Bt;
    __device__ void init(int M, int N, int K_, int G_, int c_, const void* Bt_) { nM = M / BM; nN = N / BM; nwg = nM * nN; G = G_; c = c_; K = K_; Bt = (const char*)Bt_; }
    __device__ bool next(int i, Unit& u) const {
        const long L = (long)i * G + c; if (L >= nwg) return false;
        int wgid = (int)L; { const int q = nwg / NXCD, r = nwg % NXCD, xcd = wgid % NXCD, off = wgid / NXCD; wgid = (xcd < r ? xcd * (q + 1) : r * (q + 1) + (xcd - r) * q) + off; }
        const int nig = WGM * nN, gid = wgid / nig, fm = gid * WGM, gsz = (nM - fm) < WGM ? (nM - fm) : WGM;
        u.pm = fm + ((wgid % nig) % gsz); u.pn = (wgid % nig) / gsz; u.e = 0; u.mt = 0; return true;
    }
    __device__ __forceinline__ unsigned arow(const Unit& u, int r) const { return (unsigned)(u.pm * BM + r); }
    __device__ __forceinline__ const char* bptr(const Unit& u) const { return Bt + (size_t)u.pn * BM * K * 2; }
};

template <bool GATHER_> struct MoeSched {
    static constexpr bool GATHER = GATHER_;
    const LAS int* tab;
    const int* btok;
    const char* Bt; size_t estride; int G, v, K;
    __device__ bool next(int i, Unit& u) const {
        const int L = i * G + v; const int tile = L >> 2; if (tile >= tab[64]) return false;
        int e = 0;
        for (int j = 1; j < 64; ++j) e += (tab[j] <= tile) ? 1 : 0;
        u.e = e; u.mt = tile - tab[e]; u.pm = tile; u.pn = L & 3; return true;
    }
    __device__ __forceinline__ unsigned arow(const Unit& u, int r) const {
        if (!GATHER_) return (unsigned)(u.pm * BM + r);
        const int idx = u.mt * BM + r; const int cnt = tab[72 + u.e];
        unsigned tok = 0; if (idx < cnt) tok = (unsigned)btok[(size_t)u.e * ECAP + idx] >> 1;
        return tok;
    }
    __device__ __forceinline__ const char* bptr(const Unit& u) const { return Bt + (size_t)u.e * estride + (size_t)u.pn * BM * K * 2; }
};

template <class Epi, class Sched, bool ALIGN_EPI>
__device__ __forceinline__ void gemm_phase(LAS unsigned char* lds, const void* Abase, const int K, const Sched& S, const Epi& E) {
    int tid = threadIdx.x; asm volatile("" : "+v"(tid));
    const int wid = __builtin_amdgcn_readfirstlane(tid >> 6), lane = tid & 63, wr = wid >> 2, wc = wid & 3, fr = lane & 15, fq = lane >> 4;
    const int nt = K / BK;
    int Rr[2], Cc[2]; unsigned voffB[2];
#pragma unroll
    for (int i = 0; i < 2; ++i) { stage_rc(tid * 16 + i * 8192, Rr[i], Cc[i]); const int Rb = Epi::PERM ? ((Rr[i] & ~31) + perm32(Rr[i] & 31)) : Rr[i]; voffB[i] = (unsigned)(Rb * K + Cc[i]) * 2u; }
    const size_t kstep = (size_t)(BK * 2);
    const size_t hstep = (size_t)HALF * K * 2;
    const unsigned ldsw = (unsigned)wid * 1024u;
    const int aoff = lds_byte(wr * 64 + fr, fq * 8), boff = lds_byte(wc * 32 + fr, fq * 8);
#define PG8_SA(b, h) (((b) * 2 + (h)) * HTB)
#define PG8_SB(b, h) ((4 + (b) * 2 + (h)) * HTB)
#define PG8_STAGE(bufoff, gbase, voff) do { _Pragma("unroll") for (int _i = 0; _i < 2; ++_i) \
        __builtin_amdgcn_global_load_lds((const unsigned*)((const char*)(gbase) + (voff)[_i]), (LAS unsigned*)(lds + (bufoff) + ldsw + _i * 8192), 16, 0, 0); } while (0)
#define PG8_LDA(dst, b, h) do { _Pragma("unroll") for (int m = 0; m < 4; ++m) _Pragma("unroll") for (int k = 0; k < 2; ++k) dst[m][k] = *(const LAS bf16x8*)(lds + PG8_SA(b, h) + aoff + m * 2048 + k * 1024); } while (0)
#define PG8_LDB(dst, b, h) do { _Pragma("unroll") for (int n = 0; n < 2; ++n) _Pragma("unroll") for (int k = 0; k < 2; ++k) dst[n][k] = *(const LAS bf16x8*)(lds + PG8_SB(b, h) + boff + n * 2048 + k * 1024); } while (0)
#define PG8_MMA(ai, bj, At, Bt) do { __builtin_amdgcn_s_setprio(1); _Pragma("unroll") for (int m = 0; m < 4; ++m) _Pragma("unroll") for (int n = 0; n < 2; ++n) _Pragma("unroll") for (int k = 0; k < 2; ++k) \
        acc[ai][bj][m][n] = __builtin_amdgcn_mfma_f32_16x16x32_bf16(Bt[n][k], At[m][k], acc[ai][bj][m][n], 0, 0, 0); __builtin_amdgcn_s_setprio(0); } while (0)
#define PG8_WAIT_V(n) asm volatile("s_waitcnt vmcnt(" #n ")" ::: "memory")
#define PG8_WAIT_L(n) asm volatile("s_waitcnt lgkmcnt(" #n ")" ::: "memory")
#define PG8_BAR __builtin_amdgcn_s_barrier()
#define PG8_SCHED __builtin_amdgcn_sched_barrier(0)
    Unit cur, nxt; int ui = 0;
    if (!S.next(0, cur)) return;
    f32x4 acc[2][2][4][2];
#pragma unroll
    for (int a = 0; a < 2; ++a)
#pragma unroll
        for (int b = 0; b < 2; ++b)
#pragma unroll
            for (int m = 0; m < 4; ++m)
#pragma unroll
                for (int n = 0; n < 2; ++n) acc[a][b][m][n] = (f32x4){0.f, 0.f, 0.f, 0.f};
    bf16x8 At[4][2], B0[2][2], B1[2][2];
    constexpr bool GATHER = Sched::GATHER;
    unsigned cv0[2], cv1[2], nv0[2], nv1[2];
#pragma unroll
    for (int i = 0; i < 2; ++i) {
        if constexpr (GATHER) { cv0[i] = (S.arow(cur, Rr[i]) * (unsigned)K + (unsigned)Cc[i]) * 2u; cv1[i] = (S.arow(cur, HALF + Rr[i]) * (unsigned)K + (unsigned)Cc[i]) * 2u; }
        else { cv0[i] = (unsigned)(Rr[i] * K + Cc[i]) * 2u; cv1[i] = cv0[i]; nv0[i] = cv0[i]; nv1[i] = cv0[i]; }
    }
    const char* cA = GATHER ? (const char*)Abase : (const char*)Abase + (size_t)S.arow(cur, 0) * K * 2;
    const size_t ahs = GATHER ? 0 : hstep;
    const char* cB = S.bptr(cur);
    PG8_STAGE(PG8_SB(0, 0), cB, voffB); PG8_STAGE(PG8_SB(0, 1), cB + hstep, voffB); PG8_STAGE(PG8_SA(0, 0), cA, cv0); PG8_STAGE(PG8_SA(0, 1), cA + ahs, cv1);
    if (wr == 1) PG8_BAR;
    PG8_WAIT_V(2); PG8_BAR;
    PG8_STAGE(PG8_SB(1, 0), cB + kstep, voffB); PG8_STAGE(PG8_SA(1, 0), cA + kstep, cv0); PG8_STAGE(PG8_SB(1, 1), cB + hstep + kstep, voffB);
    PG8_WAIT_V(6); PG8_BAR;
    for (;;) {
        const bool has_next = S.next(ui + 1, nxt);
        const char* nB = has_next ? S.bptr(nxt) : cB;
        const char* nA = cA;
        if constexpr (GATHER) {
#pragma unroll
            for (int i = 0; i < 2; ++i) {
                nv0[i] = has_next ? (S.arow(nxt, Rr[i]) * (unsigned)K + (unsigned)Cc[i]) * 2u : cv0[i];
                nv1[i] = has_next ? (S.arow(nxt, HALF + Rr[i]) * (unsigned)K + (unsigned)Cc[i]) * 2u : cv1[i];
            }
        } else { if (has_next) nA = (const char*)Abase + (size_t)S.arow(nxt, 0) * K * 2; }
        for (int t = 0; t < nt; t += 2) {
            const bool last = (t == nt - 2);
            if constexpr (Epi::HAS_MID) { if (t == (nt >> 1)) E.mid(acc, cur, wr, wc, fr, fq); }
            const char* a1 = cA + (size_t)(t + 1) * kstep;
            const char* a2 = last ? nA : cA + (size_t)(t + 2) * kstep; const char* b2 = last ? nB : cB + (size_t)(t + 2) * kstep;
            const char* a3 = a2 + kstep; const char* b3 = b2 + kstep;
            unsigned x0[2], x1[2];
#pragma unroll
            for (int i = 0; i < 2; ++i) { x0[i] = (GATHER && last) ? nv0[i] : cv0[i]; x1[i] = (GATHER && last) ? nv1[i] : cv1[i]; }
            PG8_LDB(B0, 0, 0); PG8_LDB(B1, 0, 1); PG8_SCHED; PG8_LDA(At, 0, 0); PG8_STAGE(PG8_SA(1, 1), a1 + ahs, cv1);
            PG8_WAIT_V(8); PG8_WAIT_L(0); PG8_BAR; PG8_MMA(0, 0, At, B0); PG8_MMA(0, 1, At, B1); PG8_BAR; PG8_SCHED;
            PG8_LDA(At, 0, 1); PG8_STAGE(PG8_SB(0, 0), b2, voffB); PG8_STAGE(PG8_SB(0, 1), b2 + hstep, voffB); PG8_STAGE(PG8_SA(0, 0), a2, x0);
            PG8_WAIT_V(8); PG8_WAIT_L(0); PG8_BAR; PG8_MMA(1, 0, At, B0); PG8_MMA(1, 1, At, B1); PG8_BAR; PG8_SCHED;
            PG8_LDB(B0, 1, 0); PG8_LDB(B1, 1, 1); PG8_SCHED; PG8_LDA(At, 1, 0); PG8_STAGE(PG8_SA(0, 1), a2 + ahs, x1);
            PG8_WAIT_V(8); PG8_WAIT_L(0); PG8_BAR; PG8_MMA(0, 0, At, B0); PG8_MMA(0, 1, At, B1); PG8_BAR; PG8_SCHED;
            PG8_LDA(At, 1, 1); PG8_STAGE(PG8_SB(1, 0), b3, voffB); PG8_STAGE(PG8_SB(1, 1), b3 + hstep, voffB); PG8_STAGE(PG8_SA(1, 0), a3, x0);
            PG8_WAIT_V(8); PG8_WAIT_L(0); PG8_BAR; PG8_MMA(1, 0, At, B0); PG8_MMA(1, 1, At, B1); PG8_BAR; PG8_SCHED;
        }
        if constexpr (ALIGN_EPI) { if (wr == 0) PG8_BAR; }
        E(acc, cur, wr, wc, fr, fq);
        if (!has_next) break;
#pragma unroll
        for (int a = 0; a < 2; ++a)
#pragma unroll
            for (int b = 0; b < 2; ++b)
#pragma unroll
                for (int m = 0; m < 4; ++m)
#pragma unroll
                    for (int n = 0; n < 2; ++n) acc[a][b][m][n] = (f32x4){0.f, 0.f, 0.f, 0.f};
        cur = nxt; cB = nB; cA = nA; ++ui;
        if constexpr (GATHER) {
#pragma unroll
            for (int i = 0; i < 2; ++i) { cv0[i] = nv0[i]; cv1[i] = nv1[i]; }
        }
        if constexpr (ALIGN_EPI) { if (wr == 1) PG8_BAR; }
    }
    PG8_WAIT_V(0);
    if constexpr (!ALIGN_EPI) { if (wr == 0) PG8_BAR; }
    PG8_BAR;
#undef PG8_SA
#undef PG8_SB
#undef PG8_STAGE
#undef PG8_LDA
#undef PG8_LDB
#undef PG8_MMA
#undef PG8_WAIT_V
#undef PG8_WAIT_L
#undef PG8_BAR
#undef PG8_SCHED
}

__device__ __forceinline__ u32x4 pack8(const f32x4 v0, const f32x4 v1) { u32x4 w; w.x = pk2(v0[0], v0[1]); w.y = pk2(v0[2], v0[3]); w.z = pk2(v1[0], v1[1]); w.w = pk2(v1[2], v1[3]); return w; }

struct EpiInA {
    static constexpr bool PERM = true, HAS_MID = false;
    bf16_t *Q, *Kb, *Vb, *R, *SH;
    __device__ __forceinline__ void operator()(const f32x4 (&acc)[2][2][4][2], const Unit& u, int wr, int wc, int fr, int fq) const {
        const int row0 = u.pm * BM + wr * 64 + fr; const int cin = wc * 32 + 8 * fq;
        if (u.pn < 3) {
#pragma unroll
            for (int bj = 0; bj < 2; ++bj) {
                bf16_t* base; int ld, col;
                if (u.pn < 2) { base = Q; ld = AW; col = u.pn * 256 + bj * 128 + cin; }
                else { base = bj == 0 ? Kb : Vb; ld = KVW; col = cin; }
#pragma unroll
                for (int ai = 0; ai < 2; ++ai)
#pragma unroll
                    for (int m = 0; m < 4; ++m) *(u32x4*)(base + (size_t)(row0 + ai * HALF + m * 16) * ld + col) = pack8(acc[ai][bj][m][0], acc[ai][bj][m][1]);
            }
        } else {
            const int col = (u.pn - 3) * 128 + cin;
#pragma unroll
            for (int ai = 0; ai < 2; ++ai)
#pragma unroll
                for (int m = 0; m < 4; ++m) {
                    f32x4 r0, r1, s0, s1;
#pragma unroll
                    for (int j = 0; j < 4; ++j) {
                        const float ea0 = __expf(-acc[ai][0][m][0][j]), eh0 = __expf(-acc[ai][1][m][0][j]), ea1 = __expf(-acc[ai][0][m][1][j]), eh1 = __expf(-acc[ai][1][m][1][j]);
                        s0[j] = 1.0f / (1.0f + eh0); s1[j] = 1.0f / (1.0f + eh1); r0[j] = (1.0f + eh0) / (1.0f + ea0); r1[j] = (1.0f + eh1) / (1.0f + ea1); }
                    const size_t off = (size_t)(row0 + ai * HALF + m * 16) * DM + col;
                    *(u32x4*)(R + off) = pack8(r0, r1); *(u32x4*)(SH + off) = pack8(s0, s1);
                }
        }
    }
};
struct EpiBf16 {
    static constexpr bool PERM = true, HAS_MID = false;
    bf16_t* O; int ldc;
    __device__ __forceinline__ void operator()(const f32x4 (&acc)[2][2][4][2], const Unit& u, int wr, int wc, int fr, int fq) const {
        const int row0 = u.pm * BM + wr * 64 + fr; const int col0 = u.pn * BM + wc * 32 + 8 * fq;
#pragma unroll
        for (int ai = 0; ai < 2; ++ai)
#pragma unroll
            for (int m = 0; m < 4; ++m)
#pragma unroll
                for (int bj = 0; bj < 2; ++bj)
                    *(u32x4*)(O + (size_t)(row0 + ai * HALF + m * 16) * ldc + col0 + bj * HALF) = pack8(acc[ai][bj][m][0], acc[ai][bj][m][1]);
    }
};
struct EpiMerge {
    static constexpr bool PERM = true, HAS_MID = true;
    const bf16_t* R; const bf16_t* SH; bf16_t* O;
    __device__ __forceinline__ void mid(f32x4 (&acc)[2][2][4][2], const Unit& u, int wr, int wc, int fr, int fq) const {
        asm volatile("" : "+v"(fr), "+v"(fq));
        const int row0 = u.pm * BM + wr * 64 + fr; const int col0 = u.pn * BM + wc * 32 + 8 * fq;
#pragma unroll
        for (int ai = 0; ai < 2; ++ai)
#pragma unroll
            for (int m = 0; m < 4; ++m)
#pragma unroll
                for (int bj = 0; bj < 2; ++bj) {
                    const u32x4 g = *(const u32x4*)(R + (size_t)(row0 + ai * HALF + m * 16) * DM + col0 + bj * HALF);
                    acc[ai][bj][m][0][0] *= bflo(g.x); acc[ai][bj][m][0][1] *= bfhi(g.x); acc[ai][bj][m][0][2] *= bflo(g.y); acc[ai][bj][m][0][3] *= bfhi(g.y);
                    acc[ai][bj][m][1][0] *= bflo(g.z); acc[ai][bj][m][1][1] *= bfhi(g.z); acc[ai][bj][m][1][2] *= bflo(g.w); acc[ai][bj][m][1][3] *= bfhi(g.w);
                    asm volatile("" ::: "memory");
                }
    }
    __device__ __forceinline__ void operator()(const f32x4 (&acc)[2][2][4][2], const Unit& u, int wr, int wc, int fr, int fq) const {
        const int row0 = u.pm * BM + wr * 64 + fr; const int col0 = u.pn * BM + wc * 32 + 8 * fq;
#pragma unroll
        for (int ai = 0; ai < 2; ++ai)
#pragma unroll
            for (int m = 0; m < 4; ++m)
#pragma unroll
                for (int bj = 0; bj < 2; ++bj) {
                    const size_t off = (size_t)(row0 + ai * HALF + m * 16) * DM + col0 + bj * HALF;
                    const u32x4 g = *(const u32x4*)(SH + off);
                    f32x4 v0 = acc[ai][bj][m][0], v1 = acc[ai][bj][m][1];
                    v0[0] *= bflo(g.x); v0[1] *= bfhi(g.x); v0[2] *= bflo(g.y); v0[3] *= bfhi(g.y);
                    v1[0] *= bflo(g.z); v1[1] *= bfhi(g.z); v1[2] *= bflo(g.w); v1[3] *= bfhi(g.w);
                    *(u32x4*)(O + off) = pack8(v0, v1);
                }
    }
};
struct EpiRes {
    static constexpr bool PERM = false, HAS_MID = false;
    const float* X; const float* gate; float* O;
    __device__ __forceinline__ void operator()(const f32x4 (&acc)[2][2][4][2], const Unit& u, int wr, int wc, int fr, int fq) const {
        const int row0 = u.pm * BM + wr * 64 + fr; const int col0 = u.pn * BM + wc * 32 + 4 * fq;
        const int b = (u.pm * BM) / SEQ;
#pragma unroll
        for (int bj = 0; bj < 2; ++bj)
#pragma unroll
            for (int n = 0; n < 2; ++n) {
                const int col = col0 + bj * HALF + n * 16;
                const f32x4 gv = *(const f32x4*)(gate + (size_t)b * 6144 + col);
#pragma unroll
                for (int ai = 0; ai < 2; ++ai)
#pragma unroll
                    for (int m = 0; m < 4; ++m) {
                        const size_t off = (size_t)(row0 + ai * HALF + m * 16) * DM + col;
                        const f32x4 xv = *(const f32x4*)(X + off);
                        *(f32x4*)(O + off) = xv * DN_ALPHA + gv * acc[ai][bj][m][n];
                    }
            }
    }
};
struct EpiSwiGLU {
    static constexpr bool PERM = true, HAS_MID = false;
    bf16_t* H;
    __device__ __forceinline__ void operator()(const f32x4 (&acc)[2][2][4][2], const Unit& u, int wr, int wc, int fr, int fq) const {
        const int row0 = u.pm * BM + wr * 64 + fr; const int col0 = u.pn * HALF + wc * 32 + 8 * fq;
#pragma unroll
        for (int ai = 0; ai < 2; ++ai)
#pragma unroll
            for (int m = 0; m < 4; ++m) {
                f32x4 v0, v1;
#pragma unroll
                for (int j = 0; j < 4; ++j) { const float a0 = acc[ai][0][m][0][j], a1 = acc[ai][0][m][1][j];
                    v0[j] = a0 * sigmoidf_(a0) * acc[ai][1][m][0][j]; v1[j] = a1 * sigmoidf_(a1) * acc[ai][1][m][1][j]; }
                *(u32x4*)(H + (size_t)(row0 + ai * HALF + m * 16) * DE + col0) = pack8(v0, v1);
            }
    }
};
struct EpiScatter {
    static constexpr bool PERM = true, HAS_MID = false;
    bf16_t* Y2; const int* btok; const float* bw; const LAS int* tab;
    __device__ __forceinline__ void operator()(const f32x4 (&acc)[2][2][4][2], const Unit& u, int wr, int wc, int fr, int fq) const {
        const int col0 = u.pn * BM + wc * 32 + 8 * fq; const int cnt = tab[72 + u.e];
#pragma unroll
        for (int ai = 0; ai < 2; ++ai)
#pragma unroll
            for (int m = 0; m < 4; ++m) {
                const int idx = u.mt * BM + ai * HALF + wr * 64 + m * 16 + fr;
                if (idx < cnt) {
                    const int dst = btok[(size_t)u.e * ECAP + idx]; const float w = bw[(size_t)u.e * ECAP + idx];
#pragma unroll
                    for (int bj = 0; bj < 2; ++bj)
                        *(u32x4*)(Y2 + (size_t)dst * DM + col0 + bj * HALF) = pack8(acc[ai][bj][m][0] * w, acc[ai][bj][m][1] * w);
                }
            }
    }
};
}

#define XB_TMO      128
#define XB_XCNT(j)  (256  + 64 * (j))
#define XB_XSUB(j)  (1280 + 64 * (j))
#define XB_XGEN(j)  (2304 + 64 * (j))
#define XB_TOP      3328
#define XB_TOPGEN   3392
#define XCD_BAR_WORDS 3456
#define XB_SPIN_CAP (1u << 22)
__device__ __forceinline__ unsigned xb_ld(unsigned* p)              { return __hip_atomic_load(p, __ATOMIC_RELAXED, __HIP_MEMORY_SCOPE_AGENT); }
__device__ __forceinline__ unsigned xb_add(unsigned* p, unsigned v) { return __hip_atomic_fetch_add(p, v, __ATOMIC_RELAXED, __HIP_MEMORY_SCOPE_AGENT); }
__device__ __forceinline__ unsigned xb_xcc_id() { return (unsigned)__builtin_amdgcn_s_getreg((3 << 11) | 20) & 0xFu; }
#define XB_SPIN(cond, bar) do { unsigned _sp = 0; while (cond) { __builtin_amdgcn_s_sleep(1); \
    if ((++_sp & 255u) == 0u) { if (xb_ld(&(bar)[XB_TMO])) break; if (_sp > XB_SPIN_CAP) { atomicAdd(&(bar)[XB_TMO], 1u); break; } } } } while (0)
__device__ __forceinline__ void xcd_barrier_post(unsigned* bar) { if (threadIdx.x == 0) (void)xb_add(&bar[XB_XCNT(xb_xcc_id())], 1u); }
__device__ __forceinline__ void xcd_barrier_complete(unsigned* bar, unsigned x, unsigned& nloc, unsigned& nx) {
    const unsigned G = gridDim.x * gridDim.y * gridDim.z;
    unsigned sum, cnt, mine, sp = 0u;
    for (;;) {
        sum = 0u; cnt = 0u; mine = 0u;
#pragma unroll
        for (unsigned j = 0; j < 16; ++j) { const unsigned c = xb_ld(&bar[XB_XCNT(j)]); sum += c; cnt += (c > 0u) ? 1u : 0u; mine = (j == x) ? c : mine; }
        if (sum == G) break;
        __builtin_amdgcn_s_sleep(1);
        if ((++sp & 255u) == 0u) { if (xb_ld(&bar[XB_TMO])) break; if (sp > XB_SPIN_CAP) { atomicAdd(&bar[XB_TMO], 1u); break; } }
    }
    nloc = mine > 0u ? mine : 1u; nx = cnt > 0u ? cnt : 1u;
}
__device__ __forceinline__ void xcd_barrier(unsigned* bar, volatile LAS unsigned* st) {
    asm volatile("s_waitcnt vmcnt(0)" ::: "memory");
    __syncthreads();
    if (threadIdx.x == 0) {
        const unsigned x = xb_xcc_id();
        __builtin_amdgcn_s_waitcnt(0);
        unsigned nloc = st[0], nx = st[1];
        if (nloc == 0u) { xcd_barrier_complete(bar, x, nloc, nx); st[0] = nloc; st[1] = nx; }
        const unsigned old = xb_add(&bar[XB_XSUB(x)], 1u);
        const unsigned gen = old / nloc;
        if (old + 1u == (gen + 1u) * nloc) {
            __builtin_amdgcn_fence(__ATOMIC_RELEASE, "agent");
            asm volatile("s_waitcnt vmcnt(0)" ::: "memory");
            const unsigned og = xb_add(&bar[XB_TOP], 1u);
            const unsigned tg = og / nx;
            if (og + 1u == (tg + 1u) * nx) xb_add(&bar[XB_TOPGEN], 1u);
            else XB_SPIN(xb_ld(&bar[XB_TOPGEN]) == tg, bar);
            __builtin_amdgcn_fence(__ATOMIC_ACQUIRE, "agent");
            xb_add(&bar[XB_XGEN(x)], 1u);
            asm volatile("s_waitcnt vmcnt(0)" ::: "memory");
        } else {
            XB_SPIN(xb_ld(&bar[XB_XGEN(x)]) == gen, bar);
            __builtin_amdgcn_fence(__ATOMIC_ACQUIRE, "agent");
            asm volatile("s_waitcnt vmcnt(0)" ::: "memory");
        }
    }
    __syncthreads();
}

struct Args { const float* in[31]; float* out; unsigned char* ws; int ph_lo, ph_hi; };
struct Frame {
    LAS unsigned char* lds; unsigned char* ws; unsigned* ctl;
    int tid, lane, wave, vcu, G;
    const float* const* in; float* out;
};
enum { I_X = 0, I_C, I_WADA, I_BADA, I_WIN, I_CONVW, I_CONVB, I_FW1, I_FB1, I_FF1, I_FW2, I_FB2, I_FF2, I_FW3, I_DECAY, I_SKIP, I_WHY, I_WATT, I_SINK, I_WOUT,
       I_LN1G, I_LN1B, I_RGW, I_RGB, I_REW, I_REB, I_EW1, I_EW3, I_EW2, I_LN2G, I_LN2B };

__device__ __forceinline__ void transpose_item(const float* W, int K, int N, bf16_t* WT, int ldt, int drow0, LAS float* scr, int kb, int nb, int lane) {
    const int k0 = 64 * kb, n0 = 32 * nb;
#pragma unroll 8
    for (int i = 0; i < 32; ++i) { const int kk = 2 * i + (lane >> 5); scr[kk * 33 + (lane & 31)] = W[(size_t)(k0 + kk) * N + n0 + (lane & 31)]; }
    LDS_WAIT(); asm volatile("" ::: "memory");
    const int c = lane & 7;
#pragma unroll
    for (int j = 0; j < 4; ++j) { const int n = (lane >> 3) + 8 * j; const LAS float* s = scr + (8 * c) * 33 + n;
        u32x4 o; o.x = pk2(s[0 * 33], s[1 * 33]); o.y = pk2(s[2 * 33], s[3 * 33]); o.z = pk2(s[4 * 33], s[5 * 33]); o.w = pk2(s[6 * 33], s[7 * 33]);
        *(u32x4*)(WT + (size_t)(drow0 + n) * ldt + k0 + 8 * c) = o; }
    LDS_WAIT(); asm volatile("" ::: "memory");
}

__device__ __forceinline__ void ph_prep(Frame& F) {
    const float* c = F.in[I_C]; const float* wada = F.in[I_WADA];
    float* modp = (float*)(F.ws + WS_MODP);
    for (int it = blockIdx.x; it < 192; it += F.G) {
        const int kc = it / 12, cg = it % 12, j = cg * 512 + F.tid;
        float a0 = 0.f, a1 = 0.f, a2 = 0.f, a3 = 0.f;
        for (int kk = 0; kk < 64; ++kk) { const int k = kc * 64 + kk; const float w = wada[(size_t)k * 6144 + j];
            const float c0 = c[k], c1 = c[1024 + k], c2 = c[2048 + k], c3 = c[3072 + k];
            a0 += c0 * sigmoidf_(c0) * w; a1 += c1 * sigmoidf_(c1) * w; a2 += c2 * sigmoidf_(c2) * w; a3 += c3 * sigmoidf_(c3) * w; }
        modp[(size_t)(kc * 4 + 0) * 6144 + j] = a0; modp[(size_t)(kc * 4 + 1) * 6144 + j] = a1; modp[(size_t)(kc * 4 + 2) * 6144 + j] = a2; modp[(size_t)(kc * 4 + 3) * 6144 + j] = a3;
    }
    LAS float* scr = (LAS float*)(F.lds + F.wave * 16384);
    const int gw = F.vcu * NWAVES + F.wave, NGW = F.G * NWAVES;
    constexpr int I_IN = 16 * 136, I_A = 8 * 32, I_H = 8 * 32, I_O = 16 * 32;
    for (int it = gw; it < I_IN + I_A + I_H + I_O; it += NGW) {
        int r = it;
        if (r < I_IN) { const int kb = r / 136, nb = r % 136, n0 = nb * 32;
            int drow;
            if (n0 < 768) drow = n0; else if (n0 < 2304) drow = N1A + (n0 - 768);
            else if (n0 < 3328) { const int d = n0 - 2304; drow = 768 + (d >> 7) * 256 + (d & 127); }
            else { const int d = n0 - 3328; drow = 768 + (d >> 7) * 256 + 128 + (d & 127); }
            transpose_item(F.in[I_WIN], DM, INW, (bf16_t*)(F.ws + WS_WIN), DM, drow, scr, kb, nb, F.lane); continue; } r -= I_IN;
        if (r < I_A) { transpose_item(F.in[I_WATT], AW, DM, (bf16_t*)(F.ws + WS_WAH), DM, (r % 32) * 32, scr, r / 32, r % 32, F.lane); continue; } r -= I_A;
        if (r < I_H) { transpose_item(F.in[I_WHY], HW, DM, (bf16_t*)(F.ws + WS_WAH) + AW, DM, (r % 32) * 32, scr, r / 32, r % 32, F.lane); continue; } r -= I_H;
        transpose_item(F.in[I_WOUT], DM, DM, (bf16_t*)(F.ws + WS_WO), DM, (r % 32) * 32, scr, r / 32, r % 32, F.lane);
    }
    {
        const float* w1 = F.in[I_FW1]; const float* b1 = F.in[I_FB1]; const float* f1 = F.in[I_FF1];
        const float* w2 = F.in[I_FW2]; const float* b2 = F.in[I_FB2]; const float* f2 = F.in[I_FF2];
        const int j = F.lane;
        for (int t = gw; t < SEQ; t += NGW) {
            const float tl = (float)t / (float)(SEQ - 1);
            const float w = 6.283185307179586f * (float)t / (float)SEQ;
            float zi = 0.f;
            if (j == 0) zi = tl;
            else if (j <= 16) { const float band = 1e-4f + (float)(j - 1) * ((15.0f - 1e-4f) / 15.0f); zi = cosf(band * w); }
            else if (j <= 32) { const float band = 1e-4f + (float)(j - 17) * ((15.0f - 1e-4f) / 15.0f); zi = -sinf(band * w); }
            float a = b1[j];
#pragma unroll
            for (int i = 0; i < FEMB; ++i) a += __shfl(zi, i) * w1[i * FH + j];
            const float h1 = sinf(f1[j] * a);
            float a2 = b2[j];
#pragma unroll
            for (int i = 0; i < FH; ++i) a2 += __shfl(h1, i) * w2[i * FH + j];
            ((bf16_t*)(F.ws + WS_HDNB))[(size_t)t * FH + j] = (bf16_t)f2bf(sinf(f2[j] * a2));
        }
    }
    {
        bf16_t* ftab = (bf16_t*)(F.ws + WS_FTAB); unsigned* twt = (unsigned*)(F.ws + WS_TWT);
        for (int i = blockIdx.x * NTHREADS + F.tid; i < 2 * 128 * 128; i += F.G * NTHREADS) {
            const int t = i >> 14, row = (i >> 7) & 127, q = i & 127;
            const int q15 = q & 15, h = q15 >> 3, j = q15 & 7; const int nat = (q & ~15) + 8 * (j >> 2) + 4 * h + (j & 3);
            const int e = (row * nat) & 127; const float x = (float)e * (2.0f / 128.0f);
            const float v = t == 0 ? cospif(x) : -sinpif(x);
            ftab[(size_t)t * (128 * 136) + row * 136 + q] = (bf16_t)f2bf(v);
        }
        for (int i = blockIdx.x * NTHREADS + F.tid; i < 16 * 64 * 16; i += F.G * NTHREADS) {
            const int r = i & 15, l = (i >> 4) & 63, ab = i >> 10, al = ab >> 2, be = ab & 3;
            const int e = ((32 * al + ((r & 3) + 8 * (r >> 2) + 4 * (l >> 5))) * (32 * be + (l & 31))) & 16383; const float x = (float)e * (2.0f / 16384.0f);
            twt[i] = pk2(cospif(x), -sinpif(x));
        }
    }
    {
        bf16_t* wr = (bf16_t*)(F.ws + WS_WRT); const float* wg = F.in[I_RGW]; const float* we = F.in[I_REW];
        for (int i = blockIdx.x * NTHREADS + F.tid; i < 80 * DM; i += F.G * NTHREADS) { const int o = i / DM, k = i % DM;
            const float w = o < 8 ? wg[k * 8 + o] : (o < 72 ? we[k * 64 + (o - 8)] : 0.f);
            const unsigned hi = f2bf(w); const float lo = w - bf2f((unsigned short)hi);
            wr[i] = (bf16_t)hi; wr[80 * DM + i] = (bf16_t)f2bf(lo); }
    }
}

__device__ __forceinline__ void ph_taps(Frame& F) {
    typedef float f32x16 __attribute__((ext_vector_type(16)));
    const bf16_t* hb = (const bf16_t*)(F.ws + WS_HDNB); const float* w3 = F.in[I_FW3]; const float* decay = F.in[I_DECAY];
    bf16_t* kraw = (bf16_t*)(F.ws + WS_KRAW); float* kpart = (float*)(F.ws + WS_KPART);
    const int lane = F.lane, lr = lane & 31, lh = lane >> 5;
    for (int it = blockIdx.x; it < 256; it += F.G) {
        const int g = it & 63, tq = it >> 6;
        bf16x8 aW[4];
#pragma unroll
        for (int s = 0; s < 4; ++s) { unsigned pk[4];
#pragma unroll
            for (int j2 = 0; j2 < 4; ++j2) { const int k = 16 * s + 8 * lh + 2 * j2; pk[j2] = pk2(w3[(size_t)k * NFILT + 32 * g + lr], w3[(size_t)(k + 1) * NFILT + 32 * g + lr]); }
            aW[s] = __builtin_bit_cast(bf16x8, (u32x4){pk[0], pk[1], pk[2], pk[3]}); }
        float dcy[16], asum[16];
#pragma unroll
        for (int r = 0; r < 16; ++r) { dcy[r] = fabsf(decay[32 * g + (r & 3) + 8 * (r >> 2) + 4 * lh]); asum[r] = 0.f; }
#pragma unroll 1
        for (int tt = 0; tt < 8; ++tt) {
            const int t = 2048 * tq + 32 * (F.wave * 8 + tt) + lr;
            f32x16 acc;
#pragma unroll
            for (int r = 0; r < 16; ++r) acc[r] = 0.f;
#pragma unroll
            for (int s = 0; s < 4; ++s) { const bf16x8 bH = *(const bf16x8*)(hb + (size_t)t * FH + 16 * s + 8 * lh); acc = __builtin_amdgcn_mfma_f32_32x32x16_bf16(aW[s], bH, acc, 0, 0, 0); }
            const float tl = (float)t / (float)(SEQ - 1);
#pragma unroll
            for (int r = 0; r < 16; ++r) { const float v = acc[r] * (__expf(-tl * dcy[r]) + 0.05f); asum[r] += fabsf(v);
                kraw[(size_t)(32 * g + (r & 3) + 8 * (r >> 2) + 4 * lh) * SEQ + t] = (bf16_t)f2bf(v); }
        }
#pragma unroll
        for (int r = 0; r < 16; ++r) { float v = asum[r];
#pragma unroll
            for (int o = 1; o < 32; o <<= 1) v += __shfl_xor(v, o);
            if (lr == 0) kpart[(size_t)(32 * g + (r & 3) + 8 * (r >> 2) + 4 * lh) * 32 + tq * 8 + F.wave] = v; }
    }
}

__device__ __forceinline__ void ph_hb(Frame& F) {
    const float* modp = (const float*)(F.ws + WS_MODP); const float* bada = F.in[I_BADA];
    float* mod = (float*)(F.ws + WS_MOD);
    for (int i = blockIdx.x * NTHREADS + F.tid; i < NB * 6144; i += F.G * NTHREADS) { const int b = i / 6144, j = i % 6144; float s = bada[j];
        for (int kc = 0; kc < 16; ++kc) s += modp[(size_t)(kc * 4 + b) * 6144 + j];
        mod[i] = s; }
    LAS float* sc = (LAS float*)F.lds; LAS float* sh = sc + DM;
    const float* x = F.in[I_X]; bf16_t* hb = (bf16_t*)(F.ws + WS_HB);
    for (int ch = blockIdx.x; ch < T / 128; ch += F.G) {
        const int b = (ch * 128) / SEQ;
        __syncthreads();
        for (int j = F.tid; j < 2 * DM; j += NTHREADS) { float s = bada[j];
            for (int kc = 0; kc < 16; ++kc) s += modp[(size_t)(kc * 4 + b) * 6144 + j];
            if (j < DM) sh[j] = s; else sc[j - DM] = 1.0f + s; }
        __syncthreads();
        for (int r = F.wave; r < 128; r += NWAVES) {
            const size_t row = (size_t)ch * 128 + r;
            const f32x4* xr = (const f32x4*)(x + row * DM) + F.lane;
            unsigned long long* o8 = (unsigned long long*)(hb + row * DM) + F.lane;
#pragma unroll
            for (int j = 0; j < 4; ++j) { const f32x4 v = xr[64 * j]; const int k = 4 * F.lane + 256 * j;
                const float h0 = v[0] * sc[k] + sh[k], h1 = v[1] * sc[k + 1] + sh[k + 1], h2 = v[2] * sc[k + 2] + sh[k + 2], h3 = v[3] * sc[k + 3] + sh[k + 3];
                o8[64 * j] = (unsigned long long)pk2(h0, h1) | ((unsigned long long)pk2(h2, h3) << 32); }
        }
    }
    __syncthreads();
}

namespace at {
typedef float f32x16 __attribute__((ext_vector_type(16)));
typedef __bf16 bf16x2_t __attribute__((ext_vector_type(2)));
constexpr int KROWB = 144, VROWB = 784, K_OFF = 0, V_OFF = 384 * KROWB;
__device__ __forceinline__ unsigned cvtpk(float lo, float hi) { f32x2 v = {lo, hi}; bf16x2_t b = __builtin_convertvector(v, bf16x2_t); return __builtin_bit_cast(unsigned, b); }
template <int S> __device__ __forceinline__ bf16x8 pack_step(const f32x16& x) {
    u32x4 p; p.x = cvtpk(x[8 * S], x[8 * S + 1]); p.y = cvtpk(x[8 * S + 2], x[8 * S + 3]); p.z = cvtpk(x[8 * S + 4], x[8 * S + 5]); p.w = cvtpk(x[8 * S + 6], x[8 * S + 7]);
    return __builtin_bit_cast(bf16x8, p);
}
__device__ __forceinline__ int kst(int k) { const int c = k & 15; return (k & ~15) + 8 * ((c >> 2) & 1) + 4 * (c >> 3) + (c & 3); }
}
__device__ __forceinline__ void ph_attn(Frame& F) {
    using namespace at;
    const bf16_t* Q = (const bf16_t*)(F.ws + WS_Q); const bf16_t* Kb = (const bf16_t*)(F.ws + WS_K); const bf16_t* Vb = (const bf16_t*)(F.ws + WS_V);
    bf16_t* O = (bf16_t*)(F.ws + WS_AH); const float* sink = F.in[I_SINK];
    LAS unsigned char* Ks = F.lds + K_OFF; LAS unsigned char* Vs = F.lds + V_OFF;
    const int wid = F.wave;
    constexpr float LOG2E = 1.4426950408889634f;
    for (int unit = blockIdx.x; unit < NB * 2 * 64; unit += F.G) {
        const int qb = unit & 63, kvh = (unit >> 6) & 1, b = unit >> 7;
        int tid = F.tid; asm volatile("" : "+v"(tid));
        const int lane = tid & 63, lr = lane & 31, lh = lane >> 5;
        __syncthreads();
#pragma unroll 1
        for (int i = 0; i < 6; ++i) {
            const int ci = tid + 512 * i, j = ci >> 3, p = ci & 7; const int kpos = qb * 128 - 128 + j;
            u32x4 kv = (u32x4){0u, 0u, 0u, 0u}, vv = kv;
            if (kpos >= 0 && kpos < SEQ) { const size_t off = ((size_t)b * SEQ + kpos) * KVW + kvh * 64 + p * 8; kv = *(const u32x4*)(Kb + off); vv = *(const u32x4*)(Vb + off); }
            *(LAS u32x4*)(Ks + j * KROWB + p * 16) = kv;
            LAS unsigned char* vp = Vs + (p * 8) * VROWB + kst(j) * 2;
            *(LAS bf16_t*)(vp) = (bf16_t)vv.x; *(LAS bf16_t*)(vp + VROWB) = (bf16_t)(vv.x >> 16);
            *(LAS bf16_t*)(vp + 2 * VROWB) = (bf16_t)vv.y; *(LAS bf16_t*)(vp + 3 * VROWB) = (bf16_t)(vv.y >> 16);
            *(LAS bf16_t*)(vp + 4 * VROWB) = (bf16_t)vv.z; *(LAS bf16_t*)(vp + 5 * VROWB) = (bf16_t)(vv.z >> 16);
            *(LAS bf16_t*)(vp + 6 * VROWB) = (bf16_t)vv.w; *(LAS bf16_t*)(vp + 7 * VROWB) = (bf16_t)(vv.w >> 16);
        }
        __syncthreads();
        const int g = wid >> 1, h = kvh * 4 + g, uh = wid & 1;
        const float slope2 = exp2f(-(float)(h + 1)) * LOG2E, c1 = 0.125f * LOG2E, m0 = sink[h] * LOG2E;
        const float d0 = (float)(4 * lh - lr);
#pragma unroll 1
        for (int ut = 0; ut < 2; ++ut) {
            const int u = 2 * uh + ut; const size_t trow = (size_t)b * SEQ + qb * 128 + 32 * u + lr;
            bf16x8 qf[4];
#pragma unroll
            for (int s4 = 0; s4 < 4; ++s4) qf[s4] = *(const bf16x8*)(Q + trow * AW + h * 64 + 16 * s4 + 8 * lh);
            f32x16 Ot[2];
#pragma unroll
            for (int r = 0; r < 16; ++r) { Ot[0][r] = 0.f; Ot[1][r] = 0.f; }
            float m = m0, l = lh == 0 ? 1.0f : 0.0f;
            int kt0 = u, kt1 = u + 8; if (qb == 0 && kt0 < 4) kt0 = 4; if (qb == 63 && kt1 > 7) kt1 = 7;
#pragma unroll 1
            for (int kt = kt0; kt <= kt1; ++kt) {
                f32x16 St;
#pragma unroll
                for (int r = 0; r < 16; ++r) St[r] = 0.f;
                LAS const unsigned char* kp = Ks + (32 * kt + lr) * KROWB + lh * 16;
#pragma unroll
                for (int s4 = 0; s4 < 4; ++s4) St = __builtin_amdgcn_mfma_f32_32x32x16_bf16(*(LAS const bf16x8*)(kp + 32 * s4), qf[s4], St, 0, 0, 0);
                const float base = (float)(32 * (kt - u) - 128) + d0; const bool edge = (kt == u) || (kt == u + 8);
                float tmax = -INFINITY;
#pragma unroll
                for (int r = 0; r < 16; ++r) { const float rel = fabsf(base + (float)((r & 3) + 8 * (r >> 2)));
                    float sv = St[r] * c1 - slope2 * rel; if (edge && rel > 128.0f) sv = -INFINITY; St[r] = sv; tmax = fmaxf(tmax, sv); }
                tmax = fmaxf(tmax, __shfl_xor(tmax, 32));
                const float mn = fmaxf(m, tmax), scl = exp2f(m - mn); m = mn; l *= scl;
#pragma unroll
                for (int r = 0; r < 16; ++r) { Ot[0][r] *= scl; Ot[1][r] *= scl; }
#pragma unroll
                for (int r = 0; r < 16; ++r) { const float p = exp2f(St[r] - mn); l += p; St[r] = p; }
                const bf16x8 pf0 = pack_step<0>(St), pf1 = pack_step<1>(St);
                LAS const unsigned char* vp = Vs + lr * VROWB + (32 * kt + 8 * lh) * 2;
#pragma unroll
                for (int dt = 0; dt < 2; ++dt) {
                    Ot[dt] = __builtin_amdgcn_mfma_f32_32x32x16_bf16(*(LAS const bf16x8*)(vp + dt * 32 * VROWB), pf0, Ot[dt], 0, 0, 0);
                    Ot[dt] = __builtin_amdgcn_mfma_f32_32x32x16_bf16(*(LAS const bf16x8*)(vp + dt * 32 * VROWB + 32), pf1, Ot[dt], 0, 0, 0);
                }
            }
            l += __shfl_xor(l, 32);
            const float il = 1.0f / l;
            bf16_t* op = O + trow * DM + h * 64 + 4 * lh;
#pragma unroll
            for (int dt = 0; dt < 2; ++dt)
#pragma unroll
                for (int gq = 0; gq < 4; ++gq)
                    *(u32x2*)(op + 32 * dt + 8 * gq) = (u32x2){cvtpk(Ot[dt][4 * gq] * il, Ot[dt][4 * gq + 1] * il), cvtpk(Ot[dt][4 * gq + 2] * il, Ot[dt][4 * gq + 3] * il)};
        }
    }
    __syncthreads();
}

__device__ __forceinline__ float block_sum(Frame& F, float v, LAS float* red) {
    v = wave_sum(v);
    __syncthreads();
    if (F.lane == 0) red[F.wave] = v;
    __syncthreads();
    float s = 0.f;
#pragma unroll
    for (int i = 0; i < NWAVES; ++i) s += red[i];
    return s;
}

namespace hy {
typedef float f32x16 __attribute__((ext_vector_type(16)));
typedef __bf16 bf16x2_t __attribute__((ext_vector_type(2)));
constexpr int ROWB = 272, TABB = 128 * ROWB, DROWB = 528, FT_OFF = 0, X_OFF = 2 * TABB, SP_OFF = 4 * TABB;
#define HY_SBAR() do { asm volatile("" ::: "memory"); __builtin_amdgcn_sched_barrier(0); } while (0)
#define MFMA32(a, b, c) __builtin_amdgcn_mfma_f32_32x32x16_bf16((a), (b), (c), 0, 0, 0)
__device__ __forceinline__ int crow(int r, int h) { return (r & 3) + 8 * (r >> 2) + 4 * h; }
__device__ __forceinline__ int q16(int c) { return 8 * ((c >> 2) & 1) + 4 * (c >> 3) + (c & 3); }
__device__ __forceinline__ int kstore(int k) { return (k & ~15) + q16(k & 15); }
__device__ __forceinline__ unsigned cvtpk(float lo, float hi) { f32x2 v = {lo, hi}; bf16x2_t b = __builtin_convertvector(v, bf16x2_t); return __builtin_bit_cast(unsigned, b); }
__device__ __forceinline__ bf16x8 neg8(bf16x8 v) { u32x4 u = __builtin_bit_cast(u32x4, v); u.x ^= 0x80008000u; u.y ^= 0x80008000u; u.z ^= 0x80008000u; u.w ^= 0x80008000u; return __builtin_bit_cast(bf16x8, u); }
template <int S> __device__ __forceinline__ bf16x8 pack_step(const f32x16& x) {
    u32x4 p; p.x = cvtpk(x[8 * S], x[8 * S + 1]); p.y = cvtpk(x[8 * S + 2], x[8 * S + 3]); p.z = cvtpk(x[8 * S + 4], x[8 * S + 5]); p.w = cvtpk(x[8 * S + 6], x[8 * S + 7]);
    return __builtin_bit_cast(bf16x8, p);
}
__device__ __forceinline__ bf16x8 ffrag(LAS const unsigned char* ft, int t, int rb, int s, int lr, int lh) {
    return *(LAS const bf16x8*)(ft + (lr * ROWB + lh * 16) + (t * TABB + rb * 32 * ROWB + 32 * s)); }
__device__ __forceinline__ bf16x8 xfrag(LAS const unsigned char* img, int rb, int cs, int lr, int lh) {
    return *(LAS const bf16x8*)(img + (lr * ROWB + lh * 16) + (rb * 32 * ROWB + 16 * cs)); }
__device__ __forceinline__ bf16x8 dfrag(LAS const unsigned char* img, int rb, int cs, int lr, int lh) {
    return *(LAS const bf16x8*)(img + (lr * DROWB + lh * 16) + (rb * 32 * DROWB + 16 * cs)); }
__device__ __forceinline__ void zero16(f32x16& x) {
#pragma unroll
    for (int r = 0; r < 16; ++r) x[r] = 0.f; }
struct ctile { u32x4 q[4]; };
__device__ __forceinline__ ctile load_ctile(const unsigned* w  ) { ctile t;
#pragma unroll
    for (int i = 0; i < 4; ++i) t.q[i] = *(const u32x4*)(w + 4 * i);
    return t; }
template <bool CONJ> __device__ __forceinline__ void cmul_tile(f32x16& xr, f32x16& xi, const ctile& t) {
#pragma unroll
    for (int i = 0; i < 4; ++i) { const unsigned w[4] = {t.q[i].x, t.q[i].y, t.q[i].z, t.q[i].w};
#pragma unroll
        for (int u = 0; u < 4; ++u) { const int r = 4 * i + u; const float wr = bflo(w[u]), wi = CONJ ? -bfhi(w[u]) : bfhi(w[u]);
            const float a = xr[r], b = xi[r]; xr[r] = a * wr - b * wi; xi[r] = a * wi + b * wr; } }
}
template <bool CPLX, int NK>
__device__ __forceinline__ void s1_tw(LAS const unsigned char* ft, LAS const unsigned char* img, const unsigned* twt, int J, int lane, bf16x8 (&bAr)[8], bf16x8 (&bAi)[8]) {
    const int lr = lane & 31, lh = lane >> 5;
#pragma unroll
    for (int hf = 0; hf < 2; ++hf) {
        const ctile tw0 = load_ctile(twt + ((size_t)(((2 * hf) * 4 + J) * 64 + lane)) * 16), tw1 = load_ctile(twt + ((size_t)(((2 * hf + 1) * 4 + J) * 64 + lane)) * 16);
        f32x16 Ar[2], Ai[2];
#pragma unroll
        for (int i = 0; i < 2; ++i) { zero16(Ar[i]); zero16(Ai[i]); }
#pragma unroll
        for (int s = 0; s < NK; ++s) {
            const bf16x8 bFr = ffrag(ft, 0, J, s, lr, lh), bFi = ffrag(ft, 1, J, s, lr, lh), bnFi = neg8(bFi);
#pragma unroll
            for (int i = 0; i < 2; ++i) {
                const bf16x8 aXr = xfrag(img, 2 * hf + i, 2 * s, lr, lh);
                Ar[i] = MFMA32(aXr, bFr, Ar[i]); Ai[i] = MFMA32(aXr, bFi, Ai[i]);
                if (CPLX) { const bf16x8 aXi = xfrag(img, 2 * hf + i, 8 + 2 * s, lr, lh); Ar[i] = MFMA32(aXi, bnFi, Ar[i]); Ai[i] = MFMA32(aXi, bFr, Ai[i]); }
            }
            HY_SBAR();
        }
#pragma unroll
        for (int i = 0; i < 2; ++i) { const int ig = 2 * hf + i;
            cmul_tile<false>(Ar[i], Ai[i], i == 0 ? tw0 : tw1);
            bAr[2 * ig] = pack_step<0>(Ar[i]); bAr[2 * ig + 1] = pack_step<1>(Ar[i]); bAi[2 * ig] = pack_step<0>(Ai[i]); bAi[2 * ig + 1] = pack_step<1>(Ai[i]);
            HY_SBAR();
        }
    }
}
__device__ __forceinline__ void s3_half(LAS const unsigned char* ft, const bf16x8 (&bAr)[8], const bf16x8 (&bAi)[8], int Ih, int lane, f32x16 (&Zr)[2], f32x16 (&Zi)[2]) {
    const int lr = lane & 31, lh = lane >> 5;
#pragma unroll
    for (int I = 0; I < 2; ++I) { zero16(Zr[I]); zero16(Zi[I]); }
#pragma unroll
    for (int s = 0; s < 8; ++s) {
        const bf16x8 bnAi = neg8(bAi[s]);
#pragma unroll
        for (int I = 0; I < 2; ++I) {
            const bf16x8 aFr = ffrag(ft, 0, 2 * Ih + I, s, lr, lh), aFi = ffrag(ft, 1, 2 * Ih + I, s, lr, lh);
            Zr[I] = MFMA32(aFr, bAr[s], Zr[I]); Zr[I] = MFMA32(aFi, bnAi, Zr[I]);
            Zi[I] = MFMA32(aFi, bAr[s], Zi[I]); Zi[I] = MFMA32(aFr, bAi[s], Zi[I]);
        }
        HY_SBAR();
    }
}
__device__ __forceinline__ void fwd_filter(LAS const unsigned char* ft, LAS const unsigned char* img, const unsigned* twt, int J, int lane, float scl, float sk, unsigned* kh  ) {
    bf16x8 bAr[8], bAi[8];
    s1_tw<false, 8>(ft, img, twt, J, lane, bAr, bAi);
#pragma unroll
    for (int Ih = 0; Ih < 2; ++Ih) {
        f32x16 Zr[2], Zi[2];
        s3_half(ft, bAr, bAi, Ih, lane, Zr, Zi);
#pragma unroll
        for (int I = 0; I < 2; ++I) { unsigned* dst = kh + ((size_t)((2 * Ih + I) * 64 + lane)) * 16;
#pragma unroll
            for (int r4 = 0; r4 < 4; ++r4) *(u32x4*)(dst + 4 * r4) = (u32x4){cvtpk(Zr[I][4 * r4] * scl + sk, Zi[I][4 * r4] * scl), cvtpk(Zr[I][4 * r4 + 1] * scl + sk, Zi[I][4 * r4 + 1] * scl),
                                                                              cvtpk(Zr[I][4 * r4 + 2] * scl + sk, Zi[I][4 * r4 + 2] * scl), cvtpk(Zr[I][4 * r4 + 3] * scl + sk, Zi[I][4 * r4 + 3] * scl)}; }
        HY_SBAR();
    }
}
__device__ __forceinline__ void s3_filt_i1(LAS const unsigned char* ft, const unsigned* khat  , const unsigned* twt, int J, int lane, const bf16x8 (&bAr)[8], const bf16x8 (&bAi)[8], u32x2 (&dpk)[4][2][4]) {
    const int lr = lane & 31, lh = lane >> 5;
    bf16x8 aYr[8], aYi[8];
#pragma unroll
    for (int Ih = 0; Ih < 2; ++Ih) {
        const ctile k0 = load_ctile(khat + ((size_t)((2 * Ih) * 64 + lane)) * 16);
        f32x16 Zr[2], Zi[2];
        s3_half(ft, bAr, bAi, Ih, lane, Zr, Zi);
        const ctile k1 = load_ctile(khat + ((size_t)((2 * Ih + 1) * 64 + lane)) * 16);
#pragma unroll
        for (int I = 0; I < 2; ++I) { const int Ig = 2 * Ih + I;
            cmul_tile<false>(Zr[I], Zi[I], I == 0 ? k0 : k1);
            aYr[2 * Ig] = pack_step<0>(Zr[I]); aYr[2 * Ig + 1] = pack_step<1>(Zr[I]); aYi[2 * Ig] = pack_step<0>(Zi[I]); aYi[2 * Ig + 1] = pack_step<1>(Zi[I]);
            HY_SBAR();
        }
    }
#pragma unroll
    for (int ch = 0; ch < 2; ++ch) {
        const ctile tw0 = load_ctile(twt + ((size_t)((J * 4 + 2 * ch) * 64 + lane)) * 16);
        f32x16 Cr[2], Ci[2];
#pragma unroll
        for (int c = 0; c < 2; ++c) { zero16(Cr[c]); zero16(Ci[c]); }
#pragma unroll
        for (int s = 0; s < 8; ++s) {
            const bf16x8 anYr = neg8(aYr[s]);
#pragma unroll
            for (int c = 0; c < 2; ++c) {
                const bf16x8 bFr = ffrag(ft, 0, 2 * ch + c, s, lr, lh), bFi = ffrag(ft, 1, 2 * ch + c, s, lr, lh);
                Cr[c] = MFMA32(aYr[s], bFr, Cr[c]); Cr[c] = MFMA32(aYi[s], bFi, Cr[c]);
                Ci[c] = MFMA32(anYr, bFi, Ci[c]); Ci[c] = MFMA32(aYi[s], bFr, Ci[c]);
            }
            HY_SBAR();
        }
        const ctile tw1 = load_ctile(twt + ((size_t)((J * 4 + 2 * ch + 1) * 64 + lane)) * 16);
#pragma unroll
        for (int c = 0; c < 2; ++c) { const int cg = 2 * ch + c;
            cmul_tile<true>(Cr[c], Ci[c], c == 0 ? tw0 : tw1);
#pragma unroll
            for (int g = 0; g < 4; ++g) {
                dpk[cg][0][g] = (u32x2){cvtpk(Cr[c][4 * g], Cr[c][4 * g + 1]), cvtpk(Cr[c][4 * g + 2], Cr[c][4 * g + 3])};
                dpk[cg][1][g] = (u32x2){cvtpk(Ci[c][4 * g], Ci[c][4 * g + 1]), cvtpk(Ci[c][4 * g + 2], Ci[c][4 * g + 3])};
            }
            HY_SBAR();
        }
    }
}
__device__ __forceinline__ void write_D(LAS unsigned char* dimg, const u32x2 (&dpk)[4][2][4], int J, int lane) {
    const int lr = lane & 31, lh = lane >> 5;
    LAS unsigned char* base = dimg + lr * DROWB + lh * 16 + J * 64;
#pragma unroll
    for (int c = 0; c < 4; ++c)
#pragma unroll
        for (int g = 0; g < 4; ++g) {
            *(LAS u32x2*)(base + c * 32 * DROWB + 32 * (g >> 1) + 8 * (g & 1)) = dpk[c][0][g];
            *(LAS u32x2*)(base + c * 32 * DROWB + 256 + 32 * (g >> 1) + 8 * (g & 1)) = dpk[c][1][g]; }
}
__device__ __forceinline__ void i3_wave(LAS const unsigned char* ft, LAS const unsigned char* dimg, int a, int c, int lane, f32x16& yr, f32x16& yi) {
    const int lr = lane & 31, lh = lane >> 5;
    zero16(yr); zero16(yi);
#pragma unroll
    for (int s = 0; s < 8; ++s) {
        const bf16x8 aFr = ffrag(ft, 0, a, s, lr, lh), aFi = ffrag(ft, 1, a, s, lr, lh), anFi = neg8(aFi);
        const bf16x8 bDr = dfrag(dimg, c, 2 * s, lr, lh), bDi = dfrag(dimg, c, 16 + 2 * s, lr, lh);
        yr = MFMA32(aFr, bDr, yr); yr = MFMA32(aFi, bDi, yr);
        yi = MFMA32(aFr, bDi, yi); yi = MFMA32(anFi, bDr, yi);
        HY_SBAR();
    }
}
__device__ __forceinline__ int img_off(int n2, int ks) { return n2 * ROWB + ks * 2; }
}

__device__ __forceinline__ void ph_hyena_fft(Frame& F) {
    using namespace hy;
    const bf16_t* UT = (const bf16_t*)(F.ws + WS_UT); bf16_t* HYT = (bf16_t*)(F.ws + WS_HYT);
    const float* hdn = (const float*)(F.ws + WS_HDN); const float* w3 = F.in[I_FW3]; const float* decay = F.in[I_DECAY];
    const float* convw = F.in[I_CONVW]; const float* convb = F.in[I_CONVB]; const float* skip = F.in[I_SKIP];
    const unsigned* twt = (const unsigned*)(F.ws + WS_TWT);
    unsigned* khat = (unsigned*)(F.ws + WS_KHAT + (size_t)blockIdx.x * 131072);
    bf16_t* gt = (bf16_t*)(F.ws + WS_GT + (size_t)blockIdx.x * 131072);
    LAS unsigned char* ft = F.lds + FT_OFF; LAS unsigned char* xr = F.lds + X_OFF;
    LAS float* w3s = (LAS float*)(F.lds + SP_OFF);
    LAS float* red = w3s + 256;
    const int wid = F.wave;
#define HY_IDS int tid = F.tid; asm volatile("" : "+v"(tid)); const int lane = tid & 63, lr = lane & 31, lh = lane >> 5; (void)lr; (void)lh; (void)lane;
    __syncthreads();
    { const u32x4* src = (const u32x4*)(F.ws + WS_FTAB);
      for (int i = F.tid; i < 2 * TABB / 16; i += NTHREADS) *(LAS u32x4*)(ft + i * 16) = src[i]; }
    for (int c = blockIdx.x; c < HW; c += F.G) {
        __syncthreads();
        { HY_IDS
        u32x4 kw[8];
#pragma unroll
        for (int i = 0; i < 8; ++i) { const int ci = tid + 512 * i; const int od = ci >> 10, t0 = (ci & 1023) * 8;
            kw[i] = *(const u32x4*)((const bf16_t*)(F.ws + WS_KRAW) + (size_t)((od >> 1) * 1024 + (od & 1) * 512 + c) * SEQ + t0); }
#pragma unroll
        for (int i = 0; i < 8; ++i) {
            const int ci = tid + 512 * i; const int od = ci >> 10, t0 = (ci & 1023) * 8, o = od >> 1, dir = od & 1;
            const u32x4 w = kw[i];
            const unsigned short e[8] = {(unsigned short)w.x, (unsigned short)(w.x >> 16), (unsigned short)w.y, (unsigned short)(w.y >> 16), (unsigned short)w.z, (unsigned short)(w.z >> 16), (unsigned short)w.w, (unsigned short)(w.w >> 16)};
            LAS unsigned char* img = xr + o * TABB;
#pragma unroll
            for (int j = 0; j < 8; ++j) { const int t = t0 + j; int n = dir ? 2 * SEQ - t : t; unsigned short v = e[j];
                if (dir && t == 0) { n = SEQ; v = 0; }
                *(LAS bf16_t*)(img + img_off(n & 127, kstore(n >> 7))) = v; }
        }
        }
        __syncthreads();
        { HY_IDS
            const int o = wid >> 2, J = wid & 3;
            float nsum = 0.f;
            { const float* kp = (const float*)(F.ws + WS_KPART);
              for (int i = 0; i < 32; ++i) nsum += kp[(size_t)(o * 1024 + c) * 32 + i] + kp[(size_t)(o * 1024 + 512 + c) * 32 + i]; }
            const float scl = 1.0f / (nsum * (float)(2 * SEQ)), sk = skip[o * HW + c] * (1.0f / (float)(2 * SEQ));
            fwd_filter(ft, xr + o * TABB, twt, J, lane, scl, sk, khat + (size_t)((o * 4 + J) * 4) * 64 * 16);
        }
        __syncthreads();
#pragma unroll 1
        for (int rd = 0; rd < 2; ++rd) { HY_IDS
            {
                u32x4 uw[8]; float ul[8], uh[8];
#pragma unroll
                for (int i = 0; i < 8; ++i) { const int blk = 8 * rd + i, g = blk >> 3, b = (blk >> 1) & 3, a = blk & 1;
                    const bf16_t* row = UT + (size_t)((g + 1) * HW + c) * T + (size_t)b * SEQ; const int t0 = 4096 * a + 8 * tid;
                    uw[i] = *(const u32x4*)(row + t0); ul[i] = t0 > 0 ? bf2f(row[t0 - 1]) : 0.f; uh[i] = t0 + 8 < SEQ ? bf2f(row[t0 + 8]) : 0.f; }
#pragma unroll
                for (int i = 0; i < 8; ++i) { const int blk = 8 * rd + i, g = blk >> 3; const int chg = (g + 1) * HW + c;
                    const float w0 = convw[chg], w1 = convw[NHY + chg], w2 = convw[2 * NHY + chg], bb = convb[chg];
                    const u32x4 w = uw[i];
                    const float u[10] = {ul[i], bflo(w.x), bfhi(w.x), bflo(w.y), bfhi(w.y), bflo(w.z), bfhi(w.z), bflo(w.w), bfhi(w.w), uh[i]};
                    float v[8];
#pragma unroll
                    for (int j = 0; j < 8; ++j) v[j] = w0 * u[j] + w1 * u[j + 1] + w2 * u[j + 2] + bb;
                    *(LAS u32x4*)(xr + i * 8192 + tid * 16) = (u32x4){pk2(v[0], v[1]), pk2(v[2], v[3]), pk2(v[4], v[5]), pk2(v[6], v[7])}; }
            }
            __syncthreads();
#pragma unroll
            for (int k = 0; k < 4; ++k) {
                const int item = tid + 512 * k, i = item >> 8, c4 = (item >> 6) & 3; const int blk = 8 * rd + i;
                LAS const bf16_t* st = (LAS const bf16_t*)(xr + i * 8192);
                unsigned pk[8];
#pragma unroll
                for (int r2 = 0; r2 < 8; ++r2) { const unsigned lo = st[crow(2 * r2, lh) * 128 + 32 * c4 + lr], hi = st[crow(2 * r2 + 1, lh) * 128 + 32 * c4 + lr]; pk[r2] = lo | (hi << 16); }
                bf16_t* dst = gt + ((size_t)((blk * 4 + c4) * 64 + lane)) * 16;
                *(u32x4*)dst = (u32x4){pk[0], pk[1], pk[2], pk[3]}; *(u32x4*)(dst + 8) = (u32x4){pk[4], pk[5], pk[6], pk[7]};
            }
            __syncthreads();
        }
        u32x2 z1p[2][2][4];
        const int p = wid >> 2, J = wid & 3, ta = wid >> 2, tc = wid & 3;
        for (int o = 0; o < 2; ++o) {
            { HY_IDS
            if (o == 0) {
                const float w0 = convw[c], w1 = convw[NHY + c], w2 = convw[2 * NHY + c], bb = convb[c];
                u32x4 uw[8]; float ul[8], uh[8];
#pragma unroll
                for (int i = 0; i < 8; ++i) { const int ci = tid + 512 * i; const int b = ci >> 10, t0 = (ci & 1023) * 8;
                    const bf16_t* row = UT + (size_t)c * T + (size_t)b * SEQ;
                    uw[i] = *(const u32x4*)(row + t0); ul[i] = t0 > 0 ? bf2f(row[t0 - 1]) : 0.f; uh[i] = t0 + 8 < SEQ ? bf2f(row[t0 + 8]) : 0.f; }
#pragma unroll
                for (int i = 0; i < 8; ++i) {
                    const int ci = tid + 512 * i; const int b = ci >> 10, t0 = (ci & 1023) * 8;
                    const u32x4 w = uw[i];
                    const float u[10] = {ul[i], bflo(w.x), bfhi(w.x), bflo(w.y), bfhi(w.y), bflo(w.z), bfhi(w.z), bflo(w.w), bfhi(w.w), uh[i]};
                    const int n1 = t0 >> 7, n2 = t0 & 127; const int ks = kstore(n1) + 64 * (b & 1);
                    LAS unsigned char* img = xr + (b >> 1) * TABB;
#pragma unroll
                    for (int j = 0; j < 8; ++j) *(LAS bf16_t*)(img + img_off(n2 + j, ks)) = (bf16_t)f2bf(w0 * u[j] + w1 * u[j + 1] + w2 * u[j + 2] + bb);
                }
            } else {
#pragma unroll
                for (int q = 0; q < 2; ++q) { LAS unsigned char* img = xr + q * TABB + (32 * tc + lr) * ROWB + lh * 16 + ta * 64;
#pragma unroll
                    for (int g = 0; g < 4; ++g) {
                        *(LAS u32x2*)(img + 32 * (g >> 1) + 8 * (g & 1)) = z1p[q][0][g];
                        *(LAS u32x2*)(img + 128 + 32 * (g >> 1) + 8 * (g & 1)) = z1p[q][1][g]; } }
            }
            }
            __syncthreads();
            u32x2 dpk[4][2][4];
            { HY_IDS
                bf16x8 bAr[8], bAi[8];
                s1_tw<true, 4>(ft, xr + p * TABB, twt, J, lane, bAr, bAi);
                __syncthreads();
                s3_filt_i1(ft, khat + (size_t)((o * 4 + J) * 4) * 64 * 16, twt, J, lane, bAr, bAi, dpk);
            }
#pragma unroll 1
            for (int q = 0; q < 2; ++q) { HY_IDS
                if (p == q) write_D(xr, dpk, J, lane);
                __syncthreads();
                const bf16_t* g0 = gt + ((size_t)((((o * 4 + 2 * q) * 2 + ta) * 4 + tc) * 64 + lane)) * 16;
                const bf16_t* g1 = gt + ((size_t)((((o * 4 + 2 * q + 1) * 2 + ta) * 4 + tc) * 64 + lane)) * 16;
                const u32x4 ga = *(const u32x4*)g0, gb = *(const u32x4*)(g0 + 8), gc = *(const u32x4*)g1, gd = *(const u32x4*)(g1 + 8);
                f32x16 yr, yi;
                i3_wave(ft, xr, ta, tc, lane, yr, yi);
                const unsigned gre[8] = {ga.x, ga.y, ga.z, ga.w, gb.x, gb.y, gb.z, gb.w}, gim[8] = {gc.x, gc.y, gc.z, gc.w, gd.x, gd.y, gd.z, gd.w};
#pragma unroll
                for (int r2 = 0; r2 < 8; ++r2) { yr[2 * r2] *= bflo(gre[r2]); yr[2 * r2 + 1] *= bfhi(gre[r2]); yi[2 * r2] *= bflo(gim[r2]); yi[2 * r2 + 1] *= bfhi(gim[r2]); }
                {
#pragma unroll
                    for (int g = 0; g < 4; ++g) { z1p[q][0][g] = (u32x2){cvtpk(yr[4 * g], yr[4 * g + 1]), cvtpk(yr[4 * g + 2], yr[4 * g + 3])};
                                                  z1p[q][1][g] = (u32x2){cvtpk(yi[4 * g], yi[4 * g + 1]), cvtpk(yi[4 * g + 2], yi[4 * g + 3])}; }
                }
                if (o == 1) {
                    bf16_t* o0 = HYT + (size_t)c * T + (size_t)(2 * q) * SEQ + 32 * tc + lr; bf16_t* o1 = o0 + SEQ;
#pragma unroll
                    for (int r = 0; r < 16; ++r) { const int n1 = 32 * ta + crow(r, lh); o0[128 * n1] = (bf16_t)f2bf(yr[r]); o1[128 * n1] = (bf16_t)f2bf(yi[r]); }
                }
                __syncthreads();
            }
        }
    }
    __syncthreads();
#undef HY_IDS
}

__device__ __forceinline__ void ph_hyT(Frame& F) {
    const bf16_t* HYT = (const bf16_t*)(F.ws + WS_HYT); bf16_t* HY = (bf16_t*)(F.ws + WS_AH) + AW;
    for (int it = blockIdx.x; it < 8 * (T / 512); it += F.G) {
        const int cb = it & 7, tb = it >> 3; const int t = tb * 512 + F.tid, c0 = cb * 64;
        unsigned w[32];
#pragma unroll
        for (int i = 0; i < 32; ++i) { const unsigned lo = HYT[(size_t)(c0 + 2 * i) * T + t], hi = HYT[(size_t)(c0 + 2 * i + 1) * T + t]; w[i] = lo | (hi << 16); }
#pragma unroll
        for (int i = 0; i < 8; ++i) *(u32x4*)(HY + (size_t)t * DM + c0 + 8 * i) = (u32x4){w[4 * i], w[4 * i + 1], w[4 * i + 2], w[4 * i + 3]};
    }
}

__device__ __forceinline__ void ph_expert_cvt(Frame& F) {
    LAS float* scr = (LAS float*)(F.lds + F.wave * 16384);
    const int gw = F.vcu * NWAVES + F.wave, NGW = F.G * NWAVES;
    bf16_t* W13 = (bf16_t*)(F.ws + WS_W13); bf16_t* W2 = (bf16_t*)(F.ws + WS_W2);
    for (int it = gw; it < NE * 768; it += NGW) {
        const int e = it / 768; int r = it % 768;
        if (r < 512) { const bool is3 = r >= 256; r &= 255; const int kb = r / 16, nb = r % 16, n0 = nb * 32;
            const int drow = (n0 >> 7) * 256 + (is3 ? 128 : 0) + (n0 & 127);
            transpose_item(F.in[is3 ? I_EW3 : I_EW1] + (size_t)e * DM * DE, DM, DE, W13 + (size_t)e * DM * DM, DM, drow, scr, kb, nb, F.lane); }
        else { r -= 512; const int kb = r / 32, nb = r % 32;
            transpose_item(F.in[I_EW2] + (size_t)e * DE * DM, DE, DM, W2 + (size_t)e * DM * DE, DE, nb * 32, scr, kb, nb, F.lane); }
    }
}

__device__ __forceinline__ void ph_ln1_route(Frame& F) {
    float* v = F.out; bf16_t* h2b = (bf16_t*)(F.ws + WS_HB); bf16_t* h2l = (bf16_t*)(F.ws + WS_Y2);
    const float* mod = (const float*)(F.ws + WS_MOD); const float* g1 = F.in[I_LN1G]; const float* b1 = F.in[I_LN1B];
    const bf16_t* wr = (const bf16_t*)(F.ws + WS_WRT); const float* bg = F.in[I_RGB]; const float* be = F.in[I_REB];
    unsigned* cnt = F.ctl + CW_CNT; int* btok = (int*)(F.ws + WS_BTOK); float* bw = (float*)(F.ws + WS_BW);
    constexpr int WROW = 272, WCH = 80 * WROW;
    LAS unsigned char* wl = F.lds;
    LAS float* lg = (LAS float*)(F.lds + 65536);
    for (int ch = blockIdx.x; ch < T / 128; ch += F.G) {
        const int b = (ch * 128) / SEQ;
        for (int rr = F.wave; rr < 128; rr += NWAVES) {
            const size_t row = (size_t)ch * 128 + rr;
            f32x4* xr = (f32x4*)(v + row * DM) + F.lane;
            f32x4 x[4]; float s = 0.f;
#pragma unroll
            for (int j = 0; j < 4; ++j) { x[j] = xr[64 * j]; s += (x[j][0] + x[j][1]) + (x[j][2] + x[j][3]); }
            const float mean = wave_sum(s) * (1.f / DM); float s2 = 0.f;
#pragma unroll
            for (int j = 0; j < 4; ++j) { x[j] = x[j] - mean; s2 += (x[j][0] * x[j][0] + x[j][1] * x[j][1]) + (x[j][2] * x[j][2] + x[j][3] * x[j][3]); }
            const float rstd = 1.f / sqrtf(wave_sum(s2) * (1.f / DM) + LN_EPS);
            unsigned long long* o8 = (unsigned long long*)(h2b + row * DM) + F.lane; unsigned long long* l8 = (unsigned long long*)(h2l + row * DM) + F.lane;
#pragma unroll
            for (int j = 0; j < 4; ++j) { const int k = 4 * F.lane + 256 * j;
                const f32x4 gg = *(const f32x4*)(g1 + k), bb = *(const f32x4*)(b1 + k);
                const f32x4 sh = *(const f32x4*)(mod + (size_t)b * 6144 + 3072 + k), sc = *(const f32x4*)(mod + (size_t)b * 6144 + 4096 + k);
                x[j] = x[j] * rstd * gg + bb; xr[64 * j] = x[j];
                const f32x4 h = x[j] * (sc + 1.0f) + sh;
                unsigned hi[4]; float lo[4];
#pragma unroll
                for (int u = 0; u < 4; ++u) { hi[u] = f2bf(h[u]); lo[u] = h[u] - bf2f((unsigned short)hi[u]); }
                o8[64 * j] = (unsigned long long)(hi[0] | (hi[1] << 16)) | ((unsigned long long)(hi[2] | (hi[3] << 16)) << 32);
                l8[64 * j] = (unsigned long long)pk2(lo[0], lo[1]) | ((unsigned long long)pk2(lo[2], lo[3]) << 32); }
        }
        __syncthreads();
        {
            const int lane = F.lane, l15 = lane & 15, l4 = lane >> 4;
            f32x4 acc[5];
#pragma unroll
            for (int n = 0; n < 5; ++n) acc[n] = (f32x4){0.f, 0.f, 0.f, 0.f};
            const size_t arow = ((size_t)ch * 128 + 16 * F.wave + l15) * DM + 8 * l4;
#pragma unroll 1
            for (int kc = 0; kc < 8; ++kc) {
                for (int i = F.tid; i < 2 * 80 * 16; i += NTHREADS) { const int part = i / 1280, r = (i % 1280) >> 4, pc = i & 15;
                    *(LAS u32x4*)(wl + part * WCH + r * WROW + pc * 16) = *(const u32x4*)(wr + (size_t)part * 80 * DM + (size_t)r * DM + kc * 128 + pc * 8); }
                __syncthreads();
#pragma unroll
                for (int s4 = 0; s4 < 4; ++s4) {
                    const bf16x8 ah = *(const bf16x8*)(h2b + arow + kc * 128 + 32 * s4), al = *(const bf16x8*)(h2l + arow + kc * 128 + 32 * s4);
#pragma unroll
                    for (int n = 0; n < 5; ++n) {
                        const bf16x8 bh = *(LAS const bf16x8*)(wl + (16 * n + l15) * WROW + (32 * s4 + 8 * l4) * 2), bl = *(LAS const bf16x8*)(wl + WCH + (16 * n + l15) * WROW + (32 * s4 + 8 * l4) * 2);
                        acc[n] = __builtin_amdgcn_mfma_f32_16x16x32_bf16(ah, bh, acc[n], 0, 0, 0);
                        acc[n] = __builtin_amdgcn_mfma_f32_16x16x32_bf16(al, bh, acc[n], 0, 0, 0);
                        acc[n] = __builtin_amdgcn_mfma_f32_16x16x32_bf16(ah, bl, acc[n], 0, 0, 0);
                    }
                }
                __syncthreads();
            }
#pragma unroll
            for (int n = 0; n < 5; ++n)
#pragma unroll
                for (int r = 0; r < 4; ++r) lg[(16 * F.wave + 4 * l4 + r) * 81 + 16 * n + l15] = acc[n][r];
        }
        __syncthreads();
        if (F.tid < 128) {
            const int row = ch * 128 + F.tid; LAS const float* lr_ = lg + F.tid * 81;
            float gl[8]; float gmax; int g = 0;
#pragma unroll
            for (int i = 0; i < 8; ++i) gl[i] = lr_[i] + bg[i];
            gmax = gl[0];
#pragma unroll
            for (int i = 1; i < 8; ++i) if (gl[i] > gmax) { gmax = gl[i]; g = i; }
            float den = 0.f;
#pragma unroll
            for (int i = 0; i < 8; ++i) den += __expf(gl[i] - gmax);
            const float pg = 1.0f / den;
            float el[8];
#pragma unroll
            for (int j = 0; j < 8; ++j) el[j] = lr_[8 + g * 8 + j] + be[g * 8 + j];
            int i1 = 0; float e1 = el[0];
#pragma unroll
            for (int j = 1; j < 8; ++j) if (el[j] > e1) { e1 = el[j]; i1 = j; }
            int i2 = -1; float e2 = -INFINITY;
#pragma unroll
            for (int j = 0; j < 8; ++j) if (j != i1 && (i2 < 0 || el[j] > e2)) { e2 = el[j]; i2 = j; }
            const float r = __expf(e2 - e1); const float wa = pg / (1.0f + r), wb = pg * r / (1.0f + r);
            const int ea = g * 8 + i1, eb = g * 8 + i2;
            const unsigned ra = atomicAdd(&cnt[ea], 1u); btok[(size_t)ea * ECAP + ra] = row * 2; bw[(size_t)ea * ECAP + ra] = wa;
            const unsigned rb = atomicAdd(&cnt[eb], 1u); btok[(size_t)eb * ECAP + rb] = row * 2 + 1; bw[(size_t)eb * ECAP + rb] = wb;
        }
        __syncthreads();
    }
}

__device__ __forceinline__ void build_moe_tab(Frame& F, LAS int* tab) {
    __syncthreads();
    if (F.tid < 64) tab[72 + F.tid] = (int)__hip_atomic_load(F.ctl + CW_CNT + F.tid, __ATOMIC_RELAXED, __HIP_MEMORY_SCOPE_AGENT);
    __syncthreads();
    if (F.tid == 0) { int s = 0; for (int e = 0; e < 64; ++e) { tab[e] = s; s += (tab[72 + e] + 255) >> 8; } tab[64] = s; }
    __syncthreads();
}

__device__ __forceinline__ void ph_final(Frame& F) {
    float* v = F.out; const bf16_t* y2 = (const bf16_t*)(F.ws + WS_Y2);
    const float* mod = (const float*)(F.ws + WS_MOD); const float* g2 = F.in[I_LN2G]; const float* b2 = F.in[I_LN2B];
    const int gw = F.vcu * NWAVES + F.wave, NGW = F.G * NWAVES;
    for (int row = gw; row < T; row += NGW) {
        const int b = row / SEQ;
        f32x4* xr = (f32x4*)(v + (size_t)row * DM) + F.lane;
        const unsigned long long* ya = (const unsigned long long*)(y2 + (size_t)(2 * row) * DM) + F.lane;
        const unsigned long long* yb = (const unsigned long long*)(y2 + (size_t)(2 * row + 1) * DM) + F.lane;
        f32x4 x[4]; float s = 0.f;
#pragma unroll
        for (int j = 0; j < 4; ++j) { const int k = 4 * F.lane + 256 * j;
            const f32x4 gt = *(const f32x4*)(mod + (size_t)b * 6144 + 5120 + k);
            const unsigned long long a = ya[64 * j], c = yb[64 * j];
            f32x4 y; y[0] = bflo((unsigned)a) + bflo((unsigned)c); y[1] = bfhi((unsigned)a) + bfhi((unsigned)c);
            y[2] = bflo((unsigned)(a >> 32)) + bflo((unsigned)(c >> 32)); y[3] = bfhi((unsigned)(a >> 32)) + bfhi((unsigned)(c >> 32));
            x[j] = xr[64 * j] * DN_ALPHA + gt * y; s += (x[j][0] + x[j][1]) + (x[j][2] + x[j][3]); }
        const float mean = wave_sum(s) * (1.f / DM); float s2 = 0.f;
#pragma unroll
        for (int j = 0; j < 4; ++j) { x[j] = x[j] - mean; s2 += (x[j][0] * x[j][0] + x[j][1] * x[j][1]) + (x[j][2] * x[j][2] + x[j][3] * x[j][3]); }
        const float rstd = 1.f / sqrtf(wave_sum(s2) * (1.f / DM) + LN_EPS);
#pragma unroll
        for (int j = 0; j < 4; ++j) { const int k = 4 * F.lane + 256 * j; xr[64 * j] = x[j] * rstd * *(const f32x4*)(g2 + k) + *(const f32x4*)(b2 + k); }
    }
}

constexpr int N_PHASES = 12;
__device__ __forceinline__ Frame make_frame(const Args& args, unsigned char* lds) {
    Frame F;
    F.lds = (LAS unsigned char*)lds; F.ws = args.ws; F.ctl = (unsigned*)(args.ws + WS_CTL);
    F.tid = threadIdx.x; F.lane = F.tid & 63; F.wave = __builtin_amdgcn_readfirstlane(F.tid >> 6);
    F.G = gridDim.x; { const int bx = blockIdx.x; F.vcu = (F.G % 8 == 0) ? (bx % 8) * (F.G / 8) + bx / 8 : bx; }
    F.in = args.in; F.out = args.out;
    return F;
}
template <unsigned PH_MASK> __global__ void __launch_bounds__(NTHREADS, 2) mk_fwd(Args args) {
    extern __shared__ __attribute__((aligned(16))) unsigned char lds[];
    for (int u = threadIdx.x; u < (LDS_BYTES - LDSCTL_OFF) / 4; u += NTHREADS) ((LAS unsigned*)((LAS unsigned char*)lds + LDSCTL_OFF))[u] = 0u;
    __syncthreads();
    constexpr bool multi = (PH_MASK & (PH_MASK - 1u)) != 0u;
    if (multi) xcd_barrier_post((unsigned*)(args.ws + WS_CTL) + CW_BAR);
#define IN(k) ((PH_MASK >> (k)) & 1u)
#define GBAR() xcd_barrier((unsigned*)(args.ws + WS_CTL) + CW_BAR, (volatile LAS unsigned*)((LAS unsigned char*)lds + MISC_OFF) + 8)
#define PH(k, ...) if (IN(k)) { __VA_ARGS__ } if (IN(k) && ((PROBE_DBL >> (k)) & 1u)) { GBAR(); __VA_ARGS__ } if (IN(k) && (k) + 1 < N_PHASES && IN((k) + 1)) GBAR();
#define SEAM(k) do { if (IN(k) && IN((k) + 1)) xcd_barrier((unsigned*)(args.ws + WS_CTL) + CW_BAR, (volatile LAS unsigned*)((LAS unsigned char*)lds + MISC_OFF) + 8); } while (0)
#define RING ((LAS unsigned char*)lds)
#define TAB ((LAS int*)((LAS unsigned char*)lds + TAB_OFF))

    PH(0, Frame F = make_frame(args, lds); ph_prep(F);
    )
    PH(1, Frame F = make_frame(args, lds); ph_taps(F); if (PROBE_SUB & 16u) ph_taps(F); ph_hb(F); if (PROBE_SUB & 32u) ph_hb(F);
    )
    PH(2,
        { pg8::DenseSched S; S.init(T, N1A, DM, gridDim.x, (int)blockIdx.x, args.ws + WS_WIN);
          pg8::EpiInA E{(bf16_t*)(args.ws + WS_Q), (bf16_t*)(args.ws + WS_K), (bf16_t*)(args.ws + WS_V), (bf16_t*)(args.ws + WS_GA), (bf16_t*)(args.ws + WS_GH)};
          pg8::gemm_phase<pg8::EpiInA, pg8::DenseSched, true>(RING, args.ws + WS_HB, DM, S, E); }
        { pg8::DenseSched S; S.init(NHY, T, DM, gridDim.x, (int)blockIdx.x, args.ws + WS_HB);
          pg8::EpiBf16 E{(bf16_t*)(args.ws + WS_UT), T};
          pg8::gemm_phase<pg8::EpiBf16, pg8::DenseSched, true>(RING, args.ws + WS_WIN + (size_t)N1A * DM * 2, DM, S, E); }
    )
    PH(3, Frame F = make_frame(args, lds); ph_attn(F); if (PROBE_SUB & 1u) ph_attn(F); ph_hyena_fft(F); if (PROBE_SUB & 2u) ph_hyena_fft(F);
    )
    PH(4, Frame F = make_frame(args, lds); ph_hyT(F);
    )
    PH(5,
        pg8::DenseSched S; S.init(T, DM, DM, gridDim.x, (int)blockIdx.x, args.ws + WS_WAH);
        pg8::EpiMerge E{(const bf16_t*)(args.ws + WS_GA), (const bf16_t*)(args.ws + WS_GH), (bf16_t*)(args.ws + WS_HB)};
        pg8::gemm_phase<pg8::EpiMerge, pg8::DenseSched, true>(RING, args.ws + WS_AH, DM, S, E);
    )
    PH(7,
        { pg8::DenseSched S; S.init(T, DM, DM, gridDim.x, (int)blockIdx.x, args.ws + WS_WO);
          pg8::EpiRes E{args.in[I_X], (const float*)(args.ws + WS_MOD) + 2048, args.out};
          pg8::gemm_phase<pg8::EpiRes, pg8::DenseSched, true>(RING, args.ws + WS_HB, DM, S, E);
          if (PROBE_SUB & 4u) pg8::gemm_phase<pg8::EpiRes, pg8::DenseSched, true>(RING, args.ws + WS_HB, DM, S, E); }
        { Frame F = make_frame(args, lds); ph_expert_cvt(F); if (PROBE_SUB & 8u) ph_expert_cvt(F); }
    )
    PH(8, Frame F = make_frame(args, lds); ph_ln1_route(F);
    )
    PH(9,
        { Frame F = make_frame(args, lds); build_moe_tab(F, TAB); }
        const int G = gridDim.x, bx = blockIdx.x, vcu = (G % 8 == 0) ? (bx % 8) * (G / 8) + bx / 8 : bx;
        pg8::MoeSched<true> S{TAB, (const int*)(args.ws + WS_BTOK), (const char*)(args.ws + WS_W13), (size_t)DM * DM * 2, G, vcu, DM};
        pg8::EpiSwiGLU E{(bf16_t*)(args.ws + WS_HACT)};
        pg8::gemm_phase<pg8::EpiSwiGLU, pg8::MoeSched<true>, true>(RING, args.ws + WS_HB, DM, S, E);
    )
    PH(10,
        { Frame F = make_frame(args, lds); build_moe_tab(F, TAB); }
        const int G = gridDim.x, bx = blockIdx.x, vcu = (G % 8 == 0) ? (bx % 8) * (G / 8) + bx / 8 : bx;
        pg8::MoeSched<false> S{TAB, (const int*)(args.ws + WS_BTOK), (const char*)(args.ws + WS_W2), (size_t)DM * DE * 2, G, vcu, DE};
        pg8::EpiScatter E{(bf16_t*)(args.ws + WS_Y2), (const int*)(args.ws + WS_BTOK), (const float*)(args.ws + WS_BW), TAB};
        pg8::gemm_phase<pg8::EpiScatter, pg8::MoeSched<false>, true>(RING, args.ws + WS_HACT, DE, S, E);
    )
    PH(11, Frame F = make_frame(args, lds); ph_final(F);
    )
#undef IN
#undef SEAM
#undef GBAR
#undef PH
#undef RING
#undef TAB
}

extern "C" void kernel_launch(void* const* d_in, const int* in_sizes, int n_in, void* d_out, int out_size, void* d_ws, size_t ws_size, hipStream_t stream) {
    static int grid = 0;
    if (grid == 0) {
        if (n_in != 31 || out_size != T * DM || ws_size < WS_END) { fprintf(stderr, "kernel_launch: unexpected shapes: n_in %d out %d ws %zu (need %zu)\n", n_in, out_size, ws_size, (size_t)WS_END); grid = -1; return; }
        int dev = 0, cus = 0;
        if (hipGetDevice(&dev) != hipSuccess || hipDeviceGetAttribute(&cus, hipDeviceAttributeMultiprocessorCount, dev) != hipSuccess) { grid = -1; return; }
        bool ok = true;
#define SET_ATTR(m) ok = ok && (hipFuncSetAttribute((const void*)mk_fwd<(m)>, hipFuncAttributeMaxDynamicSharedMemorySize, LDS_BYTES) == hipSuccess)
#if MK_N_LAUNCHES == 1
        SET_ATTR(FUSED_MASK);
#else
        { SET_ATTR(1u << 0); SET_ATTR(1u << 1); SET_ATTR(1u << 2); SET_ATTR(1u << 3); SET_ATTR(1u << 4); SET_ATTR(1u << 5); SET_ATTR(1u << 6); SET_ATTR(1u << 7); SET_ATTR(1u << 8); SET_ATTR(1u << 9); SET_ATTR(1u << 10); SET_ATTR(1u << 11); }
#endif
#undef SET_ATTR
        if (!ok) { fprintf(stderr, "kernel_launch: hipFuncSetAttribute failed\n"); grid = -1; return; }
        (void)hipGetLastError();
        grid = cus;
    }
    if (grid < 0) return;
    if (hipMemsetAsync((char*)d_ws + WS_CTL, 0, CTL_ZERO_BYTES, stream) != hipSuccess) return;
    Args a{};
    for (int i = 0; i < 31; ++i) a.in[i] = (const float*)d_in[i];
    a.out = (float*)d_out; a.ws = (unsigned char*)d_ws;
#if MK_N_LAUNCHES == 1
    a.ph_lo = 0; a.ph_hi = N_PHASES; hipLaunchKernelGGL(mk_fwd<FUSED_MASK>, dim3(grid), dim3(NTHREADS), LDS_BYTES, stream, a);
#else
    {
#define LAUNCH_PH(p) do { a.ph_lo = (p); a.ph_hi = (p) + 1; for (int rep_ = 0; rep_ < (((PROBE_DBL >> (p)) & 1u) ? 2 : 1); ++rep_) hipLaunchKernelGGL(mk_fwd<(1u << (p))>, dim3(grid), dim3(NTHREADS), LDS_BYTES, stream, a); } while (0)
        LAUNCH_PH(0); LAUNCH_PH(1); LAUNCH_PH(2); LAUNCH_PH(3); LAUNCH_PH(4); LAUNCH_PH(5); LAUNCH_PH(6); LAUNCH_PH(7); LAUNCH_PH(8); LAUNCH_PH(9); LAUNCH_PH(10); LAUNCH_PH(11);
#undef LAUNCH_PH
    }
#endif
}
```

```cpp
#include <hip/hip_runtime.h>
#include <cstdio>
#include <cstdint>

#ifndef PROBE_DBL
#define PROBE_DBL 0u
#endif
#ifndef PROBE_SUB
#define PROBE_SUB 0u
#endif
#ifndef PROBE_HY
#define PROBE_HY 0u
#endif
#ifndef FUSED_MASK
#define FUSED_MASK 0xFFFu
#endif
#ifndef MK_N_LAUNCHES
#define MK_N_LAUNCHES 1
#endif

#define GAS __attribute__((address_space(1)))
#define LAS __attribute__((address_space(3)))
typedef unsigned short bf16_t;
typedef short bf16x8 __attribute__((ext_vector_type(8)));
typedef float f32x4 __attribute__((ext_vector_type(4)));
typedef float f32x2 __attribute__((ext_vector_type(2)));
typedef unsigned u32x4 __attribute__((ext_vector_type(4)));
typedef unsigned u32x2 __attribute__((ext_vector_type(2)));

constexpr int NB = 4, SEQ = 8192, DM = 1024, T = NB * SEQ;
constexpr int AW = 512, KVW = 128, HW = 512, INW = 4352, N1A = 2816, NHY = 1536;
constexpr int NE = 64, DE = 512, ECAP = 32768;
constexpr int NFILT = 2048, FH = 64, FEMB = 33;
constexpr float LN_EPS = 1e-5f;
constexpr float DN_ALPHA = 1.189207115002721f;
constexpr int NTHREADS = 512, NWAVES = 8;

constexpr size_t MiB = 1u << 20;
constexpr size_t WS_CTL = 0, CTL_ZERO_BYTES = 1 * MiB;
constexpr size_t WS_MODP = 1 * MiB, WS_MOD = 3 * MiB, WS_HDN = 4 * MiB, WS_WRT = 6 * MiB, WS_WIN = 7 * MiB;
constexpr size_t WS_WAH = 16 * MiB, WS_WO = 18 * MiB, WS_BTOK = 20 * MiB, WS_BW = 28 * MiB;
constexpr size_t WS_HB = 36 * MiB;
constexpr size_t WS_Q = 100 * MiB, WS_K = 132 * MiB, WS_V = 140 * MiB, WS_GA = 148 * MiB, WS_GH = 212 * MiB;
constexpr size_t WS_UT = 276 * MiB, WS_TMP = 276 * MiB;
constexpr size_t WS_AH = 372 * MiB;
constexpr size_t WS_HYT = 500 * MiB;
constexpr size_t WS_W13 = 100 * MiB, WS_W2 = 228 * MiB, WS_HACT = 404 * MiB, WS_Y2 = 36 * MiB, WS_END = 532 * MiB;
constexpr size_t WS_FTAB = 15 * MiB + 524288;
constexpr size_t WS_TWT = 15 * MiB + 524288 + 73728;
constexpr size_t WS_KHAT = 36 * MiB;
constexpr size_t WS_GT = 436 * MiB;
constexpr size_t WS_Y1 = 340 * MiB;
constexpr size_t WS_H2LO = 436 * MiB;
constexpr size_t WS_KRAW = 468 * MiB;
constexpr size_t WS_KPART = 6 * MiB + 524288;  constexpr size_t WS_HDNB = WS_HDN;
constexpr int CW_BAR = 4096, CW_CNT = 8192;

constexpr int RING_BYTES = 131072, LDS_BYTES = 163840, LDSCTL_OFF = LDS_BYTES - 2048, MISC_OFF = LDSCTL_OFF + 320, TAB_OFF = LDSCTL_OFF + 1024;

#define LDS_WAIT() asm volatile("s_waitcnt lgkmcnt(0)" ::: "memory")
#define VM_WAIT() asm volatile("s_waitcnt vmcnt(0)" ::: "memory")
typedef __bf16 bf16x2_hw __attribute__((ext_vector_type(2)));
__device__ __forceinline__ unsigned pk2(float lo, float hi) { f32x2 v = {lo, hi}; bf16x2_hw b = __builtin_convertvector(v, bf16x2_hw); return __builtin_bit_cast(unsigned, b); }
__device__ __forceinline__ unsigned f2bf(float f) { return pk2(f, 0.f) & 0xffffu; }
__device__ __forceinline__ float bf2f(unsigned short b) { return __builtin_bit_cast(float, (unsigned)b << 16); }
__device__ __forceinline__ float bflo(unsigned w) { return __builtin_bit_cast(float, w << 16); }
__device__ __forceinline__ float bfhi(unsigned w) { return __builtin_bit_cast(float, w & 0xffff0000u); }
__device__ __forceinline__ float sigmoidf_(float x) { return __builtin_amdgcn_rcpf(1.0f + __expf(-x)); }
__device__ __forceinline__ float wave_sum(float v) {
#pragma unroll
    for (int o = 1; o < 64; o <<= 1) v += __shfl_xor(v, o);
    return v;
}

namespace pg8 {
constexpr int BM = 256, BK = 64, HALF = 128, HTB = HALF * BK * 2, STAGE_BYTES = 8 * HTB, NXCD = 8, WGM = 8;
__host__ __device__ __forceinline__ int lds_byte(int r, int c) { const int st = (r >> 4) * 2 + (c >> 5), rr = r & 15, cc = c & 31, ob = rr * 64 + cc * 2; return st * 1024 + (ob ^ (((ob >> 9) & 1) << 5)); }
__host__ __device__ __forceinline__ void stage_rc(int b, int& R, int& C) { const int st = b / 1024, sb = b % 1024, swz = sb ^ (((sb >> 9) & 1) << 5); R = (st >> 1) * 16 + swz / 64; C = (st & 1) * 32 + (swz % 64) / 2; }
__host__ __device__ __forceinline__ int perm32(int rho) { const int n = rho >> 4, i = rho & 15; return 8 * (i >> 2) + 4 * n + (i & 3); }

struct Unit { int pm, pn, e, mt; };

struct DenseSched {
    static constexpr bool GATHER = false;
    int nM, nN, nwg, G, c, K; const char* Bt;
    __device__ void init(int M, int N, int K_, int G_, int c_, const void* Bt_) { nM = M / BM; nN = N / BM; nwg = nM * nN; G = G_; c = c_; K = K_; Bt = (const char*)Bt_; }
    __device__ bool next(int i, Unit& u) const {
        const long L = (long)i * G + c; if (L >= nwg) return false;
        int wgid = (int)L; { const int q = nwg / NXCD, r = nwg % NXCD, xcd = wgid % NXCD, off = wgid / NXCD; wgid = (xcd < r ? xcd * (q + 1) : r * (q + 1) + (xcd - r) * q) + off; }
        const int nig = WGM * nN, gid = wgid / nig, fm = gid * WGM, gsz = (nM - fm) < WGM ? (nM - fm) : WGM;
        u.pm = fm + ((wgid % nig) % gsz); u.pn = (wgid % nig) / gsz; u.e = 0; u.mt = 0; return true;
    }
    __device__ __forceinline__ unsigned arow(const Unit& u, int r) const { return (unsigned)(u.pm * BM + r); }
    __device__ __forceinline__ const char* bptr(const Unit& u) const { return Bt + (size_t)u.pn * BM * K * 2; }
};

template <bool GATHER_> struct MoeSched {
    static constexpr bool GATHER = GATHER_;
    const LAS int* tab;
    const int* btok;
    const char* Bt; size_t estride; int G, v, K;
    __device__ bool next(int i, Unit& u) const {
        const int L = i * G + v; const int tile = L >> 2; if (tile >= tab[64]) return false;
        int e = 0;
        for (int j = 1; j < 64; ++j) e += (tab[j] <= tile) ? 1 : 0;
        u.e = e; u.mt = tile - tab[e]; u.pm = tile; u.pn = L & 3; return true;
    }
    __device__ __forceinline__ unsigned arow(const Unit& u, int r) const {
        if (!GATHER_) return (unsigned)(u.pm * BM + r);
        const int idx = u.mt * BM + r; const int cnt = tab[72 + u.e];
        unsigned tok = 0; if (idx < cnt) tok = (unsigned)btok[(size_t)u.e * ECAP + idx] >> 1;
        return tok;
    }
    __device__ __forceinline__ const char* bptr(const Unit& u) const { return Bt + (size_t)u.e * estride + (size_t)u.pn * BM * K * 2; }
};

template <class Epi, class Sched, bool ALIGN_EPI>
__device__ __forceinline__ void gemm_phase(LAS unsigned char* lds, const void* Abase, const int K, const Sched& S, const Epi& E) {
    int tid = threadIdx.x; asm volatile("" : "+v"(tid));
    const int wid = __builtin_amdgcn_readfirstlane(tid >> 6), lane = tid & 63, wr = wid >> 2, wc = wid & 3, fr = lane & 15, fq = lane >> 4;
    const int nt = K / BK;
    int Rr[2], Cc[2]; unsigned voffB[2];
#pragma unroll
    for (int i = 0; i < 2; ++i) { stage_rc(tid * 16 + i * 8192, Rr[i], Cc[i]);
        const int Rb = Epi::BMAP == 2 ? (64 * (Rr[i] >> 5) + perm32(Rr[i] & 31)) : ((Rr[i] & ~31) + perm32(Rr[i] & 31)); voffB[i] = (unsigned)(Rb * K + Cc[i]) * 2u; }
    const size_t kstep = (size_t)(BK * 2);
    const size_t hstep = (size_t)HALF * K * 2;
    const size_t bhs = (size_t)(Epi::BMAP == 2 ? 32 : HALF) * K * 2;
    LAS unsigned char* const stg = lds + RING_BYTES + wid * 2304;
    const unsigned ldsw = (unsigned)wid * 1024u;
    const int aoff = lds_byte(wr * 64 + fr, fq * 8), boff = lds_byte(wc * 32 + fr, fq * 8);
#define PG8_SA(b, h) (((b) * 2 + (h)) * HTB)
#define PG8_SB(b, h) ((4 + (b) * 2 + (h)) * HTB)
#define PG8_STAGE(bufoff, gbase, voff) do { _Pragma("unroll") for (int _i = 0; _i < 2; ++_i) \
        __builtin_amdgcn_global_load_lds((const unsigned*)((const char*)(gbase) + (voff)[_i]), (LAS unsigned*)(lds + (bufoff) + ldsw + _i * 8192), 16, 0, 0); } while (0)
#define PG8_LDA(dst, b, h) do { _Pragma("unroll") for (int m = 0; m < 4; ++m) _Pragma("unroll") for (int k = 0; k < 2; ++k) dst[m][k] = *(const LAS bf16x8*)(lds + PG8_SA(b, h) + aoff + m * 2048 + k * 1024); } while (0)
#define PG8_LDB(dst, b, h) do { _Pragma("unroll") for (int n = 0; n < 2; ++n) _Pragma("unroll") for (int k = 0; k < 2; ++k) dst[n][k] = *(const LAS bf16x8*)(lds + PG8_SB(b, h) + boff + n * 2048 + k * 1024); } while (0)
#define PG8_MMA(ai, bj, At, Bt) do { __builtin_amdgcn_s_setprio(1); _Pragma("unroll") for (int m = 0; m < 4; ++m) _Pragma("unroll") for (int n = 0; n < 2; ++n) _Pragma("unroll") for (int k = 0; k < 2; ++k) \
        acc[ai][bj][m][n] = __builtin_amdgcn_mfma_f32_16x16x32_bf16(Bt[n][k], At[m][k], acc[ai][bj][m][n], 0, 0, 0); __builtin_amdgcn_s_setprio(0); } while (0)
#define PG8_WAIT_V(n) asm volatile("s_waitcnt vmcnt(" #n ")" ::: "memory")
#define PG8_WAIT_L(n) asm volatile("s_waitcnt lgkmcnt(" #n ")" ::: "memory")
#define PG8_BAR __builtin_amdgcn_s_barrier()
#define PG8_SCHED __builtin_amdgcn_sched_barrier(0)
    Unit cur, nxt; int ui = 0;
    if (!S.next(0, cur)) return;
    f32x4 acc[2][2][4][2];
#pragma unroll
    for (int a = 0; a < 2; ++a)
#pragma unroll
        for (int b = 0; b < 2; ++b)
#pragma unroll
            for (int m = 0; m < 4; ++m)
#pragma unroll
                for (int n = 0; n < 2; ++n) acc[a][b][m][n] = (f32x4){0.f, 0.f, 0.f, 0.f};
    bf16x8 At[4][2], B0[2][2], B1[2][2];
    constexpr bool GATHER = Sched::GATHER;
    unsigned cv0[2], cv1[2], nv0[2], nv1[2];
#pragma unroll
    for (int i = 0; i < 2; ++i) {
        if constexpr (GATHER) { cv0[i] = (S.arow(cur, Rr[i]) * (unsigned)K + (unsigned)Cc[i]) * 2u; cv1[i] = (S.arow(cur, HALF + Rr[i]) * (unsigned)K + (unsigned)Cc[i]) * 2u; }
        else { cv0[i] = (unsigned)(Rr[i] * K + Cc[i]) * 2u; cv1[i] = cv0[i]; nv0[i] = cv0[i]; nv1[i] = cv0[i]; }
    }
    const char* cA = GATHER ? (const char*)Abase : (const char*)Abase + (size_t)S.arow(cur, 0) * K * 2;
    const size_t ahs = GATHER ? 0 : hstep;
    const char* cB = S.bptr(cur);
    PG8_STAGE(PG8_SB(0, 0), cB, voffB); PG8_STAGE(PG8_SB(0, 1), cB + bhs, voffB); PG8_STAGE(PG8_SA(0, 0), cA, cv0); PG8_STAGE(PG8_SA(0, 1), cA + ahs, cv1);
    if (wr == 1) PG8_BAR;
    PG8_WAIT_V(2); PG8_BAR;
    PG8_STAGE(PG8_SB(1, 0), cB + kstep, voffB); PG8_STAGE(PG8_SA(1, 0), cA + kstep, cv0); PG8_STAGE(PG8_SB(1, 1), cB + bhs + kstep, voffB);
    PG8_WAIT_V(6); PG8_BAR;
    for (;;) {
        const bool has_next = S.next(ui + 1, nxt);
        const char* nB = has_next ? S.bptr(nxt) : cB;
        const char* nA = cA;
        if constexpr (GATHER) {
#pragma unroll
            for (int i = 0; i < 2; ++i) {
                nv0[i] = has_next ? (S.arow(nxt, Rr[i]) * (unsigned)K + (unsigned)Cc[i]) * 2u : cv0[i];
                nv1[i] = has_next ? (S.arow(nxt, HALF + Rr[i]) * (unsigned)K + (unsigned)Cc[i]) * 2u : cv1[i];
            }
        } else { if (has_next) nA = (const char*)Abase + (size_t)S.arow(nxt, 0) * K * 2; }
        for (int t = 0; t < nt; t += 2) {
            const bool last = (t == nt - 2);
            if constexpr (Epi::HAS_MID) { if (t == (nt >> 1)) E.mid(acc, cur, wr, wc, fr, fq); }
            const char* a1 = cA + (size_t)(t + 1) * kstep;
            const char* a2 = last ? nA : cA + (size_t)(t + 2) * kstep; const char* b2 = last ? nB : cB + (size_t)(t + 2) * kstep;
            const char* a3 = a2 + kstep; const char* b3 = b2 + kstep;
            unsigned x0[2], x1[2];
#pragma unroll
            for (int i = 0; i < 2; ++i) { x0[i] = (GATHER && last) ? nv0[i] : cv0[i]; x1[i] = (GATHER && last) ? nv1[i] : cv1[i]; }
            PG8_LDB(B0, 0, 0); PG8_LDB(B1, 0, 1); PG8_SCHED; PG8_LDA(At, 0, 0); PG8_STAGE(PG8_SA(1, 1), a1 + ahs, cv1);
            PG8_WAIT_V(8); PG8_WAIT_L(0); PG8_BAR; PG8_MMA(0, 0, At, B0); PG8_MMA(0, 1, At, B1); PG8_BAR; PG8_SCHED;
            PG8_LDA(At, 0, 1); PG8_STAGE(PG8_SB(0, 0), b2, voffB); PG8_STAGE(PG8_SB(0, 1), b2 + bhs, voffB); PG8_STAGE(PG8_SA(0, 0), a2, x0);
            PG8_WAIT_V(8); PG8_WAIT_L(0); PG8_BAR; PG8_MMA(1, 0, At, B0); PG8_MMA(1, 1, At, B1); PG8_BAR; PG8_SCHED;
            PG8_LDB(B0, 1, 0); PG8_LDB(B1, 1, 1); PG8_SCHED; PG8_LDA(At, 1, 0); PG8_STAGE(PG8_SA(0, 1), a2 + ahs, x1);
            PG8_WAIT_V(8); PG8_WAIT_L(0); PG8_BAR; PG8_MMA(0, 0, At, B0); PG8_MMA(0, 1, At, B1); PG8_BAR; PG8_SCHED;
            PG8_LDA(At, 1, 1); PG8_STAGE(PG8_SB(1, 0), b3, voffB); PG8_STAGE(PG8_SB(1, 1), b3 + bhs, voffB); PG8_STAGE(PG8_SA(1, 0), a3, x0);
            PG8_WAIT_V(8); PG8_WAIT_L(0); PG8_BAR; PG8_MMA(1, 0, At, B0); PG8_MMA(1, 1, At, B1); PG8_BAR; PG8_SCHED;
        }
        if constexpr (ALIGN_EPI) { if (wr == 0) PG8_BAR; }
        E(acc, cur, wr, wc, fr, fq, stg, lane);
        if (!has_next) break;
#pragma unroll
        for (int a = 0; a < 2; ++a)
#pragma unroll
            for (int b = 0; b < 2; ++b)
#pragma unroll
                for (int m = 0; m < 4; ++m)
#pragma unroll
                    for (int n = 0; n < 2; ++n) acc[a][b][m][n] = (f32x4){0.f, 0.f, 0.f, 0.f};
        cur = nxt; cB = nB; cA = nA; ++ui;
        if constexpr (GATHER) {
#pragma unroll
            for (int i = 0; i < 2; ++i) { cv0[i] = nv0[i]; cv1[i] = nv1[i]; }
        }
        if constexpr (ALIGN_EPI) { if (wr == 1) PG8_BAR; }
    }
    PG8_WAIT_V(0);
    if constexpr (!ALIGN_EPI) { if (wr == 0) PG8_BAR; }
    PG8_BAR;
#undef PG8_SA
#undef PG8_SB
#undef PG8_STAGE
#undef PG8_LDA
#undef PG8_LDB
#undef PG8_MMA
#undef PG8_WAIT_V
#undef PG8_WAIT_L
#undef PG8_BAR
#undef PG8_SCHED
}

__device__ __forceinline__ u32x4 pack8(const f32x4 v0, const f32x4 v1) { u32x4 w; w.x = pk2(v0[0], v0[1]); w.y = pk2(v0[2], v0[3]); w.z = pk2(v1[0], v1[1]); w.w = pk2(v1[2], v1[3]); return w; }
template <class RowPtr, class RowOk>
__device__ __forceinline__ void staged_store(LAS unsigned char* stg, int lane, const u32x4 p0, const u32x4 p1, const RowPtr& rp, const RowOk& ok) {
    const int fr = lane & 15, fq = lane >> 4;
    *(LAS u32x4*)(stg + fr * 144 + fq * 16) = p0; *(LAS u32x4*)(stg + fr * 144 + 64 + fq * 16) = p1;
    const int r = lane >> 3, ch = lane & 7;
    const u32x4 a = *(LAS const u32x4*)(stg + r * 144 + ch * 16), b = *(LAS const u32x4*)(stg + (r + 8) * 144 + ch * 16);
    if (ok(r)) *(u32x4*)(rp(r) + ch * 8) = a;
    if (ok(r + 8)) *(u32x4*)(rp(r + 8) + ch * 8) = b;
}
struct AlwaysOk { __device__ __forceinline__ bool operator()(int) const { return true; } };
struct DenseRows { bf16_t* base; size_t ld; __device__ __forceinline__ bf16_t* operator()(int r) const { return base + (size_t)r * ld; } };

struct EpiInA {
    static constexpr int BMAP = 2; static constexpr bool HAS_MID = false;
    bf16_t *Q, *Kb, *Vb, *RS;
    __device__ __forceinline__ void operator()(const f32x4 (&acc)[2][2][4][2], const Unit& u, int wr, int wc, int fr, int fq, LAS unsigned char* stg, int lane) const {
        const int row0 = u.pm * BM + wr * 64;
        if (u.pn < 3) {
            bf16_t* base; size_t ld;
            if (u.pn < 2) { base = Q + u.pn * 256 + wc * 64; ld = AW; } else { base = (wc < 2 ? Kb : Vb) + (wc & 1) * 64; ld = KVW; }
#pragma unroll
            for (int ai = 0; ai < 2; ++ai)
#pragma unroll
                for (int m = 0; m < 4; ++m)
                    staged_store(stg, lane, pack8(acc[ai][0][m][0], acc[ai][0][m][1]), pack8(acc[ai][1][m][0], acc[ai][1][m][1]), DenseRows{base + (size_t)(row0 + ai * HALF + m * 16) * ld, ld}, AlwaysOk{});
        } else {
            bf16_t* base = RS + (u.pn - 3) * 256 + wc * 64;
#pragma unroll
            for (int ai = 0; ai < 2; ++ai)
#pragma unroll
                for (int m = 0; m < 4; ++m) {
                    f32x4 r0, r1, s0, s1;
#pragma unroll
                    for (int j = 0; j < 4; ++j) {
                        const float ea0 = __expf(-acc[ai][0][m][0][j]), eh0 = __expf(-acc[ai][1][m][0][j]), ea1 = __expf(-acc[ai][0][m][1][j]), eh1 = __expf(-acc[ai][1][m][1][j]);
                        s0[j] = __builtin_amdgcn_rcpf(1.0f + eh0); s1[j] = __builtin_amdgcn_rcpf(1.0f + eh1); r0[j] = (1.0f + eh0) * __builtin_amdgcn_rcpf(1.0f + ea0); r1[j] = (1.0f + eh1) * __builtin_amdgcn_rcpf(1.0f + ea1); }
                    staged_store(stg, lane, pack8(r0, r1), pack8(s0, s1), DenseRows{base + (size_t)(row0 + ai * HALF + m * 16) * 2048, 2048}, AlwaysOk{});
                }
        }
    }
};
struct EpiBf16 {
    static constexpr int BMAP = 2; static constexpr bool HAS_MID = false;
    bf16_t* O; int ldc;
    __device__ __forceinline__ void operator()(const f32x4 (&acc)[2][2][4][2], const Unit& u, int wr, int wc, int fr, int fq, LAS unsigned char* stg, int lane) const {
        bf16_t* base = O + (size_t)(u.pm * BM + wr * 64) * ldc + u.pn * BM + wc * 64;
#pragma unroll
        for (int ai = 0; ai < 2; ++ai)
#pragma unroll
            for (int m = 0; m < 4; ++m)
                staged_store(stg, lane, pack8(acc[ai][0][m][0], acc[ai][0][m][1]), pack8(acc[ai][1][m][0], acc[ai][1][m][1]), DenseRows{base + (size_t)(ai * HALF + m * 16) * ldc, (size_t)ldc}, AlwaysOk{});
    }
};
struct EpiMerge {
    static constexpr int BMAP = 2; static constexpr bool HAS_MID = true;
    const bf16_t* RS; bf16_t* O;
    __device__ __forceinline__ void mid(f32x4 (&acc)[2][2][4][2], const Unit& u, int wr, int wc, int fr, int fq) const {
        asm volatile("" : "+v"(fr), "+v"(fq));
        const int row0 = u.pm * BM + wr * 64 + fr;
#pragma unroll
        for (int ai = 0; ai < 2; ++ai)
#pragma unroll
            for (int mh = 0; mh < 2; ++mh) {
                u32x4 g[2][2];
#pragma unroll
                for (int mm = 0; mm < 2; ++mm)
#pragma unroll
                    for (int bj = 0; bj < 2; ++bj) g[mm][bj] = *(const u32x4*)(RS + (size_t)(row0 + ai * HALF + (2 * mh + mm) * 16) * 2048 + (8 * u.pn + 2 * wc + bj) * 64 + 8 * fq);
#pragma unroll
                for (int mm = 0; mm < 2; ++mm)
#pragma unroll
                    for (int bj = 0; bj < 2; ++bj) { const int m = 2 * mh + mm; const u32x4 gg = g[mm][bj];
                        acc[ai][bj][m][0][0] *= bflo(gg.x); acc[ai][bj][m][0][1] *= bfhi(gg.x); acc[ai][bj][m][0][2] *= bflo(gg.y); acc[ai][bj][m][0][3] *= bfhi(gg.y);
                        acc[ai][bj][m][1][0] *= bflo(gg.z); acc[ai][bj][m][1][1] *= bfhi(gg.z); acc[ai][bj][m][1][2] *= bflo(gg.w); acc[ai][bj][m][1][3] *= bfhi(gg.w); }
                asm volatile("" ::: "memory");
            }
    }
    __device__ __forceinline__ void operator()(const f32x4 (&acc)[2][2][4][2], const Unit& u, int wr, int wc, int fr, int fq, LAS unsigned char* stg, int lane) const {
        const int row0 = u.pm * BM + wr * 64;
        bf16_t* base = O + (size_t)row0 * DM + u.pn * BM + wc * 64;
#pragma unroll
        for (int ai = 0; ai < 2; ++ai)
#pragma unroll
            for (int m = 0; m < 4; ++m) {
                u32x4 pk[2];
#pragma unroll
                for (int bj = 0; bj < 2; ++bj) {
                    const u32x4 g = *(const u32x4*)(RS + (size_t)(row0 + fr + ai * HALF + m * 16) * 2048 + (8 * u.pn + 2 * wc + bj) * 64 + 32 + 8 * fq);
                    f32x4 v0 = acc[ai][bj][m][0], v1 = acc[ai][bj][m][1];
                    v0[0] *= bflo(g.x); v0[1] *= bfhi(g.x); v0[2] *= bflo(g.y); v0[3] *= bfhi(g.y);
                    v1[0] *= bflo(g.z); v1[1] *= bfhi(g.z); v1[2] *= bflo(g.w); v1[3] *= bfhi(g.w);
                    pk[bj] = pack8(v0, v1);
                }
                staged_store(stg, lane, pk[0], pk[1], DenseRows{base + (size_t)(ai * HALF + m * 16) * DM, DM}, AlwaysOk{});
            }
    }
};
struct EpiY {
    static constexpr int BMAP = 2; static constexpr bool HAS_MID = false;
    const float* gate; bf16_t* O;
    __device__ __forceinline__ void operator()(const f32x4 (&acc)[2][2][4][2], const Unit& u, int wr, int wc, int fr, int fq, LAS unsigned char* stg, int lane) const {
        const int col0 = u.pn * BM + wc * 64; const int b = (u.pm * BM) / SEQ;
        const float* gp = gate + (size_t)b * 6144 + col0 + 8 * fq;
        const f32x4 g00 = *(const f32x4*)gp, g01 = *(const f32x4*)(gp + 4), g10 = *(const f32x4*)(gp + 32), g11 = *(const f32x4*)(gp + 36);
        bf16_t* base = O + (size_t)(u.pm * BM + wr * 64) * DM + col0;
#pragma unroll
        for (int ai = 0; ai < 2; ++ai)
#pragma unroll
            for (int m = 0; m < 4; ++m)
                staged_store(stg, lane, pack8(acc[ai][0][m][0] * g00, acc[ai][0][m][1] * g01), pack8(acc[ai][1][m][0] * g10, acc[ai][1][m][1] * g11), DenseRows{base + (size_t)(ai * HALF + m * 16) * DM, DM}, AlwaysOk{});
    }
};
struct EpiNull {
    static constexpr int BMAP = 2; static constexpr bool HAS_MID = false;
    __device__ __forceinline__ void operator()(const f32x4 (&acc)[2][2][4][2], const Unit& u, int wr, int wc, int fr, int fq, LAS unsigned char* stg, int lane) const {
#pragma unroll
        for (int ai = 0; ai < 2; ++ai)
#pragma unroll
            for (int bj = 0; bj < 2; ++bj)
#pragma unroll
                for (int m = 0; m < 4; ++m) asm volatile("" :: "v"(acc[ai][bj][m][0]), "v"(acc[ai][bj][m][1]));
    }
};
struct EpiSwiGLU {
    static constexpr int BMAP = 1; static constexpr bool HAS_MID = false;
    bf16_t* H;
    __device__ __forceinline__ void operator()(const f32x4 (&acc)[2][2][4][2], const Unit& u, int wr, int wc, int fr, int fq, LAS unsigned char* stg, int lane) const {
        const int row0 = u.pm * BM + wr * 64 + fr; const int col0 = u.pn * HALF + wc * 32 + 8 * fq;
#pragma unroll
        for (int ai = 0; ai < 2; ++ai)
#pragma unroll
            for (int m = 0; m < 4; ++m) {
                f32x4 v0, v1;
#pragma unroll
                for (int j = 0; j < 4; ++j) { const float a0 = acc[ai][0][m][0][j], a1 = acc[ai][0][m][1][j];
                    v0[j] = a0 * sigmoidf_(a0) * acc[ai][1][m][0][j]; v1[j] = a1 * sigmoidf_(a1) * acc[ai][1][m][1][j]; }
                *(u32x4*)(H + (size_t)(row0 + ai * HALF + m * 16) * DE + col0) = pack8(v0, v1);
            }
    }
};
struct EpiScatter {
    static constexpr int BMAP = 2; static constexpr bool HAS_MID = false;
    bf16_t* Y2; const int* btok; const float* bw; const LAS int* tab;
    struct Rows { bf16_t* base; int d0, d1; __device__ __forceinline__ bf16_t* operator()(int r) const { return base + (size_t)(r < 8 ? d0 : d1) * DM; } };
    struct Oks { bool o0, o1; __device__ __forceinline__ bool operator()(int r) const { return r < 8 ? o0 : o1; } };
    __device__ __forceinline__ void operator()(const f32x4 (&acc)[2][2][4][2], const Unit& u, int wr, int wc, int fr, int fq, LAS unsigned char* stg, int lane) const {
        const int cnt = tab[72 + u.e]; bf16_t* base = Y2 + u.pn * BM + wc * 64;
        const int* bt = btok + (size_t)u.e * ECAP; const float* bwp = bw + (size_t)u.e * ECAP;
#pragma unroll
        for (int ai = 0; ai < 2; ++ai)
#pragma unroll
            for (int m = 0; m < 4; ++m) {
                const int g0 = u.mt * BM + ai * HALF + wr * 64 + m * 16;
                const int iw = g0 + fr, i0 = g0 + (lane >> 3), i1 = i0 + 8;
                const float w = iw < cnt ? bwp[iw] : 0.f;
                const bool o0 = i0 < cnt, o1 = i1 < cnt; const int d0 = o0 ? bt[i0] : 0, d1 = o1 ? bt[i1] : 0;
                staged_store(stg, lane, pack8(acc[ai][0][m][0] * w, acc[ai][0][m][1] * w), pack8(acc[ai][1][m][0] * w, acc[ai][1][m][1] * w), Rows{base, d0, d1}, Oks{o0, o1});
            }
    }
};
}

#define XB_TMO      128
#define XB_XCNT(j)  (256  + 64 * (j))
#define XB_XSUB(j)  (1280 + 64 * (j))
#define XB_XGEN(j)  (2304 + 64 * (j))
#define XB_TOP      3328
#define XB_TOPGEN   3392
#define XCD_BAR_WORDS 3456
#define XB_SPIN_CAP (1u << 22)
__device__ __forceinline__ unsigned xb_ld(unsigned* p)              { return __hip_atomic_load(p, __ATOMIC_RELAXED, __HIP_MEMORY_SCOPE_AGENT); }
__device__ __forceinline__ unsigned xb_add(unsigned* p, unsigned v) { return __hip_atomic_fetch_add(p, v, __ATOMIC_RELAXED, __HIP_MEMORY_SCOPE_AGENT); }
__device__ __forceinline__ unsigned xb_xcc_id() { return (unsigned)__builtin_amdgcn_s_getreg((3 << 11) | 20) & 0xFu; }
#define XB_SPIN(cond, bar) do { unsigned _sp = 0; while (cond) { __builtin_amdgcn_s_sleep(1); \
    if ((++_sp & 255u) == 0u) { if (xb_ld(&(bar)[XB_TMO])) break; if (_sp > XB_SPIN_CAP) { atomicAdd(&(bar)[XB_TMO], 1u); break; } } } } while (0)
__device__ __forceinline__ void xcd_barrier_post(unsigned* bar) { if (threadIdx.x == 0) (void)xb_add(&bar[XB_XCNT(xb_xcc_id())], 1u); }
__device__ __forceinline__ void xcd_barrier_complete(unsigned* bar, unsigned x, unsigned& nloc, unsigned& nx) {
    const unsigned G = gridDim.x * gridDim.y * gridDim.z;
    unsigned sum, cnt, mine, sp = 0u;
    for (;;) {
        sum = 0u; cnt = 0u; mine = 0u;
#pragma unroll
        for (unsigned j = 0; j < 16; ++j) { const unsigned c = xb_ld(&bar[XB_XCNT(j)]); sum += c; cnt += (c > 0u) ? 1u : 0u; mine = (j == x) ? c : mine; }
        if (sum == G) break;
        __builtin_amdgcn_s_sleep(1);
        if ((++sp & 255u) == 0u) { if (xb_ld(&bar[XB_TMO])) break; if (sp > XB_SPIN_CAP) { atomicAdd(&bar[XB_TMO], 1u); break; } }
    }
    nloc = mine > 0u ? mine : 1u; nx = cnt > 0u ? cnt : 1u;
}
__device__ __forceinline__ void xcd_barrier(unsigned* bar, volatile LAS unsigned* st) {
    asm volatile("s_waitcnt vmcnt(0)" ::: "memory");
    __syncthreads();
    if (threadIdx.x == 0) {
        const unsigned x = xb_xcc_id();
        __builtin_amdgcn_s_waitcnt(0);
        unsigned nloc = st[0], nx = st[1];
        if (nloc == 0u) { xcd_barrier_complete(bar, x, nloc, nx); st[0] = nloc; st[1] = nx; }
        const unsigned old = xb_add(&bar[XB_XSUB(x)], 1u);
        const unsigned gen = old / nloc;
        if (old + 1u == (gen + 1u) * nloc) {
            __builtin_amdgcn_fence(__ATOMIC_RELEASE, "agent");
            asm volatile("s_waitcnt vmcnt(0)" ::: "memory");
            const unsigned og = xb_add(&bar[XB_TOP], 1u);
            const unsigned tg = og / nx;
            if (og + 1u == (tg + 1u) * nx) xb_add(&bar[XB_TOPGEN], 1u);
            else XB_SPIN(xb_ld(&bar[XB_TOPGEN]) == tg, bar);
            __builtin_amdgcn_fence(__ATOMIC_ACQUIRE, "agent");
            xb_add(&bar[XB_XGEN(x)], 1u);
            asm volatile("s_waitcnt vmcnt(0)" ::: "memory");
        } else {
            XB_SPIN(xb_ld(&bar[XB_XGEN(x)]) == gen, bar);
            __builtin_amdgcn_fence(__ATOMIC_ACQUIRE, "agent");
            asm volatile("s_waitcnt vmcnt(0)" ::: "memory");
        }
    }
    __syncthreads();
}

struct Args { const float* in[31]; float* out; unsigned char* ws; int ph_lo, ph_hi; };
struct Frame {
    LAS unsigned char* lds; unsigned char* ws; unsigned* ctl;
    int tid, lane, wave, vcu, G;
    const float* const* in; float* out;
};
enum { I_X = 0, I_C, I_WADA, I_BADA, I_WIN, I_CONVW, I_CONVB, I_FW1, I_FB1, I_FF1, I_FW2, I_FB2, I_FF2, I_FW3, I_DECAY, I_SKIP, I_WHY, I_WATT, I_SINK, I_WOUT,
       I_LN1G, I_LN1B, I_RGW, I_RGB, I_REW, I_REB, I_EW1, I_EW3, I_EW2, I_LN2G, I_LN2B };

__device__ __forceinline__ void transpose_item(const float* W, int K, int N, bf16_t* WT, int ldt, int drow0, LAS float* scr, int kb, int nb, int lane) {
    const int k0 = 64 * kb, n0 = 32 * nb;
#pragma unroll 8
    for (int i = 0; i < 32; ++i) { const int kk = 2 * i + (lane >> 5); scr[kk * 33 + (lane & 31)] = W[(size_t)(k0 + kk) * N + n0 + (lane & 31)]; }
    LDS_WAIT(); asm volatile("" ::: "memory");
    const int c = lane & 7;
#pragma unroll
    for (int j = 0; j < 4; ++j) { const int n = (lane >> 3) + 8 * j; const LAS float* s = scr + (8 * c) * 33 + n;
        u32x4 o; o.x = pk2(s[0 * 33], s[1 * 33]); o.y = pk2(s[2 * 33], s[3 * 33]); o.z = pk2(s[4 * 33], s[5 * 33]); o.w = pk2(s[6 * 33], s[7 * 33]);
        *(u32x4*)(WT + (size_t)(drow0 + n) * ldt + k0 + 8 * c) = o; }
    LDS_WAIT(); asm volatile("" ::: "memory");
}

__device__ __forceinline__ void ph_prep(Frame& F) {
    const float* c = F.in[I_C]; const float* wada = F.in[I_WADA];
    float* modp = (float*)(F.ws + WS_MODP);
    for (int it = blockIdx.x; it < 192; it += F.G) {
        const int kc = it / 12, cg = it % 12, j = cg * 512 + F.tid;
        float a0 = 0.f, a1 = 0.f, a2 = 0.f, a3 = 0.f;
        for (int kk = 0; kk < 64; ++kk) { const int k = kc * 64 + kk; const float w = wada[(size_t)k * 6144 + j];
            const float c0 = c[k], c1 = c[1024 + k], c2 = c[2048 + k], c3 = c[3072 + k];
            a0 += c0 * sigmoidf_(c0) * w; a1 += c1 * sigmoidf_(c1) * w; a2 += c2 * sigmoidf_(c2) * w; a3 += c3 * sigmoidf_(c3) * w; }
        modp[(size_t)(kc * 4 + 0) * 6144 + j] = a0; modp[(size_t)(kc * 4 + 1) * 6144 + j] = a1; modp[(size_t)(kc * 4 + 2) * 6144 + j] = a2; modp[(size_t)(kc * 4 + 3) * 6144 + j] = a3;
    }
    LAS float* scr = (LAS float*)(F.lds + F.wave * 16384);
    const int gw = F.vcu * NWAVES + F.wave, NGW = F.G * NWAVES;
    constexpr int I_IN = 16 * 136, I_A = 8 * 32, I_H = 8 * 32, I_O = 16 * 32;
    for (int it = gw; it < I_IN + I_A + I_H + I_O; it += NGW) {
        int r = it;
        if (r < I_IN) { const int kb = r / 136, nb = r % 136, n0 = nb * 32;
            int drow;
            if (n0 < 768) drow = n0; else if (n0 < 2304) drow = N1A + (n0 - 768);
            else if (n0 < 3328) { const int d = n0 - 2304; drow = 768 + (d >> 5) * 64; }
            else { const int d = n0 - 3328; drow = 768 + (d >> 5) * 64 + 32; }
            transpose_item(F.in[I_WIN], DM, INW, (bf16_t*)(F.ws + WS_WIN), DM, drow, scr, kb, nb, F.lane); continue; } r -= I_IN;
        if (r < I_A) { transpose_item(F.in[I_WATT], AW, DM, (bf16_t*)(F.ws + WS_WAH), DM, (r % 32) * 32, scr, r / 32, r % 32, F.lane); continue; } r -= I_A;
        if (r < I_H) { transpose_item(F.in[I_WHY], HW, DM, (bf16_t*)(F.ws + WS_WAH) + AW, DM, (r % 32) * 32, scr, r / 32, r % 32, F.lane); continue; } r -= I_H;
        transpose_item(F.in[I_WOUT], DM, DM, (bf16_t*)(F.ws + WS_WO), DM, (r % 32) * 32, scr, r / 32, r % 32, F.lane);
    }
    {
        const float* w1 = F.in[I_FW1]; const float* b1 = F.in[I_FB1]; const float* f1 = F.in[I_FF1];
        const float* w2 = F.in[I_FW2]; const float* b2 = F.in[I_FB2]; const float* f2 = F.in[I_FF2];
        const int j = F.lane;
        for (int t = gw; t < SEQ; t += NGW) {
            const float tl = (float)t / (float)(SEQ - 1);
            const float w = 6.283185307179586f * (float)t / (float)SEQ;
            float zi = 0.f;
            if (j == 0) zi = tl;
            else if (j <= 16) { const float band = 1e-4f + (float)(j - 1) * ((15.0f - 1e-4f) / 15.0f); zi = cosf(band * w); }
            else if (j <= 32) { const float band = 1e-4f + (float)(j - 17) * ((15.0f - 1e-4f) / 15.0f); zi = -sinf(band * w); }
            float a = b1[j];
#pragma unroll
            for (int i = 0; i < FEMB; ++i) a += __shfl(zi, i) * w1[i * FH + j];
            const float h1 = sinf(f1[j] * a);
            float a2 = b2[j];
#pragma unroll
            for (int i = 0; i < FH; ++i) a2 += __shfl(h1, i) * w2[i * FH + j];
            ((bf16_t*)(F.ws + WS_HDNB))[(size_t)t * FH + j] = (bf16_t)f2bf(sinf(f2[j] * a2));
        }
    }
    {
        bf16_t* ftab = (bf16_t*)(F.ws + WS_FTAB); unsigned* twt = (unsigned*)(F.ws + WS_TWT);
        for (int i = blockIdx.x * NTHREADS + F.tid; i < 2 * 128 * 128; i += F.G * NTHREADS) {
            const int t = i >> 14, row = (i >> 7) & 127, q = i & 127;
            const int q15 = q & 15, h = q15 >> 3, j = q15 & 7; const int nat = (q & ~15) + 8 * (j >> 2) + 4 * h + (j & 3);
            const int e = (row * nat) & 127; const float x = (float)e * (2.0f / 128.0f);
            const float v = t == 0 ? cospif(x) : -sinpif(x);
            ftab[(size_t)t * (128 * 136) + row * 136 + q] = (bf16_t)f2bf(v);
        }
        for (int i = blockIdx.x * NTHREADS + F.tid; i < 16 * 64 * 16; i += F.G * NTHREADS) {
            const int r = i & 15, l = (i >> 4) & 63, ab = i >> 10, al = ab >> 2, be = ab & 3;
            const int e = ((32 * al + ((r & 3) + 8 * (r >> 2) + 4 * (l >> 5))) * (32 * be + (l & 31))) & 16383; const float x = (float)e * (2.0f / 16384.0f);
            twt[i] = pk2(cospif(x), -sinpif(x));
        }
    }
    {
        bf16_t* wr = (bf16_t*)(F.ws + WS_WRT); const float* wg = F.in[I_RGW]; const float* we = F.in[I_REW];
        for (int i = blockIdx.x * NTHREADS + F.tid; i < 80 * DM; i += F.G * NTHREADS) { const int o = i / DM, k = i % DM;
            const float w = o < 8 ? wg[k * 8 + o] : (o < 72 ? we[k * 64 + (o - 8)] : 0.f);
            const unsigned hi = f2bf(w); const float lo = w - bf2f((unsigned short)hi);
            wr[i] = (bf16_t)hi; wr[80 * DM + i] = (bf16_t)f2bf(lo); }
    }
}

__device__ __forceinline__ void ph_taps(Frame& F) {
    typedef float f32x16 __attribute__((ext_vector_type(16)));
    const bf16_t* hb = (const bf16_t*)(F.ws + WS_HDNB); const float* w3 = F.in[I_FW3]; const float* decay = F.in[I_DECAY];
    bf16_t* kraw = (bf16_t*)(F.ws + WS_KRAW); float* kpart = (float*)(F.ws + WS_KPART);
    const int lane = F.lane, lr = lane & 31, lh = lane >> 5;
    for (int it = blockIdx.x; it < 256; it += F.G) {
        const int g = it & 63, tq = it >> 6;
        bf16x8 aW[4];
#pragma unroll
        for (int s = 0; s < 4; ++s) { unsigned pk[4];
#pragma unroll
            for (int j2 = 0; j2 < 4; ++j2) { const int k = 16 * s + 8 * lh + 2 * j2; pk[j2] = pk2(w3[(size_t)k * NFILT + 32 * g + lr], w3[(size_t)(k + 1) * NFILT + 32 * g + lr]); }
            aW[s] = __builtin_bit_cast(bf16x8, (u32x4){pk[0], pk[1], pk[2], pk[3]}); }
        float dcy[16], asum[16];
#pragma unroll
        for (int r = 0; r < 16; ++r) { dcy[r] = fabsf(decay[32 * g + (r & 3) + 8 * (r >> 2) + 4 * lh]); asum[r] = 0.f; }
#pragma unroll 1
        for (int tt = 0; tt < 8; ++tt) {
            const int t = 2048 * tq + 32 * (F.wave * 8 + tt) + lr;
            f32x16 acc;
#pragma unroll
            for (int r = 0; r < 16; ++r) acc[r] = 0.f;
#pragma unroll
            for (int s = 0; s < 4; ++s) { const bf16x8 bH = *(const bf16x8*)(hb + (size_t)t * FH + 16 * s + 8 * lh); acc = __builtin_amdgcn_mfma_f32_32x32x16_bf16(aW[s], bH, acc, 0, 0, 0); }
            const float tl = (float)t / (float)(SEQ - 1);
#pragma unroll
            for (int r = 0; r < 16; ++r) { const float v = acc[r] * (__expf(-tl * dcy[r]) + 0.05f); asum[r] += fabsf(v);
                kraw[(size_t)(32 * g + (r & 3) + 8 * (r >> 2) + 4 * lh) * SEQ + t] = (bf16_t)f2bf(v); }
        }
#pragma unroll
        for (int r = 0; r < 16; ++r) { float v = asum[r];
#pragma unroll
            for (int o = 1; o < 32; o <<= 1) v += __shfl_xor(v, o);
            if (lr == 0) kpart[(size_t)(32 * g + (r & 3) + 8 * (r >> 2) + 4 * lh) * 32 + tq * 8 + F.wave] = v; }
    }
}

__device__ __forceinline__ void ph_hb(Frame& F) {
    const float* modp = (const float*)(F.ws + WS_MODP); const float* bada = F.in[I_BADA];
    float* mod = (float*)(F.ws + WS_MOD);
    for (int i = blockIdx.x * NTHREADS + F.tid; i < NB * 6144; i += F.G * NTHREADS) { const int b = i / 6144, j = i % 6144; float s = bada[j];
        for (int kc = 0; kc < 16; ++kc) s += modp[(size_t)(kc * 4 + b) * 6144 + j];
        mod[i] = s; }
    LAS float* sc = (LAS float*)F.lds; LAS float* sh = sc + DM;
    const float* x = F.in[I_X]; bf16_t* hb = (bf16_t*)(F.ws + WS_HB);
    for (int ch = blockIdx.x; ch < T / 128; ch += F.G) {
        const int b = (ch * 128) / SEQ;
        __syncthreads();
        for (int j = F.tid; j < 2 * DM; j += NTHREADS) { float s = bada[j];
            for (int kc = 0; kc < 16; ++kc) s += modp[(size_t)(kc * 4 + b) * 6144 + j];
            if (j < DM) sh[j] = s; else sc[j - DM] = 1.0f + s; }
        __syncthreads();
        for (int r0 = F.wave * 4; r0 < 128; r0 += NWAVES * 4) {
            f32x4 xv[4][4];
#pragma unroll
            for (int r = 0; r < 4; ++r) { const f32x4* xr = (const f32x4*)(x + ((size_t)ch * 128 + r0 + r) * DM) + F.lane;
#pragma unroll
                for (int j = 0; j < 4; ++j) xv[r][j] = xr[64 * j]; }
#pragma unroll
            for (int r = 0; r < 4; ++r) { unsigned long long* o8 = (unsigned long long*)(hb + ((size_t)ch * 128 + r0 + r) * DM) + F.lane;
#pragma unroll
                for (int j = 0; j < 4; ++j) { const f32x4 v = xv[r][j]; const int k = 4 * F.lane + 256 * j;
                    const float h0 = v[0] * sc[k] + sh[k], h1 = v[1] * sc[k + 1] + sh[k + 1], h2 = v[2] * sc[k + 2] + sh[k + 2], h3 = v[3] * sc[k + 3] + sh[k + 3];
                    o8[64 * j] = (unsigned long long)pk2(h0, h1) | ((unsigned long long)pk2(h2, h3) << 32); } }
        }
    }
    __syncthreads();
}

namespace at {
typedef float f32x16 __attribute__((ext_vector_type(16)));
typedef __bf16 bf16x2_t __attribute__((ext_vector_type(2)));
constexpr int KROWB = 144, VROWB = 784, K_OFF = 0, V_OFF = 384 * KROWB;
__device__ __forceinline__ unsigned cvtpk(float lo, float hi) { f32x2 v = {lo, hi}; bf16x2_t b = __builtin_convertvector(v, bf16x2_t); return __builtin_bit_cast(unsigned, b); }
template <int S> __device__ __forceinline__ bf16x8 pack_step(const f32x16& x) {
    u32x4 p; p.x = cvtpk(x[8 * S], x[8 * S + 1]); p.y = cvtpk(x[8 * S + 2], x[8 * S + 3]); p.z = cvtpk(x[8 * S + 4], x[8 * S + 5]); p.w = cvtpk(x[8 * S + 6], x[8 * S + 7]);
    return __builtin_bit_cast(bf16x8, p);
}
__device__ __forceinline__ int kst(int k) { const int c = k & 15; return (k & ~15) + 8 * ((c >> 2) & 1) + 4 * (c >> 3) + (c & 3); }
}
__device__ __forceinline__ void ph_attn(Frame& F) {
    using namespace at;
    const bf16_t* Q = (const bf16_t*)(F.ws + WS_Q); const bf16_t* Kb = (const bf16_t*)(F.ws + WS_K); const bf16_t* Vb = (const bf16_t*)(F.ws + WS_V);
    bf16_t* O = (bf16_t*)(F.ws + WS_AH); const float* sink = F.in[I_SINK];
    LAS unsigned char* Ks = F.lds + K_OFF; LAS unsigned char* Vs = F.lds + V_OFF;
    const int wid = F.wave;
    constexpr float LOG2E = 1.4426950408889634f;
    for (int unit = blockIdx.x; unit < NB * 2 * 64; unit += F.G) {
        const int qb = unit & 63, kvh = (unit >> 6) & 1, b = unit >> 7;
        int tid = F.tid; asm volatile("" : "+v"(tid));
        const int lane = tid & 63, lr = lane & 31, lh = lane >> 5;
        __syncthreads();
#pragma unroll 1
        for (int i = 0; i < 6; ++i) {
            const int ci = tid + 512 * i, j = ci >> 3, p = ci & 7; const int kpos = qb * 128 - 128 + j;
            u32x4 kv = (u32x4){0u, 0u, 0u, 0u}, vv = kv;
            if (kpos >= 0 && kpos < SEQ) { const size_t off = ((size_t)b * SEQ + kpos) * KVW + kvh * 64 + p * 8; kv = *(const u32x4*)(Kb + off); vv = *(const u32x4*)(Vb + off); }
            *(LAS u32x4*)(Ks + j * KROWB + p * 16) = kv;
            LAS unsigned char* vp = Vs + (p * 8) * VROWB + kst(j) * 2;
            *(LAS bf16_t*)(vp) = (bf16_t)vv.x; *(LAS bf16_t*)(vp + VROWB) = (bf16_t)(vv.x >> 16);
            *(LAS bf16_t*)(vp + 2 * VROWB) = (bf16_t)vv.y; *(LAS bf16_t*)(vp + 3 * VROWB) = (bf16_t)(vv.y >> 16);
            *(LAS bf16_t*)(vp + 4 * VROWB) = (bf16_t)vv.z; *(LAS bf16_t*)(vp + 5 * VROWB) = (bf16_t)(vv.z >> 16);
            *(LAS bf16_t*)(vp + 6 * VROWB) = (bf16_t)vv.w; *(LAS bf16_t*)(vp + 7 * VROWB) = (bf16_t)(vv.w >> 16);
        }
        __syncthreads();
        const int g = wid >> 1, h = kvh * 4 + g, uh = wid & 1;
        const float slope2 = exp2f(-(float)(h + 1)) * LOG2E, c1 = 0.125f * LOG2E, m0 = sink[h] * LOG2E;
        const float d0 = (float)(4 * lh - lr);
#pragma unroll 1
        for (int ut = 0; ut < 2; ++ut) {
            const int u = 2 * uh + ut; const size_t trow = (size_t)b * SEQ + qb * 128 + 32 * u + lr;
            bf16x8 qf[4];
#pragma unroll
            for (int s4 = 0; s4 < 4; ++s4) qf[s4] = *(const bf16x8*)(Q + trow * AW + h * 64 + 16 * s4 + 8 * lh);
            f32x16 Ot[2];
#pragma unroll
            for (int r = 0; r < 16; ++r) { Ot[0][r] = 0.f; Ot[1][r] = 0.f; }
            float m = m0, l = lh == 0 ? 1.0f : 0.0f;
            int kt0 = u, kt1 = u + 8; if (qb == 0 && kt0 < 4) kt0 = 4; if (qb == 63 && kt1 > 7) kt1 = 7;
#pragma unroll 1
            for (int kt = kt0; kt <= kt1; ++kt) {
                f32x16 St;
#pragma unroll
                for (int r = 0; r < 16; ++r) St[r] = 0.f;
                LAS const unsigned char* kp = Ks + (32 * kt + lr) * KROWB + lh * 16;
#pragma unroll
                for (int s4 = 0; s4 < 4; ++s4) St = __builtin_amdgcn_mfma_f32_32x32x16_bf16(*(LAS const bf16x8*)(kp + 32 * s4), qf[s4], St, 0, 0, 0);
                const float base = (float)(32 * (kt - u) - 128) + d0; const bool edge = (kt == u) || (kt == u + 8);
                float tmax = -INFINITY;
#pragma unroll
                for (int r = 0; r < 16; ++r) { const float rel = fabsf(base + (float)((r & 3) + 8 * (r >> 2)));
                    float sv = St[r] * c1 - slope2 * rel; if (edge && rel > 128.0f) sv = -INFINITY; St[r] = sv; tmax = fmaxf(tmax, sv); }
                tmax = fmaxf(tmax, __shfl_xor(tmax, 32));
                const float mn = fmaxf(m, tmax), scl = __builtin_amdgcn_exp2f(m - mn); m = mn; l *= scl;
#pragma unroll
                for (int r = 0; r < 16; ++r) { Ot[0][r] *= scl; Ot[1][r] *= scl; }
#pragma unroll
                for (int r = 0; r < 16; ++r) { const float p = __builtin_amdgcn_exp2f(St[r] - mn); l += p; St[r] = p; }
                const bf16x8 pf0 = pack_step<0>(St), pf1 = pack_step<1>(St);
                LAS const unsigned char* vp = Vs + lr * VROWB + (32 * kt + 8 * lh) * 2;
#pragma unroll
                for (int dt = 0; dt < 2; ++dt) {
                    Ot[dt] = __builtin_amdgcn_mfma_f32_32x32x16_bf16(*(LAS const bf16x8*)(vp + dt * 32 * VROWB), pf0, Ot[dt], 0, 0, 0);
                    Ot[dt] = __builtin_amdgcn_mfma_f32_32x32x16_bf16(*(LAS const bf16x8*)(vp + dt * 32 * VROWB + 32), pf1, Ot[dt], 0, 0, 0);
                }
            }
            l += __shfl_xor(l, 32);
            const float il = 1.0f / l;
            bf16_t* op = O + trow * DM + h * 64 + 4 * lh;
#pragma unroll
            for (int dt = 0; dt < 2; ++dt)
#pragma unroll
                for (int gq = 0; gq < 4; ++gq)
                    *(u32x2*)(op + 32 * dt + 8 * gq) = (u32x2){cvtpk(Ot[dt][4 * gq] * il, Ot[dt][4 * gq + 1] * il), cvtpk(Ot[dt][4 * gq + 2] * il, Ot[dt][4 * gq + 3] * il)};
        }
    }
    __syncthreads();
}

__device__ __forceinline__ float block_sum(Frame& F, float v, LAS float* red) {
    v = wave_sum(v);
    __syncthreads();
    if (F.lane == 0) red[F.wave] = v;
    __syncthreads();
    float s = 0.f;
#pragma unroll
    for (int i = 0; i < NWAVES; ++i) s += red[i];
    return s;
}

namespace hy {
typedef float f32x16 __attribute__((ext_vector_type(16)));
typedef __bf16 bf16x2_t __attribute__((ext_vector_type(2)));
constexpr int ROWB = 272, TABB = 128 * ROWB, DROWB = 528, FT_OFF = 0, X_OFF = 2 * TABB, SP_OFF = 4 * TABB;
#define HY_SBAR() do { asm volatile("" ::: "memory"); __builtin_amdgcn_sched_barrier(0); } while (0)
#define MFMA32(a, b, c) __builtin_amdgcn_mfma_f32_32x32x16_bf16((a), (b), (c), 0, 0, 0)
__device__ __forceinline__ int crow(int r, int h) { return (r & 3) + 8 * (r >> 2) + 4 * h; }
__device__ __forceinline__ int q16(int c) { return 8 * ((c >> 2) & 1) + 4 * (c >> 3) + (c & 3); }
__device__ __forceinline__ int kstore(int k) { return (k & ~15) + q16(k & 15); }
__device__ __forceinline__ unsigned cvtpk(float lo, float hi) { f32x2 v = {lo, hi}; bf16x2_t b = __builtin_convertvector(v, bf16x2_t); return __builtin_bit_cast(unsigned, b); }
__device__ __forceinline__ bf16x8 neg8(bf16x8 v) { u32x4 u = __builtin_bit_cast(u32x4, v); u.x ^= 0x80008000u; u.y ^= 0x80008000u; u.z ^= 0x80008000u; u.w ^= 0x80008000u; return __builtin_bit_cast(bf16x8, u); }
template <int S> __device__ __forceinline__ bf16x8 pack_step(const f32x16& x) {
    u32x4 p; p.x = cvtpk(x[8 * S], x[8 * S + 1]); p.y = cvtpk(x[8 * S + 2], x[8 * S + 3]); p.z = cvtpk(x[8 * S + 4], x[8 * S + 5]); p.w = cvtpk(x[8 * S + 6], x[8 * S + 7]);
    return __builtin_bit_cast(bf16x8, p);
}
__device__ __forceinline__ bf16x8 ffrag(LAS const unsigned char* ft, int t, int rb, int s, int lr, int lh) {
    return *(LAS const bf16x8*)(ft + (lr * ROWB + lh * 16) + (t * TABB + rb * 32 * ROWB + 32 * s)); }
__device__ __forceinline__ bf16x8 xfrag(LAS const unsigned char* img, int rb, int cs, int lr, int lh) {
    return *(LAS const bf16x8*)(img + (lr * ROWB + lh * 16) + (rb * 32 * ROWB + 16 * cs)); }
__device__ __forceinline__ bf16x8 dfrag(LAS const unsigned char* img, int rb, int cs, int lr, int lh) {
    return *(LAS const bf16x8*)(img + (lr * DROWB + lh * 16) + (rb * 32 * DROWB + 16 * cs)); }
__device__ __forceinline__ void zero16(f32x16& x) {
#pragma unroll
    for (int r = 0; r < 16; ++r) x[r] = 0.f; }
struct ctile { u32x4 q[4]; };
__device__ __forceinline__ ctile load_ctile(const unsigned* w  ) { ctile t;
#pragma unroll
    for (int i = 0; i < 4; ++i) t.q[i] = *(const u32x4*)(w + 4 * i);
    return t; }
template <bool CONJ> __device__ __forceinline__ void cmul_tile(f32x16& xr, f32x16& xi, const ctile& t) {
#pragma unroll
    for (int i = 0; i < 4; ++i) { const unsigned w[4] = {t.q[i].x, t.q[i].y, t.q[i].z, t.q[i].w};
#pragma unroll
        for (int u = 0; u < 4; ++u) { const int r = 4 * i + u; const float wr = bflo(w[u]), wi = CONJ ? -bfhi(w[u]) : bfhi(w[u]);
            const float a = xr[r], b = xi[r]; xr[r] = a * wr - b * wi; xi[r] = a * wi + b * wr; } }
}
template <bool CPLX, int NK>
__device__ __forceinline__ void s1_tw(LAS const unsigned char* ft, LAS const unsigned char* img, const unsigned* twt, int J, int lane, bf16x8 (&bAr)[8], bf16x8 (&bAi)[8]) {
    const int lr = lane & 31, lh = lane >> 5;
#pragma unroll
    for (int hf = 0; hf < 2; ++hf) {
        const ctile tw0 = load_ctile(twt + ((size_t)(((2 * hf) * 4 + J) * 64 + lane)) * 16), tw1 = load_ctile(twt + ((size_t)(((2 * hf + 1) * 4 + J) * 64 + lane)) * 16);
        f32x16 Ar[2], Ai[2];
#pragma unroll
        for (int i = 0; i < 2; ++i) { zero16(Ar[i]); zero16(Ai[i]); }
#pragma unroll
        for (int s = 0; s < NK; ++s) {
            const bf16x8 bFr = ffrag(ft, 0, J, s, lr, lh), bFi = ffrag(ft, 1, J, s, lr, lh), bnFi = neg8(bFi);
#pragma unroll
            for (int i = 0; i < 2; ++i) {
                const bf16x8 aXr = xfrag(img, 2 * hf + i, 2 * s, lr, lh);
                Ar[i] = MFMA32(aXr, bFr, Ar[i]); Ai[i] = MFMA32(aXr, bFi, Ai[i]);
                if (CPLX) { const bf16x8 aXi = xfrag(img, 2 * hf + i, 8 + 2 * s, lr, lh); Ar[i] = MFMA32(aXi, bnFi, Ar[i]); Ai[i] = MFMA32(aXi, bFr, Ai[i]); }
            }
            HY_SBAR();
        }
#pragma unroll
        for (int i = 0; i < 2; ++i) { const int ig = 2 * hf + i;
            cmul_tile<false>(Ar[i], Ai[i], i == 0 ? tw0 : tw1);
            bAr[2 * ig] = pack_step<0>(Ar[i]); bAr[2 * ig + 1] = pack_step<1>(Ar[i]); bAi[2 * ig] = pack_step<0>(Ai[i]); bAi[2 * ig + 1] = pack_step<1>(Ai[i]);
            HY_SBAR();
        }
    }
}
__device__ __forceinline__ void s3_half(LAS const unsigned char* ft, const bf16x8 (&bAr)[8], const bf16x8 (&bAi)[8], int Ih, int lane, f32x16 (&Zr)[2], f32x16 (&Zi)[2]) {
    const int lr = lane & 31, lh = lane >> 5;
#pragma unroll
    for (int I = 0; I < 2; ++I) { zero16(Zr[I]); zero16(Zi[I]); }
#pragma unroll
    for (int s = 0; s < 8; ++s) {
        const bf16x8 bnAi = neg8(bAi[s]);
#pragma unroll
        for (int I = 0; I < 2; ++I) {
            const bf16x8 aFr = ffrag(ft, 0, 2 * Ih + I, s, lr, lh), aFi = ffrag(ft, 1, 2 * Ih + I, s, lr, lh);
            Zr[I] = MFMA32(aFr, bAr[s], Zr[I]); Zr[I] = MFMA32(aFi, bnAi, Zr[I]);
            Zi[I] = MFMA32(aFi, bAr[s], Zi[I]); Zi[I] = MFMA32(aFr, bAi[s], Zi[I]);
        }
        HY_SBAR();
    }
}
__device__ __forceinline__ void fwd_filter(LAS const unsigned char* ft, LAS const unsigned char* img, const unsigned* twt, int J, int lane, float scl, float sk, unsigned* kh  ) {
    bf16x8 bAr[8], bAi[8];
    s1_tw<false, 8>(ft, img, twt, J, lane, bAr, bAi);
#pragma unroll
    for (int Ih = 0; Ih < 2; ++Ih) {
        f32x16 Zr[2], Zi[2];
        s3_half(ft, bAr, bAi, Ih, lane, Zr, Zi);
#pragma unroll
        for (int I = 0; I < 2; ++I) { unsigned* dst = kh + ((size_t)((2 * Ih + I) * 64 + lane)) * 16;
#pragma unroll
            for (int r4 = 0; r4 < 4; ++r4) *(u32x4*)(dst + 4 * r4) = (u32x4){cvtpk(Zr[I][4 * r4] * scl + sk, Zi[I][4 * r4] * scl), cvtpk(Zr[I][4 * r4 + 1] * scl + sk, Zi[I][4 * r4 + 1] * scl),
                                                                              cvtpk(Zr[I][4 * r4 + 2] * scl + sk, Zi[I][4 * r4 + 2] * scl), cvtpk(Zr[I][4 * r4 + 3] * scl + sk, Zi[I][4 * r4 + 3] * scl)}; }
        HY_SBAR();
    }
}
__device__ __forceinline__ void s3_filt_i1(LAS const unsigned char* ft, const unsigned* khat  , const unsigned* twt, int J, int lane, const bf16x8 (&bAr)[8], const bf16x8 (&bAi)[8], u32x2 (&dpk)[4][2][4]) {
    const int lr = lane & 31, lh = lane >> 5;
    bf16x8 aYr[8], aYi[8];
#pragma unroll
    for (int Ih = 0; Ih < 2; ++Ih) {
        const ctile k0 = load_ctile(khat + ((size_t)((2 * Ih) * 64 + lane)) * 16);
        f32x16 Zr[2], Zi[2];
        s3_half(ft, bAr, bAi, Ih, lane, Zr, Zi);
        const ctile k1 = load_ctile(khat + ((size_t)((2 * Ih + 1) * 64 + lane)) * 16);
#pragma unroll
        for (int I = 0; I < 2; ++I) { const int Ig = 2 * Ih + I;
            cmul_tile<false>(Zr[I], Zi[I], I == 0 ? k0 : k1);
            aYr[2 * Ig] = pack_step<0>(Zr[I]); aYr[2 * Ig + 1] = pack_step<1>(Zr[I]); aYi[2 * Ig] = pack_step<0>(Zi[I]); aYi[2 * Ig + 1] = pack_step<1>(Zi[I]);
            HY_SBAR();
        }
    }
#pragma unroll
    for (int ch = 0; ch < 2; ++ch) {
        const ctile tw0 = load_ctile(twt + ((size_t)((J * 4 + 2 * ch) * 64 + lane)) * 16);
        f32x16 Cr[2], Ci[2];
#pragma unroll
        for (int c = 0; c < 2; ++c) { zero16(Cr[c]); zero16(Ci[c]); }
#pragma unroll
        for (int s = 0; s < 8; ++s) {
            const bf16x8 anYr = neg8(aYr[s]);
#pragma unroll
            for (int c = 0; c < 2; ++c) {
                const bf16x8 bFr = ffrag(ft, 0, 2 * ch + c, s, lr, lh), bFi = ffrag(ft, 1, 2 * ch + c, s, lr, lh);
                Cr[c] = MFMA32(aYr[s], bFr, Cr[c]); Cr[c] = MFMA32(aYi[s], bFi, Cr[c]);
                Ci[c] = MFMA32(anYr, bFi, Ci[c]); Ci[c] = MFMA32(aYi[s], bFr, Ci[c]);
            }
            HY_SBAR();
        }
        const ctile tw1 = load_ctile(twt + ((size_t)((J * 4 + 2 * ch + 1) * 64 + lane)) * 16);
#pragma unroll
        for (int c = 0; c < 2; ++c) { const int cg = 2 * ch + c;
            cmul_tile<true>(Cr[c], Ci[c], c == 0 ? tw0 : tw1);
#pragma unroll
            for (int g = 0; g < 4; ++g) {
                dpk[cg][0][g] = (u32x2){cvtpk(Cr[c][4 * g], Cr[c][4 * g + 1]), cvtpk(Cr[c][4 * g + 2], Cr[c][4 * g + 3])};
                dpk[cg][1][g] = (u32x2){cvtpk(Ci[c][4 * g], Ci[c][4 * g + 1]), cvtpk(Ci[c][4 * g + 2], Ci[c][4 * g + 3])};
            }
            HY_SBAR();
        }
    }
}
__device__ __forceinline__ void write_D(LAS unsigned char* dimg, const u32x2 (&dpk)[4][2][4], int J, int lane) {
    const int lr = lane & 31, lh = lane >> 5;
    LAS unsigned char* base = dimg + lr * DROWB + lh * 16 + J * 64;
#pragma unroll
    for (int c = 0; c < 4; ++c)
#pragma unroll
        for (int g = 0; g < 4; ++g) {
            *(LAS u32x2*)(base + c * 32 * DROWB + 32 * (g >> 1) + 8 * (g & 1)) = dpk[c][0][g];
            *(LAS u32x2*)(base + c * 32 * DROWB + 256 + 32 * (g >> 1) + 8 * (g & 1)) = dpk[c][1][g]; }
}
__device__ __forceinline__ void i3_wave(LAS const unsigned char* ft, LAS const unsigned char* dimg, int a, int c, int lane, f32x16& yr, f32x16& yi) {
    const int lr = lane & 31, lh = lane >> 5;
    zero16(yr); zero16(yi);
#pragma unroll
    for (int s = 0; s < 8; ++s) {
        const bf16x8 aFr = ffrag(ft, 0, a, s, lr, lh), aFi = ffrag(ft, 1, a, s, lr, lh), anFi = neg8(aFi);
        const bf16x8 bDr = dfrag(dimg, c, 2 * s, lr, lh), bDi = dfrag(dimg, c, 16 + 2 * s, lr, lh);
        yr = MFMA32(aFr, bDr, yr); yr = MFMA32(aFi, bDi, yr);
        yi = MFMA32(aFr, bDi, yi); yi = MFMA32(anFi, bDr, yi);
        HY_SBAR();
    }
}
__device__ __forceinline__ int img_off(int n2, int ks) { return n2 * ROWB + ks * 2; }
}

__device__ __forceinline__ void ph_hyena_fft(Frame& F) {
    using namespace hy;
    const bf16_t* UT = (const bf16_t*)(F.ws + WS_UT); bf16_t* HYT = (bf16_t*)(F.ws + WS_HYT);
    const float* hdn = (const float*)(F.ws + WS_HDN); const float* w3 = F.in[I_FW3]; const float* decay = F.in[I_DECAY];
    const float* convw = F.in[I_CONVW]; const float* convb = F.in[I_CONVB]; const float* skip = F.in[I_SKIP];
    const unsigned* twt = (const unsigned*)(F.ws + WS_TWT);
    unsigned* khat = (unsigned*)(F.ws + WS_KHAT + (size_t)blockIdx.x * 131072);
    bf16_t* gt = (bf16_t*)(F.ws + WS_GT + (size_t)blockIdx.x * 131072);
    LAS unsigned char* ft = F.lds + FT_OFF; LAS unsigned char* xr = F.lds + X_OFF;
    LAS float* w3s = (LAS float*)(F.lds + SP_OFF);
    LAS float* red = w3s + 256;
    const int wid = F.wave;
#define HY_IDS int tid = F.tid; asm volatile("" : "+v"(tid)); const int lane = tid & 63, lr = lane & 31, lh = lane >> 5; (void)lr; (void)lh; (void)lane;
    __syncthreads();
    { const u32x4* src = (const u32x4*)(F.ws + WS_FTAB);
      for (int i = F.tid; i < 2 * TABB / 16; i += NTHREADS) *(LAS u32x4*)(ft + i * 16) = src[i]; }
    for (int c = blockIdx.x; c < HW; c += F.G) {
        __syncthreads();
        for (int repA = 0; repA < ((PROBE_HY & 1u) ? 2 : 1); ++repA) {
        if (repA) __syncthreads();
        { HY_IDS
        u32x4 kw[8];
#pragma unroll
        for (int i = 0; i < 8; ++i) { const int ci = tid + 512 * i; const int od = ci >> 10, t0 = (ci & 1023) * 8;
            kw[i] = *(const u32x4*)((const bf16_t*)(F.ws + WS_KRAW) + (size_t)((od >> 1) * 1024 + (od & 1) * 512 + c) * SEQ + t0); }
#pragma unroll
        for (int i = 0; i < 8; ++i) {
            const int ci = tid + 512 * i; const int od = ci >> 10, t0 = (ci & 1023) * 8, o = od >> 1, dir = od & 1;
            const u32x4 w = kw[i];
            const unsigned short e[8] = {(unsigned short)w.x, (unsigned short)(w.x >> 16), (unsigned short)w.y, (unsigned short)(w.y >> 16), (unsigned short)w.z, (unsigned short)(w.z >> 16), (unsigned short)w.w, (unsigned short)(w.w >> 16)};
            LAS unsigned char* img = xr + o * TABB;
#pragma unroll
            for (int j = 0; j < 8; ++j) { const int t = t0 + j; int n = dir ? 2 * SEQ - t : t; unsigned short v = e[j];
                if (dir && t == 0) { n = SEQ; v = 0; }
                *(LAS bf16_t*)(img + img_off(n & 127, kstore(n >> 7))) = v; }
        }
        }
        __syncthreads();
        { HY_IDS
            const int o = wid >> 2, J = wid & 3;
            float nsum = 0.f;
            { const float* kp = (const float*)(F.ws + WS_KPART);
              for (int i = 0; i < 32; ++i) nsum += kp[(size_t)(o * 1024 + c) * 32 + i] + kp[(size_t)(o * 1024 + 512 + c) * 32 + i]; }
            const float scl = 1.0f / (nsum * (float)(2 * SEQ)), sk = skip[o * HW + c] * (1.0f / (float)(2 * SEQ));
            fwd_filter(ft, xr + o * TABB, twt, J, lane, scl, sk, khat + (size_t)((o * 4 + J) * 4) * 64 * 16);
        }
        __syncthreads();
        }
        for (int repB = 0; repB < ((PROBE_HY & 2u) ? 2 : 1); ++repB) {
#pragma unroll 1
        for (int rd = 0; rd < 2; ++rd) { HY_IDS
            {
                u32x4 uw[8]; float ul[8], uh[8];
#pragma unroll
                for (int i = 0; i < 8; ++i) { const int blk = 8 * rd + i, g = blk >> 3, b = (blk >> 1) & 3, a = blk & 1;
                    const bf16_t* row = UT + (size_t)((g + 1) * HW + c) * T + (size_t)b * SEQ; const int t0 = 4096 * a + 8 * tid;
                    uw[i] = *(const u32x4*)(row + t0); ul[i] = t0 > 0 ? bf2f(row[t0 - 1]) : 0.f; uh[i] = t0 + 8 < SEQ ? bf2f(row[t0 + 8]) : 0.f; }
#pragma unroll
                for (int i = 0; i < 8; ++i) { const int blk = 8 * rd + i, g = blk >> 3; const int chg = (g + 1) * HW + c;
                    const float w0 = convw[chg], w1 = convw[NHY + chg], w2 = convw[2 * NHY + chg], bb = convb[chg];
                    const u32x4 w = uw[i];
                    const float u[10] = {ul[i], bflo(w.x), bfhi(w.x), bflo(w.y), bfhi(w.y), bflo(w.z), bfhi(w.z), bflo(w.w), bfhi(w.w), uh[i]};
                    float v[8];
#pragma unroll
                    for (int j = 0; j < 8; ++j) v[j] = w0 * u[j] + w1 * u[j + 1] + w2 * u[j + 2] + bb;
                    *(LAS u32x4*)(xr + i * 8192 + tid * 16) = (u32x4){pk2(v[0], v[1]), pk2(v[2], v[3]), pk2(v[4], v[5]), pk2(v[6], v[7])}; }
            }
            __syncthreads();
#pragma unroll
            for (int k = 0; k < 4; ++k) {
                const int item = tid + 512 * k, i = item >> 8, c4 = (item >> 6) & 3; const int blk = 8 * rd + i;
                LAS const bf16_t* st = (LAS const bf16_t*)(xr + i * 8192);
                unsigned pk[8];
#pragma unroll
                for (int r2 = 0; r2 < 8; ++r2) { const unsigned lo = st[crow(2 * r2, lh) * 128 + 32 * c4 + lr], hi = st[crow(2 * r2 + 1, lh) * 128 + 32 * c4 + lr]; pk[r2] = lo | (hi << 16); }
                bf16_t* dst = gt + ((size_t)((blk * 4 + c4) * 64 + lane)) * 16;
                *(u32x4*)dst = (u32x4){pk[0], pk[1], pk[2], pk[3]}; *(u32x4*)(dst + 8) = (u32x4){pk[4], pk[5], pk[6], pk[7]};
            }
            __syncthreads();
        }
        }
        for (int repC = 0; repC < ((PROBE_HY & 4u) ? 2 : 1); ++repC) {
        u32x2 z1p[2][2][4];
        const int p = wid >> 2, J = wid & 3, ta = wid >> 2, tc = wid & 3;
        for (int o = 0; o < 2; ++o) {
            { HY_IDS
            if (o == 0) {
                const float w0 = convw[c], w1 = convw[NHY + c], w2 = convw[2 * NHY + c], bb = convb[c];
                u32x4 uw[8]; float ul[8], uh[8];
#pragma unroll
                for (int i = 0; i < 8; ++i) { const int ci = tid + 512 * i; const int b = ci >> 10, t0 = (ci & 1023) * 8;
                    const bf16_t* row = UT + (size_t)c * T + (size_t)b * SEQ;
                    uw[i] = *(const u32x4*)(row + t0); ul[i] = t0 > 0 ? bf2f(row[t0 - 1]) : 0.f; uh[i] = t0 + 8 < SEQ ? bf2f(row[t0 + 8]) : 0.f; }
#pragma unroll
                for (int i = 0; i < 8; ++i) {
                    const int ci = tid + 512 * i; const int b = ci >> 10, t0 = (ci & 1023) * 8;
                    const u32x4 w = uw[i];
                    const float u[10] = {ul[i], bflo(w.x), bfhi(w.x), bflo(w.y), bfhi(w.y), bflo(w.z), bfhi(w.z), bflo(w.w), bfhi(w.w), uh[i]};
                    const int n1 = t0 >> 7, n2 = t0 & 127; const int ks = kstore(n1) + 64 * (b & 1);
                    LAS unsigned char* img = xr + (b >> 1) * TABB;
#pragma unroll
                    for (int j = 0; j < 8; ++j) *(LAS bf16_t*)(img + img_off(n2 + j, ks)) = (bf16_t)f2bf(w0 * u[j] + w1 * u[j + 1] + w2 * u[j + 2] + bb);
                }
            } else {
#pragma unroll
                for (int q = 0; q < 2; ++q) { LAS unsigned char* img = xr + q * TABB + (32 * tc + lr) * ROWB + lh * 16 + ta * 64;
#pragma unroll
                    for (int g = 0; g < 4; ++g) {
                        *(LAS u32x2*)(img + 32 * (g >> 1) + 8 * (g & 1)) = z1p[q][0][g];
                        *(LAS u32x2*)(img + 128 + 32 * (g >> 1) + 8 * (g & 1)) = z1p[q][1][g]; } }
            }
            }
            __syncthreads();
            u32x2 dpk[4][2][4];
            { HY_IDS
                bf16x8 bAr[8], bAi[8];
                s1_tw<true, 4>(ft, xr + p * TABB, twt, J, lane, bAr, bAi);
                __syncthreads();
                s3_filt_i1(ft, khat + (size_t)((o * 4 + J) * 4) * 64 * 16, twt, J, lane, bAr, bAi, dpk);
            }
#pragma unroll 1
            for (int q = 0; q < 2; ++q) { HY_IDS
                if (p == q) write_D(xr, dpk, J, lane);
                __syncthreads();
                const bf16_t* g0 = gt + ((size_t)((((o * 4 + 2 * q) * 2 + ta) * 4 + tc) * 64 + lane)) * 16;
                const bf16_t* g1 = gt + ((size_t)((((o * 4 + 2 * q + 1) * 2 + ta) * 4 + tc) * 64 + lane)) * 16;
                const u32x4 ga = *(const u32x4*)g0, gb = *(const u32x4*)(g0 + 8), gc = *(const u32x4*)g1, gd = *(const u32x4*)(g1 + 8);
                f32x16 yr, yi;
                i3_wave(ft, xr, ta, tc, lane, yr, yi);
                const unsigned gre[8] = {ga.x, ga.y, ga.z, ga.w, gb.x, gb.y, gb.z, gb.w}, gim[8] = {gc.x, gc.y, gc.z, gc.w, gd.x, gd.y, gd.z, gd.w};
#pragma unroll
                for (int r2 = 0; r2 < 8; ++r2) { yr[2 * r2] *= bflo(gre[r2]); yr[2 * r2 + 1] *= bfhi(gre[r2]); yi[2 * r2] *= bflo(gim[r2]); yi[2 * r2 + 1] *= bfhi(gim[r2]); }
                {
#pragma unroll
                    for (int g = 0; g < 4; ++g) { z1p[q][0][g] = (u32x2){cvtpk(yr[4 * g], yr[4 * g + 1]), cvtpk(yr[4 * g + 2], yr[4 * g + 3])};
                                                  z1p[q][1][g] = (u32x2){cvtpk(yi[4 * g], yi[4 * g + 1]), cvtpk(yi[4 * g + 2], yi[4 * g + 3])}; }
                }
                if (o == 1) {
                    bf16_t* o0 = HYT + (size_t)c * T + (size_t)(2 * q) * SEQ + 32 * tc + lr; bf16_t* o1 = o0 + SEQ;
#pragma unroll
                    for (int r = 0; r < 16; ++r) { const int n1 = 32 * ta + crow(r, lh); o0[128 * n1] = (bf16_t)f2bf(yr[r]); o1[128 * n1] = (bf16_t)f2bf(yi[r]); }
                }
                __syncthreads();
            }
        }
        }
    }
    __syncthreads();
#undef HY_IDS
}

__device__ __forceinline__ void ph_hyT(Frame& F) {
    const bf16_t* HYT = (const bf16_t*)(F.ws + WS_HYT); bf16_t* HY = (bf16_t*)(F.ws + WS_AH) + AW;
    for (int it = blockIdx.x; it < 8 * (T / 512); it += F.G) {
        const int cb = it & 7, tb = it >> 3; const int t = tb * 512 + F.tid, c0 = cb * 64;
        unsigned w[32];
#pragma unroll
        for (int i = 0; i < 32; ++i) { const unsigned lo = HYT[(size_t)(c0 + 2 * i) * T + t], hi = HYT[(size_t)(c0 + 2 * i + 1) * T + t]; w[i] = lo | (hi << 16); }
#pragma unroll
        for (int i = 0; i < 8; ++i) *(u32x4*)(HY + (size_t)t * DM + c0 + 8 * i) = (u32x4){w[4 * i], w[4 * i + 1], w[4 * i + 2], w[4 * i + 3]};
    }
}

__device__ __forceinline__ void ph_expert_cvt(Frame& F) {
    LAS float* scr = (LAS float*)(F.lds + F.wave * 16384);
    const int gw = F.vcu * NWAVES + F.wave, NGW = F.G * NWAVES;
    bf16_t* W13 = (bf16_t*)(F.ws + WS_W13); bf16_t* W2 = (bf16_t*)(F.ws + WS_W2);
    for (int it = gw; it < NE * 768; it += NGW) {
        const int e = it / 768; int r = it % 768;
        if (r < 512) { const bool is3 = r >= 256; r &= 255; const int kb = r / 16, nb = r % 16, n0 = nb * 32;
            const int drow = (n0 >> 7) * 256 + (is3 ? 128 : 0) + (n0 & 127);
            transpose_item(F.in[is3 ? I_EW3 : I_EW1] + (size_t)e * DM * DE, DM, DE, W13 + (size_t)e * DM * DM, DM, drow, scr, kb, nb, F.lane); }
        else { r -= 512; const int kb = r / 32, nb = r % 32;
            transpose_item(F.in[I_EW2] + (size_t)e * DE * DM, DE, DM, W2 + (size_t)e * DM * DE, DE, nb * 32, scr, kb, nb, F.lane); }
    }
}

__device__ __forceinline__ void ph_ln1_route(Frame& F) {
    const float* xin = F.in[I_X]; bf16_t* y1 = (bf16_t*)(F.ws + WS_Y1); bf16_t* h2b = (bf16_t*)(F.ws + WS_HB); bf16_t* h2l = (bf16_t*)(F.ws + WS_H2LO);
    const float* mod = (const float*)(F.ws + WS_MOD); const float* g1 = F.in[I_LN1G]; const float* b1 = F.in[I_LN1B];
    const bf16_t* wr = (const bf16_t*)(F.ws + WS_WRT); const float* bg = F.in[I_RGB]; const float* be = F.in[I_REB];
    unsigned* cnt = F.ctl + CW_CNT; int* btok = (int*)(F.ws + WS_BTOK); float* bw = (float*)(F.ws + WS_BW);
    constexpr int WROW = 272, WCH = 80 * WROW;
    LAS unsigned char* wl = F.lds;
    LAS float* lg = (LAS float*)(F.lds + 65536);
    for (int ch = blockIdx.x; ch < T / 128; ch += F.G) {
        const int b = (ch * 128) / SEQ;
        for (int rr0 = F.wave * 4; rr0 < 128; rr0 += NWAVES * 4) {
            f32x4 xin4[4][4]; unsigned long long yin4[4][4];
#pragma unroll
            for (int r = 0; r < 4; ++r) { const size_t row = (size_t)ch * 128 + rr0 + r;
                const f32x4* xi = (const f32x4*)(xin + row * DM) + F.lane; const unsigned long long* yi = (const unsigned long long*)(y1 + row * DM) + F.lane;
#pragma unroll
                for (int j = 0; j < 4; ++j) { xin4[r][j] = xi[64 * j]; yin4[r][j] = yi[64 * j]; } }
#pragma unroll
            for (int r = 0; r < 4; ++r) {
            const size_t row = (size_t)ch * 128 + rr0 + r;
            unsigned long long* x1o = (unsigned long long*)(y1 + row * DM) + F.lane;
            f32x4 x[4]; float s = 0.f;
#pragma unroll
            for (int j = 0; j < 4; ++j) { const unsigned long long yw = yin4[r][j]; const f32x4 yv = {bflo((unsigned)yw), bfhi((unsigned)yw), bflo((unsigned)(yw >> 32)), bfhi((unsigned)(yw >> 32))};
                x[j] = xin4[r][j] * DN_ALPHA + yv; s += (x[j][0] + x[j][1]) + (x[j][2] + x[j][3]); }
            const float mean = wave_sum(s) * (1.f / DM); float s2 = 0.f;
#pragma unroll
            for (int j = 0; j < 4; ++j) { x[j] = x[j] - mean; s2 += (x[j][0] * x[j][0] + x[j][1] * x[j][1]) + (x[j][2] * x[j][2] + x[j][3] * x[j][3]); }
            const float rstd = 1.f / sqrtf(wave_sum(s2) * (1.f / DM) + LN_EPS);
            unsigned long long* o8 = (unsigned long long*)(h2b + row * DM) + F.lane; unsigned long long* l8 = (unsigned long long*)(h2l + row * DM) + F.lane;
#pragma unroll
            for (int j = 0; j < 4; ++j) { const int k = 4 * F.lane + 256 * j;
                const f32x4 gg = *(const f32x4*)(g1 + k), bb = *(const f32x4*)(b1 + k);
                const f32x4 sh = *(const f32x4*)(mod + (size_t)b * 6144 + 3072 + k), sc = *(const f32x4*)(mod + (size_t)b * 6144 + 4096 + k);
                x[j] = x[j] * rstd * gg + bb; x1o[64 * j] = (unsigned long long)pk2(x[j][0], x[j][1]) | ((unsigned long long)pk2(x[j][2], x[j][3]) << 32);
                const f32x4 h = x[j] * (sc + 1.0f) + sh;
                const unsigned h01 = pk2(h[0], h[1]), h23 = pk2(h[2], h[3]);
                o8[64 * j] = (unsigned long long)h01 | ((unsigned long long)h23 << 32);
                l8[64 * j] = (unsigned long long)pk2(h[0] - bflo(h01), h[1] - bfhi(h01)) | ((unsigned long long)pk2(h[2] - bflo(h23), h[3] - bfhi(h23)) << 32); }
            }
        }
        __syncthreads();
        {
            const int lane = F.lane, l15 = lane & 15, l4 = lane >> 4;
            f32x4 acc[5];
#pragma unroll
            for (int n = 0; n < 5; ++n) acc[n] = (f32x4){0.f, 0.f, 0.f, 0.f};
            const size_t arow = ((size_t)ch * 128 + 16 * F.wave + l15) * DM + 8 * l4;
#pragma unroll 1
            for (int kc = 0; kc < 8; ++kc) {
                for (int i = F.tid; i < 2 * 80 * 16; i += NTHREADS) { const int part = i / 1280, r = (i % 1280) >> 4, pc = i & 15;
                    *(LAS u32x4*)(wl + part * WCH + r * WROW + pc * 16) = *(const u32x4*)(wr + (size_t)part * 80 * DM + (size_t)r * DM + kc * 128 + pc * 8); }
                __syncthreads();
#pragma unroll
                for (int s4 = 0; s4 < 4; ++s4) {
                    const bf16x8 ah = *(const bf16x8*)(h2b + arow + kc * 128 + 32 * s4), al = *(const bf16x8*)(h2l + arow + kc * 128 + 32 * s4);
#pragma unroll
                    for (int n = 0; n < 5; ++n) {
                        const bf16x8 bh = *(LAS const bf16x8*)(wl + (16 * n + l15) * WROW + (32 * s4 + 8 * l4) * 2), bl = *(LAS const bf16x8*)(wl + WCH + (16 * n + l15) * WROW + (32 * s4 + 8 * l4) * 2);
                        acc[n] = __builtin_amdgcn_mfma_f32_16x16x32_bf16(ah, bh, acc[n], 0, 0, 0);
                        acc[n] = __builtin_amdgcn_mfma_f32_16x16x32_bf16(al, bh, acc[n], 0, 0, 0);
                        acc[n] = __builtin_amdgcn_mfma_f32_16x16x32_bf16(ah, bl, acc[n], 0, 0, 0);
                    }
                }
                __syncthreads();
            }
#pragma unroll
            for (int n = 0; n < 5; ++n)
#pragma unroll
                for (int r = 0; r < 4; ++r) lg[(16 * F.wave + 4 * l4 + r) * 81 + 16 * n + l15] = acc[n][r];
        }
        __syncthreads();
        if (F.tid < 128) {
            const int row = ch * 128 + F.tid; LAS const float* lr_ = lg + F.tid * 81;
            float gl[8]; float gmax; int g = 0;
#pragma unroll
            for (int i = 0; i < 8; ++i) gl[i] = lr_[i] + bg[i];
            gmax = gl[0];
#pragma unroll
            for (int i = 1; i < 8; ++i) if (gl[i] > gmax) { gmax = gl[i]; g = i; }
            float den = 0.f;
#pragma unroll
            for (int i = 0; i < 8; ++i) den += __expf(gl[i] - gmax);
            const float pg = 1.0f / den;
            float el[8];
#pragma unroll
            for (int j = 0; j < 8; ++j) el[j] = lr_[8 + g * 8 + j] + be[g * 8 + j];
            int i1 = 0; float e1 = el[0];
#pragma unroll
            for (int j = 1; j < 8; ++j) if (el[j] > e1) { e1 = el[j]; i1 = j; }
            int i2 = -1; float e2 = -INFINITY;
#pragma unroll
            for (int j = 0; j < 8; ++j) if (j != i1 && (i2 < 0 || el[j] > e2)) { e2 = el[j]; i2 = j; }
            const float r = __expf(e2 - e1); const float wa = pg / (1.0f + r), wb = pg * r / (1.0f + r);
            const int ea = g * 8 + i1, eb = g * 8 + i2;
            const unsigned ra = atomicAdd(&cnt[ea], 1u); btok[(size_t)ea * ECAP + ra] = row * 2; bw[(size_t)ea * ECAP + ra] = wa;
            const unsigned rb = atomicAdd(&cnt[eb], 1u); btok[(size_t)eb * ECAP + rb] = row * 2 + 1; bw[(size_t)eb * ECAP + rb] = wb;
        }
        __syncthreads();
    }
}

__device__ __forceinline__ void build_moe_tab(Frame& F, LAS int* tab) {
    __syncthreads();
    if (F.tid < 64) tab[72 + F.tid] = (int)__hip_atomic_load(F.ctl + CW_CNT + F.tid, __ATOMIC_RELAXED, __HIP_MEMORY_SCOPE_AGENT);
    __syncthreads();
    if (F.tid == 0) { int s = 0; for (int e = 0; e < 64; ++e) { tab[e] = s; s += (tab[72 + e] + 255) >> 8; } tab[64] = s; }
    __syncthreads();
}

__device__ __forceinline__ void ph_final(Frame& F) {
    float* out = F.out; const bf16_t* y2 = (const bf16_t*)(F.ws + WS_Y2); const bf16_t* x1b = (const bf16_t*)(F.ws + WS_Y1);
    const float* mod = (const float*)(F.ws + WS_MOD); const float* g2 = F.in[I_LN2G]; const float* b2 = F.in[I_LN2B];
    const int gw = F.vcu * NWAVES + F.wave, NGW = F.G * NWAVES;
    constexpr int RB = 4;
    for (int row0 = gw * RB; row0 < T; row0 += NGW * RB) {
        const int b = row0 / SEQ;
        unsigned long long xa[RB][4], ya[RB][4], yb[RB][4];
#pragma unroll
        for (int r = 0; r < RB; ++r) { const size_t row = (size_t)row0 + r;
            const unsigned long long* xb = (const unsigned long long*)(x1b + row * DM) + F.lane;
            const unsigned long long* pa = (const unsigned long long*)(y2 + (2 * row) * DM) + F.lane; const unsigned long long* pb = (const unsigned long long*)(y2 + (2 * row + 1) * DM) + F.lane;
#pragma unroll
            for (int j = 0; j < 4; ++j) { xa[r][j] = xb[64 * j]; ya[r][j] = pa[64 * j]; yb[r][j] = pb[64 * j]; } }
#pragma unroll
        for (int r = 0; r < RB; ++r) {
            f32x4* xr = (f32x4*)(out + ((size_t)row0 + r) * DM) + F.lane;
            f32x4 x[4]; float s = 0.f;
#pragma unroll
            for (int j = 0; j < 4; ++j) { const int k = 4 * F.lane + 256 * j;
                const f32x4 gt = *(const f32x4*)(mod + (size_t)b * 6144 + 5120 + k);
                const unsigned long long a = ya[r][j], c = yb[r][j], xw = xa[r][j];
                f32x4 y; y[0] = bflo((unsigned)a) + bflo((unsigned)c); y[1] = bfhi((unsigned)a) + bfhi((unsigned)c);
                y[2] = bflo((unsigned)(a >> 32)) + bflo((unsigned)(c >> 32)); y[3] = bfhi((unsigned)(a >> 32)) + bfhi((unsigned)(c >> 32));
                const f32x4 x1 = {bflo((unsigned)xw), bfhi((unsigned)xw), bflo((unsigned)(xw >> 32)), bfhi((unsigned)(xw >> 32))};
                x[j] = x1 * DN_ALPHA + gt * y; s += (x[j][0] + x[j][1]) + (x[j][2] + x[j][3]); }
            const float mean = wave_sum(s) * (1.f / DM); float s2 = 0.f;
#pragma unroll
            for (int j = 0; j < 4; ++j) { x[j] = x[j] - mean; s2 += (x[j][0] * x[j][0] + x[j][1] * x[j][1]) + (x[j][2] * x[j][2] + x[j][3] * x[j][3]); }
            const float rstd = 1.f / sqrtf(wave_sum(s2) * (1.f / DM) + LN_EPS);
#pragma unroll
            for (int j = 0; j < 4; ++j) { const int k = 4 * F.lane + 256 * j; xr[64 * j] = x[j] * rstd * *(const f32x4*)(g2 + k) + *(const f32x4*)(b2 + k); }
        }
    }
}

constexpr int N_PHASES = 12;
__device__ __forceinline__ Frame make_frame(const Args& args, unsigned char* lds) {
    Frame F;
    F.lds = (LAS unsigned char*)lds; F.ws = args.ws; F.ctl = (unsigned*)(args.ws + WS_CTL);
    F.tid = threadIdx.x; F.lane = F.tid & 63; F.wave = __builtin_amdgcn_readfirstlane(F.tid >> 6);
    F.G = gridDim.x; { const int bx = blockIdx.x; F.vcu = (F.G % 8 == 0) ? (bx % 8) * (F.G / 8) + bx / 8 : bx; }
    F.in = args.in; F.out = args.out;
    return F;
}
template <unsigned PH_MASK> __global__ void __launch_bounds__(NTHREADS, 2) mk_fwd(Args args) {
    extern __shared__ __attribute__((aligned(16))) unsigned char lds[];
    for (int u = threadIdx.x; u < (LDS_BYTES - LDSCTL_OFF) / 4; u += NTHREADS) ((LAS unsigned*)((LAS unsigned char*)lds + LDSCTL_OFF))[u] = 0u;
    __syncthreads();
    constexpr bool multi = (PH_MASK & (PH_MASK - 1u)) != 0u;
    if (multi) xcd_barrier_post((unsigned*)(args.ws + WS_CTL) + CW_BAR);
#define IN(k) ((PH_MASK >> (k)) & 1u)
#define GBAR() xcd_barrier((unsigned*)(args.ws + WS_CTL) + CW_BAR, (volatile LAS unsigned*)((LAS unsigned char*)lds + MISC_OFF) + 8)
#define PH(k, ...) if (IN(k)) { __VA_ARGS__ } if (IN(k) && ((PROBE_DBL >> (k)) & 1u)) { GBAR(); __VA_ARGS__ } if (IN(k) && (k) + 1 < N_PHASES && IN((k) + 1)) GBAR();
#define SEAM(k) do { if (IN(k) && IN((k) + 1)) xcd_barrier((unsigned*)(args.ws + WS_CTL) + CW_BAR, (volatile LAS unsigned*)((LAS unsigned char*)lds + MISC_OFF) + 8); } while (0)
#define RING ((LAS unsigned char*)lds)
#define TAB ((LAS int*)((LAS unsigned char*)lds + TAB_OFF))

    PH(0, Frame F = make_frame(args, lds); ph_prep(F);
    )
    PH(1, Frame F = make_frame(args, lds); ph_taps(F); if (PROBE_SUB & 16u) ph_taps(F); ph_hb(F); if (PROBE_SUB & 32u) ph_hb(F);
    )
    PH(2,
        { pg8::DenseSched S; S.init(T, N1A, DM, gridDim.x, (int)blockIdx.x, args.ws + WS_WIN);
          pg8::EpiInA E{(bf16_t*)(args.ws + WS_Q), (bf16_t*)(args.ws + WS_K), (bf16_t*)(args.ws + WS_V), (bf16_t*)(args.ws + WS_GA)};
          pg8::gemm_phase<pg8::EpiInA, pg8::DenseSched, true>(RING, args.ws + WS_HB, DM, S, E); }
        { pg8::DenseSched S; S.init(NHY, T, DM, gridDim.x, (int)blockIdx.x, args.ws + WS_HB);
          pg8::EpiBf16 E{(bf16_t*)(args.ws + WS_UT), T};
          pg8::gemm_phase<pg8::EpiBf16, pg8::DenseSched, true>(RING, args.ws + WS_WIN + (size_t)N1A * DM * 2, DM, S, E); }
    )
    PH(3, Frame F = make_frame(args, lds); ph_attn(F); if (PROBE_SUB & 1u) ph_attn(F); ph_hyena_fft(F); if (PROBE_SUB & 2u) ph_hyena_fft(F);
    )
    PH(4, Frame F = make_frame(args, lds); ph_hyT(F);
    )
    PH(5,
        pg8::DenseSched S; S.init(T, DM, DM, gridDim.x, (int)blockIdx.x, args.ws + WS_WAH);
        pg8::EpiMerge E{(const bf16_t*)(args.ws + WS_GA), (bf16_t*)(args.ws + WS_HB)};
        pg8::gemm_phase<pg8::EpiMerge, pg8::DenseSched, true>(RING, args.ws + WS_AH, DM, S, E);
    )
    PH(7,
        { pg8::DenseSched S; S.init(T, DM, DM, gridDim.x, (int)blockIdx.x, args.ws + WS_WO);
          pg8::EpiY E{(const float*)(args.ws + WS_MOD) + 2048, (bf16_t*)(args.ws + WS_Y1)};
          pg8::gemm_phase<pg8::EpiY, pg8::DenseSched, true>(RING, args.ws + WS_HB, DM, S, E);
          if (PROBE_SUB & 4u) pg8::gemm_phase<pg8::EpiY, pg8::DenseSched, true>(RING, args.ws + WS_HB, DM, S, E);
          if (PROBE_SUB & 64u) { pg8::EpiNull EN; pg8::gemm_phase<pg8::EpiNull, pg8::DenseSched, true>(RING, args.ws + WS_HB, DM, S, EN); } }
        { Frame F = make_frame(args, lds); ph_expert_cvt(F); if (PROBE_SUB & 8u) ph_expert_cvt(F); }
    )
    PH(8, Frame F = make_frame(args, lds); ph_ln1_route(F);
    )
    PH(9,
        { Frame F = make_frame(args, lds); build_moe_tab(F, TAB); }
        const int G = gridDim.x, bx = blockIdx.x, vcu = (G % 8 == 0) ? (bx % 8) * (G / 8) + bx / 8 : bx;
        pg8::MoeSched<true> S{TAB, (const int*)(args.ws + WS_BTOK), (const char*)(args.ws + WS_W13), (size_t)DM * DM * 2, G, vcu, DM};
        pg8::EpiSwiGLU E{(bf16_t*)(args.ws + WS_HACT)};
        pg8::gemm_phase<pg8::EpiSwiGLU, pg8::MoeSched<true>, true>(RING, args.ws + WS_HB, DM, S, E);
    )
    PH(10,
        { Frame F = make_frame(args, lds); build_moe_tab(F, TAB); }
        const int G = gridDim.x, bx = blockIdx.x, vcu = (G % 8 == 0) ? (bx % 8) * (G / 8) + bx / 8 : bx;
        pg8::MoeSched<false> S{TAB, (const int*)(args.ws + WS_BTOK), (const char*)(args.ws + WS_W2), (size_t)DM * DE * 2, G, vcu, DE};
        pg8::EpiScatter E{(bf16_t*)(args.ws + WS_Y2), (const int*)(args.ws + WS_BTOK), (const float*)(args.ws + WS_BW), TAB};
        pg8::gemm_phase<pg8::EpiScatter, pg8::MoeSched<false>, true>(RING, args.ws + WS_HACT, DE, S, E);
    )
    PH(11, Frame F = make_frame(args, lds); ph_final(F);
    )
#undef IN
#undef SEAM
#undef GBAR
#undef PH
#undef RING
#undef TAB
}

extern "C" void kernel_launch(void* const* d_in, const int* in_sizes, int n_in, void* d_out, int out_size, void* d_ws, size_t ws_size, hipStream_t stream) {
    static int grid = 0;
    if (grid == 0) {
        if (n_in != 31 || out_size != T * DM || ws_size < WS_END) { fprintf(stderr, "kernel_launch: unexpected shapes: n_in %d out %d ws %zu (need %zu)\n", n_in, out_size, ws_size, (size_t)WS_END); grid = -1; return; }
        int dev = 0, cus = 0;
        if (hipGetDevice(&dev) != hipSuccess || hipDeviceGetAttribute(&cus, hipDeviceAttributeMultiprocessorCount, dev) != hipSuccess) { grid = -1; return; }
        bool ok = true;
#define SET_ATTR(m) ok = ok && (hipFuncSetAttribute((const void*)mk_fwd<(m)>, hipFuncAttributeMaxDynamicSharedMemorySize, LDS_BYTES) == hipSuccess)
#if MK_N_LAUNCHES == 1
        SET_ATTR(FUSED_MASK);
#else
        { SET_ATTR(1u << 0); SET_ATTR(1u << 1); SET_ATTR(1u << 2); SET_ATTR(1u << 3); SET_ATTR(1u << 4); SET_ATTR(1u << 5); SET_ATTR(1u << 6); SET_ATTR(1u << 7); SET_ATTR(1u << 8); SET_ATTR(1u << 9); SET_ATTR(1u << 10); SET_ATTR(1u << 11); }
#endif
#undef SET_ATTR
        if (!ok) { fprintf(stderr, "kernel_launch: hipFuncSetAttribute failed\n"); grid = -1; return; }
        (void)hipGetLastError();
        grid = cus;
    }
    if (grid < 0) return;
    if (hipMemsetAsync((char*)d_ws + WS_CTL, 0, CTL_ZERO_BYTES, stream) != hipSuccess) return;
    Args a{};
    for (int i = 0; i < 31; ++i) a.in[i] = (const float*)d_in[i];
    a.out = (float*)d_out; a.ws = (unsigned char*)d_ws;
#if MK_N_LAUNCHES == 1
    a.ph_lo = 0; a.ph_hi = N_PHASES; hipLaunchKernelGGL(mk_fwd<FUSED_MASK>, dim3(grid), dim3(NTHREADS), LDS_BYTES, stream, a);
#else
    {
#define LAUNCH_PH(p) do { a.ph_lo = (p); a.ph_hi = (p) + 1; for (int rep_ = 0; rep_ < (((PROBE_DBL >> (p)) & 1u) ? 2 : 1); ++rep_) hipLaunchKernelGGL(mk_fwd<(1u << (p))>, dim3(grid), dim3(NTHREADS), LDS_BYTES, stream, a); } while (0)
        LAUNCH_PH(0); LAUNCH_PH(1); LAUNCH_PH(2); LAUNCH_PH(3); LAUNCH_PH(4); LAUNCH_PH(5); LAUNCH_PH(6); LAUNCH_PH(7); LAUNCH_PH(8); LAUNCH_PH(9); LAUNCH_PH(10); LAUNCH_PH(11);
#undef LAUNCH_PH
    }
#endif
}
```

```cpp
#include <hip/hip_runtime.h>
#include <cstdio>
#include <cstdint>

#ifndef PROBE_DBL
#define PROBE_DBL 0u
#endif
#ifndef PROBE_SUB
#define PROBE_SUB 0u
#endif
#ifndef PROBE_HY
#define PROBE_HY 0u
#endif
#ifndef FUSED_MASK
#define FUSED_MASK 0xFFFu
#endif
#ifndef MK_N_LAUNCHES
#define MK_N_LAUNCHES 1
#endif

#define GAS __attribute__((address_space(1)))
#define LAS __attribute__((address_space(3)))
typedef unsigned short bf16_t;
typedef short bf16x8 __attribute__((ext_vector_type(8)));
typedef float f32x4 __attribute__((ext_vector_type(4)));
typedef float f32x2 __attribute__((ext_vector_type(2)));
typedef unsigned u32x4 __attribute__((ext_vector_type(4)));
typedef unsigned u32x2 __attribute__((ext_vector_type(2)));

constexpr int NB = 4, SEQ = 8192, DM = 1024, T = NB * SEQ;
constexpr int AW = 512, KVW = 128, HW = 512, INW = 4352, N1A = 2816, NHY = 1536;
constexpr int NE = 64, DE = 512, ECAP = 32768;
constexpr int NFILT = 2048, FH = 64, FEMB = 33;
constexpr float LN_EPS = 1e-5f;
constexpr float DN_ALPHA = 1.189207115002721f;
constexpr int NTHREADS = 512, NWAVES = 8;

constexpr size_t MiB = 1u << 20;
constexpr size_t WS_CTL = 0, CTL_ZERO_BYTES = 1 * MiB;
constexpr size_t WS_MODP = 1 * MiB, WS_MOD = 3 * MiB, WS_HDN = 4 * MiB, WS_WRT = 6 * MiB, WS_WIN = 7 * MiB;
constexpr size_t WS_WAH = 16 * MiB, WS_WO = 18 * MiB, WS_BTOK = 20 * MiB, WS_BW = 28 * MiB;
constexpr size_t WS_HB = 36 * MiB;
constexpr size_t WS_Q = 100 * MiB, WS_K = 132 * MiB, WS_V = 140 * MiB, WS_GA = 148 * MiB, WS_GH = 212 * MiB;
constexpr size_t WS_UT = 276 * MiB, WS_TMP = 276 * MiB;
constexpr size_t WS_AH = 372 * MiB;
constexpr size_t WS_HYT = 500 * MiB;
constexpr size_t WS_W13 = 100 * MiB, WS_W2 = 228 * MiB, WS_HACT = 404 * MiB, WS_Y2 = 36 * MiB, WS_END = 532 * MiB;
constexpr size_t WS_FTAB = 15 * MiB + 524288;
constexpr size_t WS_TWT = 15 * MiB + 524288 + 73728;
constexpr size_t WS_KHAT = 36 * MiB;
constexpr size_t WS_GT = 436 * MiB;
constexpr size_t WS_Y1 = 340 * MiB;
constexpr size_t WS_H2LO = 436 * MiB;
constexpr size_t WS_KRAW = 468 * MiB;
constexpr size_t WS_KPART = 6 * MiB + 524288;  constexpr size_t WS_HDNB = WS_HDN;
constexpr int CW_BAR = 4096, CW_CNT = 8192;

constexpr int RING_BYTES = 131072, LDS_BYTES = 163840, LDSCTL_OFF = LDS_BYTES - 2048, MISC_OFF = LDSCTL_OFF + 320, TAB_OFF = LDSCTL_OFF + 1024;

#define LDS_WAIT() asm volatile("s_waitcnt lgkmcnt(0)" ::: "memory")
#define VM_WAIT() asm volatile("s_waitcnt vmcnt(0)" ::: "memory")
typedef __bf16 bf16x2_hw __attribute__((ext_vector_type(2)));
__device__ __forceinline__ unsigned pk2(float lo, float hi) { f32x2 v = {lo, hi}; bf16x2_hw b = __builtin_convertvector(v, bf16x2_hw); return __builtin_bit_cast(unsigned, b); }
__device__ __forceinline__ unsigned f2bf(float f) { return pk2(f, 0.f) & 0xffffu; }
__device__ __forceinline__ float bf2f(unsigned short b) { return __builtin_bit_cast(float, (unsigned)b << 16); }
__device__ __forceinline__ float bflo(unsigned w) { return __builtin_bit_cast(float, w << 16); }
__device__ __forceinline__ float bfhi(unsigned w) { return __builtin_bit_cast(float, w & 0xffff0000u); }
__device__ __forceinline__ float sigmoidf_(float x) { return __builtin_amdgcn_rcpf(1.0f + __expf(-x)); }
__device__ __forceinline__ float wave_sum(float v) {
#pragma unroll
    for (int o = 1; o < 64; o <<= 1) v += __shfl_xor(v, o);
    return v;
}

namespace pg8 {
constexpr int BM = 256, BK = 64, HALF = 128, HTB = HALF * BK * 2, STAGE_BYTES = 8 * HTB, NXCD = 8, WGM = 8;
__host__ __device__ __forceinline__ int lds_byte(int r, int c) { const int st = (r >> 4) * 2 + (c >> 5), rr = r & 15, cc = c & 31, ob = rr * 64 + cc * 2; return st * 1024 + (ob ^ (((ob >> 9) & 1) << 5)); }
__host__ __device__ __forceinline__ void stage_rc(int b, int& R, int& C) { const int st = b / 1024, sb = b % 1024, swz = sb ^ (((sb >> 9) & 1) << 5); R = (st >> 1) * 16 + swz / 64; C = (st & 1) * 32 + (swz % 64) / 2; }
__host__ __device__ __forceinline__ int perm32(int rho) { const int n = rho >> 4, i = rho & 15; return 8 * (i >> 2) + 4 * n + (i & 3); }

struct Unit { int pm, pn, e, mt, li; };

struct DenseSched {
    static constexpr bool GATHER = false;
    int nM, nN, nwg, G, c, K; const char* Bt;
    __device__ void init(int M, int N, int K_, int G_, int c_, const void* Bt_) { nM = M / BM; nN = N / BM; nwg = nM * nN; G = G_; c = c_; K = K_; Bt = (const char*)Bt_; }
    __device__ bool next(int i, Unit& u) const {
        const long L = (long)i * G + c; if (L >= nwg) return false;
        int wgid = (int)L; { const int q = nwg / NXCD, r = nwg % NXCD, xcd = wgid % NXCD, off = wgid / NXCD; wgid = (xcd < r ? xcd * (q + 1) : r * (q + 1) + (xcd - r) * q) + off; }
        const int nig = WGM * nN, gid = wgid / nig, fm = gid * WGM, gsz = (nM - fm) < WGM ? (nM - fm) : WGM;
        u.pm = fm + ((wgid % nig) % gsz); u.pn = (wgid % nig) / gsz; u.e = 0; u.mt = 0; u.li = 0; return true;
    }
    __device__ __forceinline__ unsigned arow(const Unit& u, int r) const { return (unsigned)(u.pm * BM + r); }
    __device__ __forceinline__ const char* bptr(const Unit& u) const { return Bt + (size_t)u.pn * BM * K * 2; }
};

constexpr int MOE_MAXU = 6;
template <bool GATHER_> struct MoeSched {
    static constexpr bool GATHER = GATHER_;
    const LAS int* tab;
    const LAS int* ulist;
    const LAS int* rowtab;
    const char* Bt; size_t estride; int K;
    __device__ bool next(int i, Unit& u) const {
        if (i >= MOE_MAXU || ulist[4 * i + 3] == 0) return false;
        u.e = ulist[4 * i]; u.mt = ulist[4 * i + 1]; u.pm = ulist[4 * i + 2]; u.pn = ulist[4 * i + 3] - 1; u.li = i; return true;
    }
    __device__ __forceinline__ unsigned arow(const Unit& u, int r) const {
        if (!GATHER_) return (unsigned)(u.pm * BM + r);
        return (unsigned)rowtab[u.li * 256 + r];
    }
    __device__ __forceinline__ const char* bptr(const Unit& u) const { return Bt + (size_t)u.e * estride + (size_t)u.pn * BM * K * 2; }
};

template <class Epi, class Sched, bool ALIGN_EPI>
__device__ __forceinline__ void gemm_phase(LAS unsigned char* lds, const void* Abase, const int K, const Sched& S, const Epi& E) {
    int tid = threadIdx.x; asm volatile("" : "+v"(tid));
    const int wid = __builtin_amdgcn_readfirstlane(tid >> 6), lane = tid & 63, wr = wid >> 2, wc = wid & 3, fr = lane & 15, fq = lane >> 4;
    const int nt = K / BK;
    int Rr[2], Cc[2]; unsigned voffB[2];
#pragma unroll
    for (int i = 0; i < 2; ++i) { stage_rc(tid * 16 + i * 8192, Rr[i], Cc[i]);
        const int Rb = Epi::BMAP == 2 ? (64 * (Rr[i] >> 5) + perm32(Rr[i] & 31)) : ((Rr[i] & ~31) + perm32(Rr[i] & 31)); voffB[i] = (unsigned)(Rb * K + Cc[i]) * 2u; }
    const size_t kstep = (size_t)(BK * 2);
    const size_t hstep = (size_t)HALF * K * 2;
    const size_t bhs = (size_t)(Epi::BMAP == 2 ? 32 : HALF) * K * 2;
    LAS unsigned char* const stg = lds + RING_BYTES + wid * 2304;
    const unsigned ldsw = (unsigned)wid * 1024u;
    const int aoff = lds_byte(wr * 64 + fr, fq * 8), boff = lds_byte(wc * 32 + fr, fq * 8);
#define PG8_SA(b, h) (((b) * 2 + (h)) * HTB)
#define PG8_SB(b, h) ((4 + (b) * 2 + (h)) * HTB)
#define PG8_STAGE(bufoff, gbase, voff) do { _Pragma("unroll") for (int _i = 0; _i < 2; ++_i) \
        __builtin_amdgcn_global_load_lds((const unsigned*)((const char*)(gbase) + (voff)[_i]), (LAS unsigned*)(lds + (bufoff) + ldsw + _i * 8192), 16, 0, 0); } while (0)
#define PG8_LDA(dst, b, h) do { _Pragma("unroll") for (int m = 0; m < 4; ++m) _Pragma("unroll") for (int k = 0; k < 2; ++k) dst[m][k] = *(const LAS bf16x8*)(lds + PG8_SA(b, h) + aoff + m * 2048 + k * 1024); } while (0)
#define PG8_LDB(dst, b, h) do { _Pragma("unroll") for (int n = 0; n < 2; ++n) _Pragma("unroll") for (int k = 0; k < 2; ++k) dst[n][k] = *(const LAS bf16x8*)(lds + PG8_SB(b, h) + boff + n * 2048 + k * 1024); } while (0)
#define PG8_MMA(ai, bj, At, Bt) do { __builtin_amdgcn_s_setprio(1); _Pragma("unroll") for (int m = 0; m < 4; ++m) _Pragma("unroll") for (int n = 0; n < 2; ++n) _Pragma("unroll") for (int k = 0; k < 2; ++k) \
        acc[ai][bj][m][n] = __builtin_amdgcn_mfma_f32_16x16x32_bf16(Bt[n][k], At[m][k], acc[ai][bj][m][n], 0, 0, 0); __builtin_amdgcn_s_setprio(0); } while (0)
#define PG8_WAIT_V(n) asm volatile("s_waitcnt vmcnt(" #n ")" ::: "memory")
#define PG8_WAIT_L(n) asm volatile("s_waitcnt lgkmcnt(" #n ")" ::: "memory")
#define PG8_BAR __builtin_amdgcn_s_barrier()
#define PG8_SCHED __builtin_amdgcn_sched_barrier(0)
    Unit cur, nxt; int ui = 0;
    if (!S.next(0, cur)) return;
    f32x4 acc[2][2][4][2];
#pragma unroll
    for (int a = 0; a < 2; ++a)
#pragma unroll
        for (int b = 0; b < 2; ++b)
#pragma unroll
            for (int m = 0; m < 4; ++m)
#pragma unroll
                for (int n = 0; n < 2; ++n) acc[a][b][m][n] = (f32x4){0.f, 0.f, 0.f, 0.f};
    bf16x8 At[4][2], B0[2][2], B1[2][2];
    constexpr bool GATHER = Sched::GATHER;
    unsigned cv0[2], cv1[2], nv0[2], nv1[2];
#pragma unroll
    for (int i = 0; i < 2; ++i) {
        if constexpr (GATHER) { cv0[i] = (S.arow(cur, Rr[i]) * (unsigned)K + (unsigned)Cc[i]) * 2u; cv1[i] = (S.arow(cur, HALF + Rr[i]) * (unsigned)K + (unsigned)Cc[i]) * 2u; }
        else { cv0[i] = (unsigned)(Rr[i] * K + Cc[i]) * 2u; cv1[i] = cv0[i]; nv0[i] = cv0[i]; nv1[i] = cv0[i]; }
    }
    const char* cA = GATHER ? (const char*)Abase : (const char*)Abase + (size_t)S.arow(cur, 0) * K * 2;
    const size_t ahs = GATHER ? 0 : hstep;
    const char* cB = S.bptr(cur);
    PG8_STAGE(PG8_SB(0, 0), cB, voffB); PG8_STAGE(PG8_SB(0, 1), cB + bhs, voffB); PG8_STAGE(PG8_SA(0, 0), cA, cv0); PG8_STAGE(PG8_SA(0, 1), cA + ahs, cv1);
    if (wr == 1) PG8_BAR;
    PG8_WAIT_V(2); PG8_BAR;
    PG8_STAGE(PG8_SB(1, 0), cB + kstep, voffB); PG8_STAGE(PG8_SA(1, 0), cA + kstep, cv0); PG8_STAGE(PG8_SB(1, 1), cB + bhs + kstep, voffB);
    PG8_WAIT_V(6); PG8_BAR;
    for (;;) {
        const bool has_next = S.next(ui + 1, nxt);
        const char* nB = has_next ? S.bptr(nxt) : cB;
        const char* nA = cA;
        if constexpr (GATHER) {
#pragma unroll
            for (int i = 0; i < 2; ++i) {
                nv0[i] = has_next ? (S.arow(nxt, Rr[i]) * (unsigned)K + (unsigned)Cc[i]) * 2u : cv0[i];
                nv1[i] = has_next ? (S.arow(nxt, HALF + Rr[i]) * (unsigned)K + (unsigned)Cc[i]) * 2u : cv1[i];
            }
        } else { if (has_next) nA = (const char*)Abase + (size_t)S.arow(nxt, 0) * K * 2; }
        for (int t = 0; t < nt; t += 2) {
            const bool last = (t == nt - 2);
            if constexpr (Epi::HAS_MID) { if (t == (nt >> 1)) E.mid(acc, cur, wr, wc, fr, fq); }
            const char* a1 = cA + (size_t)(t + 1) * kstep;
            const char* a2 = last ? nA : cA + (size_t)(t + 2) * kstep; const char* b2 = last ? nB : cB + (size_t)(t + 2) * kstep;
            const char* a3 = a2 + kstep; const char* b3 = b2 + kstep;
            unsigned x0[2], x1[2];
#pragma unroll
            for (int i = 0; i < 2; ++i) { x0[i] = (GATHER && last) ? nv0[i] : cv0[i]; x1[i] = (GATHER && last) ? nv1[i] : cv1[i]; }
            PG8_LDB(B0, 0, 0); PG8_LDB(B1, 0, 1); PG8_SCHED; PG8_LDA(At, 0, 0); PG8_STAGE(PG8_SA(1, 1), a1 + ahs, cv1);
            PG8_WAIT_V(8); PG8_WAIT_L(0); PG8_BAR; PG8_MMA(0, 0, At, B0); PG8_MMA(0, 1, At, B1); PG8_BAR; PG8_SCHED;
            PG8_LDA(At, 0, 1); PG8_STAGE(PG8_SB(0, 0), b2, voffB); PG8_STAGE(PG8_SB(0, 1), b2 + bhs, voffB); PG8_STAGE(PG8_SA(0, 0), a2, x0);
            PG8_WAIT_V(8); PG8_WAIT_L(0); PG8_BAR; PG8_MMA(1, 0, At, B0); PG8_MMA(1, 1, At, B1); PG8_BAR; PG8_SCHED;
            PG8_LDB(B0, 1, 0); PG8_LDB(B1, 1, 1); PG8_SCHED; PG8_LDA(At, 1, 0); PG8_STAGE(PG8_SA(0, 1), a2 + ahs, x1);
            PG8_WAIT_V(8); PG8_WAIT_L(0); PG8_BAR; PG8_MMA(0, 0, At, B0); PG8_MMA(0, 1, At, B1); PG8_BAR; PG8_SCHED;
            PG8_LDA(At, 1, 1); PG8_STAGE(PG8_SB(1, 0), b3, voffB); PG8_STAGE(PG8_SB(1, 1), b3 + bhs, voffB); PG8_STAGE(PG8_SA(1, 0), a3, x0);
            PG8_WAIT_V(8); PG8_WAIT_L(0); PG8_BAR; PG8_MMA(1, 0, At, B0); PG8_MMA(1, 1, At, B1); PG8_BAR; PG8_SCHED;
        }
        if constexpr (ALIGN_EPI) { if (wr == 0) PG8_BAR; }
        E(acc, cur, wr, wc, fr, fq, stg, lane);
        if (!has_next) break;
#pragma unroll
        for (int a = 0; a < 2; ++a)
#pragma unroll
            for (int b = 0; b < 2; ++b)
#pragma unroll
                for (int m = 0; m < 4; ++m)
#pragma unroll
                    for (int n = 0; n < 2; ++n) acc[a][b][m][n] = (f32x4){0.f, 0.f, 0.f, 0.f};
        cur = nxt; cB = nB; cA = nA; ++ui;
        if constexpr (GATHER) {
#pragma unroll
            for (int i = 0; i < 2; ++i) { cv0[i] = nv0[i]; cv1[i] = nv1[i]; }
        }
        if constexpr (ALIGN_EPI) { if (wr == 1) PG8_BAR; }
    }
    PG8_WAIT_V(0);
    if constexpr (!ALIGN_EPI) { if (wr == 0) PG8_BAR; }
    PG8_BAR;
#undef PG8_SA
#undef PG8_SB
#undef PG8_STAGE
#undef PG8_LDA
#undef PG8_LDB
#undef PG8_MMA
#undef PG8_WAIT_V
#undef PG8_WAIT_L
#undef PG8_BAR
#undef PG8_SCHED
}

__device__ __forceinline__ u32x4 pack8(const f32x4 v0, const f32x4 v1) { u32x4 w; w.x = pk2(v0[0], v0[1]); w.y = pk2(v0[2], v0[3]); w.z = pk2(v1[0], v1[1]); w.w = pk2(v1[2], v1[3]); return w; }
template <class RowPtr, class RowOk>
__device__ __forceinline__ void staged_store(LAS unsigned char* stg, int lane, const u32x4 p0, const u32x4 p1, const RowPtr& rp, const RowOk& ok) {
    const int fr = lane & 15, fq = lane >> 4;
    *(LAS u32x4*)(stg + fr * 144 + fq * 16) = p0; *(LAS u32x4*)(stg + fr * 144 + 64 + fq * 16) = p1;
    const int r = lane >> 3, ch = lane & 7;
    const u32x4 a = *(LAS const u32x4*)(stg + r * 144 + ch * 16), b = *(LAS const u32x4*)(stg + (r + 8) * 144 + ch * 16);
    if (ok(r)) *(u32x4*)(rp(r) + ch * 8) = a;
    if (ok(r + 8)) *(u32x4*)(rp(r + 8) + ch * 8) = b;
}
struct AlwaysOk { __device__ __forceinline__ bool operator()(int) const { return true; } };
struct DenseRows { bf16_t* base; size_t ld; __device__ __forceinline__ bf16_t* operator()(int r) const { return base + (size_t)r * ld; } };

struct EpiInA {
    static constexpr int BMAP = 2; static constexpr bool HAS_MID = false;
    bf16_t *Q, *Kb, *Vb, *RS;
    __device__ __forceinline__ void operator()(const f32x4 (&acc)[2][2][4][2], const Unit& u, int wr, int wc, int fr, int fq, LAS unsigned char* stg, int lane) const {
        const int row0 = u.pm * BM + wr * 64;
        if (u.pn < 3) {
            bf16_t* base; size_t ld;
            if (u.pn < 2) { base = Q + u.pn * 256 + wc * 64; ld = AW; } else { base = (wc < 2 ? Kb : Vb) + (wc & 1) * 64; ld = KVW; }
#pragma unroll
            for (int ai = 0; ai < 2; ++ai)
#pragma unroll
                for (int m = 0; m < 4; ++m)
                    staged_store(stg, lane, pack8(acc[ai][0][m][0], acc[ai][0][m][1]), pack8(acc[ai][1][m][0], acc[ai][1][m][1]), DenseRows{base + (size_t)(row0 + ai * HALF + m * 16) * ld, ld}, AlwaysOk{});
        } else {
            bf16_t* base = RS + (u.pn - 3) * 256 + wc * 64;
#pragma unroll
            for (int ai = 0; ai < 2; ++ai)
#pragma unroll
                for (int m = 0; m < 4; ++m) {
                    f32x4 r0, r1, s0, s1;
#pragma unroll
                    for (int j = 0; j < 4; ++j) {
                        const float ea0 = __expf(-acc[ai][0][m][0][j]), eh0 = __expf(-acc[ai][1][m][0][j]), ea1 = __expf(-acc[ai][0][m][1][j]), eh1 = __expf(-acc[ai][1][m][1][j]);
                        s0[j] = __builtin_amdgcn_rcpf(1.0f + eh0); s1[j] = __builtin_amdgcn_rcpf(1.0f + eh1); r0[j] = (1.0f + eh0) * __builtin_amdgcn_rcpf(1.0f + ea0); r1[j] = (1.0f + eh1) * __builtin_amdgcn_rcpf(1.0f + ea1); }
                    staged_store(stg, lane, pack8(r0, r1), pack8(s0, s1), DenseRows{base + (size_t)(row0 + ai * HALF + m * 16) * 2048, 2048}, AlwaysOk{});
                }
        }
    }
};
struct EpiBf16 {
    static constexpr int BMAP = 2; static constexpr bool HAS_MID = false;
    bf16_t* O; int ldc;
    __device__ __forceinline__ void operator()(const f32x4 (&acc)[2][2][4][2], const Unit& u, int wr, int wc, int fr, int fq, LAS unsigned char* stg, int lane) const {
        bf16_t* base = O + (size_t)(u.pm * BM + wr * 64) * ldc + u.pn * BM + wc * 64;
#pragma unroll
        for (int ai = 0; ai < 2; ++ai)
#pragma unroll
            for (int m = 0; m < 4; ++m)
                staged_store(stg, lane, pack8(acc[ai][0][m][0], acc[ai][0][m][1]), pack8(acc[ai][1][m][0], acc[ai][1][m][1]), DenseRows{base + (size_t)(ai * HALF + m * 16) * ldc, (size_t)ldc}, AlwaysOk{});
    }
};
struct EpiMerge {
    static constexpr int BMAP = 2; static constexpr bool HAS_MID = true;
    const bf16_t* RS; bf16_t* O;
    __device__ __forceinline__ void mid(f32x4 (&acc)[2][2][4][2], const Unit& u, int wr, int wc, int fr, int fq) const {
        asm volatile("" : "+v"(fr), "+v"(fq));
        const int row0 = u.pm * BM + wr * 64 + fr;
#pragma unroll
        for (int ai = 0; ai < 2; ++ai)
#pragma unroll
            for (int mh = 0; mh < 2; ++mh) {
                u32x4 g[2][2];
#pragma unroll
                for (int mm = 0; mm < 2; ++mm)
#pragma unroll
                    for (int bj = 0; bj < 2; ++bj) g[mm][bj] = *(const u32x4*)(RS + (size_t)(row0 + ai * HALF + (2 * mh + mm) * 16) * 2048 + (8 * u.pn + 2 * wc + bj) * 64 + 8 * fq);
#pragma unroll
                for (int mm = 0; mm < 2; ++mm)
#pragma unroll
                    for (int bj = 0; bj < 2; ++bj) { const int m = 2 * mh + mm; const u32x4 gg = g[mm][bj];
                        acc[ai][bj][m][0][0] *= bflo(gg.x); acc[ai][bj][m][0][1] *= bfhi(gg.x); acc[ai][bj][m][0][2] *= bflo(gg.y); acc[ai][bj][m][0][3] *= bfhi(gg.y);
                        acc[ai][bj][m][1][0] *= bflo(gg.z); acc[ai][bj][m][1][1] *= bfhi(gg.z); acc[ai][bj][m][1][2] *= bflo(gg.w); acc[ai][bj][m][1][3] *= bfhi(gg.w); }
                asm volatile("" ::: "memory");
            }
    }
    __device__ __forceinline__ void operator()(const f32x4 (&acc)[2][2][4][2], const Unit& u, int wr, int wc, int fr, int fq, LAS unsigned char* stg, int lane) const {
        const int row0 = u.pm * BM + wr * 64;
        bf16_t* base = O + (size_t)row0 * DM + u.pn * BM + wc * 64;
#pragma unroll
        for (int ai = 0; ai < 2; ++ai)
#pragma unroll
            for (int m = 0; m < 4; ++m) {
                u32x4 pk[2];
#pragma unroll
                for (int bj = 0; bj < 2; ++bj) {
                    const u32x4 g = *(const u32x4*)(RS + (size_t)(row0 + fr + ai * HALF + m * 16) * 2048 + (8 * u.pn + 2 * wc + bj) * 64 + 32 + 8 * fq);
                    f32x4 v0 = acc[ai][bj][m][0], v1 = acc[ai][bj][m][1];
                    v0[0] *= bflo(g.x); v0[1] *= bfhi(g.x); v0[2] *= bflo(g.y); v0[3] *= bfhi(g.y);
                    v1[0] *= bflo(g.z); v1[1] *= bfhi(g.z); v1[2] *= bflo(g.w); v1[3] *= bfhi(g.w);
                    pk[bj] = pack8(v0, v1);
                }
                staged_store(stg, lane, pk[0], pk[1], DenseRows{base + (size_t)(ai * HALF + m * 16) * DM, DM}, AlwaysOk{});
            }
    }
};
struct EpiY {
    static constexpr int BMAP = 2; static constexpr bool HAS_MID = false;
    const float* gate; bf16_t* O;
    __device__ __forceinline__ void operator()(const f32x4 (&acc)[2][2][4][2], const Unit& u, int wr, int wc, int fr, int fq, LAS unsigned char* stg, int lane) const {
        const int col0 = u.pn * BM + wc * 64; const int b = (u.pm * BM) / SEQ;
        const float* gp = gate + (size_t)b * 6144 + col0 + 8 * fq;
        const f32x4 g00 = *(const f32x4*)gp, g01 = *(const f32x4*)(gp + 4), g10 = *(const f32x4*)(gp + 32), g11 = *(const f32x4*)(gp + 36);
        bf16_t* base = O + (size_t)(u.pm * BM + wr * 64) * DM + col0;
#pragma unroll
        for (int ai = 0; ai < 2; ++ai)
#pragma unroll
            for (int m = 0; m < 4; ++m)
                staged_store(stg, lane, pack8(acc[ai][0][m][0] * g00, acc[ai][0][m][1] * g01), pack8(acc[ai][1][m][0] * g10, acc[ai][1][m][1] * g11), DenseRows{base + (size_t)(ai * HALF + m * 16) * DM, DM}, AlwaysOk{});
    }
};
struct EpiNull {
    static constexpr int BMAP = 2; static constexpr bool HAS_MID = false;
    __device__ __forceinline__ void operator()(const f32x4 (&acc)[2][2][4][2], const Unit& u, int wr, int wc, int fr, int fq, LAS unsigned char* stg, int lane) const {
#pragma unroll
        for (int ai = 0; ai < 2; ++ai)
#pragma unroll
            for (int bj = 0; bj < 2; ++bj)
#pragma unroll
                for (int m = 0; m < 4; ++m) asm volatile("" :: "v"(acc[ai][bj][m][0]), "v"(acc[ai][bj][m][1]));
    }
};
struct EpiSwiGLU {
    static constexpr int BMAP = 1; static constexpr bool HAS_MID = false;
    bf16_t* H;
    __device__ __forceinline__ void operator()(const f32x4 (&acc)[2][2][4][2], const Unit& u, int wr, int wc, int fr, int fq, LAS unsigned char* stg, int lane) const {
        const int row0 = u.pm * BM + wr * 64 + fr; const int col0 = u.pn * HALF + wc * 32 + 8 * fq;
#pragma unroll
        for (int ai = 0; ai < 2; ++ai)
#pragma unroll
            for (int m = 0; m < 4; ++m) {
                f32x4 v0, v1;
#pragma unroll
                for (int j = 0; j < 4; ++j) { const float a0 = acc[ai][0][m][0][j], a1 = acc[ai][0][m][1][j];
                    v0[j] = a0 * sigmoidf_(a0) * acc[ai][1][m][0][j]; v1[j] = a1 * sigmoidf_(a1) * acc[ai][1][m][1][j]; }
                *(u32x4*)(H + (size_t)(row0 + ai * HALF + m * 16) * DE + col0) = pack8(v0, v1);
            }
    }
};
struct EpiScatter {
    static constexpr int BMAP = 2; static constexpr bool HAS_MID = false;
    bf16_t* Y2; const LAS int* rowtab; const LAS float* wtab;
    struct Rows { bf16_t* base; int d0, d1; __device__ __forceinline__ bf16_t* operator()(int r) const { return base + (size_t)(r < 8 ? d0 : d1) * DM; } };
    struct Oks { bool o0, o1; __device__ __forceinline__ bool operator()(int r) const { return r < 8 ? o0 : o1; } };
    __device__ __forceinline__ void operator()(const f32x4 (&acc)[2][2][4][2], const Unit& u, int wr, int wc, int fr, int fq, LAS unsigned char* stg, int lane) const {
        bf16_t* base = Y2 + u.pn * BM + wc * 64;
        const LAS int* rt = rowtab + u.li * 256; const LAS float* wt = wtab + u.li * 256;
#pragma unroll
        for (int ai = 0; ai < 2; ++ai)
#pragma unroll
            for (int m = 0; m < 4; ++m) {
                const int g0 = ai * HALF + wr * 64 + m * 16;
                const float w = wt[g0 + fr]; const int d0 = rt[g0 + (lane >> 3)], d1 = rt[g0 + (lane >> 3) + 8];
                staged_store(stg, lane, pack8(acc[ai][0][m][0] * w, acc[ai][0][m][1] * w), pack8(acc[ai][1][m][0] * w, acc[ai][1][m][1] * w), Rows{base, d0 < 0 ? 0 : d0, d1 < 0 ? 0 : d1}, Oks{d0 >= 0, d1 >= 0});
            }
    }
};
}

#define XB_TMO      128
#define XB_XCNT(j)  (256  + 64 * (j))
#define XB_XSUB(j)  (1280 + 64 * (j))
#define XB_XGEN(j)  (2304 + 64 * (j))
#define XB_TOP      3328
#define XB_TOPGEN   3392
#define XCD_BAR_WORDS 3456
#define XB_SPIN_CAP (1u << 22)
__device__ __forceinline__ unsigned xb_ld(unsigned* p)              { return __hip_atomic_load(p, __ATOMIC_RELAXED, __HIP_MEMORY_SCOPE_AGENT); }
__device__ __forceinline__ unsigned xb_add(unsigned* p, unsigned v) { return __hip_atomic_fetch_add(p, v, __ATOMIC_RELAXED, __HIP_MEMORY_SCOPE_AGENT); }
__device__ __forceinline__ unsigned xb_xcc_id() { return (unsigned)__builtin_amdgcn_s_getreg((3 << 11) | 20) & 0xFu; }
#define XB_SPIN(cond, bar) do { unsigned _sp = 0; while (cond) { __builtin_amdgcn_s_sleep(1); \
    if ((++_sp & 255u) == 0u) { if (xb_ld(&(bar)[XB_TMO])) break; if (_sp > XB_SPIN_CAP) { atomicAdd(&(bar)[XB_TMO], 1u); break; } } } } while (0)
__device__ __forceinline__ void xcd_barrier_post(unsigned* bar) { if (threadIdx.x == 0) (void)xb_add(&bar[XB_XCNT(xb_xcc_id())], 1u); }
__device__ __forceinline__ void xcd_barrier_complete(unsigned* bar, unsigned x, unsigned& nloc, unsigned& nx) {
    const unsigned G = gridDim.x * gridDim.y * gridDim.z;
    unsigned sum, cnt, mine, sp = 0u;
    for (;;) {
        sum = 0u; cnt = 0u; mine = 0u;
#pragma unroll
        for (unsigned j = 0; j < 16; ++j) { const unsigned c = xb_ld(&bar[XB_XCNT(j)]); sum += c; cnt += (c > 0u) ? 1u : 0u; mine = (j == x) ? c : mine; }
        if (sum == G) break;
        __builtin_amdgcn_s_sleep(1);
        if ((++sp & 255u) == 0u) { if (xb_ld(&bar[XB_TMO])) break; if (sp > XB_SPIN_CAP) { atomicAdd(&bar[XB_TMO], 1u); break; } }
    }
    nloc = mine > 0u ? mine : 1u; nx = cnt > 0u ? cnt : 1u;
}
__device__ __forceinline__ void xcd_barrier(unsigned* bar, volatile LAS unsigned* st) {
    asm volatile("s_waitcnt vmcnt(0)" ::: "memory");
    __syncthreads();
    if (threadIdx.x == 0) {
        const unsigned x = xb_xcc_id();
        __builtin_amdgcn_s_waitcnt(0);
        unsigned nloc = st[0], nx = st[1];
        if (nloc == 0u) { xcd_barrier_complete(bar, x, nloc, nx); st[0] = nloc; st[1] = nx; }
        const unsigned old = xb_add(&bar[XB_XSUB(x)], 1u);
        const unsigned gen = old / nloc;
        if (old + 1u == (gen + 1u) * nloc) {
            __builtin_amdgcn_fence(__ATOMIC_RELEASE, "agent");
            asm volatile("s_waitcnt vmcnt(0)" ::: "memory");
            const unsigned og = xb_add(&bar[XB_TOP], 1u);
            const unsigned tg = og / nx;
            if (og + 1u == (tg + 1u) * nx) xb_add(&bar[XB_TOPGEN], 1u);
            else XB_SPIN(xb_ld(&bar[XB_TOPGEN]) == tg, bar);
            __builtin_amdgcn_fence(__ATOMIC_ACQUIRE, "agent");
            xb_add(&bar[XB_XGEN(x)], 1u);
            asm volatile("s_waitcnt vmcnt(0)" ::: "memory");
        } else {
            XB_SPIN(xb_ld(&bar[XB_XGEN(x)]) == gen, bar);
            __builtin_amdgcn_fence(__ATOMIC_ACQUIRE, "agent");
            asm volatile("s_waitcnt vmcnt(0)" ::: "memory");
        }
    }
    __syncthreads();
}

struct Args { const float* in[31]; float* out; unsigned char* ws; int ph_lo, ph_hi; };
struct Frame {
    LAS unsigned char* lds; unsigned char* ws; unsigned* ctl;
    int tid, lane, wave, vcu, G;
    const float* const* in; float* out;
};
enum { I_X = 0, I_C, I_WADA, I_BADA, I_WIN, I_CONVW, I_CONVB, I_FW1, I_FB1, I_FF1, I_FW2, I_FB2, I_FF2, I_FW3, I_DECAY, I_SKIP, I_WHY, I_WATT, I_SINK, I_WOUT,
       I_LN1G, I_LN1B, I_RGW, I_RGB, I_REW, I_REB, I_EW1, I_EW3, I_EW2, I_LN2G, I_LN2B };

__device__ __forceinline__ void transpose_item(const float* W, int K, int N, bf16_t* WT, int ldt, int drow0, LAS float* scr, int kb, int nb, int lane) {
    const int k0 = 64 * kb, n0 = 32 * nb;
#pragma unroll 8
    for (int i = 0; i < 32; ++i) { const int kk = 2 * i + (lane >> 5); scr[kk * 33 + (lane & 31)] = W[(size_t)(k0 + kk) * N + n0 + (lane & 31)]; }
    LDS_WAIT(); asm volatile("" ::: "memory");
    const int c = lane & 7;
#pragma unroll
    for (int j = 0; j < 4; ++j) { const int n = (lane >> 3) + 8 * j; const LAS float* s = scr + (8 * c) * 33 + n;
        u32x4 o; o.x = pk2(s[0 * 33], s[1 * 33]); o.y = pk2(s[2 * 33], s[3 * 33]); o.z = pk2(s[4 * 33], s[5 * 33]); o.w = pk2(s[6 * 33], s[7 * 33]);
        *(u32x4*)(WT + (size_t)(drow0 + n) * ldt + k0 + 8 * c) = o; }
    LDS_WAIT(); asm volatile("" ::: "memory");
}

__device__ __forceinline__ void ph_prep(Frame& F) {
    const float* c = F.in[I_C]; const float* wada = F.in[I_WADA];
    float* modp = (float*)(F.ws + WS_MODP);
    for (int it = blockIdx.x; it < 192; it += F.G) {
        const int kc = it / 12, cg = it % 12, j = cg * 512 + F.tid;
        float a0 = 0.f, a1 = 0.f, a2 = 0.f, a3 = 0.f;
        for (int kk = 0; kk < 64; ++kk) { const int k = kc * 64 + kk; const float w = wada[(size_t)k * 6144 + j];
            const float c0 = c[k], c1 = c[1024 + k], c2 = c[2048 + k], c3 = c[3072 + k];
            a0 += c0 * sigmoidf_(c0) * w; a1 += c1 * sigmoidf_(c1) * w; a2 += c2 * sigmoidf_(c2) * w; a3 += c3 * sigmoidf_(c3) * w; }
        modp[(size_t)(kc * 4 + 0) * 6144 + j] = a0; modp[(size_t)(kc * 4 + 1) * 6144 + j] = a1; modp[(size_t)(kc * 4 + 2) * 6144 + j] = a2; modp[(size_t)(kc * 4 + 3) * 6144 + j] = a3;
    }
    LAS float* scr = (LAS float*)(F.lds + F.wave * 16384);
    const int gw = F.vcu * NWAVES + F.wave, NGW = F.G * NWAVES;
    constexpr int I_IN = 16 * 136, I_A = 8 * 32, I_H = 8 * 32, I_O = 16 * 32;
    for (int it = gw; it < I_IN + I_A + I_H + I_O; it += NGW) {
        int r = it;
        if (r < I_IN) { const int kb = r / 136, nb = r % 136, n0 = nb * 32;
            int drow;
            if (n0 < 768) drow = n0; else if (n0 < 2304) drow = N1A + (n0 - 768);
            else if (n0 < 3328) { const int d = n0 - 2304; drow = 768 + (d >> 5) * 64; }
            else { const int d = n0 - 3328; drow = 768 + (d >> 5) * 64 + 32; }
            transpose_item(F.in[I_WIN], DM, INW, (bf16_t*)(F.ws + WS_WIN), DM, drow, scr, kb, nb, F.lane); continue; } r -= I_IN;
        if (r < I_A) { transpose_item(F.in[I_WATT], AW, DM, (bf16_t*)(F.ws + WS_WAH), DM, (r % 32) * 32, scr, r / 32, r % 32, F.lane); continue; } r -= I_A;
        if (r < I_H) { transpose_item(F.in[I_WHY], HW, DM, (bf16_t*)(F.ws + WS_WAH) + AW, DM, (r % 32) * 32, scr, r / 32, r % 32, F.lane); continue; } r -= I_H;
        transpose_item(F.in[I_WOUT], DM, DM, (bf16_t*)(F.ws + WS_WO), DM, (r % 32) * 32, scr, r / 32, r % 32, F.lane);
    }
    {
        const float* w1 = F.in[I_FW1]; const float* b1 = F.in[I_FB1]; const float* f1 = F.in[I_FF1];
        const float* w2 = F.in[I_FW2]; const float* b2 = F.in[I_FB2]; const float* f2 = F.in[I_FF2];
        const int j = F.lane;
        for (int t = gw; t < SEQ; t += NGW) {
            const float tl = (float)t / (float)(SEQ - 1);
            const float w = 6.283185307179586f * (float)t / (float)SEQ;
            float zi = 0.f;
            if (j == 0) zi = tl;
            else if (j <= 16) { const float band = 1e-4f + (float)(j - 1) * ((15.0f - 1e-4f) / 15.0f); zi = cosf(band * w); }
            else if (j <= 32) { const float band = 1e-4f + (float)(j - 17) * ((15.0f - 1e-4f) / 15.0f); zi = -sinf(band * w); }
            float a = b1[j];
#pragma unroll
            for (int i = 0; i < FEMB; ++i) a += __shfl(zi, i) * w1[i * FH + j];
            const float h1 = sinf(f1[j] * a);
            float a2 = b2[j];
#pragma unroll
            for (int i = 0; i < FH; ++i) a2 += __shfl(h1, i) * w2[i * FH + j];
            ((bf16_t*)(F.ws + WS_HDNB))[(size_t)t * FH + j] = (bf16_t)f2bf(sinf(f2[j] * a2));
        }
    }
    {
        bf16_t* ftab = (bf16_t*)(F.ws + WS_FTAB); unsigned* twt = (unsigned*)(F.ws + WS_TWT);
        for (int i = blockIdx.x * NTHREADS + F.tid; i < 2 * 128 * 128; i += F.G * NTHREADS) {
            const int t = i >> 14, row = (i >> 7) & 127, q = i & 127;
            const int q15 = q & 15, h = q15 >> 3, j = q15 & 7; const int nat = (q & ~15) + 8 * (j >> 2) + 4 * h + (j & 3);
            const int e = (row * nat) & 127; const float x = (float)e * (2.0f / 128.0f);
            const float v = t == 0 ? cospif(x) : -sinpif(x);
            ftab[(size_t)t * (128 * 136) + row * 136 + q] = (bf16_t)f2bf(v);
        }
        for (int i = blockIdx.x * NTHREADS + F.tid; i < 16 * 64 * 16; i += F.G * NTHREADS) {
            const int r = i & 15, l = (i >> 4) & 63, ab = i >> 10, al = ab >> 2, be = ab & 3;
            const int e = ((32 * al + ((r & 3) + 8 * (r >> 2) + 4 * (l >> 5))) * (32 * be + (l & 31))) & 16383; const float x = (float)e * (2.0f / 16384.0f);
            twt[i] = pk2(cospif(x), -sinpif(x));
        }
    }
    {
        bf16_t* wr = (bf16_t*)(F.ws + WS_WRT); const float* wg = F.in[I_RGW]; const float* we = F.in[I_REW];
        for (int i = blockIdx.x * NTHREADS + F.tid; i < 80 * DM; i += F.G * NTHREADS) { const int o = i / DM, k = i % DM;
            const float w = o < 8 ? wg[k * 8 + o] : (o < 72 ? we[k * 64 + (o - 8)] : 0.f);
            const unsigned hi = f2bf(w); const float lo = w - bf2f((unsigned short)hi);
            wr[i] = (bf16_t)hi; wr[80 * DM + i] = (bf16_t)f2bf(lo); }
    }
}

__device__ __forceinline__ void ph_taps(Frame& F) {
    typedef float f32x16 __attribute__((ext_vector_type(16)));
    const bf16_t* hb = (const bf16_t*)(F.ws + WS_HDNB); const float* w3 = F.in[I_FW3]; const float* decay = F.in[I_DECAY];
    bf16_t* kraw = (bf16_t*)(F.ws + WS_KRAW); float* kpart = (float*)(F.ws + WS_KPART);
    const int lane = F.lane, lr = lane & 31, lh = lane >> 5;
    for (int it = blockIdx.x; it < 256; it += F.G) {
        const int g = it & 63, tq = it >> 6;
        bf16x8 aW[4];
#pragma unroll
        for (int s = 0; s < 4; ++s) { unsigned pk[4];
#pragma unroll
            for (int j2 = 0; j2 < 4; ++j2) { const int k = 16 * s + 8 * lh + 2 * j2; pk[j2] = pk2(w3[(size_t)k * NFILT + 32 * g + lr], w3[(size_t)(k + 1) * NFILT + 32 * g + lr]); }
            aW[s] = __builtin_bit_cast(bf16x8, (u32x4){pk[0], pk[1], pk[2], pk[3]}); }
        float dcy[16], asum[16];
#pragma unroll
        for (int r = 0; r < 16; ++r) { dcy[r] = fabsf(decay[32 * g + (r & 3) + 8 * (r >> 2) + 4 * lh]); asum[r] = 0.f; }
#pragma unroll 1
        for (int tt = 0; tt < 8; ++tt) {
            const int t = 2048 * tq + 32 * (F.wave * 8 + tt) + lr;
            f32x16 acc;
#pragma unroll
            for (int r = 0; r < 16; ++r) acc[r] = 0.f;
#pragma unroll
            for (int s = 0; s < 4; ++s) { const bf16x8 bH = *(const bf16x8*)(hb + (size_t)t * FH + 16 * s + 8 * lh); acc = __builtin_amdgcn_mfma_f32_32x32x16_bf16(aW[s], bH, acc, 0, 0, 0); }
            const float tl = (float)t / (float)(SEQ - 1);
#pragma unroll
            for (int r = 0; r < 16; ++r) { const float v = acc[r] * (__expf(-tl * dcy[r]) + 0.05f); asum[r] += fabsf(v);
                kraw[(size_t)(32 * g + (r & 3) + 8 * (r >> 2) + 4 * lh) * SEQ + t] = (bf16_t)f2bf(v); }
        }
#pragma unroll
        for (int r = 0; r < 16; ++r) { float v = asum[r];
#pragma unroll
            for (int o = 1; o < 32; o <<= 1) v += __shfl_xor(v, o);
            if (lr == 0) kpart[(size_t)(32 * g + (r & 3) + 8 * (r >> 2) + 4 * lh) * 32 + tq * 8 + F.wave] = v; }
    }
}

__device__ __forceinline__ void ph_hb(Frame& F) {
    const float* modp = (const float*)(F.ws + WS_MODP); const float* bada = F.in[I_BADA];
    float* mod = (float*)(F.ws + WS_MOD);
    for (int i = blockIdx.x * NTHREADS + F.tid; i < NB * 6144; i += F.G * NTHREADS) { const int b = i / 6144, j = i % 6144; float s = bada[j];
        for (int kc = 0; kc < 16; ++kc) s += modp[(size_t)(kc * 4 + b) * 6144 + j];
        mod[i] = s; }
    LAS float* sc = (LAS float*)F.lds; LAS float* sh = sc + DM;
    const float* x = F.in[I_X]; bf16_t* hb = (bf16_t*)(F.ws + WS_HB);
    for (int ch = blockIdx.x; ch < T / 128; ch += F.G) {
        const int b = (ch * 128) / SEQ;
        __syncthreads();
        for (int j = F.tid; j < 2 * DM; j += NTHREADS) { float s = bada[j];
            for (int kc = 0; kc < 16; ++kc) s += modp[(size_t)(kc * 4 + b) * 6144 + j];
            if (j < DM) sh[j] = s; else sc[j - DM] = 1.0f + s; }
        __syncthreads();
        for (int r0 = F.wave * 4; r0 < 128; r0 += NWAVES * 4) {
            f32x4 xv[4][4];
#pragma unroll
            for (int r = 0; r < 4; ++r) { const f32x4* xr = (const f32x4*)(x + ((size_t)ch * 128 + r0 + r) * DM) + F.lane;
#pragma unroll
                for (int j = 0; j < 4; ++j) xv[r][j] = xr[64 * j]; }
#pragma unroll
            for (int r = 0; r < 4; ++r) { unsigned long long* o8 = (unsigned long long*)(hb + ((size_t)ch * 128 + r0 + r) * DM) + F.lane;
#pragma unroll
                for (int j = 0; j < 4; ++j) { const f32x4 v = xv[r][j]; const int k = 4 * F.lane + 256 * j;
                    const float h0 = v[0] * sc[k] + sh[k], h1 = v[1] * sc[k + 1] + sh[k + 1], h2 = v[2] * sc[k + 2] + sh[k + 2], h3 = v[3] * sc[k + 3] + sh[k + 3];
                    o8[64 * j] = (unsigned long long)pk2(h0, h1) | ((unsigned long long)pk2(h2, h3) << 32); } }
        }
    }
    __syncthreads();
}

namespace at {
typedef float f32x16 __attribute__((ext_vector_type(16)));
typedef __bf16 bf16x2_t __attribute__((ext_vector_type(2)));
constexpr int KROWB = 144, VROWB = 784, K_OFF = 0, V_OFF = 384 * KROWB;
__device__ __forceinline__ unsigned cvtpk(float lo, float hi) { f32x2 v = {lo, hi}; bf16x2_t b = __builtin_convertvector(v, bf16x2_t); return __builtin_bit_cast(unsigned, b); }
template <int S> __device__ __forceinline__ bf16x8 pack_step(const f32x16& x) {
    u32x4 p; p.x = cvtpk(x[8 * S], x[8 * S + 1]); p.y = cvtpk(x[8 * S + 2], x[8 * S + 3]); p.z = cvtpk(x[8 * S + 4], x[8 * S + 5]); p.w = cvtpk(x[8 * S + 6], x[8 * S + 7]);
    return __builtin_bit_cast(bf16x8, p);
}
__device__ __forceinline__ int kst(int k) { const int c = k & 15; return (k & ~15) + 8 * ((c >> 2) & 1) + 4 * (c >> 3) + (c & 3); }
}
__device__ __forceinline__ void ph_attn(Frame& F) {
    using namespace at;
    const bf16_t* Q = (const bf16_t*)(F.ws + WS_Q); const bf16_t* Kb = (const bf16_t*)(F.ws + WS_K); const bf16_t* Vb = (const bf16_t*)(F.ws + WS_V);
    bf16_t* O = (bf16_t*)(F.ws + WS_AH); const float* sink = F.in[I_SINK];
    LAS unsigned char* Ks = F.lds + K_OFF; LAS unsigned char* Vs = F.lds + V_OFF;
    const int wid = F.wave;
    constexpr float LOG2E = 1.4426950408889634f;
    for (int unit = blockIdx.x; unit < NB * 2 * 64; unit += F.G) {
        const int qb = unit & 63, kvh = (unit >> 6) & 1, b = unit >> 7;
        int tid = F.tid; asm volatile("" : "+v"(tid));
        const int lane = tid & 63, lr = lane & 31, lh = lane >> 5;
        __syncthreads();
#pragma unroll 1
        for (int i = 0; i < 6; ++i) {
            const int ci = tid + 512 * i, j = ci >> 3, p = ci & 7; const int kpos = qb * 128 - 128 + j;
            u32x4 kv = (u32x4){0u, 0u, 0u, 0u}, vv = kv;
            if (kpos >= 0 && kpos < SEQ) { const size_t off = ((size_t)b * SEQ + kpos) * KVW + kvh * 64 + p * 8; kv = *(const u32x4*)(Kb + off); vv = *(const u32x4*)(Vb + off); }
            *(LAS u32x4*)(Ks + j * KROWB + p * 16) = kv;
            LAS unsigned char* vp = Vs + (p * 8) * VROWB + kst(j) * 2;
            *(LAS bf16_t*)(vp) = (bf16_t)vv.x; *(LAS bf16_t*)(vp + VROWB) = (bf16_t)(vv.x >> 16);
            *(LAS bf16_t*)(vp + 2 * VROWB) = (bf16_t)vv.y; *(LAS bf16_t*)(vp + 3 * VROWB) = (bf16_t)(vv.y >> 16);
            *(LAS bf16_t*)(vp + 4 * VROWB) = (bf16_t)vv.z; *(LAS bf16_t*)(vp + 5 * VROWB) = (bf16_t)(vv.z >> 16);
            *(LAS bf16_t*)(vp + 6 * VROWB) = (bf16_t)vv.w; *(LAS bf16_t*)(vp + 7 * VROWB) = (bf16_t)(vv.w >> 16);
        }
        __syncthreads();
        const int g = wid >> 1, h = kvh * 4 + g, uh = wid & 1;
        const float slope2 = exp2f(-(float)(h + 1)) * LOG2E, c1 = 0.125f * LOG2E, m0 = sink[h] * LOG2E;
        const float d0 = (float)(4 * lh - lr);
#pragma unroll 1
        for (int ut = 0; ut < 2; ++ut) {
            const int u = 2 * uh + ut; const size_t trow = (size_t)b * SEQ + qb * 128 + 32 * u + lr;
            bf16x8 qf[4];
#pragma unroll
            for (int s4 = 0; s4 < 4; ++s4) qf[s4] = *(const bf16x8*)(Q + trow * AW + h * 64 + 16 * s4 + 8 * lh);
            f32x16 Ot[2];
#pragma unroll
            for (int r = 0; r < 16; ++r) { Ot[0][r] = 0.f; Ot[1][r] = 0.f; }
            float m = m0, l = lh == 0 ? 1.0f : 0.0f;
            int kt0 = u, kt1 = u + 8; if (qb == 0 && kt0 < 4) kt0 = 4; if (qb == 63 && kt1 > 7) kt1 = 7;
#pragma unroll 1
            for (int kt = kt0; kt <= kt1; ++kt) {
                f32x16 St;
#pragma unroll
                for (int r = 0; r < 16; ++r) St[r] = 0.f;
                LAS const unsigned char* kp = Ks + (32 * kt + lr) * KROWB + lh * 16;
#pragma unroll
                for (int s4 = 0; s4 < 4; ++s4) St = __builtin_amdgcn_mfma_f32_32x32x16_bf16(*(LAS const bf16x8*)(kp + 32 * s4), qf[s4], St, 0, 0, 0);
                const float base = (float)(32 * (kt - u) - 128) + d0; const bool edge = (kt == u) || (kt == u + 8);
                float tmax = -INFINITY;
#pragma unroll
                for (int r = 0; r < 16; ++r) { const float rel = fabsf(base + (float)((r & 3) + 8 * (r >> 2)));
                    float sv = St[r] * c1 - slope2 * rel; if (edge && rel > 128.0f) sv = -INFINITY; St[r] = sv; tmax = fmaxf(tmax, sv); }
                tmax = fmaxf(tmax, __shfl_xor(tmax, 32));
                const float mn = fmaxf(m, tmax), scl = __builtin_amdgcn_exp2f(m - mn); m = mn; l *= scl;
#pragma unroll
                for (int r = 0; r < 16; ++r) { Ot[0][r] *= scl; Ot[1][r] *= scl; }
#pragma unroll
                for (int r = 0; r < 16; ++r) { const float p = __builtin_amdgcn_exp2f(St[r] - mn); l += p; St[r] = p; }
                const bf16x8 pf0 = pack_step<0>(St), pf1 = pack_step<1>(St);
                LAS const unsigned char* vp = Vs + lr * VROWB + (32 * kt + 8 * lh) * 2;
#pragma unroll
                for (int dt = 0; dt < 2; ++dt) {
                    Ot[dt] = __builtin_amdgcn_mfma_f32_32x32x16_bf16(*(LAS const bf16x8*)(vp + dt * 32 * VROWB), pf0, Ot[dt], 0, 0, 0);
                    Ot[dt] = __builtin_amdgcn_mfma_f32_32x32x16_bf16(*(LAS const bf16x8*)(vp + dt * 32 * VROWB + 32), pf1, Ot[dt], 0, 0, 0);
                }
            }
            l += __shfl_xor(l, 32);
            const float il = 1.0f / l;
            bf16_t* op = O + trow * DM + h * 64 + 4 * lh;
#pragma unroll
            for (int dt = 0; dt < 2; ++dt)
#pragma unroll
                for (int gq = 0; gq < 4; ++gq)
                    *(u32x2*)(op + 32 * dt + 8 * gq) = (u32x2){cvtpk(Ot[dt][4 * gq] * il, Ot[dt][4 * gq + 1] * il), cvtpk(Ot[dt][4 * gq + 2] * il, Ot[dt][4 * gq + 3] * il)};
        }
    }
    __syncthreads();
}

__device__ __forceinline__ float block_sum(Frame& F, float v, LAS float* red) {
    v = wave_sum(v);
    __syncthreads();
    if (F.lane == 0) red[F.wave] = v;
    __syncthreads();
    float s = 0.f;
#pragma unroll
    for (int i = 0; i < NWAVES; ++i) s += red[i];
    return s;
}

typedef short v4i16_t __attribute__((ext_vector_type(4)));
__device__ __forceinline__ u32x2 lds_tr4(LAS const unsigned char* p) { return __builtin_bit_cast(u32x2, __builtin_amdgcn_ds_read_tr16_b64_v4i16((LAS v4i16_t*)p)); }
namespace hy {
typedef float f32x16 __attribute__((ext_vector_type(16)));
typedef __bf16 bf16x2_t __attribute__((ext_vector_type(2)));
constexpr int ROWB = 272, TABB = 128 * ROWB, DROWB = 528, FT_OFF = 0, X_OFF = 2 * TABB, SP_OFF = 4 * TABB;
#define HY_SBAR() do { asm volatile("" ::: "memory"); __builtin_amdgcn_sched_barrier(0); } while (0)
#define MFMA32(a, b, c) __builtin_amdgcn_mfma_f32_32x32x16_bf16((a), (b), (c), 0, 0, 0)
__device__ __forceinline__ int crow(int r, int h) { return (r & 3) + 8 * (r >> 2) + 4 * h; }
__device__ __forceinline__ int q16(int c) { return 8 * ((c >> 2) & 1) + 4 * (c >> 3) + (c & 3); }
__device__ __forceinline__ int kstore(int k) { return (k & ~15) + q16(k & 15); }
__device__ __forceinline__ unsigned cvtpk(float lo, float hi) { f32x2 v = {lo, hi}; bf16x2_t b = __builtin_convertvector(v, bf16x2_t); return __builtin_bit_cast(unsigned, b); }
__device__ __forceinline__ bf16x8 neg8(bf16x8 v) { u32x4 u = __builtin_bit_cast(u32x4, v); u.x ^= 0x80008000u; u.y ^= 0x80008000u; u.z ^= 0x80008000u; u.w ^= 0x80008000u; return __builtin_bit_cast(bf16x8, u); }
template <int S> __device__ __forceinline__ bf16x8 pack_step(const f32x16& x) {
    u32x4 p; p.x = cvtpk(x[8 * S], x[8 * S + 1]); p.y = cvtpk(x[8 * S + 2], x[8 * S + 3]); p.z = cvtpk(x[8 * S + 4], x[8 * S + 5]); p.w = cvtpk(x[8 * S + 6], x[8 * S + 7]);
    return __builtin_bit_cast(bf16x8, p);
}
__device__ __forceinline__ bf16x8 ffrag(LAS const unsigned char* ft, int t, int rb, int s, int lr, int lh) {
    return *(LAS const bf16x8*)(ft + (lr * ROWB + lh * 16) + (t * TABB + rb * 32 * ROWB + 32 * s)); }
__device__ __forceinline__ bf16x8 xfrag(LAS const unsigned char* img, int rb, int cs, int lr, int lh) {
    return *(LAS const bf16x8*)(img + (lr * ROWB + lh * 16) + (rb * 32 * ROWB + 16 * cs)); }
__device__ __forceinline__ bf16x8 dfrag(LAS const unsigned char* img, int rb, int cs, int lr, int lh) {
    return *(LAS const bf16x8*)(img + (lr * DROWB + lh * 16) + (rb * 32 * DROWB + 16 * cs)); }
__device__ __forceinline__ void zero16(f32x16& x) {
#pragma unroll
    for (int r = 0; r < 16; ++r) x[r] = 0.f; }
struct ctile { u32x4 q[4]; };
__device__ __forceinline__ ctile load_ctile(const unsigned* w  ) { ctile t;
#pragma unroll
    for (int i = 0; i < 4; ++i) t.q[i] = *(const u32x4*)(w + 4 * i);
    return t; }
template <bool CONJ> __device__ __forceinline__ void cmul_tile(f32x16& xr, f32x16& xi, const ctile& t) {
#pragma unroll
    for (int i = 0; i < 4; ++i) { const unsigned w[4] = {t.q[i].x, t.q[i].y, t.q[i].z, t.q[i].w};
#pragma unroll
        for (int u = 0; u < 4; ++u) { const int r = 4 * i + u; const float wr = bflo(w[u]), wi = CONJ ? -bfhi(w[u]) : bfhi(w[u]);
            const float a = xr[r], b = xi[r]; xr[r] = a * wr - b * wi; xi[r] = a * wi + b * wr; } }
}
template <bool CPLX, int NK>
__device__ __forceinline__ void s1_tw(LAS const unsigned char* ft, LAS const unsigned char* img, const unsigned* twt, int J, int lane, bf16x8 (&bAr)[8], bf16x8 (&bAi)[8]) {
    const int lr = lane & 31, lh = lane >> 5;
#pragma unroll
    for (int hf = 0; hf < 2; ++hf) {
        const ctile tw0 = load_ctile(twt + ((size_t)(((2 * hf) * 4 + J) * 64 + lane)) * 16), tw1 = load_ctile(twt + ((size_t)(((2 * hf + 1) * 4 + J) * 64 + lane)) * 16);
        f32x16 Ar[2], Ai[2];
#pragma unroll
        for (int i = 0; i < 2; ++i) { zero16(Ar[i]); zero16(Ai[i]); }
#pragma unroll
        for (int s = 0; s < NK; ++s) {
            const bf16x8 bFr = ffrag(ft, 0, J, s, lr, lh), bFi = ffrag(ft, 1, J, s, lr, lh), bnFi = neg8(bFi);
#pragma unroll
            for (int i = 0; i < 2; ++i) {
                const bf16x8 aXr = xfrag(img, 2 * hf + i, 2 * s, lr, lh);
                Ar[i] = MFMA32(aXr, bFr, Ar[i]); Ai[i] = MFMA32(aXr, bFi, Ai[i]);
                if (CPLX) { const bf16x8 aXi = xfrag(img, 2 * hf + i, 8 + 2 * s, lr, lh); Ar[i] = MFMA32(aXi, bnFi, Ar[i]); Ai[i] = MFMA32(aXi, bFr, Ai[i]); }
            }
            HY_SBAR();
        }
#pragma unroll
        for (int i = 0; i < 2; ++i) { const int ig = 2 * hf + i;
            cmul_tile<false>(Ar[i], Ai[i], i == 0 ? tw0 : tw1);
            bAr[2 * ig] = pack_step<0>(Ar[i]); bAr[2 * ig + 1] = pack_step<1>(Ar[i]); bAi[2 * ig] = pack_step<0>(Ai[i]); bAi[2 * ig + 1] = pack_step<1>(Ai[i]);
            HY_SBAR();
        }
    }
}
__device__ __forceinline__ void s3_half(LAS const unsigned char* ft, const bf16x8 (&bAr)[8], const bf16x8 (&bAi)[8], int Ih, int lane, f32x16 (&Zr)[2], f32x16 (&Zi)[2]) {
    const int lr = lane & 31, lh = lane >> 5;
#pragma unroll
    for (int I = 0; I < 2; ++I) { zero16(Zr[I]); zero16(Zi[I]); }
#pragma unroll
    for (int s = 0; s < 8; ++s) {
        const bf16x8 bnAi = neg8(bAi[s]);
#pragma unroll
        for (int I = 0; I < 2; ++I) {
            const bf16x8 aFr = ffrag(ft, 0, 2 * Ih + I, s, lr, lh), aFi = ffrag(ft, 1, 2 * Ih + I, s, lr, lh);
            Zr[I] = MFMA32(aFr, bAr[s], Zr[I]); Zr[I] = MFMA32(aFi, bnAi, Zr[I]);
            Zi[I] = MFMA32(aFi, bAr[s], Zi[I]); Zi[I] = MFMA32(aFr, bAi[s], Zi[I]);
        }
        HY_SBAR();
    }
}
__device__ __forceinline__ void fwd_filter(LAS const unsigned char* ft, LAS const unsigned char* img, const unsigned* twt, int J, int lane, float scl, float sk, unsigned* kh  ) {
    bf16x8 bAr[8], bAi[8];
    s1_tw<false, 8>(ft, img, twt, J, lane, bAr, bAi);
#pragma unroll
    for (int Ih = 0; Ih < 2; ++Ih) {
        f32x16 Zr[2], Zi[2];
        s3_half(ft, bAr, bAi, Ih, lane, Zr, Zi);
#pragma unroll
        for (int I = 0; I < 2; ++I) { unsigned* dst = kh + ((size_t)((2 * Ih + I) * 64 + lane)) * 16;
#pragma unroll
            for (int r4 = 0; r4 < 4; ++r4) *(u32x4*)(dst + 4 * r4) = (u32x4){cvtpk(Zr[I][4 * r4] * scl + sk, Zi[I][4 * r4] * scl), cvtpk(Zr[I][4 * r4 + 1] * scl + sk, Zi[I][4 * r4 + 1] * scl),
                                                                              cvtpk(Zr[I][4 * r4 + 2] * scl + sk, Zi[I][4 * r4 + 2] * scl), cvtpk(Zr[I][4 * r4 + 3] * scl + sk, Zi[I][4 * r4 + 3] * scl)}; }
        HY_SBAR();
    }
}
__device__ __forceinline__ void s3_filt_i1(LAS const unsigned char* ft, const unsigned* khat  , const unsigned* twt, int J, int lane, const bf16x8 (&bAr)[8], const bf16x8 (&bAi)[8], u32x2 (&dpk)[4][2][4]) {
    const int lr = lane & 31, lh = lane >> 5;
    bf16x8 aYr[8], aYi[8];
#pragma unroll
    for (int Ih = 0; Ih < 2; ++Ih) {
        const ctile k0 = load_ctile(khat + ((size_t)((2 * Ih) * 64 + lane)) * 16);
        f32x16 Zr[2], Zi[2];
        s3_half(ft, bAr, bAi, Ih, lane, Zr, Zi);
        const ctile k1 = load_ctile(khat + ((size_t)((2 * Ih + 1) * 64 + lane)) * 16);
#pragma unroll
        for (int I = 0; I < 2; ++I) { const int Ig = 2 * Ih + I;
            cmul_tile<false>(Zr[I], Zi[I], I == 0 ? k0 : k1);
            aYr[2 * Ig] = pack_step<0>(Zr[I]); aYr[2 * Ig + 1] = pack_step<1>(Zr[I]); aYi[2 * Ig] = pack_step<0>(Zi[I]); aYi[2 * Ig + 1] = pack_step<1>(Zi[I]);
            HY_SBAR();
        }
    }
#pragma unroll
    for (int ch = 0; ch < 2; ++ch) {
        const ctile tw0 = load_ctile(twt + ((size_t)((J * 4 + 2 * ch) * 64 + lane)) * 16);
        f32x16 Cr[2], Ci[2];
#pragma unroll
        for (int c = 0; c < 2; ++c) { zero16(Cr[c]); zero16(Ci[c]); }
#pragma unroll
        for (int s = 0; s < 8; ++s) {
            const bf16x8 anYr = neg8(aYr[s]);
#pragma unroll
            for (int c = 0; c < 2; ++c) {
                const bf16x8 bFr = ffrag(ft, 0, 2 * ch + c, s, lr, lh), bFi = ffrag(ft, 1, 2 * ch + c, s, lr, lh);
                Cr[c] = MFMA32(aYr[s], bFr, Cr[c]); Cr[c] = MFMA32(aYi[s], bFi, Cr[c]);
                Ci[c] = MFMA32(anYr, bFi, Ci[c]); Ci[c] = MFMA32(aYi[s], bFr, Ci[c]);
            }
            HY_SBAR();
        }
        const ctile tw1 = load_ctile(twt + ((size_t)((J * 4 + 2 * ch + 1) * 64 + lane)) * 16);
#pragma unroll
        for (int c = 0; c < 2; ++c) { const int cg = 2 * ch + c;
            cmul_tile<true>(Cr[c], Ci[c], c == 0 ? tw0 : tw1);
#pragma unroll
            for (int g = 0; g < 4; ++g) {
                dpk[cg][0][g] = (u32x2){cvtpk(Cr[c][4 * g], Cr[c][4 * g + 1]), cvtpk(Cr[c][4 * g + 2], Cr[c][4 * g + 3])};
                dpk[cg][1][g] = (u32x2){cvtpk(Ci[c][4 * g], Ci[c][4 * g + 1]), cvtpk(Ci[c][4 * g + 2], Ci[c][4 * g + 3])};
            }
            HY_SBAR();
        }
    }
}
__device__ __forceinline__ void write_D(LAS unsigned char* dimg, const u32x2 (&dpk)[4][2][4], int J, int lane) {
    const int lr = lane & 31, lh = lane >> 5;
    LAS unsigned char* base = dimg + lr * DROWB + lh * 16 + J * 64;
#pragma unroll
    for (int c = 0; c < 4; ++c)
#pragma unroll
        for (int g = 0; g < 4; ++g) {
            *(LAS u32x2*)(base + c * 32 * DROWB + 32 * (g >> 1) + 8 * (g & 1)) = dpk[c][0][g];
            *(LAS u32x2*)(base + c * 32 * DROWB + 256 + 32 * (g >> 1) + 8 * (g & 1)) = dpk[c][1][g]; }
}
__device__ __forceinline__ void i3_wave(LAS const unsigned char* ft, LAS const unsigned char* dimg, int a, int c, int lane, f32x16& yr, f32x16& yi) {
    const int lr = lane & 31, lh = lane >> 5;
    zero16(yr); zero16(yi);
#pragma unroll
    for (int s = 0; s < 8; ++s) {
        const bf16x8 aFr = ffrag(ft, 0, a, s, lr, lh), aFi = ffrag(ft, 1, a, s, lr, lh), anFi = neg8(aFi);
        const bf16x8 bDr = dfrag(dimg, c, 2 * s, lr, lh), bDi = dfrag(dimg, c, 16 + 2 * s, lr, lh);
        yr = MFMA32(aFr, bDr, yr); yr = MFMA32(aFi, bDi, yr);
        yi = MFMA32(aFr, bDi, yi); yi = MFMA32(anFi, bDr, yi);
        HY_SBAR();
    }
}
__device__ __forceinline__ int img_off(int n2, int ks) { return n2 * ROWB + ks * 2; }
}

__device__ __forceinline__ void ph_hyena_fft(Frame& F) {
    using namespace hy;
    const bf16_t* UT = (const bf16_t*)(F.ws + WS_UT); bf16_t* HYT = (bf16_t*)(F.ws + WS_HYT);
    const float* hdn = (const float*)(F.ws + WS_HDN); const float* w3 = F.in[I_FW3]; const float* decay = F.in[I_DECAY];
    const float* convw = F.in[I_CONVW]; const float* convb = F.in[I_CONVB]; const float* skip = F.in[I_SKIP];
    const unsigned* twt = (const unsigned*)(F.ws + WS_TWT);
    unsigned* khat = (unsigned*)(F.ws + WS_KHAT + (size_t)blockIdx.x * 131072);
    bf16_t* gt = (bf16_t*)(F.ws + WS_GT + (size_t)blockIdx.x * 131072);
    LAS unsigned char* ft = F.lds + FT_OFF; LAS unsigned char* xr = F.lds + X_OFF;
    LAS float* w3s = (LAS float*)(F.lds + SP_OFF);
    LAS float* red = w3s + 256;
    const int wid = F.wave;
#define HY_IDS int tid = F.tid; asm volatile("" : "+v"(tid)); const int lane = tid & 63, lr = lane & 31, lh = lane >> 5; (void)lr; (void)lh; (void)lane;
    __syncthreads();
    { const u32x4* src = (const u32x4*)(F.ws + WS_FTAB);
      for (int i = F.tid; i < 2 * TABB / 16; i += NTHREADS) *(LAS u32x4*)(ft + i * 16) = src[i]; }
    for (int c = blockIdx.x; c < HW; c += F.G) {
        __syncthreads();
        for (int repA = 0; repA < ((PROBE_HY & 1u) ? 2 : 1); ++repA) {
        if (repA) __syncthreads();
        { HY_IDS
        u32x4 kw[8];
#pragma unroll
        for (int i = 0; i < 8; ++i) { const int ci = tid + 512 * i; const int od = ci >> 10, t0 = (ci & 1023) * 8;
            kw[i] = *(const u32x4*)((const bf16_t*)(F.ws + WS_KRAW) + (size_t)((od >> 1) * 1024 + (od & 1) * 512 + c) * SEQ + t0); }
#pragma unroll
        for (int i = 0; i < 8; ++i) {
            const int ci = tid + 512 * i; const int od = ci >> 10, t0 = (ci & 1023) * 8, o = od >> 1, dir = od & 1;
            const u32x4 w = kw[i];
            const unsigned short e[8] = {(unsigned short)w.x, (unsigned short)(w.x >> 16), (unsigned short)w.y, (unsigned short)(w.y >> 16), (unsigned short)w.z, (unsigned short)(w.z >> 16), (unsigned short)w.w, (unsigned short)(w.w >> 16)};
            LAS unsigned char* img = xr + o * TABB;
#pragma unroll
            for (int j = 0; j < 8; ++j) { const int t = t0 + j; int n = dir ? 2 * SEQ - t : t; unsigned short v = e[j];
                if (dir && t == 0) { n = SEQ; v = 0; }
                *(LAS bf16_t*)(img + img_off(n & 127, kstore(n >> 7))) = v; }
        }
        }
        __syncthreads();
        { HY_IDS
            const int o = wid >> 2, J = wid & 3;
            float nsum = 0.f;
            { const float* kp = (const float*)(F.ws + WS_KPART);
              for (int i = 0; i < 32; ++i) nsum += kp[(size_t)(o * 1024 + c) * 32 + i] + kp[(size_t)(o * 1024 + 512 + c) * 32 + i]; }
            const float scl = 1.0f / (nsum * (float)(2 * SEQ)), sk = skip[o * HW + c] * (1.0f / (float)(2 * SEQ));
            fwd_filter(ft, xr + o * TABB, twt, J, lane, scl, sk, khat + (size_t)((o * 4 + J) * 4) * 64 * 16);
        }
        __syncthreads();
        }
        for (int repB = 0; repB < ((PROBE_HY & 2u) ? 2 : 1); ++repB) {
#pragma unroll 1
        for (int rd = 0; rd < 2; ++rd) { HY_IDS
            {
                u32x4 uw[8]; float ul[8], uh[8];
#pragma unroll
                for (int i = 0; i < 8; ++i) { const int blk = 8 * rd + i, g = blk >> 3, b = (blk >> 1) & 3, a = blk & 1;
                    const bf16_t* row = UT + (size_t)((g + 1) * HW + c) * T + (size_t)b * SEQ; const int t0 = 4096 * a + 8 * tid;
                    uw[i] = *(const u32x4*)(row + t0); ul[i] = t0 > 0 ? bf2f(row[t0 - 1]) : 0.f; uh[i] = t0 + 8 < SEQ ? bf2f(row[t0 + 8]) : 0.f; }
#pragma unroll
                for (int i = 0; i < 8; ++i) { const int blk = 8 * rd + i, g = blk >> 3; const int chg = (g + 1) * HW + c;
                    const float w0 = convw[chg], w1 = convw[NHY + chg], w2 = convw[2 * NHY + chg], bb = convb[chg];
                    const u32x4 w = uw[i];
                    const float u[10] = {ul[i], bflo(w.x), bfhi(w.x), bflo(w.y), bfhi(w.y), bflo(w.z), bfhi(w.z), bflo(w.w), bfhi(w.w), uh[i]};
                    float v[8];
#pragma unroll
                    for (int j = 0; j < 8; ++j) v[j] = w0 * u[j] + w1 * u[j + 1] + w2 * u[j + 2] + bb;
                    *(LAS u32x4*)(xr + i * (32 * ROWB) + (tid >> 4) * ROWB + (tid & 15) * 16) = (u32x4){pk2(v[0], v[1]), pk2(v[2], v[3]), pk2(v[4], v[5]), pk2(v[6], v[7])}; }
            }
            __syncthreads();
#pragma unroll
            for (int k = 0; k < 4; ++k) {
                const int item = tid + 512 * k, i = item >> 8, c4 = (item >> 6) & 3; const int blk = 8 * rd + i;
                LAS const unsigned char* a = xr + i * (32 * ROWB) + (4 * lh + ((lane & 15) >> 2)) * ROWB + (32 * c4 + 16 * ((lane >> 4) & 1) + 4 * (lane & 3)) * 2;
                const u32x2 q0 = lds_tr4(a), q1 = lds_tr4(a + 8 * ROWB), q2 = lds_tr4(a + 16 * ROWB), q3 = lds_tr4(a + 24 * ROWB);
                bf16_t* dst = gt + ((size_t)((blk * 4 + c4) * 64 + lane)) * 16;
                *(u32x4*)dst = (u32x4){q0.x, q0.y, q1.x, q1.y}; *(u32x4*)(dst + 8) = (u32x4){q2.x, q2.y, q3.x, q3.y};
            }
            __syncthreads();
        }
        }
        for (int repC = 0; repC < ((PROBE_HY & 4u) ? 2 : 1); ++repC) {
        u32x2 z1p[2][2][4];
        const int p = wid >> 2, J = wid & 3, ta = wid >> 2, tc = wid & 3;
        for (int o = 0; o < 2; ++o) {
            { HY_IDS
            if (o == 0) {
                const float w0 = convw[c], w1 = convw[NHY + c], w2 = convw[2 * NHY + c], bb = convb[c];
                u32x4 uw[8]; float ul[8], uh[8];
#pragma unroll
                for (int i = 0; i < 8; ++i) { const int ci = tid + 512 * i; const int b = ci >> 10, t0 = (ci & 1023) * 8;
                    const bf16_t* row = UT + (size_t)c * T + (size_t)b * SEQ;
                    uw[i] = *(const u32x4*)(row + t0); ul[i] = t0 > 0 ? bf2f(row[t0 - 1]) : 0.f; uh[i] = t0 + 8 < SEQ ? bf2f(row[t0 + 8]) : 0.f; }
#pragma unroll
                for (int i = 0; i < 8; ++i) {
                    const int ci = tid + 512 * i; const int b = ci >> 10, t0 = (ci & 1023) * 8;
                    const u32x4 w = uw[i];
                    const float u[10] = {ul[i], bflo(w.x), bfhi(w.x), bflo(w.y), bfhi(w.y), bflo(w.z), bfhi(w.z), bflo(w.w), bfhi(w.w), uh[i]};
                    const int n1 = t0 >> 7, n2 = t0 & 127; const int ks = kstore(n1) + 64 * (b & 1);
                    LAS unsigned char* img = xr + (b >> 1) * TABB;
#pragma unroll
                    for (int j = 0; j < 8; ++j) *(LAS bf16_t*)(img + img_off(n2 + j, ks)) = (bf16_t)f2bf(w0 * u[j] + w1 * u[j + 1] + w2 * u[j + 2] + bb);
                }
            } else {
#pragma unroll
                for (int q = 0; q < 2; ++q) { LAS unsigned char* img = xr + q * TABB + (32 * tc + lr) * ROWB + lh * 16 + ta * 64;
#pragma unroll
                    for (int g = 0; g < 4; ++g) {
                        *(LAS u32x2*)(img + 32 * (g >> 1) + 8 * (g & 1)) = z1p[q][0][g];
                        *(LAS u32x2*)(img + 128 + 32 * (g >> 1) + 8 * (g & 1)) = z1p[q][1][g]; } }
            }
            }
            __syncthreads();
            u32x2 dpk[4][2][4];
            { HY_IDS
                bf16x8 bAr[8], bAi[8];
                s1_tw<true, 4>(ft, xr + p * TABB, twt, J, lane, bAr, bAi);
                __syncthreads();
                s3_filt_i1(ft, khat + (size_t)((o * 4 + J) * 4) * 64 * 16, twt, J, lane, bAr, bAi, dpk);
            }
#pragma unroll 1
            for (int q = 0; q < 2; ++q) { HY_IDS
                if (p == q) write_D(xr, dpk, J, lane);
                __syncthreads();
                const bf16_t* g0 = gt + ((size_t)((((o * 4 + 2 * q) * 2 + ta) * 4 + tc) * 64 + lane)) * 16;
                const bf16_t* g1 = gt + ((size_t)((((o * 4 + 2 * q + 1) * 2 + ta) * 4 + tc) * 64 + lane)) * 16;
                const u32x4 ga = *(const u32x4*)g0, gb = *(const u32x4*)(g0 + 8), gc = *(const u32x4*)g1, gd = *(const u32x4*)(g1 + 8);
                f32x16 yr, yi;
                i3_wave(ft, xr, ta, tc, lane, yr, yi);
                const unsigned gre[8] = {ga.x, ga.y, ga.z, ga.w, gb.x, gb.y, gb.z, gb.w}, gim[8] = {gc.x, gc.y, gc.z, gc.w, gd.x, gd.y, gd.z, gd.w};
#pragma unroll
                for (int r2 = 0; r2 < 8; ++r2) { yr[2 * r2] *= bflo(gre[r2]); yr[2 * r2 + 1] *= bfhi(gre[r2]); yi[2 * r2] *= bflo(gim[r2]); yi[2 * r2 + 1] *= bfhi(gim[r2]); }
                {
#pragma unroll
                    for (int g = 0; g < 4; ++g) { z1p[q][0][g] = (u32x2){cvtpk(yr[4 * g], yr[4 * g + 1]), cvtpk(yr[4 * g + 2], yr[4 * g + 3])};
                                                  z1p[q][1][g] = (u32x2){cvtpk(yi[4 * g], yi[4 * g + 1]), cvtpk(yi[4 * g + 2], yi[4 * g + 3])}; }
                }
                if (o == 1) {
                    bf16_t* o0 = HYT + (size_t)c * T + (size_t)(2 * q) * SEQ + 32 * tc + lr; bf16_t* o1 = o0 + SEQ;
#pragma unroll
                    for (int r = 0; r < 16; ++r) { const int n1 = 32 * ta + crow(r, lh); o0[128 * n1] = (bf16_t)f2bf(yr[r]); o1[128 * n1] = (bf16_t)f2bf(yi[r]); }
                }
                __syncthreads();
            }
        }
        }
    }
    __syncthreads();
#undef HY_IDS
}

__device__ __forceinline__ void ph_hyT(Frame& F) {
    const bf16_t* HYT = (const bf16_t*)(F.ws + WS_HYT); bf16_t* HY = (bf16_t*)(F.ws + WS_AH) + AW;
    constexpr int TROW = 144;
    LAS unsigned char* tl = F.lds + F.wave * (64 * TROW);
    const int gw = F.vcu * NWAVES + F.wave, NGW = F.G * NWAVES;
    int lane = F.lane; asm volatile("" : "+v"(lane));
    for (int it = gw; it < 8 * (T / 64); it += NGW) {
        const int cb = it & 7, tb = it >> 3; const int c0 = cb * 64, t0 = tb * 64;
        u32x4 v[8];
#pragma unroll
        for (int j = 0; j < 8; ++j) v[j] = *(const u32x4*)(HYT + (size_t)(c0 + 8 * j + (lane >> 3)) * T + t0 + 8 * (lane & 7));
#pragma unroll
        for (int j = 0; j < 8; ++j) *(LAS u32x4*)(tl + (8 * j + (lane >> 3)) * TROW + (lane & 7) * 16) = v[j];
        const int q = (lane & 15) >> 2, p = lane & 3, g = lane >> 4;
#pragma unroll
        for (int ps = 0; ps < 4; ++ps)
#pragma unroll
            for (int hf = 0; hf < 2; ++hf) {
                LAS const unsigned char* a = tl + (32 * hf + 8 * g + q) * TROW + (16 * ps + 4 * p) * 2;
                const u32x2 lo = lds_tr4(a), hi = lds_tr4(a + 4 * TROW);
                *(u32x4*)(HY + (size_t)(t0 + 16 * ps + (lane & 15)) * DM + c0 + 32 * hf + 8 * g) = (u32x4){lo.x, lo.y, hi.x, hi.y};
            }
    }
}

__device__ __forceinline__ void ph_expert_cvt(Frame& F) {
    LAS float* scr = (LAS float*)(F.lds + F.wave * 16384);
    const int gw = F.vcu * NWAVES + F.wave, NGW = F.G * NWAVES;
    bf16_t* W13 = (bf16_t*)(F.ws + WS_W13); bf16_t* W2 = (bf16_t*)(F.ws + WS_W2);
    for (int it = gw; it < NE * 768; it += NGW) {
        const int e = it / 768; int r = it % 768;
        if (r < 512) { const bool is3 = r >= 256; r &= 255; const int kb = r / 16, nb = r % 16, n0 = nb * 32;
            const int drow = (n0 >> 7) * 256 + (is3 ? 128 : 0) + (n0 & 127);
            transpose_item(F.in[is3 ? I_EW3 : I_EW1] + (size_t)e * DM * DE, DM, DE, W13 + (size_t)e * DM * DM, DM, drow, scr, kb, nb, F.lane); }
        else { r -= 512; const int kb = r / 32, nb = r % 32;
            transpose_item(F.in[I_EW2] + (size_t)e * DE * DM, DE, DM, W2 + (size_t)e * DM * DE, DE, nb * 32, scr, kb, nb, F.lane); }
    }
}

__device__ __forceinline__ void ph_ln1_route(Frame& F) {
    int tid = threadIdx.x; asm volatile("" : "+v"(tid));
    const float* xin = F.in[I_X]; bf16_t* y1 = (bf16_t*)(F.ws + WS_Y1); bf16_t* h2b = (bf16_t*)(F.ws + WS_HB); bf16_t* h2l = (bf16_t*)(F.ws + WS_H2LO);
    const float* mod = (const float*)(F.ws + WS_MOD); const float* g1 = F.in[I_LN1G]; const float* b1 = F.in[I_LN1B];
    const bf16_t* wr = (const bf16_t*)(F.ws + WS_WRT); const float* bg = F.in[I_RGB]; const float* be = F.in[I_REB];
    unsigned* cnt = F.ctl + CW_CNT; int* btok = (int*)(F.ws + WS_BTOK); float* bw = (float*)(F.ws + WS_BW);
    constexpr int WROW = 272, WCH = 80 * WROW;
    LAS unsigned char* wl = F.lds;
    LAS float* lg = (LAS float*)(F.lds + 65536);
    for (int ch = blockIdx.x; ch < T / 128; ch += F.G) {
        const int b = (ch * 128) / SEQ;
        for (int rr0 = F.wave * 4; rr0 < 128; rr0 += NWAVES * 4) {
            f32x4 xin4[4][4]; unsigned long long yin4[4][4];
#pragma unroll
            for (int r = 0; r < 4; ++r) { const size_t row = (size_t)ch * 128 + rr0 + r;
                const f32x4* xi = (const f32x4*)(xin + row * DM) + F.lane; const unsigned long long* yi = (const unsigned long long*)(y1 + row * DM) + F.lane;
#pragma unroll
                for (int j = 0; j < 4; ++j) { xin4[r][j] = xi[64 * j]; yin4[r][j] = yi[64 * j]; } }
#pragma unroll
            for (int r = 0; r < 4; ++r) {
            const size_t row = (size_t)ch * 128 + rr0 + r;
            unsigned long long* x1o = (unsigned long long*)(y1 + row * DM) + F.lane;
            f32x4 x[4]; float s = 0.f;
#pragma unroll
            for (int j = 0; j < 4; ++j) { const unsigned long long yw = yin4[r][j]; const f32x4 yv = {bflo((unsigned)yw), bfhi((unsigned)yw), bflo((unsigned)(yw >> 32)), bfhi((unsigned)(yw >> 32))};
                x[j] = xin4[r][j] * DN_ALPHA + yv; s += (x[j][0] + x[j][1]) + (x[j][2] + x[j][3]); }
            const float mean = wave_sum(s) * (1.f / DM); float s2 = 0.f;
#pragma unroll
            for (int j = 0; j < 4; ++j) { x[j] = x[j] - mean; s2 += (x[j][0] * x[j][0] + x[j][1] * x[j][1]) + (x[j][2] * x[j][2] + x[j][3] * x[j][3]); }
            const float rstd = 1.f / sqrtf(wave_sum(s2) * (1.f / DM) + LN_EPS);
            unsigned long long* o8 = (unsigned long long*)(h2b + row * DM) + F.lane; unsigned long long* l8 = (unsigned long long*)(h2l + row * DM) + F.lane;
#pragma unroll
            for (int j = 0; j < 4; ++j) { const int k = 4 * F.lane + 256 * j;
                const f32x4 gg = *(const f32x4*)(g1 + k), bb = *(const f32x4*)(b1 + k);
                const f32x4 sh = *(const f32x4*)(mod + (size_t)b * 6144 + 3072 + k), sc = *(const f32x4*)(mod + (size_t)b * 6144 + 4096 + k);
                x[j] = x[j] * rstd * gg + bb; x1o[64 * j] = (unsigned long long)pk2(x[j][0], x[j][1]) | ((unsigned long long)pk2(x[j][2], x[j][3]) << 32);
                const f32x4 h = x[j] * (sc + 1.0f) + sh;
                const unsigned h01 = pk2(h[0], h[1]), h23 = pk2(h[2], h[3]);
                o8[64 * j] = (unsigned long long)h01 | ((unsigned long long)h23 << 32);
                l8[64 * j] = (unsigned long long)pk2(h[0] - bflo(h01), h[1] - bfhi(h01)) | ((unsigned long long)pk2(h[2] - bflo(h23), h[3] - bfhi(h23)) << 32); }
            }
        }
        __syncthreads();
        {
            const int lane = F.lane, l15 = lane & 15, l4 = lane >> 4;
            f32x4 acc[5];
#pragma unroll
            for (int n = 0; n < 5; ++n) acc[n] = (f32x4){0.f, 0.f, 0.f, 0.f};
            const size_t arow = ((size_t)ch * 128 + 16 * F.wave + l15) * DM + 8 * l4;
#pragma unroll 1
            for (int kc = 0; kc < 8; ++kc) {
                for (int i = tid; i < 2 * 80 * 16; i += NTHREADS) { const int part = i / 1280, r = (i % 1280) >> 4, pc = i & 15;
                    *(LAS u32x4*)(wl + part * WCH + r * WROW + pc * 16) = *(const u32x4*)(wr + (size_t)part * 80 * DM + (size_t)r * DM + kc * 128 + pc * 8); }
                __syncthreads();
#pragma unroll
                for (int s4 = 0; s4 < 4; ++s4) {
                    const bf16x8 ah = *(const bf16x8*)(h2b + arow + kc * 128 + 32 * s4), al = *(const bf16x8*)(h2l + arow + kc * 128 + 32 * s4);
#pragma unroll
                    for (int n = 0; n < 5; ++n) {
                        const bf16x8 bh = *(LAS const bf16x8*)(wl + (16 * n + l15) * WROW + (32 * s4 + 8 * l4) * 2), bl = *(LAS const bf16x8*)(wl + WCH + (16 * n + l15) * WROW + (32 * s4 + 8 * l4) * 2);
                        acc[n] = __builtin_amdgcn_mfma_f32_16x16x32_bf16(ah, bh, acc[n], 0, 0, 0);
                        acc[n] = __builtin_amdgcn_mfma_f32_16x16x32_bf16(al, bh, acc[n], 0, 0, 0);
                        acc[n] = __builtin_amdgcn_mfma_f32_16x16x32_bf16(ah, bl, acc[n], 0, 0, 0);
                    }
                }
                __syncthreads();
            }
#pragma unroll
            for (int n = 0; n < 5; ++n)
#pragma unroll
                for (int r = 0; r < 4; ++r) lg[(16 * F.wave + 4 * l4 + r) * 81 + 16 * n + l15] = acc[n][r];
        }
        __syncthreads();
        LAS int* hist = (LAS int*)(F.lds + 110592); LAS int* hbase = hist + 64; LAS int* aexp = hist + 128; LAS int* arank = aexp + 256; LAS float* aw = (LAS float*)(arank + 256);
        if (tid < 64) hist[tid] = 0;
        __syncthreads();
        if (tid < 128) {
            LAS const float* lr_ = lg + tid * 81;
            float gl[8]; float gmax; int g = 0;
#pragma unroll
            for (int i = 0; i < 8; ++i) gl[i] = lr_[i] + bg[i];
            gmax = gl[0];
#pragma unroll
            for (int i = 1; i < 8; ++i) if (gl[i] > gmax) { gmax = gl[i]; g = i; }
            float den = 0.f;
#pragma unroll
            for (int i = 0; i < 8; ++i) den += __expf(gl[i] - gmax);
            const float pg = 1.0f / den;
            float el[8];
#pragma unroll
            for (int j = 0; j < 8; ++j) el[j] = lr_[8 + g * 8 + j] + be[g * 8 + j];
            int i1 = 0; float e1 = el[0];
#pragma unroll
            for (int j = 1; j < 8; ++j) if (el[j] > e1) { e1 = el[j]; i1 = j; }
            int i2 = -1; float e2 = -INFINITY;
#pragma unroll
            for (int j = 0; j < 8; ++j) if (j != i1 && (i2 < 0 || el[j] > e2)) { e2 = el[j]; i2 = j; }
            const float r = __expf(e2 - e1); const float wa = pg / (1.0f + r), wb = pg * r / (1.0f + r);
            const int ea = g * 8 + i1, eb = g * 8 + i2;
            aexp[2 * tid] = ea; aw[2 * tid] = wa; arank[2 * tid] = __hip_atomic_fetch_add(&hist[ea], 1, __ATOMIC_RELAXED, __HIP_MEMORY_SCOPE_WORKGROUP);
            aexp[2 * tid + 1] = eb; aw[2 * tid + 1] = wb; arank[2 * tid + 1] = __hip_atomic_fetch_add(&hist[eb], 1, __ATOMIC_RELAXED, __HIP_MEMORY_SCOPE_WORKGROUP);
        }
        __syncthreads();
        if (tid < 64) { const int n = hist[tid]; hbase[tid] = n > 0 ? (int)atomicAdd(&cnt[32 * tid], (unsigned)n) : 0; }
        __syncthreads();
        if (tid < 256) { const int e = aexp[tid]; const size_t pos = (size_t)e * ECAP + hbase[e] + arank[tid];
            btok[pos] = (ch * 128 + (tid >> 1)) * 2 + (tid & 1); bw[pos] = aw[tid]; }
        __syncthreads();
    }
}

constexpr int MOE_UL_OFF = TAB_OFF + 576, MOE_RT_OFF = 149504, MOE_WT_OFF = MOE_RT_OFF + pg8::MOE_MAXU * 1024;
static_assert(MOE_WT_OFF + pg8::MOE_MAXU * 1024 <= LDSCTL_OFF && MOE_UL_OFF + pg8::MOE_MAXU * 16 <= LDS_BYTES, "MoE LDS tables");
template <bool DOWN> __device__ __forceinline__ void build_moe_tab(Frame& F, LAS int* tab) {
    LAS int* ulist = (LAS int*)(F.lds + MOE_UL_OFF); LAS int* rowtab = (LAS int*)(F.lds + MOE_RT_OFF); LAS float* wtab = (LAS float*)(F.lds + MOE_WT_OFF);
    const int* btok = (const int*)(F.ws + WS_BTOK); const float* bw = (const float*)(F.ws + WS_BW);
    int tid = threadIdx.x; asm volatile("" : "+v"(tid));
    __syncthreads();
    if (tid < 64) tab[72 + tid] = (int)__hip_atomic_load(F.ctl + CW_CNT + 32 * tid, __ATOMIC_RELAXED, __HIP_MEMORY_SCOPE_AGENT);
    __syncthreads();
    if (tid == 0) { int s = 0; for (int e = 0; e < 64; ++e) { tab[e] = s; s += (tab[72 + e] + 255) >> 8; } tab[64] = s; }
    __syncthreads();
    if (tid < pg8::MOE_MAXU) {
        const int L = tid * F.G + F.vcu, tile = L >> 2; const bool valid = tile < tab[64];
        int e = 0;
        for (int j = 1; j < 64; ++j) e += (tab[j] <= tile) ? 1 : 0;
        ulist[4 * tid] = e; ulist[4 * tid + 1] = tile - tab[e]; ulist[4 * tid + 2] = tile; ulist[4 * tid + 3] = valid ? (L & 3) + 1 : 0;
    }
    __syncthreads();
    for (int i = tid; i < pg8::MOE_MAXU * 256; i += NTHREADS) {
        const int ui = i >> 8, r = i & 255;
        if (ulist[4 * ui + 3] != 0) {
            const int e = ulist[4 * ui], idx = ulist[4 * ui + 1] * 256 + r; const bool in = idx < tab[72 + e];
            const int bt = in ? btok[(size_t)e * ECAP + idx] : -1;
            if (DOWN) { rowtab[i] = bt; wtab[i] = in ? bw[(size_t)e * ECAP + idx] : 0.f; }
            else rowtab[i] = in ? (bt >> 1) : 0;
        }
    }
    __syncthreads();
}

__device__ __forceinline__ void ph_final(Frame& F) {
    float* out = F.out; const bf16_t* y2 = (const bf16_t*)(F.ws + WS_Y2); const bf16_t* x1b = (const bf16_t*)(F.ws + WS_Y1);
    const float* mod = (const float*)(F.ws + WS_MOD); const float* g2 = F.in[I_LN2G]; const float* b2 = F.in[I_LN2B];
    const int gw = F.vcu * NWAVES + F.wave, NGW = F.G * NWAVES;
    constexpr int RB = 4;
    for (int row0 = gw * RB; row0 < T; row0 += NGW * RB) {
        const int b = row0 / SEQ;
        unsigned long long xa[RB][4], ya[RB][4], yb[RB][4];
#pragma unroll
        for (int r = 0; r < RB; ++r) { const size_t row = (size_t)row0 + r;
            const unsigned long long* xb = (const unsigned long long*)(x1b + row * DM) + F.lane;
            const unsigned long long* pa = (const unsigned long long*)(y2 + (2 * row) * DM) + F.lane; const unsigned long long* pb = (const unsigned long long*)(y2 + (2 * row + 1) * DM) + F.lane;
#pragma unroll
            for (int j = 0; j < 4; ++j) { xa[r][j] = xb[64 * j]; ya[r][j] = pa[64 * j]; yb[r][j] = pb[64 * j]; } }
#pragma unroll
        for (int r = 0; r < RB; ++r) {
            f32x4* xr = (f32x4*)(out + ((size_t)row0 + r) * DM) + F.lane;
            f32x4 x[4]; float s = 0.f;
#pragma unroll
            for (int j = 0; j < 4; ++j) { const int k = 4 * F.lane + 256 * j;
                const f32x4 gt = *(const f32x4*)(mod + (size_t)b * 6144 + 5120 + k);
                const unsigned long long a = ya[r][j], c = yb[r][j], xw = xa[r][j];
                f32x4 y; y[0] = bflo((unsigned)a) + bflo((unsigned)c); y[1] = bfhi((unsigned)a) + bfhi((unsigned)c);
                y[2] = bflo((unsigned)(a >> 32)) + bflo((unsigned)(c >> 32)); y[3] = bfhi((unsigned)(a >> 32)) + bfhi((unsigned)(c >> 32));
                const f32x4 x1 = {bflo((unsigned)xw), bfhi((unsigned)xw), bflo((unsigned)(xw >> 32)), bfhi((unsigned)(xw >> 32))};
                x[j] = x1 * DN_ALPHA + gt * y; s += (x[j][0] + x[j][1]) + (x[j][2] + x[j][3]); }
            const float mean = wave_sum(s) * (1.f / DM); float s2 = 0.f;
#pragma unroll
            for (int j = 0; j < 4; ++j) { x[j] = x[j] - mean; s2 += (x[j][0] * x[j][0] + x[j][1] * x[j][1]) + (x[j][2] * x[j][2] + x[j][3] * x[j][3]); }
            const float rstd = 1.f / sqrtf(wave_sum(s2) * (1.f / DM) + LN_EPS);
#pragma unroll
            for (int j = 0; j < 4; ++j) { const int k = 4 * F.lane + 256 * j; xr[64 * j] = x[j] * rstd * *(const f32x4*)(g2 + k) + *(const f32x4*)(b2 + k); }
        }
    }
}

constexpr int N_PHASES = 12;
__device__ __forceinline__ Frame make_frame(const Args& args, unsigned char* lds) {
    Frame F;
    F.lds = (LAS unsigned char*)lds; F.ws = args.ws; F.ctl = (unsigned*)(args.ws + WS_CTL);
    F.tid = threadIdx.x; F.lane = F.tid & 63; F.wave = __builtin_amdgcn_readfirstlane(F.tid >> 6);
    F.G = gridDim.x; { const int bx = blockIdx.x; F.vcu = (F.G % 8 == 0) ? (bx % 8) * (F.G / 8) + bx / 8 : bx; }
    F.in = args.in; F.out = args.out;
    return F;
}
template <unsigned PH_MASK> __global__ void __launch_bounds__(NTHREADS, 2) mk_fwd(Args args) {
    extern __shared__ __attribute__((aligned(16))) unsigned char lds[];
    for (int u = threadIdx.x; u < (LDS_BYTES - LDSCTL_OFF) / 4; u += NTHREADS) ((LAS unsigned*)((LAS unsigned char*)lds + LDSCTL_OFF))[u] = 0u;
    __syncthreads();
    constexpr bool multi = (PH_MASK & (PH_MASK - 1u)) != 0u;
    if (multi) xcd_barrier_post((unsigned*)(args.ws + WS_CTL) + CW_BAR);
#define IN(k) ((PH_MASK >> (k)) & 1u)
#define GBAR() xcd_barrier((unsigned*)(args.ws + WS_CTL) + CW_BAR, (volatile LAS unsigned*)((LAS unsigned char*)lds + MISC_OFF) + 8)
#define PH(k, ...) if (IN(k)) { __VA_ARGS__ } if (IN(k) && ((PROBE_DBL >> (k)) & 1u)) { GBAR(); __VA_ARGS__ } if (IN(k) && (k) + 1 < N_PHASES && IN((k) + 1)) GBAR();
#define SEAM(k) do { if (IN(k) && IN((k) + 1)) xcd_barrier((unsigned*)(args.ws + WS_CTL) + CW_BAR, (volatile LAS unsigned*)((LAS unsigned char*)lds + MISC_OFF) + 8); } while (0)
#define RING ((LAS unsigned char*)lds)
#define TAB ((LAS int*)((LAS unsigned char*)lds + TAB_OFF))

    PH(0, Frame F = make_frame(args, lds); ph_prep(F);
    )
    PH(1, Frame F = make_frame(args, lds); ph_taps(F); if (PROBE_SUB & 16u) ph_taps(F); ph_hb(F); if (PROBE_SUB & 32u) ph_hb(F);
    )
    PH(2,
        { pg8::DenseSched S; S.init(T, N1A, DM, gridDim.x, (int)blockIdx.x, args.ws + WS_WIN);
          pg8::EpiInA E{(bf16_t*)(args.ws + WS_Q), (bf16_t*)(args.ws + WS_K), (bf16_t*)(args.ws + WS_V), (bf16_t*)(args.ws + WS_GA)};
          pg8::gemm_phase<pg8::EpiInA, pg8::DenseSched, true>(RING, args.ws + WS_HB, DM, S, E); }
        { pg8::DenseSched S; S.init(NHY, T, DM, gridDim.x, (int)blockIdx.x, args.ws + WS_HB);
          pg8::EpiBf16 E{(bf16_t*)(args.ws + WS_UT), T};
          pg8::gemm_phase<pg8::EpiBf16, pg8::DenseSched, true>(RING, args.ws + WS_WIN + (size_t)N1A * DM * 2, DM, S, E); }
    )
    PH(3, Frame F = make_frame(args, lds); ph_attn(F); if (PROBE_SUB & 1u) ph_attn(F); ph_hyena_fft(F); if (PROBE_SUB & 2u) ph_hyena_fft(F);
    )
    PH(4, Frame F = make_frame(args, lds); ph_hyT(F);
    )
    PH(5,
        pg8::DenseSched S; S.init(T, DM, DM, gridDim.x, (int)blockIdx.x, args.ws + WS_WAH);
        pg8::EpiMerge E{(const bf16_t*)(args.ws + WS_GA), (bf16_t*)(args.ws + WS_HB)};
        pg8::gemm_phase<pg8::EpiMerge, pg8::DenseSched, true>(RING, args.ws + WS_AH, DM, S, E);
    )
    PH(7,
        { pg8::DenseSched S; S.init(T, DM, DM, gridDim.x, (int)blockIdx.x, args.ws + WS_WO);
          pg8::EpiY E{(const float*)(args.ws + WS_MOD) + 2048, (bf16_t*)(args.ws + WS_Y1)};
          pg8::gemm_phase<pg8::EpiY, pg8::DenseSched, true>(RING, args.ws + WS_HB, DM, S, E);
          if (PROBE_SUB & 4u) pg8::gemm_phase<pg8::EpiY, pg8::DenseSched, true>(RING, args.ws + WS_HB, DM, S, E);
          if (PROBE_SUB & 64u) { pg8::EpiNull EN; pg8::gemm_phase<pg8::EpiNull, pg8::DenseSched, true>(RING, args.ws + WS_HB, DM, S, EN); } }
        { Frame F = make_frame(args, lds); ph_expert_cvt(F); if (PROBE_SUB & 8u) ph_expert_cvt(F); }
    )
    PH(8, Frame F = make_frame(args, lds); ph_ln1_route(F);
    )
    PH(9,
        { Frame F = make_frame(args, lds); build_moe_tab<false>(F, TAB); }
        pg8::MoeSched<true> S{TAB, (const LAS int*)((LAS unsigned char*)lds + MOE_UL_OFF), (const LAS int*)((LAS unsigned char*)lds + MOE_RT_OFF), (const char*)(args.ws + WS_W13), (size_t)DM * DM * 2, DM};
        pg8::EpiSwiGLU E{(bf16_t*)(args.ws + WS_HACT)};
        pg8::gemm_phase<pg8::EpiSwiGLU, pg8::MoeSched<true>, true>(RING, args.ws + WS_HB, DM, S, E);
    )
    PH(10,
        { Frame F = make_frame(args, lds); build_moe_tab<true>(F, TAB); }
        pg8::MoeSched<false> S{TAB, (const LAS int*)((LAS unsigned char*)lds + MOE_UL_OFF), (const LAS int*)((LAS unsigned char*)lds + MOE_RT_OFF), (const char*)(args.ws + WS_W2), (size_t)DM * DE * 2, DE};
        pg8::EpiScatter E{(bf16_t*)(args.ws + WS_Y2), (const LAS int*)((LAS unsigned char*)lds + MOE_RT_OFF), (const LAS float*)((LAS unsigned char*)lds + MOE_WT_OFF)};
        pg8::gemm_phase<pg8::EpiScatter, pg8::MoeSched<false>, true>(RING, args.ws + WS_HACT, DE, S, E);
    )
    PH(11, Frame F = make_frame(args, lds); ph_final(F);
    )
#undef IN
#undef SEAM
#undef GBAR
#undef PH
#undef RING
#undef TAB
}

extern "C" void kernel_launch(void* const* d_in, const int* in_sizes, int n_in, void* d_out, int out_size, void* d_ws, size_t ws_size, hipStream_t stream) {
    static int grid = 0;
    if (grid == 0) {
        if (n_in != 31 || out_size != T * DM || ws_size < WS_END) { fprintf(stderr, "kernel_launch: unexpected shapes: n_in %d out %d ws %zu (need %zu)\n", n_in, out_size, ws_size, (size_t)WS_END); grid = -1; return; }
        int dev = 0, cus = 0;
        if (hipGetDevice(&dev) != hipSuccess || hipDeviceGetAttribute(&cus, hipDeviceAttributeMultiprocessorCount, dev) != hipSuccess) { grid = -1; return; }
        bool ok = true;
#define SET_ATTR(m) ok = ok && (hipFuncSetAttribute((const void*)mk_fwd<(m)>, hipFuncAttributeMaxDynamicSharedMemorySize, LDS_BYTES) == hipSuccess)
#if MK_N_LAUNCHES == 1
        SET_ATTR(FUSED_MASK);
#else
        { SET_ATTR(1u << 0); SET_ATTR(1u << 1); SET_ATTR(1u << 2); SET_ATTR(1u << 3); SET_ATTR(1u << 4); SET_ATTR(1u << 5); SET_ATTR(1u << 6); SET_ATTR(1u << 7); SET_ATTR(1u << 8); SET_ATTR(1u << 9); SET_ATTR(1u << 10); SET_ATTR(1u << 11); }
#endif
#undef SET_ATTR
        if (!ok) { fprintf(stderr, "kernel_launch: hipFuncSetAttribute failed\n"); grid = -1; return; }
        (void)hipGetLastError();
        grid = cus;
    }
    if (grid < 0) return;
    if (hipMemsetAsync((char*)d_ws + WS_CTL, 0, CTL_ZERO_BYTES, stream) != hipSuccess) return;
    Args a{};
    for (int i = 0; i < 31; ++i) a.in[i] = (const float*)d_in[i];
    a.out = (float*)d_out; a.ws = (unsigned char*)d_ws;
#if MK_N_LAUNCHES == 1
    a.ph_lo = 0; a.ph_hi = N_PHASES; hipLaunchKernelGGL(mk_fwd<FUSED_MASK>, dim3(grid), dim3(NTHREADS), LDS_BYTES, stream, a);
#else
    {
#define LAUNCH_PH(p) do { a.ph_lo = (p); a.ph_hi = (p) + 1; for (int rep_ = 0; rep_ < (((PROBE_DBL >> (p)) & 1u) ? 2 : 1); ++rep_) hipLaunchKernelGGL(mk_fwd<(1u << (p))>, dim3(grid), dim3(NTHREADS), LDS_BYTES, stream, a); } while (0)
        LAUNCH_PH(0); LAUNCH_PH(1); LAUNCH_PH(2); LAUNCH_PH(3); LAUNCH_PH(4); LAUNCH_PH(5); LAUNCH_PH(6); LAUNCH_PH(7); LAUNCH_PH(8); LAUNCH_PH(9); LAUNCH_PH(10); LAUNCH_PH(11);
#undef LAUNCH_PH
    }
#endif
}
```

```cpp
#include <hip/hip_runtime.h>
#include <cstdio>
#include <cstdint>

#ifndef PROBE_DBL
#define PROBE_DBL 0u
#endif
#ifndef PROBE_SUB
#define PROBE_SUB 0u
#endif
#ifndef PROBE_HY
#define PROBE_HY 0u
#endif
#ifndef PROBE_T
#define PROBE_T (-1)
#endif
#ifndef PROBE_TJ
#define PROBE_TJ (PROBE_T + 1)
#endif
#ifndef FUSED_MASK
#define FUSED_MASK 0xFFFu
#endif
#ifndef MK_N_LAUNCHES
#define MK_N_LAUNCHES 1
#endif

#define GAS __attribute__((address_space(1)))
#define LAS __attribute__((address_space(3)))
typedef unsigned short bf16_t;
typedef short bf16x8 __attribute__((ext_vector_type(8)));
typedef float f32x4 __attribute__((ext_vector_type(4)));
typedef float f32x2 __attribute__((ext_vector_type(2)));
typedef unsigned u32x4 __attribute__((ext_vector_type(4)));
typedef unsigned u32x2 __attribute__((ext_vector_type(2)));

constexpr int NB = 4, SEQ = 8192, DM = 1024, T = NB * SEQ;
constexpr int AW = 512, KVW = 128, HW = 512, INW = 4352, N1A = 2816, NHY = 1536;
constexpr int NE = 64, DE = 512, ECAP = 32768;
constexpr int NFILT = 2048, FH = 64, FEMB = 33;
constexpr float LN_EPS = 1e-5f;
constexpr float DN_ALPHA = 1.189207115002721f;
constexpr int NTHREADS = 512, NWAVES = 8;

constexpr size_t MiB = 1u << 20;
constexpr size_t WS_CTL = 0, CTL_ZERO_BYTES = 1 * MiB;
constexpr size_t WS_MODP = 1 * MiB, WS_MOD = 3 * MiB, WS_HDN = 4 * MiB, WS_WRT = 6 * MiB, WS_WIN = 7 * MiB;
constexpr size_t WS_WAH = 16 * MiB, WS_WO = 18 * MiB, WS_BTOK = 20 * MiB, WS_BW = 28 * MiB;
constexpr size_t WS_HB = 36 * MiB;
constexpr size_t WS_Q = 100 * MiB, WS_K = 132 * MiB, WS_V = 140 * MiB, WS_GA = 148 * MiB, WS_GH = 212 * MiB;
constexpr size_t WS_UT = 276 * MiB, WS_TMP = 276 * MiB;
constexpr size_t WS_AH = 372 * MiB;
constexpr size_t WS_HYT = 500 * MiB;
constexpr size_t WS_W13 = 100 * MiB, WS_W2 = 228 * MiB, WS_HACT = 404 * MiB, WS_Y2 = 36 * MiB, WS_END = 532 * MiB;
constexpr size_t WS_FTAB = 15 * MiB + 524288;
constexpr size_t WS_TWT = 15 * MiB + 524288 + 73728;
constexpr size_t WS_KHAT = 36 * MiB;
constexpr size_t WS_GT = 436 * MiB;
constexpr size_t WS_Y1 = 340 * MiB;
constexpr size_t WS_H2LO = 436 * MiB;
constexpr size_t WS_KRAW = 468 * MiB;
constexpr size_t WS_KPART = 6 * MiB + 524288;  constexpr size_t WS_HDNB = WS_HDN;
constexpr int CW_BAR = 4096, CW_CNT = 8192;

constexpr int RING_BYTES = 131072, LDS_BYTES = 163840, LDSCTL_OFF = LDS_BYTES - 2048, MISC_OFF = LDSCTL_OFF + 320, TAB_OFF = LDSCTL_OFF + 1024;

#define LDS_WAIT() asm volatile("s_waitcnt lgkmcnt(0)" ::: "memory")
#define VM_WAIT() asm volatile("s_waitcnt vmcnt(0)" ::: "memory")
typedef __bf16 bf16x2_hw __attribute__((ext_vector_type(2)));
__device__ __forceinline__ unsigned pk2(float lo, float hi) { f32x2 v = {lo, hi}; bf16x2_hw b = __builtin_convertvector(v, bf16x2_hw); return __builtin_bit_cast(unsigned, b); }
__device__ __forceinline__ unsigned f2bf(float f) { return pk2(f, 0.f) & 0xffffu; }
__device__ __forceinline__ float bf2f(unsigned short b) { return __builtin_bit_cast(float, (unsigned)b << 16); }
__device__ __forceinline__ float bflo(unsigned w) { return __builtin_bit_cast(float, w << 16); }
__device__ __forceinline__ float bfhi(unsigned w) { return __builtin_bit_cast(float, w & 0xffff0000u); }
__device__ __forceinline__ float sigmoidf_(float x) { return __builtin_amdgcn_rcpf(1.0f + __expf(-x)); }
__device__ __forceinline__ float wave_sum(float v) {
#pragma unroll
    for (int o = 1; o < 64; o <<= 1) v += __shfl_xor(v, o);
    return v;
}

#define FSTAMP(i) do { if (PROBE_T >= 0 && blockIdx.x == 0 && threadIdx.x == 0) ((volatile LAS unsigned*)(F.lds + LDSCTL_OFF))[(i)] = (unsigned)__builtin_amdgcn_s_memrealtime(); } while (0)
namespace pg8 {
constexpr int BM = 256, BK = 64, HALF = 128, HTB = HALF * BK * 2, STAGE_BYTES = 8 * HTB, NXCD = 8, WGM = 8;
__host__ __device__ __forceinline__ int lds_byte(int r, int c) { const int st = (r >> 4) * 2 + (c >> 5), rr = r & 15, cc = c & 31, ob = rr * 64 + cc * 2; return st * 1024 + (ob ^ (((ob >> 9) & 1) << 5)); }
__host__ __device__ __forceinline__ void stage_rc(int b, int& R, int& C) { const int st = b / 1024, sb = b % 1024, swz = sb ^ (((sb >> 9) & 1) << 5); R = (st >> 1) * 16 + swz / 64; C = (st & 1) * 32 + (swz % 64) / 2; }
__host__ __device__ __forceinline__ int perm32(int rho) { const int n = rho >> 4, i = rho & 15; return 8 * (i >> 2) + 4 * n + (i & 3); }

struct Unit { int pm, pn, e, mt, li; };

struct DenseSched {
    static constexpr bool GATHER = false;
    int nM, nN, nwg, G, c, K; const char* Bt;
    __device__ void init(int M, int N, int K_, int G_, int c_, const void* Bt_) { nM = M / BM; nN = N / BM; nwg = nM * nN; G = G_; c = c_; K = K_; Bt = (const char*)Bt_; }
    __device__ bool next(int i, Unit& u) const {
        const long L = (long)i * G + c; if (L >= nwg) return false;
        int wgid = (int)L; { const int q = nwg / NXCD, r = nwg % NXCD, xcd = wgid % NXCD, off = wgid / NXCD; wgid = (xcd < r ? xcd * (q + 1) : r * (q + 1) + (xcd - r) * q) + off; }
        const int nig = WGM * nN, gid = wgid / nig, fm = gid * WGM, gsz = (nM - fm) < WGM ? (nM - fm) : WGM;
        u.pm = fm + ((wgid % nig) % gsz); u.pn = (wgid % nig) / gsz; u.e = 0; u.mt = 0; u.li = 0; return true;
    }
    __device__ __forceinline__ unsigned arow(const Unit& u, int r) const { return (unsigned)(u.pm * BM + r); }
    __device__ __forceinline__ const char* bptr(const Unit& u) const { return Bt + (size_t)u.pn * BM * K * 2; }
};

constexpr int MOE_MAXU = 6;
template <bool GATHER_> struct MoeSched {
    static constexpr bool GATHER = GATHER_;
    const LAS int* tab;
    const LAS int* ulist;
    const LAS int* rowtab;
    const char* Bt; size_t estride; int K;
    __device__ bool next(int i, Unit& u) const {
        if (i >= MOE_MAXU || ulist[4 * i + 3] == 0) return false;
        u.e = ulist[4 * i]; u.mt = ulist[4 * i + 1]; u.pm = ulist[4 * i + 2]; u.pn = ulist[4 * i + 3] - 1; u.li = i; return true;
    }
    __device__ __forceinline__ unsigned arow(const Unit& u, int r) const {
        if (!GATHER_) return (unsigned)(u.pm * BM + r);
        return (unsigned)rowtab[u.li * 256 + r];
    }
    __device__ __forceinline__ const char* bptr(const Unit& u) const { return Bt + (size_t)u.e * estride + (size_t)u.pn * BM * K * 2; }
};

template <class Epi, class Sched, bool ALIGN_EPI>
__device__ __forceinline__ void gemm_phase(LAS unsigned char* lds, const void* Abase, const int K, const Sched& S, const Epi& E) {
    int tid = threadIdx.x; asm volatile("" : "+v"(tid));
    const int wid = __builtin_amdgcn_readfirstlane(tid >> 6), lane = tid & 63, wr = wid >> 2, wc = wid & 3, fr = lane & 15, fq = lane >> 4;
    const int nt = K / BK;
    int Rr[2], Cc[2]; unsigned voffB[2];
#pragma unroll
    for (int i = 0; i < 2; ++i) { stage_rc(tid * 16 + i * 8192, Rr[i], Cc[i]);
        const int Rb = Epi::BMAP == 2 ? (64 * (Rr[i] >> 5) + perm32(Rr[i] & 31)) : ((Rr[i] & ~31) + perm32(Rr[i] & 31)); voffB[i] = (unsigned)(Rb * K + Cc[i]) * 2u; }
    const size_t kstep = (size_t)(BK * 2);
    const size_t hstep = (size_t)HALF * K * 2;
    const size_t bhs = (size_t)(Epi::BMAP == 2 ? 32 : HALF) * K * 2;
    LAS unsigned char* const stg = lds + RING_BYTES + wid * 2304;
    const unsigned ldsw = (unsigned)wid * 1024u;
    const int aoff = lds_byte(wr * 64 + fr, fq * 8), boff = lds_byte(wc * 32 + fr, fq * 8);
#define PG8_SA(b, h) (((b) * 2 + (h)) * HTB)
#define PG8_SB(b, h) ((4 + (b) * 2 + (h)) * HTB)
#define PG8_STAGE(bufoff, gbase, voff) do { _Pragma("unroll") for (int _i = 0; _i < 2; ++_i) \
        __builtin_amdgcn_global_load_lds((const unsigned*)((const char*)(gbase) + (voff)[_i]), (LAS unsigned*)(lds + (bufoff) + ldsw + _i * 8192), 16, 0, 0); } while (0)
#define PG8_LDA(dst, b, h) do { _Pragma("unroll") for (int m = 0; m < 4; ++m) _Pragma("unroll") for (int k = 0; k < 2; ++k) dst[m][k] = *(const LAS bf16x8*)(lds + PG8_SA(b, h) + aoff + m * 2048 + k * 1024); } while (0)
#define PG8_LDB(dst, b, h) do { _Pragma("unroll") for (int n = 0; n < 2; ++n) _Pragma("unroll") for (int k = 0; k < 2; ++k) dst[n][k] = *(const LAS bf16x8*)(lds + PG8_SB(b, h) + boff + n * 2048 + k * 1024); } while (0)
#define PG8_MMA(ai, bj, At, Bt) do { __builtin_amdgcn_s_setprio(1); _Pragma("unroll") for (int m = 0; m < 4; ++m) _Pragma("unroll") for (int n = 0; n < 2; ++n) _Pragma("unroll") for (int k = 0; k < 2; ++k) \
        acc[ai][bj][m][n] = __builtin_amdgcn_mfma_f32_16x16x32_bf16(Bt[n][k], At[m][k], acc[ai][bj][m][n], 0, 0, 0); __builtin_amdgcn_s_setprio(0); } while (0)
#define PG8_WAIT_V(n) asm volatile("s_waitcnt vmcnt(" #n ")" ::: "memory")
#define PG8_WAIT_L(n) asm volatile("s_waitcnt lgkmcnt(" #n ")" ::: "memory")
#define PG8_BAR __builtin_amdgcn_s_barrier()
#define PG8_SCHED __builtin_amdgcn_sched_barrier(0)
    Unit cur, nxt; int ui = 0;
    if (!S.next(0, cur)) return;
    f32x4 acc[2][2][4][2];
#pragma unroll
    for (int a = 0; a < 2; ++a)
#pragma unroll
        for (int b = 0; b < 2; ++b)
#pragma unroll
            for (int m = 0; m < 4; ++m)
#pragma unroll
                for (int n = 0; n < 2; ++n) acc[a][b][m][n] = (f32x4){0.f, 0.f, 0.f, 0.f};
    bf16x8 At[4][2], B0[2][2], B1[2][2];
    constexpr bool GATHER = Sched::GATHER;
    unsigned cv0[2], cv1[2], nv0[2], nv1[2];
#pragma unroll
    for (int i = 0; i < 2; ++i) {
        if constexpr (GATHER) { cv0[i] = (S.arow(cur, Rr[i]) * (unsigned)K + (unsigned)Cc[i]) * 2u; cv1[i] = (S.arow(cur, HALF + Rr[i]) * (unsigned)K + (unsigned)Cc[i]) * 2u; }
        else { cv0[i] = (unsigned)(Rr[i] * K + Cc[i]) * 2u; cv1[i] = cv0[i]; nv0[i] = cv0[i]; nv1[i] = cv0[i]; }
    }
    const char* cA = GATHER ? (const char*)Abase : (const char*)Abase + (size_t)S.arow(cur, 0) * K * 2;
    const size_t ahs = GATHER ? 0 : hstep;
    const char* cB = S.bptr(cur);
    PG8_STAGE(PG8_SB(0, 0), cB, voffB); PG8_STAGE(PG8_SB(0, 1), cB + bhs, voffB); PG8_STAGE(PG8_SA(0, 0), cA, cv0); PG8_STAGE(PG8_SA(0, 1), cA + ahs, cv1);
    if (wr == 1) PG8_BAR;
    PG8_WAIT_V(2); PG8_BAR;
    PG8_STAGE(PG8_SB(1, 0), cB + kstep, voffB); PG8_STAGE(PG8_SA(1, 0), cA + kstep, cv0); PG8_STAGE(PG8_SB(1, 1), cB + bhs + kstep, voffB);
    PG8_WAIT_V(6); PG8_BAR;
    for (;;) {
        const bool has_next = S.next(ui + 1, nxt);
        const char* nB = has_next ? S.bptr(nxt) : cB;
        const char* nA = cA;
        if constexpr (GATHER) {
#pragma unroll
            for (int i = 0; i < 2; ++i) {
                nv0[i] = has_next ? (S.arow(nxt, Rr[i]) * (unsigned)K + (unsigned)Cc[i]) * 2u : cv0[i];
                nv1[i] = has_next ? (S.arow(nxt, HALF + Rr[i]) * (unsigned)K + (unsigned)Cc[i]) * 2u : cv1[i];
            }
        } else { if (has_next) nA = (const char*)Abase + (size_t)S.arow(nxt, 0) * K * 2; }
        for (int t = 0; t < nt; t += 2) {
            const bool last = (t == nt - 2);
            if constexpr (Epi::HAS_MID) { if (t == (nt >> 1)) E.mid(acc, cur, wr, wc, fr, fq); }
            const char* a1 = cA + (size_t)(t + 1) * kstep;
            const char* a2 = last ? nA : cA + (size_t)(t + 2) * kstep; const char* b2 = last ? nB : cB + (size_t)(t + 2) * kstep;
            const char* a3 = a2 + kstep; const char* b3 = b2 + kstep;
            unsigned x0[2], x1[2];
#pragma unroll
            for (int i = 0; i < 2; ++i) { x0[i] = (GATHER && last) ? nv0[i] : cv0[i]; x1[i] = (GATHER && last) ? nv1[i] : cv1[i]; }
            PG8_LDB(B0, 0, 0); PG8_LDB(B1, 0, 1); PG8_SCHED; PG8_LDA(At, 0, 0); PG8_STAGE(PG8_SA(1, 1), a1 + ahs, cv1);
            PG8_WAIT_V(8); PG8_WAIT_L(0); PG8_BAR; PG8_MMA(0, 0, At, B0); PG8_MMA(0, 1, At, B1); PG8_BAR; PG8_SCHED;
            PG8_LDA(At, 0, 1); PG8_STAGE(PG8_SB(0, 0), b2, voffB); PG8_STAGE(PG8_SB(0, 1), b2 + bhs, voffB); PG8_STAGE(PG8_SA(0, 0), a2, x0);
            PG8_WAIT_V(8); PG8_WAIT_L(0); PG8_BAR; PG8_MMA(1, 0, At, B0); PG8_MMA(1, 1, At, B1); PG8_BAR; PG8_SCHED;
            PG8_LDB(B0, 1, 0); PG8_LDB(B1, 1, 1); PG8_SCHED; PG8_LDA(At, 1, 0); PG8_STAGE(PG8_SA(0, 1), a2 + ahs, x1);
            PG8_WAIT_V(8); PG8_WAIT_L(0); PG8_BAR; PG8_MMA(0, 0, At, B0); PG8_MMA(0, 1, At, B1); PG8_BAR; PG8_SCHED;
            PG8_LDA(At, 1, 1); PG8_STAGE(PG8_SB(1, 0), b3, voffB); PG8_STAGE(PG8_SB(1, 1), b3 + bhs, voffB); PG8_STAGE(PG8_SA(1, 0), a3, x0);
            PG8_WAIT_V(8); PG8_WAIT_L(0); PG8_BAR; PG8_MMA(1, 0, At, B0); PG8_MMA(1, 1, At, B1); PG8_BAR; PG8_SCHED;
        }
        if constexpr (ALIGN_EPI) { if (wr == 0) PG8_BAR; }
        E(acc, cur, wr, wc, fr, fq, stg, lane);
        if (!has_next) break;
#pragma unroll
        for (int a = 0; a < 2; ++a)
#pragma unroll
            for (int b = 0; b < 2; ++b)
#pragma unroll
                for (int m = 0; m < 4; ++m)
#pragma unroll
                    for (int n = 0; n < 2; ++n) acc[a][b][m][n] = (f32x4){0.f, 0.f, 0.f, 0.f};
        cur = nxt; cB = nB; cA = nA; ++ui;
        if constexpr (GATHER) {
#pragma unroll
            for (int i = 0; i < 2; ++i) { cv0[i] = nv0[i]; cv1[i] = nv1[i]; }
        }
        if constexpr (ALIGN_EPI) { if (wr == 1) PG8_BAR; }
    }
    PG8_WAIT_V(0);
    if constexpr (!ALIGN_EPI) { if (wr == 0) PG8_BAR; }
    PG8_BAR;
#undef PG8_SA
#undef PG8_SB
#undef PG8_STAGE
#undef PG8_LDA
#undef PG8_LDB
#undef PG8_MMA
#undef PG8_WAIT_V
#undef PG8_WAIT_L
#undef PG8_BAR
#undef PG8_SCHED
}

__device__ __forceinline__ u32x4 pack8(const f32x4 v0, const f32x4 v1) { u32x4 w; w.x = pk2(v0[0], v0[1]); w.y = pk2(v0[2], v0[3]); w.z = pk2(v1[0], v1[1]); w.w = pk2(v1[2], v1[3]); return w; }
template <class RowPtr, class RowOk>
__device__ __forceinline__ void staged_store(LAS unsigned char* stg, int lane, const u32x4 p0, const u32x4 p1, const RowPtr& rp, const RowOk& ok) {
    const int fr = lane & 15, fq = lane >> 4;
    *(LAS u32x4*)(stg + fr * 144 + fq * 16) = p0; *(LAS u32x4*)(stg + fr * 144 + 64 + fq * 16) = p1;
    const int r = lane >> 3, ch = lane & 7;
    const u32x4 a = *(LAS const u32x4*)(stg + r * 144 + ch * 16), b = *(LAS const u32x4*)(stg + (r + 8) * 144 + ch * 16);
    if (ok(r)) *(u32x4*)(rp(r) + ch * 8) = a;
    if (ok(r + 8)) *(u32x4*)(rp(r + 8) + ch * 8) = b;
}
__device__ __forceinline__ void staged_store2(LAS unsigned char* stg, int lane, const u32x4 p0, const u32x4 p1, bf16_t* a, bf16_t* b, size_t ld) {
    const int fr = lane & 15, fq = lane >> 4;
    *(LAS u32x4*)(stg + fr * 144 + fq * 16) = p0; *(LAS u32x4*)(stg + fr * 144 + 64 + fq * 16) = p1;
    const int r = lane >> 2, ch = lane & 3;
    const u32x4 x = *(LAS const u32x4*)(stg + r * 144 + ch * 16), y = *(LAS const u32x4*)(stg + r * 144 + 64 + ch * 16);
    *(u32x4*)(a + (size_t)r * ld + ch * 8) = x; *(u32x4*)(b + (size_t)r * ld + ch * 8) = y;
}
struct AlwaysOk { __device__ __forceinline__ bool operator()(int) const { return true; } };
struct DenseRows { bf16_t* base; size_t ld; __device__ __forceinline__ bf16_t* operator()(int r) const { return base + (size_t)r * ld; } };

struct EpiInA {
    static constexpr int BMAP = 2; static constexpr bool HAS_MID = false;
    bf16_t *Q, *Kb, *Vb, *RS;
    __device__ __forceinline__ void operator()(const f32x4 (&acc)[2][2][4][2], const Unit& u, int wr, int wc, int fr, int fq, LAS unsigned char* stg, int lane) const {
        const int row0 = u.pm * BM + wr * 64;
        if (u.pn < 3) {
            bf16_t* base; size_t ld;
            if (u.pn < 2) { base = Q + u.pn * 256 + wc * 64; ld = AW; } else { base = (wc < 2 ? Kb : Vb) + (wc & 1) * 64; ld = KVW; }
#pragma unroll
            for (int ai = 0; ai < 2; ++ai)
#pragma unroll
                for (int m = 0; m < 4; ++m)
                    staged_store(stg, lane, pack8(acc[ai][0][m][0], acc[ai][0][m][1]), pack8(acc[ai][1][m][0], acc[ai][1][m][1]), DenseRows{base + (size_t)(row0 + ai * HALF + m * 16) * ld, ld}, AlwaysOk{});
        } else {
            bf16_t* rb = RS + (u.pn - 3) * 128 + wc * 32; bf16_t* sb = rb + (size_t)T * DM;
#pragma unroll
            for (int ai = 0; ai < 2; ++ai)
#pragma unroll
                for (int m = 0; m < 4; ++m) {
                    f32x4 r0, r1, s0, s1;
#pragma unroll
                    for (int j = 0; j < 4; ++j) {
                        const float ea0 = __expf(-acc[ai][0][m][0][j]), eh0 = __expf(-acc[ai][1][m][0][j]), ea1 = __expf(-acc[ai][0][m][1][j]), eh1 = __expf(-acc[ai][1][m][1][j]);
                        s0[j] = __builtin_amdgcn_rcpf(1.0f + eh0); s1[j] = __builtin_amdgcn_rcpf(1.0f + eh1); r0[j] = (1.0f + eh0) * __builtin_amdgcn_rcpf(1.0f + ea0); r1[j] = (1.0f + eh1) * __builtin_amdgcn_rcpf(1.0f + ea1); }
                    staged_store2(stg, lane, pack8(r0, r1), pack8(s0, s1), rb + (size_t)(row0 + ai * HALF + m * 16) * DM, sb + (size_t)(row0 + ai * HALF + m * 16) * DM, DM);
                }
        }
    }
};
struct EpiBf16 {
    static constexpr int BMAP = 2; static constexpr bool HAS_MID = false;
    bf16_t* O; int ldc;
    __device__ __forceinline__ void operator()(const f32x4 (&acc)[2][2][4][2], const Unit& u, int wr, int wc, int fr, int fq, LAS unsigned char* stg, int lane) const {
        bf16_t* base = O + (size_t)(u.pm * BM + wr * 64) * ldc + u.pn * BM + wc * 64;
#pragma unroll
        for (int ai = 0; ai < 2; ++ai)
#pragma unroll
            for (int m = 0; m < 4; ++m)
                staged_store(stg, lane, pack8(acc[ai][0][m][0], acc[ai][0][m][1]), pack8(acc[ai][1][m][0], acc[ai][1][m][1]), DenseRows{base + (size_t)(ai * HALF + m * 16) * ldc, (size_t)ldc}, AlwaysOk{});
    }
};
struct EpiMerge {
    static constexpr int BMAP = 2; static constexpr bool HAS_MID = true;
    const bf16_t* RS; bf16_t* O;
    __device__ __forceinline__ void mid(f32x4 (&acc)[2][2][4][2], const Unit& u, int wr, int wc, int fr, int fq) const {
        asm volatile("" : "+v"(fr), "+v"(fq));
        const int row0 = u.pm * BM + wr * 64 + fr;
#pragma unroll
        for (int ai = 0; ai < 2; ++ai)
#pragma unroll
            for (int mh = 0; mh < 2; ++mh) {
                u32x4 g[2][2];
#pragma unroll
                for (int mm = 0; mm < 2; ++mm)
#pragma unroll
                    for (int bj = 0; bj < 2; ++bj) g[mm][bj] = *(const u32x4*)(RS + (size_t)(row0 + ai * HALF + (2 * mh + mm) * 16) * DM + u.pn * BM + wc * 64 + bj * 32 + 8 * fq);
#pragma unroll
                for (int mm = 0; mm < 2; ++mm)
#pragma unroll
                    for (int bj = 0; bj < 2; ++bj) { const int m = 2 * mh + mm; const u32x4 gg = g[mm][bj];
                        acc[ai][bj][m][0][0] *= bflo(gg.x); acc[ai][bj][m][0][1] *= bfhi(gg.x); acc[ai][bj][m][0][2] *= bflo(gg.y); acc[ai][bj][m][0][3] *= bfhi(gg.y);
                        acc[ai][bj][m][1][0] *= bflo(gg.z); acc[ai][bj][m][1][1] *= bfhi(gg.z); acc[ai][bj][m][1][2] *= bflo(gg.w); acc[ai][bj][m][1][3] *= bfhi(gg.w); }
                asm volatile("" ::: "memory");
            }
    }
    __device__ __forceinline__ void operator()(const f32x4 (&acc)[2][2][4][2], const Unit& u, int wr, int wc, int fr, int fq, LAS unsigned char* stg, int lane) const {
        const int row0 = u.pm * BM + wr * 64;
        bf16_t* base = O + (size_t)row0 * DM + u.pn * BM + wc * 64;
#pragma unroll
        for (int ai = 0; ai < 2; ++ai)
#pragma unroll
            for (int m = 0; m < 4; ++m) {
                u32x4 pk[2];
#pragma unroll
                for (int bj = 0; bj < 2; ++bj) {
                    const u32x4 g = *(const u32x4*)(RS + (size_t)T * DM + (size_t)(row0 + fr + ai * HALF + m * 16) * DM + u.pn * BM + wc * 64 + bj * 32 + 8 * fq);
                    f32x4 v0 = acc[ai][bj][m][0], v1 = acc[ai][bj][m][1];
                    v0[0] *= bflo(g.x); v0[1] *= bfhi(g.x); v0[2] *= bflo(g.y); v0[3] *= bfhi(g.y);
                    v1[0] *= bflo(g.z); v1[1] *= bfhi(g.z); v1[2] *= bflo(g.w); v1[3] *= bfhi(g.w);
                    pk[bj] = pack8(v0, v1);
                }
                staged_store(stg, lane, pk[0], pk[1], DenseRows{base + (size_t)(ai * HALF + m * 16) * DM, DM}, AlwaysOk{});
            }
    }
};
struct EpiY {
    static constexpr int BMAP = 2; static constexpr bool HAS_MID = false;
    const float* gate; bf16_t* O;
    __device__ __forceinline__ void operator()(const f32x4 (&acc)[2][2][4][2], const Unit& u, int wr, int wc, int fr, int fq, LAS unsigned char* stg, int lane) const {
        const int col0 = u.pn * BM + wc * 64; const int b = (u.pm * BM) / SEQ;
        const float* gp = gate + (size_t)b * 6144 + col0 + 8 * fq;
        const f32x4 g00 = *(const f32x4*)gp, g01 = *(const f32x4*)(gp + 4), g10 = *(const f32x4*)(gp + 32), g11 = *(const f32x4*)(gp + 36);
        bf16_t* base = O + (size_t)(u.pm * BM + wr * 64) * DM + col0;
#pragma unroll
        for (int ai = 0; ai < 2; ++ai)
#pragma unroll
            for (int m = 0; m < 4; ++m)
                staged_store(stg, lane, pack8(acc[ai][0][m][0] * g00, acc[ai][0][m][1] * g01), pack8(acc[ai][1][m][0] * g10, acc[ai][1][m][1] * g11), DenseRows{base + (size_t)(ai * HALF + m * 16) * DM, DM}, AlwaysOk{});
    }
};
struct EpiNull {
    static constexpr int BMAP = 2; static constexpr bool HAS_MID = false;
    __device__ __forceinline__ void operator()(const f32x4 (&acc)[2][2][4][2], const Unit& u, int wr, int wc, int fr, int fq, LAS unsigned char* stg, int lane) const {
#pragma unroll
        for (int ai = 0; ai < 2; ++ai)
#pragma unroll
            for (int bj = 0; bj < 2; ++bj)
#pragma unroll
                for (int m = 0; m < 4; ++m) asm volatile("" :: "v"(acc[ai][bj][m][0]), "v"(acc[ai][bj][m][1]));
    }
};
struct EpiSwiGLU {
    static constexpr int BMAP = 1; static constexpr bool HAS_MID = false;
    bf16_t* H;
    __device__ __forceinline__ void operator()(const f32x4 (&acc)[2][2][4][2], const Unit& u, int wr, int wc, int fr, int fq, LAS unsigned char* stg, int lane) const {
        const int row0 = u.pm * BM + wr * 64 + fr; const int col0 = u.pn * HALF + wc * 32 + 8 * fq;
#pragma unroll
        for (int ai = 0; ai < 2; ++ai)
#pragma unroll
            for (int m = 0; m < 4; ++m) {
                f32x4 v0, v1;
#pragma unroll
                for (int j = 0; j < 4; ++j) { const float a0 = acc[ai][0][m][0][j], a1 = acc[ai][0][m][1][j];
                    v0[j] = a0 * sigmoidf_(a0) * acc[ai][1][m][0][j]; v1[j] = a1 * sigmoidf_(a1) * acc[ai][1][m][1][j]; }
                *(u32x4*)(H + (size_t)(row0 + ai * HALF + m * 16) * DE + col0) = pack8(v0, v1);
            }
    }
};
struct EpiScatter {
    static constexpr int BMAP = 2; static constexpr bool HAS_MID = false;
    bf16_t* Y2; const LAS int* rowtab; const LAS float* wtab;
    struct Rows { bf16_t* base; int d0, d1; __device__ __forceinline__ bf16_t* operator()(int r) const { return base + (size_t)(r < 8 ? d0 : d1) * DM; } };
    struct Oks { bool o0, o1; __device__ __forceinline__ bool operator()(int r) const { return r < 8 ? o0 : o1; } };
    __device__ __forceinline__ void operator()(const f32x4 (&acc)[2][2][4][2], const Unit& u, int wr, int wc, int fr, int fq, LAS unsigned char* stg, int lane) const {
        bf16_t* base = Y2 + u.pn * BM + wc * 64;
        const LAS int* rt = rowtab + u.li * 256; const LAS float* wt = wtab + u.li * 256;
#pragma unroll
        for (int ai = 0; ai < 2; ++ai)
#pragma unroll
            for (int m = 0; m < 4; ++m) {
                const int g0 = ai * HALF + wr * 64 + m * 16;
                const float w = wt[g0 + fr]; const int d0 = rt[g0 + (lane >> 3)], d1 = rt[g0 + (lane >> 3) + 8];
                staged_store(stg, lane, pack8(acc[ai][0][m][0] * w, acc[ai][0][m][1] * w), pack8(acc[ai][1][m][0] * w, acc[ai][1][m][1] * w), Rows{base, d0 < 0 ? 0 : d0, d1 < 0 ? 0 : d1}, Oks{d0 >= 0, d1 >= 0});
            }
    }
};
}

#define XB_TMO      128
#define XB_XCNT(j)  (256  + 64 * (j))
#define XB_XSUB(j)  (1280 + 64 * (j))
#define XB_XGEN(j)  (2304 + 64 * (j))
#define XB_TOP      3328
#define XB_TOPGEN   3392
#define XCD_BAR_WORDS 3456
#define XB_SPIN_CAP (1u << 22)
__device__ __forceinline__ unsigned xb_ld(unsigned* p)              { return __hip_atomic_load(p, __ATOMIC_RELAXED, __HIP_MEMORY_SCOPE_AGENT); }
__device__ __forceinline__ unsigned xb_add(unsigned* p, unsigned v) { return __hip_atomic_fetch_add(p, v, __ATOMIC_RELAXED, __HIP_MEMORY_SCOPE_AGENT); }
__device__ __forceinline__ unsigned xb_xcc_id() { return (unsigned)__builtin_amdgcn_s_getreg((3 << 11) | 20) & 0xFu; }
#define XB_SPIN(cond, bar) do { unsigned _sp = 0; while (cond) { __builtin_amdgcn_s_sleep(1); \
    if ((++_sp & 255u) == 0u) { if (xb_ld(&(bar)[XB_TMO])) break; if (_sp > XB_SPIN_CAP) { atomicAdd(&(bar)[XB_TMO], 1u); break; } } } } while (0)
__device__ __forceinline__ void xcd_barrier_post(unsigned* bar) { if (threadIdx.x == 0) (void)xb_add(&bar[XB_XCNT(xb_xcc_id())], 1u); }
__device__ __forceinline__ void xcd_barrier_complete(unsigned* bar, unsigned x, unsigned& nloc, unsigned& nx) {
    const unsigned G = gridDim.x * gridDim.y * gridDim.z;
    unsigned sum, cnt, mine, sp = 0u;
    for (;;) {
        sum = 0u; cnt = 0u; mine = 0u;
#pragma unroll
        for (unsigned j = 0; j < 16; ++j) { const unsigned c = xb_ld(&bar[XB_XCNT(j)]); sum += c; cnt += (c > 0u) ? 1u : 0u; mine = (j == x) ? c : mine; }
        if (sum == G) break;
        __builtin_amdgcn_s_sleep(1);
        if ((++sp & 255u) == 0u) { if (xb_ld(&bar[XB_TMO])) break; if (sp > XB_SPIN_CAP) { atomicAdd(&bar[XB_TMO], 1u); break; } }
    }
    nloc = mine > 0u ? mine : 1u; nx = cnt > 0u ? cnt : 1u;
}
__device__ __forceinline__ void xcd_barrier(unsigned* bar, volatile LAS unsigned* st) {
    asm volatile("s_waitcnt vmcnt(0)" ::: "memory");
    __syncthreads();
    if (threadIdx.x == 0) {
        const unsigned x = xb_xcc_id();
        __builtin_amdgcn_s_waitcnt(0);
        unsigned nloc = st[0], nx = st[1];
        if (nloc == 0u) { xcd_barrier_complete(bar, x, nloc, nx); st[0] = nloc; st[1] = nx; }
        const unsigned old = xb_add(&bar[XB_XSUB(x)], 1u);
        const unsigned gen = old / nloc;
        if (old + 1u == (gen + 1u) * nloc) {
            __builtin_amdgcn_fence(__ATOMIC_RELEASE, "agent");
            asm volatile("s_waitcnt vmcnt(0)" ::: "memory");
            const unsigned og = xb_add(&bar[XB_TOP], 1u);
            const unsigned tg = og / nx;
            if (og + 1u == (tg + 1u) * nx) xb_add(&bar[XB_TOPGEN], 1u);
            else XB_SPIN(xb_ld(&bar[XB_TOPGEN]) == tg, bar);
            __builtin_amdgcn_fence(__ATOMIC_ACQUIRE, "agent");
            xb_add(&bar[XB_XGEN(x)], 1u);
            asm volatile("s_waitcnt vmcnt(0)" ::: "memory");
        } else {
            XB_SPIN(xb_ld(&bar[XB_XGEN(x)]) == gen, bar);
            __builtin_amdgcn_fence(__ATOMIC_ACQUIRE, "agent");
            asm volatile("s_waitcnt vmcnt(0)" ::: "memory");
        }
    }
    __syncthreads();
}

struct Args { const float* in[31]; float* out; unsigned char* ws; int ph_lo, ph_hi; };
struct Frame {
    LAS unsigned char* lds; unsigned char* ws; unsigned* ctl;
    int tid, lane, wave, vcu, G;
    const float* const* in; float* out;
};
enum { I_X = 0, I_C, I_WADA, I_BADA, I_WIN, I_CONVW, I_CONVB, I_FW1, I_FB1, I_FF1, I_FW2, I_FB2, I_FF2, I_FW3, I_DECAY, I_SKIP, I_WHY, I_WATT, I_SINK, I_WOUT,
       I_LN1G, I_LN1B, I_RGW, I_RGB, I_REW, I_REB, I_EW1, I_EW3, I_EW2, I_LN2G, I_LN2B };

__device__ __forceinline__ void transpose_item(const float* W, int K, int N, bf16_t* WT, int ldt, int drow0, LAS float* scr, int kb, int nb, int lane) {
    const int k0 = 64 * kb, n0 = 32 * nb;
#pragma unroll 8
    for (int i = 0; i < 32; ++i) { const int kk = 2 * i + (lane >> 5); scr[kk * 33 + (lane & 31)] = W[(size_t)(k0 + kk) * N + n0 + (lane & 31)]; }
    LDS_WAIT(); asm volatile("" ::: "memory");
    const int c = lane & 7;
#pragma unroll
    for (int j = 0; j < 4; ++j) { const int n = (lane >> 3) + 8 * j; const LAS float* s = scr + (8 * c) * 33 + n;
        u32x4 o; o.x = pk2(s[0 * 33], s[1 * 33]); o.y = pk2(s[2 * 33], s[3 * 33]); o.z = pk2(s[4 * 33], s[5 * 33]); o.w = pk2(s[6 * 33], s[7 * 33]);
        *(u32x4*)(WT + (size_t)(drow0 + n) * ldt + k0 + 8 * c) = o; }
    LDS_WAIT(); asm volatile("" ::: "memory");
}

__device__ __forceinline__ void ph_prep(Frame& F) {
    const float* c = F.in[I_C]; const float* wada = F.in[I_WADA];
    float* modp = (float*)(F.ws + WS_MODP);
    for (int it = blockIdx.x; it < 192; it += F.G) {
        const int kc = it / 12, cg = it % 12, j = cg * 512 + F.tid;
        float a0 = 0.f, a1 = 0.f, a2 = 0.f, a3 = 0.f;
#pragma unroll 16
        for (int kk = 0; kk < 64; ++kk) { const int k = kc * 64 + kk; const float w = wada[(size_t)k * 6144 + j];
            const float c0 = c[k], c1 = c[1024 + k], c2 = c[2048 + k], c3 = c[3072 + k];
            a0 += c0 * sigmoidf_(c0) * w; a1 += c1 * sigmoidf_(c1) * w; a2 += c2 * sigmoidf_(c2) * w; a3 += c3 * sigmoidf_(c3) * w; }
        modp[(size_t)(kc * 4 + 0) * 6144 + j] = a0; modp[(size_t)(kc * 4 + 1) * 6144 + j] = a1; modp[(size_t)(kc * 4 + 2) * 6144 + j] = a2; modp[(size_t)(kc * 4 + 3) * 6144 + j] = a3;
    }
    LAS float* scr = (LAS float*)(F.lds + F.wave * 16384);
    const int gw = F.vcu * NWAVES + F.wave, NGW = F.G * NWAVES;
    constexpr int I_IN = 16 * 136, I_A = 8 * 32, I_H = 8 * 32, I_O = 16 * 32;
    for (int it = gw; it < I_IN + I_A + I_H + I_O; it += NGW) {
        int r = it;
        if (r < I_IN) { const int kb = r / 136, nb = r % 136, n0 = nb * 32;
            int drow;
            if (n0 < 768) drow = n0; else if (n0 < 2304) drow = N1A + (n0 - 768);
            else if (n0 < 3328) { const int d = n0 - 2304; drow = 768 + (d >> 5) * 64; }
            else { const int d = n0 - 3328; drow = 768 + (d >> 5) * 64 + 32; }
            transpose_item(F.in[I_WIN], DM, INW, (bf16_t*)(F.ws + WS_WIN), DM, drow, scr, kb, nb, F.lane); continue; } r -= I_IN;
        if (r < I_A) { transpose_item(F.in[I_WATT], AW, DM, (bf16_t*)(F.ws + WS_WAH), DM, (r % 32) * 32, scr, r / 32, r % 32, F.lane); continue; } r -= I_A;
        if (r < I_H) { transpose_item(F.in[I_WHY], HW, DM, (bf16_t*)(F.ws + WS_WAH) + AW, DM, (r % 32) * 32, scr, r / 32, r % 32, F.lane); continue; } r -= I_H;
        transpose_item(F.in[I_WOUT], DM, DM, (bf16_t*)(F.ws + WS_WO), DM, (r % 32) * 32, scr, r / 32, r % 32, F.lane);
    }
    {
        const float* w1 = F.in[I_FW1]; const float* b1 = F.in[I_FB1]; const float* f1 = F.in[I_FF1];
        const float* w2 = F.in[I_FW2]; const float* b2 = F.in[I_FB2]; const float* f2 = F.in[I_FF2];
        const int j = F.lane;
        for (int t = gw; t < SEQ; t += NGW) {
            const float tl = (float)t / (float)(SEQ - 1);
            const float w = 6.283185307179586f * (float)t / (float)SEQ;
            float zi = 0.f;
            if (j == 0) zi = tl;
            else if (j <= 16) { const float band = 1e-4f + (float)(j - 1) * ((15.0f - 1e-4f) / 15.0f); zi = cosf(band * w); }
            else if (j <= 32) { const float band = 1e-4f + (float)(j - 17) * ((15.0f - 1e-4f) / 15.0f); zi = -sinf(band * w); }
            float a = b1[j];
#pragma unroll
            for (int i = 0; i < FEMB; ++i) a += __shfl(zi, i) * w1[i * FH + j];
            const float h1 = sinf(f1[j] * a);
            float a2 = b2[j];
#pragma unroll
            for (int i = 0; i < FH; ++i) a2 += __shfl(h1, i) * w2[i * FH + j];
            ((bf16_t*)(F.ws + WS_HDNB))[(size_t)t * FH + j] = (bf16_t)f2bf(sinf(f2[j] * a2));
        }
    }
    {
        bf16_t* ftab = (bf16_t*)(F.ws + WS_FTAB); unsigned* twt = (unsigned*)(F.ws + WS_TWT);
        for (int i = blockIdx.x * NTHREADS + F.tid; i < 2 * 128 * 128; i += F.G * NTHREADS) {
            const int t = i >> 14, row = (i >> 7) & 127, q = i & 127;
            const int q15 = q & 15, h = q15 >> 3, j = q15 & 7; const int nat = (q & ~15) + 8 * (j >> 2) + 4 * h + (j & 3);
            const int e = (row * nat) & 127; const float x = (float)e * (2.0f / 128.0f);
            const float v = t == 0 ? cospif(x) : -sinpif(x);
            ftab[(size_t)t * (128 * 136) + row * 136 + q] = (bf16_t)f2bf(v);
        }
        for (int i = blockIdx.x * NTHREADS + F.tid; i < 16 * 64 * 16; i += F.G * NTHREADS) {
            const int r = i & 15, l = (i >> 4) & 63, ab = i >> 10, al = ab >> 2, be = ab & 3;
            const int e = ((32 * al + ((r & 3) + 8 * (r >> 2) + 4 * (l >> 5))) * (32 * be + (l & 31))) & 16383; const float x = (float)e * (2.0f / 16384.0f);
            twt[i] = pk2(cospif(x), -sinpif(x));
        }
    }
    {
        bf16_t* wr = (bf16_t*)(F.ws + WS_WRT); const float* wg = F.in[I_RGW]; const float* we = F.in[I_REW];
        for (int i = blockIdx.x * NTHREADS + F.tid; i < 80 * DM; i += F.G * NTHREADS) { const int o = i / DM, k = i % DM;
            const float w = o < 8 ? wg[k * 8 + o] : (o < 72 ? we[k * 64 + (o - 8)] : 0.f);
            const unsigned hi = f2bf(w); const float lo = w - bf2f((unsigned short)hi);
            wr[i] = (bf16_t)hi; wr[80 * DM + i] = (bf16_t)f2bf(lo); }
    }
}

__device__ __forceinline__ void ph_taps(Frame& F) {
    typedef float f32x16 __attribute__((ext_vector_type(16)));
    const bf16_t* hb = (const bf16_t*)(F.ws + WS_HDNB); const float* w3 = F.in[I_FW3]; const float* decay = F.in[I_DECAY];
    bf16_t* kraw = (bf16_t*)(F.ws + WS_KRAW); float* kpart = (float*)(F.ws + WS_KPART);
    const int lane = F.lane, lr = lane & 31, lh = lane >> 5;
    for (int it = blockIdx.x; it < 256; it += F.G) {
        const int g = it & 63, tq = it >> 6;
        bf16x8 aW[4];
#pragma unroll
        for (int s = 0; s < 4; ++s) { unsigned pk[4];
#pragma unroll
            for (int j2 = 0; j2 < 4; ++j2) { const int k = 16 * s + 8 * lh + 2 * j2; pk[j2] = pk2(w3[(size_t)k * NFILT + 32 * g + lr], w3[(size_t)(k + 1) * NFILT + 32 * g + lr]); }
            aW[s] = __builtin_bit_cast(bf16x8, (u32x4){pk[0], pk[1], pk[2], pk[3]}); }
        float dcy[16], asum[16];
#pragma unroll
        for (int r = 0; r < 16; ++r) { dcy[r] = fabsf(decay[32 * g + (r & 3) + 8 * (r >> 2) + 4 * lh]); asum[r] = 0.f; }
#pragma unroll 1
        for (int tt = 0; tt < 8; ++tt) {
            const int t = 2048 * tq + 32 * (F.wave * 8 + tt) + lr;
            f32x16 acc;
#pragma unroll
            for (int r = 0; r < 16; ++r) acc[r] = 0.f;
#pragma unroll
            for (int s = 0; s < 4; ++s) { const bf16x8 bH = *(const bf16x8*)(hb + (size_t)t * FH + 16 * s + 8 * lh); acc = __builtin_amdgcn_mfma_f32_32x32x16_bf16(aW[s], bH, acc, 0, 0, 0); }
            const float tl = (float)t / (float)(SEQ - 1);
#pragma unroll
            for (int r = 0; r < 16; ++r) { const float v = acc[r] * (__expf(-tl * dcy[r]) + 0.05f); asum[r] += fabsf(v);
                kraw[(size_t)(32 * g + (r & 3) + 8 * (r >> 2) + 4 * lh) * SEQ + t] = (bf16_t)f2bf(v); }
        }
#pragma unroll
        for (int r = 0; r < 16; ++r) { float v = asum[r];
#pragma unroll
            for (int o = 1; o < 32; o <<= 1) v += __shfl_xor(v, o);
            if (lr == 0) kpart[(size_t)(32 * g + (r & 3) + 8 * (r >> 2) + 4 * lh) * 32 + tq * 8 + F.wave] = v; }
    }
}

__device__ __forceinline__ void ph_hb(Frame& F) {
    const float* modp = (const float*)(F.ws + WS_MODP); const float* bada = F.in[I_BADA];
    float* mod = (float*)(F.ws + WS_MOD);
    for (int i = blockIdx.x * NTHREADS + F.tid; i < NB * 6144; i += F.G * NTHREADS) { const int b = i / 6144, j = i % 6144; float s = bada[j];
#pragma unroll
        for (int kc = 0; kc < 16; ++kc) s += modp[(size_t)(kc * 4 + b) * 6144 + j];
        mod[i] = s; }
    LAS float* sc = (LAS float*)F.lds; LAS float* sh = sc + DM;
    const float* x = F.in[I_X]; bf16_t* hb = (bf16_t*)(F.ws + WS_HB);
    for (int ch = blockIdx.x; ch < T / 128; ch += F.G) {
        const int b = (ch * 128) / SEQ;
        __syncthreads();
#pragma unroll
        for (int j = F.tid; j < 2 * DM; j += NTHREADS) { float s = bada[j];
#pragma unroll
            for (int kc = 0; kc < 16; ++kc) s += modp[(size_t)(kc * 4 + b) * 6144 + j];
            if (j < DM) sh[j] = s; else sc[j - DM] = 1.0f + s; }
        __syncthreads();
        for (int r0 = F.wave * 4; r0 < 128; r0 += NWAVES * 4) {
            f32x4 xv[4][4];
#pragma unroll
            for (int r = 0; r < 4; ++r) { const f32x4* xr = (const f32x4*)(x + ((size_t)ch * 128 + r0 + r) * DM) + F.lane;
#pragma unroll
                for (int j = 0; j < 4; ++j) xv[r][j] = xr[64 * j]; }
#pragma unroll
            for (int r = 0; r < 4; ++r) { unsigned long long* o8 = (unsigned long long*)(hb + ((size_t)ch * 128 + r0 + r) * DM) + F.lane;
#pragma unroll
                for (int j = 0; j < 4; ++j) { const f32x4 v = xv[r][j]; const int k = 4 * F.lane + 256 * j;
                    const float h0 = v[0] * sc[k] + sh[k], h1 = v[1] * sc[k + 1] + sh[k + 1], h2 = v[2] * sc[k + 2] + sh[k + 2], h3 = v[3] * sc[k + 3] + sh[k + 3];
                    o8[64 * j] = (unsigned long long)pk2(h0, h1) | ((unsigned long long)pk2(h2, h3) << 32); } }
        }
    }
    __syncthreads();
}

namespace at {
typedef float f32x16 __attribute__((ext_vector_type(16)));
typedef __bf16 bf16x2_t __attribute__((ext_vector_type(2)));
constexpr int KROWB = 144, VROWB = 784, K_OFF = 0, V_OFF = 384 * KROWB;
__device__ __forceinline__ unsigned cvtpk(float lo, float hi) { f32x2 v = {lo, hi}; bf16x2_t b = __builtin_convertvector(v, bf16x2_t); return __builtin_bit_cast(unsigned, b); }
template <int S> __device__ __forceinline__ bf16x8 pack_step(const f32x16& x) {
    u32x4 p; p.x = cvtpk(x[8 * S], x[8 * S + 1]); p.y = cvtpk(x[8 * S + 2], x[8 * S + 3]); p.z = cvtpk(x[8 * S + 4], x[8 * S + 5]); p.w = cvtpk(x[8 * S + 6], x[8 * S + 7]);
    return __builtin_bit_cast(bf16x8, p);
}
__device__ __forceinline__ int kst(int k) { const int c = k & 15; return (k & ~15) + 8 * ((c >> 2) & 1) + 4 * (c >> 3) + (c & 3); }
}
__device__ __forceinline__ void ph_attn(Frame& F) {
    using namespace at;
    const bf16_t* Q = (const bf16_t*)(F.ws + WS_Q); const bf16_t* Kb = (const bf16_t*)(F.ws + WS_K); const bf16_t* Vb = (const bf16_t*)(F.ws + WS_V);
    bf16_t* O = (bf16_t*)(F.ws + WS_AH); const float* sink = F.in[I_SINK];
    LAS unsigned char* Ks = F.lds + K_OFF; LAS unsigned char* Vs = F.lds + V_OFF;
    const int wid = F.wave;
    constexpr float LOG2E = 1.4426950408889634f;
    for (int unit = blockIdx.x; unit < NB * 2 * 64; unit += F.G) {
        const int qb = unit & 63, kvh = (unit >> 6) & 1, b = unit >> 7;
        int tid = F.tid; asm volatile("" : "+v"(tid));
        const int lane = tid & 63, lr = lane & 31, lh = lane >> 5;
        __syncthreads();
        {
            u32x4 kv[6], vv[6];
#pragma unroll
            for (int i = 0; i < 6; ++i) { const int ci = tid + 512 * i, j = ci >> 3, p = ci & 7; const int kpos = qb * 128 - 128 + j;
                kv[i] = (u32x4){0u, 0u, 0u, 0u}; vv[i] = kv[i];
                if (kpos >= 0 && kpos < SEQ) { const size_t off = ((size_t)b * SEQ + kpos) * KVW + kvh * 64 + p * 8; kv[i] = *(const u32x4*)(Kb + off); vv[i] = *(const u32x4*)(Vb + off); } }
#pragma unroll
            for (int i = 0; i < 6; ++i) { const int ci = tid + 512 * i, j = ci >> 3, p = ci & 7;
                *(LAS u32x4*)(Ks + j * KROWB + p * 16) = kv[i];
                LAS unsigned char* vp = Vs + (p * 8) * VROWB + kst(j) * 2;
                *(LAS bf16_t*)(vp) = (bf16_t)vv[i].x; *(LAS bf16_t*)(vp + VROWB) = (bf16_t)(vv[i].x >> 16);
                *(LAS bf16_t*)(vp + 2 * VROWB) = (bf16_t)vv[i].y; *(LAS bf16_t*)(vp + 3 * VROWB) = (bf16_t)(vv[i].y >> 16);
                *(LAS bf16_t*)(vp + 4 * VROWB) = (bf16_t)vv[i].z; *(LAS bf16_t*)(vp + 5 * VROWB) = (bf16_t)(vv[i].z >> 16);
                *(LAS bf16_t*)(vp + 6 * VROWB) = (bf16_t)vv[i].w; *(LAS bf16_t*)(vp + 7 * VROWB) = (bf16_t)(vv[i].w >> 16); }
        }
        __syncthreads();
        const int g = wid >> 1, h = kvh * 4 + g, uh = wid & 1;
        const float slope2 = exp2f(-(float)(h + 1)) * LOG2E, c1 = 0.125f * LOG2E, m0 = sink[h] * LOG2E;
        const float d0 = (float)(4 * lh - lr);
#pragma unroll 1
        for (int ut = 0; ut < 2; ++ut) {
            const int u = 2 * uh + ut; const size_t trow = (size_t)b * SEQ + qb * 128 + 32 * u + lr;
            bf16x8 qf[4];
#pragma unroll
            for (int s4 = 0; s4 < 4; ++s4) qf[s4] = *(const bf16x8*)(Q + trow * AW + h * 64 + 16 * s4 + 8 * lh);
            f32x16 Ot[2];
#pragma unroll
            for (int r = 0; r < 16; ++r) { Ot[0][r] = 0.f; Ot[1][r] = 0.f; }
            float m = m0, l = lh == 0 ? 1.0f : 0.0f;
            int kt0 = u, kt1 = u + 8; if (qb == 0 && kt0 < 4) kt0 = 4; if (qb == 63 && kt1 > 7) kt1 = 7;
#pragma unroll 1
            for (int kt = kt0; kt <= kt1; ++kt) {
                f32x16 St;
#pragma unroll
                for (int r = 0; r < 16; ++r) St[r] = 0.f;
                LAS const unsigned char* kp = Ks + (32 * kt + lr) * KROWB + lh * 16;
#pragma unroll
                for (int s4 = 0; s4 < 4; ++s4) St = __builtin_amdgcn_mfma_f32_32x32x16_bf16(*(LAS const bf16x8*)(kp + 32 * s4), qf[s4], St, 0, 0, 0);
                const float base = (float)(32 * (kt - u) - 128) + d0; const bool edge = (kt == u) || (kt == u + 8);
                float tmax = -INFINITY;
#pragma unroll
                for (int r = 0; r < 16; ++r) { const float rel = fabsf(base + (float)((r & 3) + 8 * (r >> 2)));
                    float sv = St[r] * c1 - slope2 * rel; if (edge && rel > 128.0f) sv = -INFINITY; St[r] = sv; tmax = fmaxf(tmax, sv); }
                tmax = fmaxf(tmax, __shfl_xor(tmax, 32));
                const float mn = fmaxf(m, tmax), scl = __builtin_amdgcn_exp2f(m - mn); m = mn; l *= scl;
#pragma unroll
                for (int r = 0; r < 16; ++r) { Ot[0][r] *= scl; Ot[1][r] *= scl; }
#pragma unroll
                for (int r = 0; r < 16; ++r) { const float p = __builtin_amdgcn_exp2f(St[r] - mn); l += p; St[r] = p; }
                const bf16x8 pf0 = pack_step<0>(St), pf1 = pack_step<1>(St);
                LAS const unsigned char* vp = Vs + lr * VROWB + (32 * kt + 8 * lh) * 2;
#pragma unroll
                for (int dt = 0; dt < 2; ++dt) {
                    Ot[dt] = __builtin_amdgcn_mfma_f32_32x32x16_bf16(*(LAS const bf16x8*)(vp + dt * 32 * VROWB), pf0, Ot[dt], 0, 0, 0);
                    Ot[dt] = __builtin_amdgcn_mfma_f32_32x32x16_bf16(*(LAS const bf16x8*)(vp + dt * 32 * VROWB + 32), pf1, Ot[dt], 0, 0, 0);
                }
            }
            l += __shfl_xor(l, 32);
            const float il = 1.0f / l;
            bf16_t* op = O + trow * DM + h * 64 + 4 * lh;
#pragma unroll
            for (int dt = 0; dt < 2; ++dt)
#pragma unroll
                for (int gq = 0; gq < 4; ++gq)
                    *(u32x2*)(op + 32 * dt + 8 * gq) = (u32x2){cvtpk(Ot[dt][4 * gq] * il, Ot[dt][4 * gq + 1] * il), cvtpk(Ot[dt][4 * gq + 2] * il, Ot[dt][4 * gq + 3] * il)};
        }
    }
    __syncthreads();
}

__device__ __forceinline__ float block_sum(Frame& F, float v, LAS float* red) {
    v = wave_sum(v);
    __syncthreads();
    if (F.lane == 0) red[F.wave] = v;
    __syncthreads();
    float s = 0.f;
#pragma unroll
    for (int i = 0; i < NWAVES; ++i) s += red[i];
    return s;
}

typedef short v4i16_t __attribute__((ext_vector_type(4)));
__device__ __forceinline__ u32x2 lds_tr4(LAS const unsigned char* p) { return __builtin_bit_cast(u32x2, __builtin_amdgcn_ds_read_tr16_b64_v4i16((LAS v4i16_t*)p)); }
namespace hy {
typedef float f32x16 __attribute__((ext_vector_type(16)));
typedef __bf16 bf16x2_t __attribute__((ext_vector_type(2)));
constexpr int ROWB = 272, TABB = 128 * ROWB, DROWB = 528, FT_OFF = 0, X_OFF = 2 * TABB, SP_OFF = 4 * TABB;
#define HY_SBAR() do { asm volatile("" ::: "memory"); __builtin_amdgcn_sched_barrier(0); } while (0)
#define MFMA32(a, b, c) __builtin_amdgcn_mfma_f32_32x32x16_bf16((a), (b), (c), 0, 0, 0)
__device__ __forceinline__ int crow(int r, int h) { return (r & 3) + 8 * (r >> 2) + 4 * h; }
__device__ __forceinline__ int q16(int c) { return 8 * ((c >> 2) & 1) + 4 * (c >> 3) + (c & 3); }
__device__ __forceinline__ int kstore(int k) { return (k & ~15) + q16(k & 15); }
__device__ __forceinline__ unsigned cvtpk(float lo, float hi) { f32x2 v = {lo, hi}; bf16x2_t b = __builtin_convertvector(v, bf16x2_t); return __builtin_bit_cast(unsigned, b); }
__device__ __forceinline__ bf16x8 neg8(bf16x8 v) { u32x4 u = __builtin_bit_cast(u32x4, v); u.x ^= 0x80008000u; u.y ^= 0x80008000u; u.z ^= 0x80008000u; u.w ^= 0x80008000u; return __builtin_bit_cast(bf16x8, u); }
template <int S> __device__ __forceinline__ bf16x8 pack_step(const f32x16& x) {
    u32x4 p; p.x = cvtpk(x[8 * S], x[8 * S + 1]); p.y = cvtpk(x[8 * S + 2], x[8 * S + 3]); p.z = cvtpk(x[8 * S + 4], x[8 * S + 5]); p.w = cvtpk(x[8 * S + 6], x[8 * S + 7]);
    return __builtin_bit_cast(bf16x8, p);
}
__device__ __forceinline__ bf16x8 ffrag(LAS const unsigned char* ft, int t, int rb, int s, int lr, int lh) {
    return *(LAS const bf16x8*)(ft + (lr * ROWB + lh * 16) + (t * TABB + rb * 32 * ROWB + 32 * s)); }
__device__ __forceinline__ bf16x8 xfrag(LAS const unsigned char* img, int rb, int cs, int lr, int lh) {
    return *(LAS const bf16x8*)(img + (lr * ROWB + lh * 16) + (rb * 32 * ROWB + 16 * cs)); }
__device__ __forceinline__ bf16x8 dfrag(LAS const unsigned char* img, int rb, int cs, int lr, int lh) {
    return *(LAS const bf16x8*)(img + (lr * DROWB + lh * 16) + (rb * 32 * DROWB + 16 * cs)); }
__device__ __forceinline__ void zero16(f32x16& x) {
#pragma unroll
    for (int r = 0; r < 16; ++r) x[r] = 0.f; }
struct ctile { u32x4 q[4]; };
__device__ __forceinline__ ctile load_ctile(const unsigned* w  ) { ctile t;
#pragma unroll
    for (int i = 0; i < 4; ++i) t.q[i] = *(const u32x4*)(w + 4 * i);
    return t; }
template <bool CONJ> __device__ __forceinline__ void cmul_tile(f32x16& xr, f32x16& xi, const ctile& t) {
#pragma unroll
    for (int i = 0; i < 4; ++i) { const unsigned w[4] = {t.q[i].x, t.q[i].y, t.q[i].z, t.q[i].w};
#pragma unroll
        for (int u = 0; u < 4; ++u) { const int r = 4 * i + u; const float wr = bflo(w[u]), wi = CONJ ? -bfhi(w[u]) : bfhi(w[u]);
            const float a = xr[r], b = xi[r]; xr[r] = a * wr - b * wi; xi[r] = a * wi + b * wr; } }
}
template <bool CPLX, int NK>
__device__ __forceinline__ void s1_tw(LAS const unsigned char* ft, LAS const unsigned char* img, const unsigned* twt, int J, int lane, bf16x8 (&bAr)[8], bf16x8 (&bAi)[8]) {
    const int lr = lane & 31, lh = lane >> 5;
#pragma unroll
    for (int hf = 0; hf < 2; ++hf) {
        const ctile tw0 = load_ctile(twt + ((size_t)(((2 * hf) * 4 + J) * 64 + lane)) * 16), tw1 = load_ctile(twt + ((size_t)(((2 * hf + 1) * 4 + J) * 64 + lane)) * 16);
        f32x16 Ar[2], Ai[2];
#pragma unroll
        for (int i = 0; i < 2; ++i) { zero16(Ar[i]); zero16(Ai[i]); }
#pragma unroll
        for (int s = 0; s < NK; ++s) {
            const bf16x8 bFr = ffrag(ft, 0, J, s, lr, lh), bFi = ffrag(ft, 1, J, s, lr, lh), bnFi = neg8(bFi);
#pragma unroll
            for (int i = 0; i < 2; ++i) {
                const bf16x8 aXr = xfrag(img, 2 * hf + i, 2 * s, lr, lh);
                Ar[i] = MFMA32(aXr, bFr, Ar[i]); Ai[i] = MFMA32(aXr, bFi, Ai[i]);
                if (CPLX) { const bf16x8 aXi = xfrag(img, 2 * hf + i, 8 + 2 * s, lr, lh); Ar[i] = MFMA32(aXi, bnFi, Ar[i]); Ai[i] = MFMA32(aXi, bFr, Ai[i]); }
            }
            HY_SBAR();
        }
#pragma unroll
        for (int i = 0; i < 2; ++i) { const int ig = 2 * hf + i;
            cmul_tile<false>(Ar[i], Ai[i], i == 0 ? tw0 : tw1);
            bAr[2 * ig] = pack_step<0>(Ar[i]); bAr[2 * ig + 1] = pack_step<1>(Ar[i]); bAi[2 * ig] = pack_step<0>(Ai[i]); bAi[2 * ig + 1] = pack_step<1>(Ai[i]);
            HY_SBAR();
        }
    }
}
__device__ __forceinline__ void s3_half(LAS const unsigned char* ft, const bf16x8 (&bAr)[8], const bf16x8 (&bAi)[8], int Ih, int lane, f32x16 (&Zr)[2], f32x16 (&Zi)[2]) {
    const int lr = lane & 31, lh = lane >> 5;
#pragma unroll
    for (int I = 0; I < 2; ++I) { zero16(Zr[I]); zero16(Zi[I]); }
#pragma unroll
    for (int s = 0; s < 8; ++s) {
        const bf16x8 bnAi = neg8(bAi[s]);
#pragma unroll
        for (int I = 0; I < 2; ++I) {
            const bf16x8 aFr = ffrag(ft, 0, 2 * Ih + I, s, lr, lh), aFi = ffrag(ft, 1, 2 * Ih + I, s, lr, lh);
            Zr[I] = MFMA32(aFr, bAr[s], Zr[I]); Zr[I] = MFMA32(aFi, bnAi, Zr[I]);
            Zi[I] = MFMA32(aFi, bAr[s], Zi[I]); Zi[I] = MFMA32(aFr, bAi[s], Zi[I]);
        }
        HY_SBAR();
    }
}
__device__ __forceinline__ void fwd_filter(LAS const unsigned char* ft, LAS const unsigned char* img, const unsigned* twt, int J, int lane, float scl, float sk, unsigned* kh  ) {
    bf16x8 bAr[8], bAi[8];
    s1_tw<false, 8>(ft, img, twt, J, lane, bAr, bAi);
#pragma unroll
    for (int Ih = 0; Ih < 2; ++Ih) {
        f32x16 Zr[2], Zi[2];
        s3_half(ft, bAr, bAi, Ih, lane, Zr, Zi);
#pragma unroll
        for (int I = 0; I < 2; ++I) { unsigned* dst = kh + ((size_t)((2 * Ih + I) * 64 + lane)) * 16;
#pragma unroll
            for (int r4 = 0; r4 < 4; ++r4) *(u32x4*)(dst + 4 * r4) = (u32x4){cvtpk(Zr[I][4 * r4] * scl + sk, Zi[I][4 * r4] * scl), cvtpk(Zr[I][4 * r4 + 1] * scl + sk, Zi[I][4 * r4 + 1] * scl),
                                                                              cvtpk(Zr[I][4 * r4 + 2] * scl + sk, Zi[I][4 * r4 + 2] * scl), cvtpk(Zr[I][4 * r4 + 3] * scl + sk, Zi[I][4 * r4 + 3] * scl)}; }
        HY_SBAR();
    }
}
__device__ __forceinline__ void s3_filt_i1(LAS const unsigned char* ft, const unsigned* khat  , const unsigned* twt, int J, int lane, const bf16x8 (&bAr)[8], const bf16x8 (&bAi)[8], u32x2 (&dpk)[4][2][4]) {
    const int lr = lane & 31, lh = lane >> 5;
    bf16x8 aYr[8], aYi[8];
#pragma unroll
    for (int Ih = 0; Ih < 2; ++Ih) {
        const ctile k0 = load_ctile(khat + ((size_t)((2 * Ih) * 64 + lane)) * 16);
        f32x16 Zr[2], Zi[2];
        s3_half(ft, bAr, bAi, Ih, lane, Zr, Zi);
        const ctile k1 = load_ctile(khat + ((size_t)((2 * Ih + 1) * 64 + lane)) * 16);
#pragma unroll
        for (int I = 0; I < 2; ++I) { const int Ig = 2 * Ih + I;
            cmul_tile<false>(Zr[I], Zi[I], I == 0 ? k0 : k1);
            aYr[2 * Ig] = pack_step<0>(Zr[I]); aYr[2 * Ig + 1] = pack_step<1>(Zr[I]); aYi[2 * Ig] = pack_step<0>(Zi[I]); aYi[2 * Ig + 1] = pack_step<1>(Zi[I]);
            HY_SBAR();
        }
    }
#pragma unroll
    for (int ch = 0; ch < 2; ++ch) {
        const ctile tw0 = load_ctile(twt + ((size_t)((J * 4 + 2 * ch) * 64 + lane)) * 16);
        f32x16 Cr[2], Ci[2];
#pragma unroll
        for (int c = 0; c < 2; ++c) { zero16(Cr[c]); zero16(Ci[c]); }
#pragma unroll
        for (int s = 0; s < 8; ++s) {
            const bf16x8 anYr = neg8(aYr[s]);
#pragma unroll
            for (int c = 0; c < 2; ++c) {
                const bf16x8 bFr = ffrag(ft, 0, 2 * ch + c, s, lr, lh), bFi = ffrag(ft, 1, 2 * ch + c, s, lr, lh);
                Cr[c] = MFMA32(aYr[s], bFr, Cr[c]); Cr[c] = MFMA32(aYi[s], bFi, Cr[c]);
                Ci[c] = MFMA32(anYr, bFi, Ci[c]); Ci[c] = MFMA32(aYi[s], bFr, Ci[c]);
            }
            HY_SBAR();
        }
        const ctile tw1 = load_ctile(twt + ((size_t)((J * 4 + 2 * ch + 1) * 64 + lane)) * 16);
#pragma unroll
        for (int c = 0; c < 2; ++c) { const int cg = 2 * ch + c;
            cmul_tile<true>(Cr[c], Ci[c], c == 0 ? tw0 : tw1);
#pragma unroll
            for (int g = 0; g < 4; ++g) {
                dpk[cg][0][g] = (u32x2){cvtpk(Cr[c][4 * g], Cr[c][4 * g + 1]), cvtpk(Cr[c][4 * g + 2], Cr[c][4 * g + 3])};
                dpk[cg][1][g] = (u32x2){cvtpk(Ci[c][4 * g], Ci[c][4 * g + 1]), cvtpk(Ci[c][4 * g + 2], Ci[c][4 * g + 3])};
            }
            HY_SBAR();
        }
    }
}
__device__ __forceinline__ void write_D(LAS unsigned char* dimg, const u32x2 (&dpk)[4][2][4], int J, int lane) {
    const int lr = lane & 31, lh = lane >> 5;
    LAS unsigned char* base = dimg + lr * DROWB + lh * 16 + J * 64;
#pragma unroll
    for (int c = 0; c < 4; ++c)
#pragma unroll
        for (int g = 0; g < 4; ++g) {
            *(LAS u32x2*)(base + c * 32 * DROWB + 32 * (g >> 1) + 8 * (g & 1)) = dpk[c][0][g];
            *(LAS u32x2*)(base + c * 32 * DROWB + 256 + 32 * (g >> 1) + 8 * (g & 1)) = dpk[c][1][g]; }
}
__device__ __forceinline__ void i3_wave(LAS const unsigned char* ft, LAS const unsigned char* dimg, int a, int c, int lane, f32x16& yr, f32x16& yi) {
    const int lr = lane & 31, lh = lane >> 5;
    zero16(yr); zero16(yi);
#pragma unroll
    for (int s = 0; s < 8; ++s) {
        const bf16x8 aFr = ffrag(ft, 0, a, s, lr, lh), aFi = ffrag(ft, 1, a, s, lr, lh), anFi = neg8(aFi);
        const bf16x8 bDr = dfrag(dimg, c, 2 * s, lr, lh), bDi = dfrag(dimg, c, 16 + 2 * s, lr, lh);
        yr = MFMA32(aFr, bDr, yr); yr = MFMA32(aFi, bDi, yr);
        yi = MFMA32(aFr, bDi, yi); yi = MFMA32(anFi, bDr, yi);
        HY_SBAR();
    }
}
__device__ __forceinline__ int img_off(int n2, int ks) { return n2 * ROWB + ks * 2; }
}

__device__ __forceinline__ void ph_hyena_fft(Frame& F) {
    using namespace hy;
    const bf16_t* UT = (const bf16_t*)(F.ws + WS_UT); bf16_t* HYT = (bf16_t*)(F.ws + WS_HYT);
    const float* hdn = (const float*)(F.ws + WS_HDN); const float* w3 = F.in[I_FW3]; const float* decay = F.in[I_DECAY];
    const float* convw = F.in[I_CONVW]; const float* convb = F.in[I_CONVB]; const float* skip = F.in[I_SKIP];
    const unsigned* twt = (const unsigned*)(F.ws + WS_TWT);
    unsigned* khat = (unsigned*)(F.ws + WS_KHAT + (size_t)blockIdx.x * 131072);
    bf16_t* gt = (bf16_t*)(F.ws + WS_GT + (size_t)blockIdx.x * 131072);
    LAS unsigned char* ft = F.lds + FT_OFF; LAS unsigned char* xr = F.lds + X_OFF;
    LAS float* w3s = (LAS float*)(F.lds + SP_OFF);
    LAS float* red = w3s + 256;
    const int wid = F.wave;
#define HY_IDS int tid = F.tid; asm volatile("" : "+v"(tid)); const int lane = tid & 63, lr = lane & 31, lh = lane >> 5; (void)lr; (void)lh; (void)lane;
    __syncthreads();
    { const u32x4* src = (const u32x4*)(F.ws + WS_FTAB);
      for (int i = F.tid; i < 2 * TABB / 16; i += NTHREADS) *(LAS u32x4*)(ft + i * 16) = src[i]; }
    for (int c = blockIdx.x; c < HW; c += F.G) {
        __syncthreads();
        for (int repA = 0; repA < ((PROBE_HY & 1u) ? 2 : 1); ++repA) {
        if (repA) __syncthreads();
        { HY_IDS
        u32x4 kw[8];
#pragma unroll
        for (int i = 0; i < 8; ++i) { const int ci = tid + 512 * i; const int od = ci >> 10, t0 = (ci & 1023) * 8;
            kw[i] = *(const u32x4*)((const bf16_t*)(F.ws + WS_KRAW) + (size_t)((od >> 1) * 1024 + (od & 1) * 512 + c) * SEQ + t0); }
#pragma unroll
        for (int i = 0; i < 8; ++i) {
            const int ci = tid + 512 * i; const int od = ci >> 10, t0 = (ci & 1023) * 8, o = od >> 1, dir = od & 1;
            const u32x4 w = kw[i];
            const unsigned short e[8] = {(unsigned short)w.x, (unsigned short)(w.x >> 16), (unsigned short)w.y, (unsigned short)(w.y >> 16), (unsigned short)w.z, (unsigned short)(w.z >> 16), (unsigned short)w.w, (unsigned short)(w.w >> 16)};
            LAS unsigned char* img = xr + o * TABB;
#pragma unroll
            for (int j = 0; j < 8; ++j) { const int t = t0 + j; int n = dir ? 2 * SEQ - t : t; unsigned short v = e[j];
                if (dir && t == 0) { n = SEQ; v = 0; }
                *(LAS bf16_t*)(img + img_off(n & 127, kstore(n >> 7))) = v; }
        }
        }
        __syncthreads();
        { HY_IDS
            const int o = wid >> 2, J = wid & 3;
            float nsum = 0.f;
            { const float* kp = (const float*)(F.ws + WS_KPART);
              for (int i = 0; i < 32; ++i) nsum += kp[(size_t)(o * 1024 + c) * 32 + i] + kp[(size_t)(o * 1024 + 512 + c) * 32 + i]; }
            const float scl = 1.0f / (nsum * (float)(2 * SEQ)), sk = skip[o * HW + c] * (1.0f / (float)(2 * SEQ));
            fwd_filter(ft, xr + o * TABB, twt, J, lane, scl, sk, khat + (size_t)((o * 4 + J) * 4) * 64 * 16);
        }
        __syncthreads();
        }
        for (int repB = 0; repB < ((PROBE_HY & 2u) ? 2 : 1); ++repB) {
#pragma unroll 1
        for (int rd = 0; rd < 2; ++rd) { HY_IDS
            {
                u32x4 uw[8]; float ul[8], uh[8];
#pragma unroll
                for (int i = 0; i < 8; ++i) { const int blk = 8 * rd + i, g = blk >> 3, b = (blk >> 1) & 3, a = blk & 1;
                    const bf16_t* row = UT + (size_t)((g + 1) * HW + c) * T + (size_t)b * SEQ; const int t0 = 4096 * a + 8 * tid;
                    uw[i] = *(const u32x4*)(row + t0); ul[i] = t0 > 0 ? bf2f(row[t0 - 1]) : 0.f; uh[i] = t0 + 8 < SEQ ? bf2f(row[t0 + 8]) : 0.f; }
#pragma unroll
                for (int i = 0; i < 8; ++i) { const int blk = 8 * rd + i, g = blk >> 3; const int chg = (g + 1) * HW + c;
                    const float w0 = convw[chg], w1 = convw[NHY + chg], w2 = convw[2 * NHY + chg], bb = convb[chg];
                    const u32x4 w = uw[i];
                    const float u[10] = {ul[i], bflo(w.x), bfhi(w.x), bflo(w.y), bfhi(w.y), bflo(w.z), bfhi(w.z), bflo(w.w), bfhi(w.w), uh[i]};
                    float v[8];
#pragma unroll
                    for (int j = 0; j < 8; ++j) v[j] = w0 * u[j] + w1 * u[j + 1] + w2 * u[j + 2] + bb;
                    *(LAS u32x4*)(xr + i * (32 * ROWB) + (tid >> 4) * ROWB + (tid & 15) * 16) = (u32x4){pk2(v[0], v[1]), pk2(v[2], v[3]), pk2(v[4], v[5]), pk2(v[6], v[7])}; }
            }
            __syncthreads();
#pragma unroll
            for (int k = 0; k < 4; ++k) {
                const int item = tid + 512 * k, i = item >> 8, c4 = (item >> 6) & 3; const int blk = 8 * rd + i;
                LAS const unsigned char* a = xr + i * (32 * ROWB) + (4 * lh + ((lane & 15) >> 2)) * ROWB + (32 * c4 + 16 * ((lane >> 4) & 1) + 4 * (lane & 3)) * 2;
                const u32x2 q0 = lds_tr4(a), q1 = lds_tr4(a + 8 * ROWB), q2 = lds_tr4(a + 16 * ROWB), q3 = lds_tr4(a + 24 * ROWB);
                bf16_t* dst = gt + ((size_t)((blk * 4 + c4) * 64 + lane)) * 16;
                *(u32x4*)dst = (u32x4){q0.x, q0.y, q1.x, q1.y}; *(u32x4*)(dst + 8) = (u32x4){q2.x, q2.y, q3.x, q3.y};
            }
            __syncthreads();
        }
        }
        for (int repC = 0; repC < ((PROBE_HY & 4u) ? 2 : 1); ++repC) {
        u32x2 z1p[2][2][4];
        const int p = wid >> 2, J = wid & 3, ta = wid >> 2, tc = wid & 3;
        for (int o = 0; o < 2; ++o) {
            { HY_IDS
            if (o == 0) {
                const float w0 = convw[c], w1 = convw[NHY + c], w2 = convw[2 * NHY + c], bb = convb[c];
                u32x4 uw[8]; float ul[8], uh[8];
#pragma unroll
                for (int i = 0; i < 8; ++i) { const int ci = tid + 512 * i; const int b = ci >> 10, t0 = (ci & 1023) * 8;
                    const bf16_t* row = UT + (size_t)c * T + (size_t)b * SEQ;
                    uw[i] = *(const u32x4*)(row + t0); ul[i] = t0 > 0 ? bf2f(row[t0 - 1]) : 0.f; uh[i] = t0 + 8 < SEQ ? bf2f(row[t0 + 8]) : 0.f; }
#pragma unroll
                for (int i = 0; i < 8; ++i) {
                    const int ci = tid + 512 * i; const int b = ci >> 10, t0 = (ci & 1023) * 8;
                    const u32x4 w = uw[i];
                    const float u[10] = {ul[i], bflo(w.x), bfhi(w.x), bflo(w.y), bfhi(w.y), bflo(w.z), bfhi(w.z), bflo(w.w), bfhi(w.w), uh[i]};
                    const int n1 = t0 >> 7, n2 = t0 & 127; const int ks = kstore(n1) + 64 * (b & 1);
                    LAS unsigned char* img = xr + (b >> 1) * TABB;
#pragma unroll
                    for (int j = 0; j < 8; ++j) *(LAS bf16_t*)(img + img_off(n2 + j, ks)) = (bf16_t)f2bf(w0 * u[j] + w1 * u[j + 1] + w2 * u[j + 2] + bb);
                }
            } else {
#pragma unroll
                for (int q = 0; q < 2; ++q) { LAS unsigned char* img = xr + q * TABB + (32 * tc + lr) * ROWB + lh * 16 + ta * 64;
#pragma unroll
                    for (int g = 0; g < 4; ++g) {
                        *(LAS u32x2*)(img + 32 * (g >> 1) + 8 * (g & 1)) = z1p[q][0][g];
                        *(LAS u32x2*)(img + 128 + 32 * (g >> 1) + 8 * (g & 1)) = z1p[q][1][g]; } }
            }
            }
            __syncthreads();
            u32x2 dpk[4][2][4];
            { HY_IDS
                bf16x8 bAr[8], bAi[8];
                s1_tw<true, 4>(ft, xr + p * TABB, twt, J, lane, bAr, bAi);
                __syncthreads();
                s3_filt_i1(ft, khat + (size_t)((o * 4 + J) * 4) * 64 * 16, twt, J, lane, bAr, bAi, dpk);
            }
#pragma unroll 1
            for (int q = 0; q < 2; ++q) { HY_IDS
                if (p == q) write_D(xr, dpk, J, lane);
                __syncthreads();
                const bf16_t* g0 = gt + ((size_t)((((o * 4 + 2 * q) * 2 + ta) * 4 + tc) * 64 + lane)) * 16;
                const bf16_t* g1 = gt + ((size_t)((((o * 4 + 2 * q + 1) * 2 + ta) * 4 + tc) * 64 + lane)) * 16;
                const u32x4 ga = *(const u32x4*)g0, gb = *(const u32x4*)(g0 + 8), gc = *(const u32x4*)g1, gd = *(const u32x4*)(g1 + 8);
                f32x16 yr, yi;
                i3_wave(ft, xr, ta, tc, lane, yr, yi);
                const unsigned gre[8] = {ga.x, ga.y, ga.z, ga.w, gb.x, gb.y, gb.z, gb.w}, gim[8] = {gc.x, gc.y, gc.z, gc.w, gd.x, gd.y, gd.z, gd.w};
#pragma unroll
                for (int r2 = 0; r2 < 8; ++r2) { yr[2 * r2] *= bflo(gre[r2]); yr[2 * r2 + 1] *= bfhi(gre[r2]); yi[2 * r2] *= bflo(gim[r2]); yi[2 * r2 + 1] *= bfhi(gim[r2]); }
                {
#pragma unroll
                    for (int g = 0; g < 4; ++g) { z1p[q][0][g] = (u32x2){cvtpk(yr[4 * g], yr[4 * g + 1]), cvtpk(yr[4 * g + 2], yr[4 * g + 3])};
                                                  z1p[q][1][g] = (u32x2){cvtpk(yi[4 * g], yi[4 * g + 1]), cvtpk(yi[4 * g + 2], yi[4 * g + 3])}; }
                }
                if (o == 1) {
                    bf16_t* o0 = HYT + (size_t)c * T + (size_t)(2 * q) * SEQ + 32 * tc + lr; bf16_t* o1 = o0 + SEQ;
#pragma unroll
                    for (int r = 0; r < 16; ++r) { const int n1 = 32 * ta + crow(r, lh); o0[128 * n1] = (bf16_t)f2bf(yr[r]); o1[128 * n1] = (bf16_t)f2bf(yi[r]); }
                }
                __syncthreads();
            }
        }
        }
    }
    __syncthreads();
#undef HY_IDS
}

__device__ __forceinline__ void ph_hyT(Frame& F) {
    const bf16_t* HYT = (const bf16_t*)(F.ws + WS_HYT); bf16_t* HY = (bf16_t*)(F.ws + WS_AH) + AW;
    constexpr int TROW = 144;
    LAS unsigned char* tl = F.lds + F.wave * (64 * TROW);
    const int gw = F.vcu * NWAVES + F.wave, NGW = F.G * NWAVES;
    int lane = F.lane; asm volatile("" : "+v"(lane));
    for (int it = gw; it < 8 * (T / 64); it += NGW) {
        const int cb = it & 7, tb = it >> 3; const int c0 = cb * 64, t0 = tb * 64;
        u32x4 v[8];
#pragma unroll
        for (int j = 0; j < 8; ++j) v[j] = *(const u32x4*)(HYT + (size_t)(c0 + 8 * j + (lane >> 3)) * T + t0 + 8 * (lane & 7));
#pragma unroll
        for (int j = 0; j < 8; ++j) *(LAS u32x4*)(tl + (8 * j + (lane >> 3)) * TROW + (lane & 7) * 16) = v[j];
        const int q = (lane & 15) >> 2, p = lane & 3, g = lane >> 4;
#pragma unroll
        for (int ps = 0; ps < 4; ++ps)
#pragma unroll
            for (int hf = 0; hf < 2; ++hf) {
                LAS const unsigned char* a = tl + (32 * hf + 8 * g + q) * TROW + (16 * ps + 4 * p) * 2;
                const u32x2 lo = lds_tr4(a), hi = lds_tr4(a + 4 * TROW);
                *(u32x4*)(HY + (size_t)(t0 + 16 * ps + (lane & 15)) * DM + c0 + 32 * hf + 8 * g) = (u32x4){lo.x, lo.y, hi.x, hi.y};
            }
    }
}

__device__ __forceinline__ void ph_expert_cvt(Frame& F) {
    LAS float* scr = (LAS float*)(F.lds + F.wave * 16384);
    const int gw = F.vcu * NWAVES + F.wave, NGW = F.G * NWAVES;
    bf16_t* W13 = (bf16_t*)(F.ws + WS_W13); bf16_t* W2 = (bf16_t*)(F.ws + WS_W2);
    for (int it = gw; it < NE * 768; it += NGW) {
        const int e = it / 768; int r = it % 768;
        if (r < 512) { const bool is3 = r >= 256; r &= 255; const int kb = r / 16, nb = r % 16, n0 = nb * 32;
            const int drow = (n0 >> 7) * 256 + (is3 ? 128 : 0) + (n0 & 127);
            transpose_item(F.in[is3 ? I_EW3 : I_EW1] + (size_t)e * DM * DE, DM, DE, W13 + (size_t)e * DM * DM, DM, drow, scr, kb, nb, F.lane); }
        else { r -= 512; const int kb = r / 32, nb = r % 32;
            transpose_item(F.in[I_EW2] + (size_t)e * DE * DM, DE, DM, W2 + (size_t)e * DM * DE, DE, nb * 32, scr, kb, nb, F.lane); }
    }
}

__device__ __forceinline__ void ph_ln1_route(Frame& F) {
    int tid = threadIdx.x; asm volatile("" : "+v"(tid));
    const float* xin = F.in[I_X]; bf16_t* y1 = (bf16_t*)(F.ws + WS_Y1); bf16_t* h2b = (bf16_t*)(F.ws + WS_HB); bf16_t* h2l = (bf16_t*)(F.ws + WS_H2LO);
    const float* mod = (const float*)(F.ws + WS_MOD); const float* g1 = F.in[I_LN1G]; const float* b1 = F.in[I_LN1B];
    const bf16_t* wr = (const bf16_t*)(F.ws + WS_WRT); const float* bg = F.in[I_RGB]; const float* be = F.in[I_REB];
    unsigned* cnt = F.ctl + CW_CNT; int* btok = (int*)(F.ws + WS_BTOK); float* bw = (float*)(F.ws + WS_BW);
    constexpr int WROW = 272, WCH = 80 * WROW;
    LAS unsigned char* wl = F.lds;
    LAS float* lg = (LAS float*)(F.lds + 65536);
    for (int ch = blockIdx.x; ch < T / 128; ch += F.G) {
        const int b = (ch * 128) / SEQ;
        for (int rr0 = F.wave * 4; rr0 < 128; rr0 += NWAVES * 4) {
            f32x4 xin4[4][4]; unsigned long long yin4[4][4];
#pragma unroll
            for (int r = 0; r < 4; ++r) { const size_t row = (size_t)ch * 128 + rr0 + r;
                const f32x4* xi = (const f32x4*)(xin + row * DM) + F.lane; const unsigned long long* yi = (const unsigned long long*)(y1 + row * DM) + F.lane;
#pragma unroll
                for (int j = 0; j < 4; ++j) { xin4[r][j] = xi[64 * j]; yin4[r][j] = yi[64 * j]; } }
#pragma unroll
            for (int r = 0; r < 4; ++r) {
            const size_t row = (size_t)ch * 128 + rr0 + r;
            unsigned long long* x1o = (unsigned long long*)(y1 + row * DM) + F.lane;
            f32x4 x[4]; float s = 0.f;
#pragma unroll
            for (int j = 0; j < 4; ++j) { const unsigned long long yw = yin4[r][j]; const f32x4 yv = {bflo((unsigned)yw), bfhi((unsigned)yw), bflo((unsigned)(yw >> 32)), bfhi((unsigned)(yw >> 32))};
                x[j] = xin4[r][j] * DN_ALPHA + yv; s += (x[j][0] + x[j][1]) + (x[j][2] + x[j][3]); }
            const float mean = wave_sum(s) * (1.f / DM); float s2 = 0.f;
#pragma unroll
            for (int j = 0; j < 4; ++j) { x[j] = x[j] - mean; s2 += (x[j][0] * x[j][0] + x[j][1] * x[j][1]) + (x[j][2] * x[j][2] + x[j][3] * x[j][3]); }
            const float rstd = 1.f / sqrtf(wave_sum(s2) * (1.f / DM) + LN_EPS);
            unsigned long long* o8 = (unsigned long long*)(h2b + row * DM) + F.lane; unsigned long long* l8 = (unsigned long long*)(h2l + row * DM) + F.lane;
#pragma unroll
            for (int j = 0; j < 4; ++j) { const int k = 4 * F.lane + 256 * j;
                const f32x4 gg = *(const f32x4*)(g1 + k), bb = *(const f32x4*)(b1 + k);
                const f32x4 sh = *(const f32x4*)(mod + (size_t)b * 6144 + 3072 + k), sc = *(const f32x4*)(mod + (size_t)b * 6144 + 4096 + k);
                x[j] = x[j] * rstd * gg + bb; x1o[64 * j] = (unsigned long long)pk2(x[j][0], x[j][1]) | ((unsigned long long)pk2(x[j][2], x[j][3]) << 32);
                const f32x4 h = x[j] * (sc + 1.0f) + sh;
                const unsigned h01 = pk2(h[0], h[1]), h23 = pk2(h[2], h[3]);
                o8[64 * j] = (unsigned long long)h01 | ((unsigned long long)h23 << 32);
                l8[64 * j] = (unsigned long long)pk2(h[0] - bflo(h01), h[1] - bfhi(h01)) | ((unsigned long long)pk2(h[2] - bflo(h23), h[3] - bfhi(h23)) << 32); }
            }
        }
        FSTAMP(36);
        __syncthreads();
        {
            const int lane = F.lane, l15 = lane & 15, l4 = lane >> 4;
            f32x4 acc[5];
#pragma unroll
            for (int n = 0; n < 5; ++n) acc[n] = (f32x4){0.f, 0.f, 0.f, 0.f};
            const size_t arow = ((size_t)ch * 128 + 16 * F.wave + l15) * DM + 8 * l4;
            u32x4 wv[3][5]; bf16x8 ah[3][4], al[3][4];
#define RT_LOAD(set, kc_) do { _Pragma("unroll") for (int ii = 0; ii < 5; ++ii) { const int i = tid + 512 * ii, part = i / 1280, r = (i % 1280) >> 4, pc = i & 15; \
        wv[set][ii] = *(const u32x4*)(wr + (size_t)part * 80 * DM + (size_t)r * DM + (kc_) * 128 + pc * 8); } \
    _Pragma("unroll") for (int s4 = 0; s4 < 4; ++s4) { ah[set][s4] = *(const bf16x8*)(h2b + arow + (kc_) * 128 + 32 * s4); al[set][s4] = *(const bf16x8*)(h2l + arow + (kc_) * 128 + 32 * s4); } } while (0)
            RT_LOAD(0, 0); RT_LOAD(1, 1);
#pragma unroll
            for (int kc = 0; kc < 8; ++kc) {
                const int cs = kc % 3;
#pragma unroll
                for (int ii = 0; ii < 5; ++ii) { const int i = tid + 512 * ii, part = i / 1280, r = (i % 1280) >> 4, pc = i & 15; *(LAS u32x4*)(wl + part * WCH + r * WROW + pc * 16) = wv[cs][ii]; }
                asm volatile("s_waitcnt lgkmcnt(0)" ::: "memory"); __builtin_amdgcn_s_barrier(); asm volatile("" ::: "memory");
                if (kc + 2 < 8) RT_LOAD((kc + 2) % 3, kc + 2);
#pragma unroll
                for (int s4 = 0; s4 < 4; ++s4) {
#pragma unroll
                    for (int n = 0; n < 5; ++n) {
                        const bf16x8 bh = *(LAS const bf16x8*)(wl + (16 * n + l15) * WROW + (32 * s4 + 8 * l4) * 2), bl = *(LAS const bf16x8*)(wl + WCH + (16 * n + l15) * WROW + (32 * s4 + 8 * l4) * 2);
                        acc[n] = __builtin_amdgcn_mfma_f32_16x16x32_bf16(ah[cs][s4], bh, acc[n], 0, 0, 0);
                        acc[n] = __builtin_amdgcn_mfma_f32_16x16x32_bf16(al[cs][s4], bh, acc[n], 0, 0, 0);
                        acc[n] = __builtin_amdgcn_mfma_f32_16x16x32_bf16(ah[cs][s4], bl, acc[n], 0, 0, 0);
                    }
                }
                asm volatile("s_waitcnt lgkmcnt(0)" ::: "memory"); __builtin_amdgcn_s_barrier(); asm volatile("" ::: "memory");
            }
#undef RT_LOAD
#pragma unroll
            for (int n = 0; n < 5; ++n)
#pragma unroll
                for (int r = 0; r < 4; ++r) lg[(16 * F.wave + 4 * l4 + r) * 81 + 16 * n + l15] = acc[n][r];
        }
        __syncthreads();
        FSTAMP(37);
        LAS int* hist = (LAS int*)(F.lds + 110592); LAS int* hbase = hist + 64; LAS int* aexp = hist + 128; LAS int* arank = aexp + 256; LAS float* aw = (LAS float*)(arank + 256);
        if (tid < 64) hist[tid] = 0;
        __syncthreads();
        if (tid < 128) {
            LAS const float* lr_ = lg + tid * 81;
            float gl[8]; float gmax; int g = 0;
#pragma unroll
            for (int i = 0; i < 8; ++i) gl[i] = lr_[i] + bg[i];
            gmax = gl[0];
#pragma unroll
            for (int i = 1; i < 8; ++i) if (gl[i] > gmax) { gmax = gl[i]; g = i; }
            float den = 0.f;
#pragma unroll
            for (int i = 0; i < 8; ++i) den += __expf(gl[i] - gmax);
            const float pg = 1.0f / den;
            float el[8];
#pragma unroll
            for (int j = 0; j < 8; ++j) el[j] = lr_[8 + g * 8 + j] + be[g * 8 + j];
            int i1 = 0; float e1 = el[0];
#pragma unroll
            for (int j = 1; j < 8; ++j) if (el[j] > e1) { e1 = el[j]; i1 = j; }
            int i2 = -1; float e2 = -INFINITY;
#pragma unroll
            for (int j = 0; j < 8; ++j) if (j != i1 && (i2 < 0 || el[j] > e2)) { e2 = el[j]; i2 = j; }
            const float r = __expf(e2 - e1); const float wa = pg / (1.0f + r), wb = pg * r / (1.0f + r);
            const int ea = g * 8 + i1, eb = g * 8 + i2;
            aexp[2 * tid] = ea; aw[2 * tid] = wa; arank[2 * tid] = __hip_atomic_fetch_add(&hist[ea], 1, __ATOMIC_RELAXED, __HIP_MEMORY_SCOPE_WORKGROUP);
            aexp[2 * tid + 1] = eb; aw[2 * tid + 1] = wb; arank[2 * tid + 1] = __hip_atomic_fetch_add(&hist[eb], 1, __ATOMIC_RELAXED, __HIP_MEMORY_SCOPE_WORKGROUP);
        }
        __syncthreads();
        if (tid < 64) { const int n = hist[tid]; hbase[tid] = n > 0 ? (int)atomicAdd(&cnt[32 * tid], (unsigned)n) : 0; }
        __syncthreads();
        if (tid < 256) { const int e = aexp[tid]; const size_t pos = (size_t)e * ECAP + hbase[e] + arank[tid];
            btok[pos] = (ch * 128 + (tid >> 1)) * 2 + (tid & 1); bw[pos] = aw[tid]; }
        __syncthreads();
    }
}

constexpr int MOE_UL_OFF = TAB_OFF + 576, MOE_RT_OFF = 149504, MOE_WT_OFF = MOE_RT_OFF + pg8::MOE_MAXU * 1024;
static_assert(MOE_WT_OFF + pg8::MOE_MAXU * 1024 <= LDSCTL_OFF && MOE_UL_OFF + pg8::MOE_MAXU * 16 <= LDS_BYTES, "MoE LDS tables");
template <bool DOWN> __device__ __forceinline__ void build_moe_tab(Frame& F, LAS int* tab) {
    LAS int* ulist = (LAS int*)(F.lds + MOE_UL_OFF); LAS int* rowtab = (LAS int*)(F.lds + MOE_RT_OFF); LAS float* wtab = (LAS float*)(F.lds + MOE_WT_OFF);
    const int* btok = (const int*)(F.ws + WS_BTOK); const float* bw = (const float*)(F.ws + WS_BW);
    int tid = threadIdx.x; asm volatile("" : "+v"(tid));
    __syncthreads();
    if (tid < 64) tab[72 + tid] = (int)__hip_atomic_load(F.ctl + CW_CNT + 32 * tid, __ATOMIC_RELAXED, __HIP_MEMORY_SCOPE_AGENT);
    __syncthreads();
    if (tid == 0) { int s = 0; for (int e = 0; e < 64; ++e) { tab[e] = s; s += (tab[72 + e] + 255) >> 8; } tab[64] = s; }
    __syncthreads();
    if (tid < pg8::MOE_MAXU) {
        const int L = tid * F.G + F.vcu, tile = L >> 2; const bool valid = tile < tab[64];
        int e = 0;
        for (int j = 1; j < 64; ++j) e += (tab[j] <= tile) ? 1 : 0;
        ulist[4 * tid] = e; ulist[4 * tid + 1] = tile - tab[e]; ulist[4 * tid + 2] = tile; ulist[4 * tid + 3] = valid ? (L & 3) + 1 : 0;
    }
    __syncthreads();
    for (int i = tid; i < pg8::MOE_MAXU * 256; i += NTHREADS) {
        const int ui = i >> 8, r = i & 255;
        if (ulist[4 * ui + 3] != 0) {
            const int e = ulist[4 * ui], idx = ulist[4 * ui + 1] * 256 + r; const bool in = idx < tab[72 + e];
            const int bt = in ? btok[(size_t)e * ECAP + idx] : -1;
            if (DOWN) { rowtab[i] = bt; wtab[i] = in ? bw[(size_t)e * ECAP + idx] : 0.f; }
            else rowtab[i] = in ? (bt >> 1) : 0;
        }
    }
    __syncthreads();
}

__device__ __forceinline__ void ph_final(Frame& F) {
    float* out = F.out; const bf16_t* y2 = (const bf16_t*)(F.ws + WS_Y2); const bf16_t* x1b = (const bf16_t*)(F.ws + WS_Y1);
    const float* mod = (const float*)(F.ws + WS_MOD); const float* g2 = F.in[I_LN2G]; const float* b2 = F.in[I_LN2B];
    const int gw = F.vcu * NWAVES + F.wave, NGW = F.G * NWAVES;
    constexpr int RB = 4;
    for (int row0 = gw * RB; row0 < T; row0 += NGW * RB) {
        const int b = row0 / SEQ;
        unsigned long long xa[RB][4], ya[RB][4], yb[RB][4];
#pragma unroll
        for (int r = 0; r < RB; ++r) { const size_t row = (size_t)row0 + r;
            const unsigned long long* xb = (const unsigned long long*)(x1b + row * DM) + F.lane;
            const unsigned long long* pa = (const unsigned long long*)(y2 + (2 * row) * DM) + F.lane; const unsigned long long* pb = (const unsigned long long*)(y2 + (2 * row + 1) * DM) + F.lane;
#pragma unroll
            for (int j = 0; j < 4; ++j) { xa[r][j] = xb[64 * j]; ya[r][j] = pa[64 * j]; yb[r][j] = pb[64 * j]; } }
#pragma unroll
        for (int r = 0; r < RB; ++r) {
            f32x4* xr = (f32x4*)(out + ((size_t)row0 + r) * DM) + F.lane;
            f32x4 x[4]; float s = 0.f;
#pragma unroll
            for (int j = 0; j < 4; ++j) { const int k = 4 * F.lane + 256 * j;
                const f32x4 gt = *(const f32x4*)(mod + (size_t)b * 6144 + 5120 + k);
                const unsigned long long a = ya[r][j], c = yb[r][j], xw = xa[r][j];
                f32x4 y; y[0] = bflo((unsigned)a) + bflo((unsigned)c); y[1] = bfhi((unsigned)a) + bfhi((unsigned)c);
                y[2] = bflo((unsigned)(a >> 32)) + bflo((unsigned)(c >> 32)); y[3] = bfhi((unsigned)(a >> 32)) + bfhi((unsigned)(c >> 32));
                const f32x4 x1 = {bflo((unsigned)xw), bfhi((unsigned)xw), bflo((unsigned)(xw >> 32)), bfhi((unsigned)(xw >> 32))};
                x[j] = x1 * DN_ALPHA + gt * y; s += (x[j][0] + x[j][1]) + (x[j][2] + x[j][3]); }
            const float mean = wave_sum(s) * (1.f / DM); float s2 = 0.f;
#pragma unroll
            for (int j = 0; j < 4; ++j) { x[j] = x[j] - mean; s2 += (x[j][0] * x[j][0] + x[j][1] * x[j][1]) + (x[j][2] * x[j][2] + x[j][3] * x[j][3]); }
            const float rstd = 1.f / sqrtf(wave_sum(s2) * (1.f / DM) + LN_EPS);
#pragma unroll
            for (int j = 0; j < 4; ++j) { const int k = 4 * F.lane + 256 * j; xr[64 * j] = x[j] * rstd * *(const f32x4*)(g2 + k) + *(const f32x4*)(b2 + k); }
        }
    }
}

constexpr int N_PHASES = 12;
__device__ __forceinline__ Frame make_frame(const Args& args, unsigned char* lds) {
    Frame F;
    F.lds = (LAS unsigned char*)lds; F.ws = args.ws; F.ctl = (unsigned*)(args.ws + WS_CTL);
    F.tid = threadIdx.x; F.lane = F.tid & 63; F.wave = __builtin_amdgcn_readfirstlane(F.tid >> 6);
    F.G = gridDim.x; { const int bx = blockIdx.x; F.vcu = (F.G % 8 == 0) ? (bx % 8) * (F.G / 8) + bx / 8 : bx; }
    F.in = args.in; F.out = args.out;
    return F;
}
template <unsigned PH_MASK> __global__ void __launch_bounds__(NTHREADS, 2) mk_fwd(Args args) {
    extern __shared__ __attribute__((aligned(16))) unsigned char lds[];
    for (int u = threadIdx.x; u < (LDS_BYTES - LDSCTL_OFF) / 4; u += NTHREADS) ((LAS unsigned*)((LAS unsigned char*)lds + LDSCTL_OFF))[u] = 0u;
    __syncthreads();
    constexpr bool multi = (PH_MASK & (PH_MASK - 1u)) != 0u;
    if (multi) xcd_barrier_post((unsigned*)(args.ws + WS_CTL) + CW_BAR);
#define IN(k) ((PH_MASK >> (k)) & 1u)
#define GBAR() xcd_barrier((unsigned*)(args.ws + WS_CTL) + CW_BAR, (volatile LAS unsigned*)((LAS unsigned char*)lds + MISC_OFF) + 8)
#define STAMP(i) do { if (PROBE_T >= 0 && blockIdx.x == 0 && threadIdx.x == 0) ((volatile LAS unsigned*)((LAS unsigned char*)lds + LDSCTL_OFF))[(i)] = (unsigned)__builtin_amdgcn_s_memrealtime(); } while (0)
#define PH(k, ...) if (IN(k)) { STAMP(2 * (k)); { __VA_ARGS__ } STAMP(2 * (k) + 1); } if (IN(k) && ((PROBE_DBL >> (k)) & 1u)) { GBAR(); __VA_ARGS__ } if (IN(k) && (k) + 1 < N_PHASES && IN((k) + 1)) GBAR();
#define SEAM(k) do { if (IN(k) && IN((k) + 1)) xcd_barrier((unsigned*)(args.ws + WS_CTL) + CW_BAR, (volatile LAS unsigned*)((LAS unsigned char*)lds + MISC_OFF) + 8); } while (0)
#define RING ((LAS unsigned char*)lds)
#define TAB ((LAS int*)((LAS unsigned char*)lds + TAB_OFF))

    PH(0, Frame F = make_frame(args, lds); ph_prep(F);
    )
    PH(1, Frame F = make_frame(args, lds); ph_taps(F); if (PROBE_SUB & 16u) ph_taps(F); ph_hb(F); if (PROBE_SUB & 32u) ph_hb(F);
    )
    PH(2,
        { pg8::DenseSched S; S.init(T, N1A, DM, gridDim.x, (int)blockIdx.x, args.ws + WS_WIN);
          pg8::EpiInA E{(bf16_t*)(args.ws + WS_Q), (bf16_t*)(args.ws + WS_K), (bf16_t*)(args.ws + WS_V), (bf16_t*)(args.ws + WS_GA)};
          pg8::gemm_phase<pg8::EpiInA, pg8::DenseSched, true>(RING, args.ws + WS_HB, DM, S, E); }
        { pg8::DenseSched S; S.init(NHY, T, DM, gridDim.x, (int)blockIdx.x, args.ws + WS_HB);
          pg8::EpiBf16 E{(bf16_t*)(args.ws + WS_UT), T};
          pg8::gemm_phase<pg8::EpiBf16, pg8::DenseSched, true>(RING, args.ws + WS_WIN + (size_t)N1A * DM * 2, DM, S, E); }
    )
    PH(3, Frame F = make_frame(args, lds); ph_attn(F); FSTAMP(24); if (PROBE_SUB & 1u) ph_attn(F); ph_hyena_fft(F); if (PROBE_SUB & 2u) ph_hyena_fft(F);
    )
    PH(4, Frame F = make_frame(args, lds); ph_hyT(F);
    )
    PH(5,
        pg8::DenseSched S; S.init(T, DM, DM, gridDim.x, (int)blockIdx.x, args.ws + WS_WAH);
        pg8::EpiMerge E{(const bf16_t*)(args.ws + WS_GA), (bf16_t*)(args.ws + WS_HB)};
        pg8::gemm_phase<pg8::EpiMerge, pg8::DenseSched, true>(RING, args.ws + WS_AH, DM, S, E);
    )
    PH(7,
        { pg8::DenseSched S; S.init(T, DM, DM, gridDim.x, (int)blockIdx.x, args.ws + WS_WO);
          pg8::EpiY E{(const float*)(args.ws + WS_MOD) + 2048, (bf16_t*)(args.ws + WS_Y1)};
          pg8::gemm_phase<pg8::EpiY, pg8::DenseSched, true>(RING, args.ws + WS_HB, DM, S, E);
          if (PROBE_SUB & 4u) pg8::gemm_phase<pg8::EpiY, pg8::DenseSched, true>(RING, args.ws + WS_HB, DM, S, E);
          if (PROBE_SUB & 64u) { pg8::EpiNull EN; pg8::gemm_phase<pg8::EpiNull, pg8::DenseSched, true>(RING, args.ws + WS_HB, DM, S, EN); } }
        { Frame F = make_frame(args, lds); FSTAMP(35); ph_expert_cvt(F); if (PROBE_SUB & 8u) ph_expert_cvt(F); }
    )
    PH(8, Frame F = make_frame(args, lds); ph_ln1_route(F);
    )
    PH(9,
        { Frame F = make_frame(args, lds); build_moe_tab<false>(F, TAB); }
        pg8::MoeSched<true> S{TAB, (const LAS int*)((LAS unsigned char*)lds + MOE_UL_OFF), (const LAS int*)((LAS unsigned char*)lds + MOE_RT_OFF), (const char*)(args.ws + WS_W13), (size_t)DM * DM * 2, DM};
        pg8::EpiSwiGLU E{(bf16_t*)(args.ws + WS_HACT)};
        pg8::gemm_phase<pg8::EpiSwiGLU, pg8::MoeSched<true>, true>(RING, args.ws + WS_HB, DM, S, E);
    )
    PH(10,
        { Frame F = make_frame(args, lds); build_moe_tab<true>(F, TAB); }
        pg8::MoeSched<false> S{TAB, (const LAS int*)((LAS unsigned char*)lds + MOE_UL_OFF), (const LAS int*)((LAS unsigned char*)lds + MOE_RT_OFF), (const char*)(args.ws + WS_W2), (size_t)DM * DE * 2, DE};
        pg8::EpiScatter E{(bf16_t*)(args.ws + WS_Y2), (const LAS int*)((LAS unsigned char*)lds + MOE_RT_OFF), (const LAS float*)((LAS unsigned char*)lds + MOE_WT_OFF)};
        pg8::gemm_phase<pg8::EpiScatter, pg8::MoeSched<false>, true>(RING, args.ws + WS_HACT, DE, S, E);
    )
    PH(11, Frame F = make_frame(args, lds); ph_final(F);
    )
    if (PROBE_T >= 0 && blockIdx.x == 0 && threadIdx.x == 0) {
        volatile LAS unsigned* st = (volatile LAS unsigned*)((LAS unsigned char*)lds + LDSCTL_OFF);
        const unsigned d = st[PROBE_TJ] - st[PROBE_T]; const unsigned t0 = (unsigned)__builtin_amdgcn_s_memrealtime();
        while ((unsigned)__builtin_amdgcn_s_memrealtime() - t0 < 16u * d) __builtin_amdgcn_s_sleep(8);
    }
#undef IN
#undef SEAM
#undef GBAR
#undef PH
#undef RING
#undef TAB
}

extern "C" void kernel_launch(void* const* d_in, const int* in_sizes, int n_in, void* d_out, int out_size, void* d_ws, size_t ws_size, hipStream_t stream) {
    static int grid = 0;
    if (grid == 0) {
        if (n_in != 31 || out_size != T * DM || ws_size < WS_END) { fprintf(stderr, "kernel_launch: unexpected shapes: n_in %d out %d ws %zu (need %zu)\n", n_in, out_size, ws_size, (size_t)WS_END); grid = -1; return; }
        int dev = 0, cus = 0;
        if (hipGetDevice(&dev) != hipSuccess || hipDeviceGetAttribute(&cus, hipDeviceAttributeMultiprocessorCount, dev) != hipSuccess) { grid = -1; return; }
        bool ok = true;
#define SET_ATTR(m) ok = ok && (hipFuncSetAttribute((const void*)mk_fwd<(m)>, hipFuncAttributeMaxDynamicSharedMemorySize, LDS_BYTES) == hipSuccess)
#if MK_N_LAUNCHES == 1
        SET_ATTR(FUSED_MASK);
#else
        { SET_ATTR(1u << 0); SET_ATTR(1u << 1); SET_ATTR(1u << 2); SET_ATTR(1u << 3); SET_ATTR(1u << 4); SET_ATTR(1u << 5); SET_ATTR(1u << 6); SET_ATTR(1u << 7); SET_ATTR(1u << 8); SET_ATTR(1u << 9); SET_ATTR(1u << 10); SET_ATTR(1u << 11); }
#endif
#undef SET_ATTR
        if (!ok) { fprintf(stderr, "kernel_launch: hipFuncSetAttribute failed\n"); grid = -1; return; }
        (void)hipGetLastError();
        grid = cus;
    }
    if (grid < 0) return;
    if (hipMemsetAsync((char*)d_ws + WS_CTL, 0, CTL_ZERO_BYTES, stream) != hipSuccess) return;
    Args a{};
    for (int i = 0; i < 31; ++i) a.in[i] = (const float*)d_in[i];
    a.out = (float*)d_out; a.ws = (unsigned char*)d_ws;
#if MK_N_LAUNCHES == 1
    a.ph_lo = 0; a.ph_hi = N_PHASES; hipLaunchKernelGGL(mk_fwd<FUSED_MASK>, dim3(grid), dim3(NTHREADS), LDS_BYTES, stream, a);
#else
    {
#define LAUNCH_PH(p) do { a.ph_lo = (p); a.ph_hi = (p) + 1; for (int rep_ = 0; rep_ < (((PROBE_DBL >> (p)) & 1u) ? 2 : 1); ++rep_) hipLaunchKernelGGL(mk_fwd<(1u << (p))>, dim3(grid), dim3(NTHREADS), LDS_BYTES, stream, a); } while (0)
        LAUNCH_PH(0); LAUNCH_PH(1); LAUNCH_PH(2); LAUNCH_PH(3); LAUNCH_PH(4); LAUNCH_PH(5); LAUNCH_PH(6); LAUNCH_PH(7); LAUNCH_PH(8); LAUNCH_PH(9); LAUNCH_PH(10); LAUNCH_PH(11);
#undef LAUNCH_PH
    }
#endif
}
```

```cpp
#include <hip/hip_runtime.h>
#include <cstdio>
#include <cstdint>

#ifndef PROBE_DBL
#define PROBE_DBL 0u
#endif
#ifndef PROBE_SUB
#define PROBE_SUB 0u
#endif
#ifndef PROBE_HY
#define PROBE_HY 0u
#endif
#ifndef PROBE_T
#define PROBE_T (-1)
#endif
#ifndef PROBE_TJ
#define PROBE_TJ (PROBE_T + 1)
#endif
#ifndef FUSED_MASK
#define FUSED_MASK 0xFFFu
#endif
#ifndef MK_N_LAUNCHES
#define MK_N_LAUNCHES 1
#endif

#define GAS __attribute__((address_space(1)))
#define LAS __attribute__((address_space(3)))
typedef unsigned short bf16_t;
typedef short bf16x8 __attribute__((ext_vector_type(8)));
typedef float f32x4 __attribute__((ext_vector_type(4)));
typedef float f32x2 __attribute__((ext_vector_type(2)));
typedef unsigned u32x4 __attribute__((ext_vector_type(4)));
typedef unsigned u32x2 __attribute__((ext_vector_type(2)));

constexpr int NB = 4, SEQ = 8192, DM = 1024, T = NB * SEQ;
constexpr int AW = 512, KVW = 128, HW = 512, INW = 4352, N1A = 2816, NHY = 1536;
constexpr int NE = 64, DE = 512, ECAP = 32768;
constexpr int NFILT = 2048, FH = 64, FEMB = 33;
constexpr float LN_EPS = 1e-5f;
constexpr float DN_ALPHA = 1.189207115002721f;
constexpr int NTHREADS = 512, NWAVES = 8;

constexpr size_t MiB = 1u << 20;
constexpr size_t WS_CTL = 0, CTL_ZERO_BYTES = 1 * MiB;
constexpr size_t WS_MODP = 1 * MiB, WS_MOD = 3 * MiB, WS_HDN = 4 * MiB, WS_WRT = 6 * MiB, WS_WIN = 7 * MiB;
constexpr size_t WS_WAH = 16 * MiB, WS_WO = 18 * MiB, WS_BTOK = 20 * MiB, WS_BW = 28 * MiB;
constexpr size_t WS_HB = 36 * MiB;
constexpr size_t WS_Q = 100 * MiB, WS_K = 132 * MiB, WS_V = 140 * MiB, WS_GA = 148 * MiB, WS_GH = 212 * MiB;
constexpr size_t WS_UT = 276 * MiB, WS_TMP = 276 * MiB;
constexpr size_t WS_AH = 372 * MiB;
constexpr size_t WS_HYT = 500 * MiB;
constexpr size_t WS_W13 = 100 * MiB, WS_W2 = 228 * MiB, WS_HACT = 404 * MiB, WS_Y2 = 36 * MiB, WS_END = 532 * MiB;
constexpr size_t WS_FTAB = 15 * MiB + 524288;
constexpr size_t WS_TWT = 15 * MiB + 524288 + 73728;
constexpr size_t WS_KHAT = 36 * MiB;
constexpr size_t WS_GT = 436 * MiB;
constexpr size_t WS_Y1 = 340 * MiB;
constexpr size_t WS_H2LO = 436 * MiB;
constexpr size_t WS_KRAW = 468 * MiB;
constexpr size_t WS_KPART = 6 * MiB + 524288;  constexpr size_t WS_HDNB = WS_HDN;
constexpr int CW_BAR = 4096, CW_CNT = 8192;

constexpr int RING_BYTES = 131072, LDS_BYTES = 163840, LDSCTL_OFF = LDS_BYTES - 2048, MISC_OFF = LDSCTL_OFF + 320, TAB_OFF = LDSCTL_OFF + 1024;

#define LDS_WAIT() asm volatile("s_waitcnt lgkmcnt(0)" ::: "memory")
#define VM_WAIT() asm volatile("s_waitcnt vmcnt(0)" ::: "memory")
typedef __bf16 bf16x2_hw __attribute__((ext_vector_type(2)));
__device__ __forceinline__ unsigned pk2(float lo, float hi) { f32x2 v = {lo, hi}; bf16x2_hw b = __builtin_convertvector(v, bf16x2_hw); return __builtin_bit_cast(unsigned, b); }
__device__ __forceinline__ unsigned f2bf(float f) { return pk2(f, 0.f) & 0xffffu; }
__device__ __forceinline__ float bf2f(unsigned short b) { return __builtin_bit_cast(float, (unsigned)b << 16); }
__device__ __forceinline__ float bflo(unsigned w) { return __builtin_bit_cast(float, w << 16); }
__device__ __forceinline__ float bfhi(unsigned w) { return __builtin_bit_cast(float, w & 0xffff0000u); }
__device__ __forceinline__ float sigmoidf_(float x) { return __builtin_amdgcn_rcpf(1.0f + __expf(-x)); }
__device__ __forceinline__ float wave_sum(float v) {
#pragma unroll
    for (int o = 1; o < 64; o <<= 1) v += __shfl_xor(v, o);
    return v;
}

#define FSTAMP(i) do { if (PROBE_T >= 0 && blockIdx.x == 0 && threadIdx.x == 0) ((volatile LAS unsigned*)(F.lds + LDSCTL_OFF))[(i)] = (unsigned)__builtin_amdgcn_s_memrealtime(); } while (0)
namespace pg8 {
constexpr int BM = 256, BK = 64, HALF = 128, HTB = HALF * BK * 2, STAGE_BYTES = 8 * HTB, NXCD = 8, WGM = 8;
__host__ __device__ __forceinline__ int lds_byte(int r, int c) { const int st = (r >> 4) * 2 + (c >> 5), rr = r & 15, cc = c & 31, ob = rr * 64 + cc * 2; return st * 1024 + (ob ^ (((ob >> 9) & 1) << 5)); }
__host__ __device__ __forceinline__ void stage_rc(int b, int& R, int& C) { const int st = b / 1024, sb = b % 1024, swz = sb ^ (((sb >> 9) & 1) << 5); R = (st >> 1) * 16 + swz / 64; C = (st & 1) * 32 + (swz % 64) / 2; }
__host__ __device__ __forceinline__ int perm32(int rho) { const int n = rho >> 4, i = rho & 15; return 8 * (i >> 2) + 4 * n + (i & 3); }

struct Unit { int pm, pn, e, mt, li; };

struct DenseSched {
    static constexpr bool GATHER = false;
    int nM, nN, nwg, G, c, K; const char* Bt;
    __device__ void init(int M, int N, int K_, int G_, int c_, const void* Bt_) { nM = M / BM; nN = N / BM; nwg = nM * nN; G = G_; c = c_; K = K_; Bt = (const char*)Bt_; }
    __device__ bool next(int i, Unit& u) const {
        const long L = (long)i * G + c; if (L >= nwg) return false;
        int wgid = (int)L; { const int q = nwg / NXCD, r = nwg % NXCD, xcd = wgid % NXCD, off = wgid / NXCD; wgid = (xcd < r ? xcd * (q + 1) : r * (q + 1) + (xcd - r) * q) + off; }
        const int nig = WGM * nN, gid = wgid / nig, fm = gid * WGM, gsz = (nM - fm) < WGM ? (nM - fm) : WGM;
        u.pm = fm + ((wgid % nig) % gsz); u.pn = (wgid % nig) / gsz; u.e = 0; u.mt = 0; u.li = 0; return true;
    }
    __device__ __forceinline__ unsigned arow(const Unit& u, int r) const { return (unsigned)(u.pm * BM + r); }
    __device__ __forceinline__ const char* bptr(const Unit& u) const { return Bt + (size_t)u.pn * BM * K * 2; }
};

constexpr int MOE_MAXU = 6;
template <bool GATHER_> struct MoeSched {
    static constexpr bool GATHER = GATHER_;
    const LAS int* tab;
    const LAS int* ulist;
    const LAS int* rowtab;
    const char* Bt; size_t estride; int K;
    __device__ bool next(int i, Unit& u) const {
        if (i >= MOE_MAXU || ulist[4 * i + 3] == 0) return false;
        u.e = ulist[4 * i]; u.mt = ulist[4 * i + 1]; u.pm = ulist[4 * i + 2]; u.pn = ulist[4 * i + 3] - 1; u.li = i; return true;
    }
    __device__ __forceinline__ unsigned arow(const Unit& u, int r) const {
        if (!GATHER_) return (unsigned)(u.pm * BM + r);
        return (unsigned)rowtab[u.li * 256 + r];
    }
    __device__ __forceinline__ const char* bptr(const Unit& u) const { return Bt + (size_t)u.e * estride + (size_t)u.pn * BM * K * 2; }
};

template <class Epi, class Sched, bool ALIGN_EPI>
__device__ __forceinline__ void gemm_phase(LAS unsigned char* lds, const void* Abase, const int K, const Sched& S, const Epi& E) {
    int tid = threadIdx.x; asm volatile("" : "+v"(tid));
    const int wid = __builtin_amdgcn_readfirstlane(tid >> 6), lane = tid & 63, wr = wid >> 2, wc = wid & 3, fr = lane & 15, fq = lane >> 4;
    const int nt = K / BK;
    int Rr[2], Cc[2]; unsigned voffB[2];
#pragma unroll
    for (int i = 0; i < 2; ++i) { stage_rc(tid * 16 + i * 8192, Rr[i], Cc[i]);
        const int Rb = Epi::BMAP == 2 ? (64 * (Rr[i] >> 5) + perm32(Rr[i] & 31)) : ((Rr[i] & ~31) + perm32(Rr[i] & 31)); voffB[i] = (unsigned)(Rb * K + Cc[i]) * 2u; }
    const size_t kstep = (size_t)(BK * 2);
    const size_t hstep = (size_t)HALF * K * 2;
    const size_t bhs = (size_t)(Epi::BMAP == 2 ? 32 : HALF) * K * 2;
    LAS unsigned char* const stg = lds + RING_BYTES + wid * 2304;
    const unsigned ldsw = (unsigned)wid * 1024u;
    const int aoff = lds_byte(wr * 64 + fr, fq * 8), boff = lds_byte(wc * 32 + fr, fq * 8);
#define PG8_SA(b, h) (((b) * 2 + (h)) * HTB)
#define PG8_SB(b, h) ((4 + (b) * 2 + (h)) * HTB)
#define PG8_STAGE(bufoff, gbase, voff) do { _Pragma("unroll") for (int _i = 0; _i < 2; ++_i) \
        __builtin_amdgcn_global_load_lds((const unsigned*)((const char*)(gbase) + (voff)[_i]), (LAS unsigned*)(lds + (bufoff) + ldsw + _i * 8192), 16, 0, 0); } while (0)
#define PG8_LDA(dst, b, h) do { _Pragma("unroll") for (int m = 0; m < 4; ++m) _Pragma("unroll") for (int k = 0; k < 2; ++k) dst[m][k] = *(const LAS bf16x8*)(lds + PG8_SA(b, h) + aoff + m * 2048 + k * 1024); } while (0)
#define PG8_LDB(dst, b, h) do { _Pragma("unroll") for (int n = 0; n < 2; ++n) _Pragma("unroll") for (int k = 0; k < 2; ++k) dst[n][k] = *(const LAS bf16x8*)(lds + PG8_SB(b, h) + boff + n * 2048 + k * 1024); } while (0)
#define PG8_MMA(ai, bj, At, Bt) do { __builtin_amdgcn_s_setprio(1); _Pragma("unroll") for (int m = 0; m < 4; ++m) _Pragma("unroll") for (int n = 0; n < 2; ++n) _Pragma("unroll") for (int k = 0; k < 2; ++k) \
        acc[ai][bj][m][n] = __builtin_amdgcn_mfma_f32_16x16x32_bf16(Bt[n][k], At[m][k], acc[ai][bj][m][n], 0, 0, 0); __builtin_amdgcn_s_setprio(0); } while (0)
#define PG8_WAIT_V(n) asm volatile("s_waitcnt vmcnt(" #n ")" ::: "memory")
#define PG8_WAIT_L(n) asm volatile("s_waitcnt lgkmcnt(" #n ")" ::: "memory")
#define PG8_BAR __builtin_amdgcn_s_barrier()
#define PG8_SCHED __builtin_amdgcn_sched_barrier(0)
    Unit cur, nxt; int ui = 0;
    if (!S.next(0, cur)) return;
    f32x4 acc[2][2][4][2];
#pragma unroll
    for (int a = 0; a < 2; ++a)
#pragma unroll
        for (int b = 0; b < 2; ++b)
#pragma unroll
            for (int m = 0; m < 4; ++m)
#pragma unroll
                for (int n = 0; n < 2; ++n) acc[a][b][m][n] = (f32x4){0.f, 0.f, 0.f, 0.f};
    bf16x8 At[4][2], B0[2][2], B1[2][2];
    constexpr bool GATHER = Sched::GATHER;
    unsigned cv0[2], cv1[2], nv0[2], nv1[2];
#pragma unroll
    for (int i = 0; i < 2; ++i) {
        if constexpr (GATHER) { cv0[i] = (S.arow(cur, Rr[i]) * (unsigned)K + (unsigned)Cc[i]) * 2u; cv1[i] = (S.arow(cur, HALF + Rr[i]) * (unsigned)K + (unsigned)Cc[i]) * 2u; }
        else { cv0[i] = (unsigned)(Rr[i] * K + Cc[i]) * 2u; cv1[i] = cv0[i]; nv0[i] = cv0[i]; nv1[i] = cv0[i]; }
    }
    const char* cA = GATHER ? (const char*)Abase : (const char*)Abase + (size_t)S.arow(cur, 0) * K * 2;
    const size_t ahs = GATHER ? 0 : hstep;
    const char* cB = S.bptr(cur);
    PG8_STAGE(PG8_SB(0, 0), cB, voffB); PG8_STAGE(PG8_SB(0, 1), cB + bhs, voffB); PG8_STAGE(PG8_SA(0, 0), cA, cv0); PG8_STAGE(PG8_SA(0, 1), cA + ahs, cv1);
    if (wr == 1) PG8_BAR;
    PG8_WAIT_V(2); PG8_BAR;
    PG8_STAGE(PG8_SB(1, 0), cB + kstep, voffB); PG8_STAGE(PG8_SA(1, 0), cA + kstep, cv0); PG8_STAGE(PG8_SB(1, 1), cB + bhs + kstep, voffB);
    PG8_WAIT_V(6); PG8_BAR;
    for (;;) {
        const bool has_next = S.next(ui + 1, nxt);
        const char* nB = has_next ? S.bptr(nxt) : cB;
        const char* nA = cA;
        if constexpr (GATHER) {
#pragma unroll
            for (int i = 0; i < 2; ++i) {
                nv0[i] = has_next ? (S.arow(nxt, Rr[i]) * (unsigned)K + (unsigned)Cc[i]) * 2u : cv0[i];
                nv1[i] = has_next ? (S.arow(nxt, HALF + Rr[i]) * (unsigned)K + (unsigned)Cc[i]) * 2u : cv1[i];
            }
        } else { if (has_next) nA = (const char*)Abase + (size_t)S.arow(nxt, 0) * K * 2; }
        for (int t = 0; t < nt; t += 2) {
            const bool last = (t == nt - 2);
            if constexpr (Epi::HAS_MID) { if (t == (nt >> 1)) E.mid(acc, cur, wr, wc, fr, fq); }
            const char* a1 = cA + (size_t)(t + 1) * kstep;
            const char* a2 = last ? nA : cA + (size_t)(t + 2) * kstep; const char* b2 = last ? nB : cB + (size_t)(t + 2) * kstep;
            const char* a3 = a2 + kstep; const char* b3 = b2 + kstep;
            unsigned x0[2], x1[2];
#pragma unroll
            for (int i = 0; i < 2; ++i) { x0[i] = (GATHER && last) ? nv0[i] : cv0[i]; x1[i] = (GATHER && last) ? nv1[i] : cv1[i]; }
            PG8_LDB(B0, 0, 0); PG8_LDB(B1, 0, 1); PG8_SCHED; PG8_LDA(At, 0, 0); PG8_STAGE(PG8_SA(1, 1), a1 + ahs, cv1);
            PG8_WAIT_V(8); PG8_WAIT_L(0); PG8_BAR; PG8_MMA(0, 0, At, B0); PG8_MMA(0, 1, At, B1); PG8_BAR; PG8_SCHED;
            PG8_LDA(At, 0, 1); PG8_STAGE(PG8_SB(0, 0), b2, voffB); PG8_STAGE(PG8_SB(0, 1), b2 + bhs, voffB); PG8_STAGE(PG8_SA(0, 0), a2, x0);
            PG8_WAIT_V(8); PG8_WAIT_L(0); PG8_BAR; PG8_MMA(1, 0, At, B0); PG8_MMA(1, 1, At, B1); PG8_BAR; PG8_SCHED;
            PG8_LDB(B0, 1, 0); PG8_LDB(B1, 1, 1); PG8_SCHED; PG8_LDA(At, 1, 0); PG8_STAGE(PG8_SA(0, 1), a2 + ahs, x1);
            PG8_WAIT_V(8); PG8_WAIT_L(0); PG8_BAR; PG8_MMA(0, 0, At, B0); PG8_MMA(0, 1, At, B1); PG8_BAR; PG8_SCHED;
            PG8_LDA(At, 1, 1); PG8_STAGE(PG8_SB(1, 0), b3, voffB); PG8_STAGE(PG8_SB(1, 1), b3 + bhs, voffB); PG8_STAGE(PG8_SA(1, 0), a3, x0);
            PG8_WAIT_V(8); PG8_WAIT_L(0); PG8_BAR; PG8_MMA(1, 0, At, B0); PG8_MMA(1, 1, At, B1); PG8_BAR; PG8_SCHED;
        }
        if constexpr (ALIGN_EPI) { if (wr == 0) PG8_BAR; }
        E(acc, cur, wr, wc, fr, fq, stg, lane);
        if (!has_next) break;
#pragma unroll
        for (int a = 0; a < 2; ++a)
#pragma unroll
            for (int b = 0; b < 2; ++b)
#pragma unroll
                for (int m = 0; m < 4; ++m)
#pragma unroll
                    for (int n = 0; n < 2; ++n) acc[a][b][m][n] = (f32x4){0.f, 0.f, 0.f, 0.f};
        cur = nxt; cB = nB; cA = nA; ++ui;
        if constexpr (GATHER) {
#pragma unroll
            for (int i = 0; i < 2; ++i) { cv0[i] = nv0[i]; cv1[i] = nv1[i]; }
        }
        if constexpr (ALIGN_EPI) { if (wr == 1) PG8_BAR; }
    }
    PG8_WAIT_V(0);
    if constexpr (!ALIGN_EPI) { if (wr == 0) PG8_BAR; }
    PG8_BAR;
#undef PG8_SA
#undef PG8_SB
#undef PG8_STAGE
#undef PG8_LDA
#undef PG8_LDB
#undef PG8_MMA
#undef PG8_WAIT_V
#undef PG8_WAIT_L
#undef PG8_BAR
#undef PG8_SCHED
}

__device__ __forceinline__ u32x4 pack8(const f32x4 v0, const f32x4 v1) { u32x4 w; w.x = pk2(v0[0], v0[1]); w.y = pk2(v0[2], v0[3]); w.z = pk2(v1[0], v1[1]); w.w = pk2(v1[2], v1[3]); return w; }
template <class RowPtr, class RowOk>
__device__ __forceinline__ void staged_store(LAS unsigned char* stg, int lane, const u32x4 p0, const u32x4 p1, const RowPtr& rp, const RowOk& ok) {
    const int fr = lane & 15, fq = lane >> 4;
    *(LAS u32x4*)(stg + fr * 144 + fq * 16) = p0; *(LAS u32x4*)(stg + fr * 144 + 64 + fq * 16) = p1;
    const int r = lane >> 3, ch = lane & 7;
    const u32x4 a = *(LAS const u32x4*)(stg + r * 144 + ch * 16), b = *(LAS const u32x4*)(stg + (r + 8) * 144 + ch * 16);
    if (ok(r)) *(u32x4*)(rp(r) + ch * 8) = a;
    if (ok(r + 8)) *(u32x4*)(rp(r + 8) + ch * 8) = b;
}
__device__ __forceinline__ void staged_store2(LAS unsigned char* stg, int lane, const u32x4 p0, const u32x4 p1, bf16_t* a, bf16_t* b, size_t ld) {
    const int fr = lane & 15, fq = lane >> 4;
    *(LAS u32x4*)(stg + fr * 144 + fq * 16) = p0; *(LAS u32x4*)(stg + fr * 144 + 64 + fq * 16) = p1;
    const int r = lane >> 2, ch = lane & 3;
    const u32x4 x = *(LAS const u32x4*)(stg + r * 144 + ch * 16), y = *(LAS const u32x4*)(stg + r * 144 + 64 + ch * 16);
    *(u32x4*)(a + (size_t)r * ld + ch * 8) = x; *(u32x4*)(b + (size_t)r * ld + ch * 8) = y;
}
struct AlwaysOk { __device__ __forceinline__ bool operator()(int) const { return true; } };
struct DenseRows { bf16_t* base; size_t ld; __device__ __forceinline__ bf16_t* operator()(int r) const { return base + (size_t)r * ld; } };

struct EpiInA {
    static constexpr int BMAP = 2; static constexpr bool HAS_MID = false;
    bf16_t *Q, *Kb, *Vb, *RS;
    __device__ __forceinline__ void operator()(const f32x4 (&acc)[2][2][4][2], const Unit& u, int wr, int wc, int fr, int fq, LAS unsigned char* stg, int lane) const {
        const int row0 = u.pm * BM + wr * 64;
        if (u.pn < 3) {
            bf16_t* base; size_t ld;
            if (u.pn < 2) { base = Q + u.pn * 256 + wc * 64; ld = AW; } else { base = (wc < 2 ? Kb : Vb) + (wc & 1) * 64; ld = KVW; }
#pragma unroll
            for (int ai = 0; ai < 2; ++ai)
#pragma unroll
                for (int m = 0; m < 4; ++m)
                    staged_store(stg, lane, pack8(acc[ai][0][m][0], acc[ai][0][m][1]), pack8(acc[ai][1][m][0], acc[ai][1][m][1]), DenseRows{base + (size_t)(row0 + ai * HALF + m * 16) * ld, ld}, AlwaysOk{});
        } else {
            bf16_t* rb = RS + (u.pn - 3) * 128 + wc * 32; bf16_t* sb = rb + (size_t)T * DM;
#pragma unroll
            for (int ai = 0; ai < 2; ++ai)
#pragma unroll
                for (int m = 0; m < 4; ++m) {
                    f32x4 r0, r1, s0, s1;
#pragma unroll
                    for (int j = 0; j < 4; ++j) {
                        const float ea0 = __expf(-acc[ai][0][m][0][j]), eh0 = __expf(-acc[ai][1][m][0][j]), ea1 = __expf(-acc[ai][0][m][1][j]), eh1 = __expf(-acc[ai][1][m][1][j]);
                        s0[j] = __builtin_amdgcn_rcpf(1.0f + eh0); s1[j] = __builtin_amdgcn_rcpf(1.0f + eh1); r0[j] = (1.0f + eh0) * __builtin_amdgcn_rcpf(1.0f + ea0); r1[j] = (1.0f + eh1) * __builtin_amdgcn_rcpf(1.0f + ea1); }
                    staged_store2(stg, lane, pack8(r0, r1), pack8(s0, s1), rb + (size_t)(row0 + ai * HALF + m * 16) * DM, sb + (size_t)(row0 + ai * HALF + m * 16) * DM, DM);
                }
        }
    }
};
struct EpiBf16 {
    static constexpr int BMAP = 2; static constexpr bool HAS_MID = false;
    bf16_t* O; int ldc;
    __device__ __forceinline__ void operator()(const f32x4 (&acc)[2][2][4][2], const Unit& u, int wr, int wc, int fr, int fq, LAS unsigned char* stg, int lane) const {
        bf16_t* base = O + (size_t)(u.pm * BM + wr * 64) * ldc + u.pn * BM + wc * 64;
#pragma unroll
        for (int ai = 0; ai < 2; ++ai)
#pragma unroll
            for (int m = 0; m < 4; ++m)
                staged_store(stg, lane, pack8(acc[ai][0][m][0], acc[ai][0][m][1]), pack8(acc[ai][1][m][0], acc[ai][1][m][1]), DenseRows{base + (size_t)(ai * HALF + m * 16) * ldc, (size_t)ldc}, AlwaysOk{});
    }
};
struct EpiMerge {
    static constexpr int BMAP = 2; static constexpr bool HAS_MID = true;
    const bf16_t* RS; bf16_t* O;
    __device__ __forceinline__ void mid(f32x4 (&acc)[2][2][4][2], const Unit& u, int wr, int wc, int fr, int fq) const {
        asm volatile("" : "+v"(fr), "+v"(fq));
        const int row0 = u.pm * BM + wr * 64 + fr;
#pragma unroll
        for (int ai = 0; ai < 2; ++ai)
#pragma unroll
            for (int mh = 0; mh < 2; ++mh) {
                u32x4 g[2][2];
#pragma unroll
                for (int mm = 0; mm < 2; ++mm)
#pragma unroll
                    for (int bj = 0; bj < 2; ++bj) g[mm][bj] = *(const u32x4*)(RS + (size_t)(row0 + ai * HALF + (2 * mh + mm) * 16) * DM + u.pn * BM + wc * 64 + bj * 32 + 8 * fq);
#pragma unroll
                for (int mm = 0; mm < 2; ++mm)
#pragma unroll
                    for (int bj = 0; bj < 2; ++bj) { const int m = 2 * mh + mm; const u32x4 gg = g[mm][bj];
                        acc[ai][bj][m][0][0] *= bflo(gg.x); acc[ai][bj][m][0][1] *= bfhi(gg.x); acc[ai][bj][m][0][2] *= bflo(gg.y); acc[ai][bj][m][0][3] *= bfhi(gg.y);
                        acc[ai][bj][m][1][0] *= bflo(gg.z); acc[ai][bj][m][1][1] *= bfhi(gg.z); acc[ai][bj][m][1][2] *= bflo(gg.w); acc[ai][bj][m][1][3] *= bfhi(gg.w); }
                asm volatile("" ::: "memory");
            }
    }
    __device__ __forceinline__ void operator()(const f32x4 (&acc)[2][2][4][2], const Unit& u, int wr, int wc, int fr, int fq, LAS unsigned char* stg, int lane) const {
        const int row0 = u.pm * BM + wr * 64;
        bf16_t* base = O + (size_t)row0 * DM + u.pn * BM + wc * 64;
#pragma unroll
        for (int ai = 0; ai < 2; ++ai)
#pragma unroll
            for (int m = 0; m < 4; ++m) {
                u32x4 pk[2];
#pragma unroll
                for (int bj = 0; bj < 2; ++bj) {
                    const u32x4 g = *(const u32x4*)(RS + (size_t)T * DM + (size_t)(row0 + fr + ai * HALF + m * 16) * DM + u.pn * BM + wc * 64 + bj * 32 + 8 * fq);
                    f32x4 v0 = acc[ai][bj][m][0], v1 = acc[ai][bj][m][1];
                    v0[0] *= bflo(g.x); v0[1] *= bfhi(g.x); v0[2] *= bflo(g.y); v0[3] *= bfhi(g.y);
                    v1[0] *= bflo(g.z); v1[1] *= bfhi(g.z); v1[2] *= bflo(g.w); v1[3] *= bfhi(g.w);
                    pk[bj] = pack8(v0, v1);
                }
                staged_store(stg, lane, pk[0], pk[1], DenseRows{base + (size_t)(ai * HALF + m * 16) * DM, DM}, AlwaysOk{});
            }
    }
};
struct EpiY {
    static constexpr int BMAP = 2; static constexpr bool HAS_MID = false;
    const float* gate; bf16_t* O;
    __device__ __forceinline__ void operator()(const f32x4 (&acc)[2][2][4][2], const Unit& u, int wr, int wc, int fr, int fq, LAS unsigned char* stg, int lane) const {
        const int col0 = u.pn * BM + wc * 64; const int b = (u.pm * BM) / SEQ;
        const float* gp = gate + (size_t)b * 6144 + col0 + 8 * fq;
        const f32x4 g00 = *(const f32x4*)gp, g01 = *(const f32x4*)(gp + 4), g10 = *(const f32x4*)(gp + 32), g11 = *(const f32x4*)(gp + 36);
        bf16_t* base = O + (size_t)(u.pm * BM + wr * 64) * DM + col0;
#pragma unroll
        for (int ai = 0; ai < 2; ++ai)
#pragma unroll
            for (int m = 0; m < 4; ++m)
                staged_store(stg, lane, pack8(acc[ai][0][m][0] * g00, acc[ai][0][m][1] * g01), pack8(acc[ai][1][m][0] * g10, acc[ai][1][m][1] * g11), DenseRows{base + (size_t)(ai * HALF + m * 16) * DM, DM}, AlwaysOk{});
    }
};
struct EpiNull {
    static constexpr int BMAP = 2; static constexpr bool HAS_MID = false;
    __device__ __forceinline__ void operator()(const f32x4 (&acc)[2][2][4][2], const Unit& u, int wr, int wc, int fr, int fq, LAS unsigned char* stg, int lane) const {
#pragma unroll
        for (int ai = 0; ai < 2; ++ai)
#pragma unroll
            for (int bj = 0; bj < 2; ++bj)
#pragma unroll
                for (int m = 0; m < 4; ++m) asm volatile("" :: "v"(acc[ai][bj][m][0]), "v"(acc[ai][bj][m][1]));
    }
};
struct EpiSwiGLU {
    static constexpr int BMAP = 1; static constexpr bool HAS_MID = false;
    bf16_t* H;
    __device__ __forceinline__ void operator()(const f32x4 (&acc)[2][2][4][2], const Unit& u, int wr, int wc, int fr, int fq, LAS unsigned char* stg, int lane) const {
        const int row0 = u.pm * BM + wr * 64 + fr; const int col0 = u.pn * HALF + wc * 32 + 8 * fq;
#pragma unroll
        for (int ai = 0; ai < 2; ++ai)
#pragma unroll
            for (int m = 0; m < 4; ++m) {
                f32x4 v0, v1;
#pragma unroll
                for (int j = 0; j < 4; ++j) { const float a0 = acc[ai][0][m][0][j], a1 = acc[ai][0][m][1][j];
                    v0[j] = a0 * sigmoidf_(a0) * acc[ai][1][m][0][j]; v1[j] = a1 * sigmoidf_(a1) * acc[ai][1][m][1][j]; }
                *(u32x4*)(H + (size_t)(row0 + ai * HALF + m * 16) * DE + col0) = pack8(v0, v1);
            }
    }
};
struct EpiScatter {
    static constexpr int BMAP = 2; static constexpr bool HAS_MID = false;
    bf16_t* Y2; const LAS int* rowtab; const LAS float* wtab;
    struct Rows { bf16_t* base; int d0, d1; __device__ __forceinline__ bf16_t* operator()(int r) const { return base + (size_t)(r < 8 ? d0 : d1) * DM; } };
    struct Oks { bool o0, o1; __device__ __forceinline__ bool operator()(int r) const { return r < 8 ? o0 : o1; } };
    __device__ __forceinline__ void operator()(const f32x4 (&acc)[2][2][4][2], const Unit& u, int wr, int wc, int fr, int fq, LAS unsigned char* stg, int lane) const {
        bf16_t* base = Y2 + u.pn * BM + wc * 64;
        const LAS int* rt = rowtab + u.li * 256; const LAS float* wt = wtab + u.li * 256;
#pragma unroll
        for (int ai = 0; ai < 2; ++ai)
#pragma unroll
            for (int m = 0; m < 4; ++m) {
                const int g0 = ai * HALF + wr * 64 + m * 16;
                const float w = wt[g0 + fr]; const int d0 = rt[g0 + (lane >> 3)], d1 = rt[g0 + (lane >> 3) + 8];
                staged_store(stg, lane, pack8(acc[ai][0][m][0] * w, acc[ai][0][m][1] * w), pack8(acc[ai][1][m][0] * w, acc[ai][1][m][1] * w), Rows{base, d0 < 0 ? 0 : d0, d1 < 0 ? 0 : d1}, Oks{d0 >= 0, d1 >= 0});
            }
    }
};
}

#define XB_TMO      128
#define XB_XCNT(j)  (256  + 64 * (j))
#define XB_XSUB(j)  (1280 + 64 * (j))
#define XB_XGEN(j)  (2304 + 64 * (j))
#define XB_TOP      3328
#define XB_TOPGEN   3392
#define XCD_BAR_WORDS 3456
#define XB_SPIN_CAP (1u << 22)
__device__ __forceinline__ unsigned xb_ld(unsigned* p)              { return __hip_atomic_load(p, __ATOMIC_RELAXED, __HIP_MEMORY_SCOPE_AGENT); }
__device__ __forceinline__ unsigned xb_add(unsigned* p, unsigned v) { return __hip_atomic_fetch_add(p, v, __ATOMIC_RELAXED, __HIP_MEMORY_SCOPE_AGENT); }
__device__ __forceinline__ unsigned xb_xcc_id() { return (unsigned)__builtin_amdgcn_s_getreg((3 << 11) | 20) & 0xFu; }
#define XB_SPIN(cond, bar) do { unsigned _sp = 0; while (cond) { __builtin_amdgcn_s_sleep(1); \
    if ((++_sp & 255u) == 0u) { if (xb_ld(&(bar)[XB_TMO])) break; if (_sp > XB_SPIN_CAP) { atomicAdd(&(bar)[XB_TMO], 1u); break; } } } } while (0)
__device__ __forceinline__ void xcd_barrier_post(unsigned* bar) { if (threadIdx.x == 0) (void)xb_add(&bar[XB_XCNT(xb_xcc_id())], 1u); }
__device__ __forceinline__ void xcd_barrier_complete(unsigned* bar, unsigned x, unsigned& nloc, unsigned& nx) {
    const unsigned G = gridDim.x * gridDim.y * gridDim.z;
    unsigned sum, cnt, mine, sp = 0u;
    for (;;) {
        sum = 0u; cnt = 0u; mine = 0u;
#pragma unroll
        for (unsigned j = 0; j < 16; ++j) { const unsigned c = xb_ld(&bar[XB_XCNT(j)]); sum += c; cnt += (c > 0u) ? 1u : 0u; mine = (j == x) ? c : mine; }
        if (sum == G) break;
        __builtin_amdgcn_s_sleep(1);
        if ((++sp & 255u) == 0u) { if (xb_ld(&bar[XB_TMO])) break; if (sp > XB_SPIN_CAP) { atomicAdd(&bar[XB_TMO], 1u); break; } }
    }
    nloc = mine > 0u ? mine : 1u; nx = cnt > 0u ? cnt : 1u;
}
__device__ __forceinline__ void xcd_barrier(unsigned* bar, volatile LAS unsigned* st) {
    asm volatile("s_waitcnt vmcnt(0)" ::: "memory");
    __syncthreads();
    if (threadIdx.x == 0) {
        const unsigned x = xb_xcc_id();
        __builtin_amdgcn_s_waitcnt(0);
        unsigned nloc = st[0], nx = st[1];
        if (nloc == 0u) { xcd_barrier_complete(bar, x, nloc, nx); st[0] = nloc; st[1] = nx; }
        const unsigned old = xb_add(&bar[XB_XSUB(x)], 1u);
        const unsigned gen = old / nloc;
        if (old + 1u == (gen + 1u) * nloc) {
            __builtin_amdgcn_fence(__ATOMIC_RELEASE, "agent");
            asm volatile("s_waitcnt vmcnt(0)" ::: "memory");
            const unsigned og = xb_add(&bar[XB_TOP], 1u);
            const unsigned tg = og / nx;
            if (og + 1u == (tg + 1u) * nx) xb_add(&bar[XB_TOPGEN], 1u);
            else XB_SPIN(xb_ld(&bar[XB_TOPGEN]) == tg, bar);
            __builtin_amdgcn_fence(__ATOMIC_ACQUIRE, "agent");
            xb_add(&bar[XB_XGEN(x)], 1u);
            asm volatile("s_waitcnt vmcnt(0)" ::: "memory");
        } else {
            XB_SPIN(xb_ld(&bar[XB_XGEN(x)]) == gen, bar);
            __builtin_amdgcn_fence(__ATOMIC_ACQUIRE, "agent");
            asm volatile("s_waitcnt vmcnt(0)" ::: "memory");
        }
    }
    __syncthreads();
}

struct Args { const float* in[31]; float* out; unsigned char* ws; int ph_lo, ph_hi; };
struct Frame {
    LAS unsigned char* lds; unsigned char* ws; unsigned* ctl;
    int tid, lane, wave, vcu, G;
    const float* const* in; float* out;
};
enum { I_X = 0, I_C, I_WADA, I_BADA, I_WIN, I_CONVW, I_CONVB, I_FW1, I_FB1, I_FF1, I_FW2, I_FB2, I_FF2, I_FW3, I_DECAY, I_SKIP, I_WHY, I_WATT, I_SINK, I_WOUT,
       I_LN1G, I_LN1B, I_RGW, I_RGB, I_REW, I_REB, I_EW1, I_EW3, I_EW2, I_LN2G, I_LN2B };

__device__ __forceinline__ void transpose_item(const float* W, int K, int N, bf16_t* WT, int ldt, int drow0, LAS float* scr, int kb, int nb, int lane) {
    const int k0 = 64 * kb, n0 = 32 * nb;
#pragma unroll 8
    for (int i = 0; i < 32; ++i) { const int kk = 2 * i + (lane >> 5); scr[kk * 33 + (lane & 31)] = W[(size_t)(k0 + kk) * N + n0 + (lane & 31)]; }
    LDS_WAIT(); asm volatile("" ::: "memory");
    const int c = lane & 7;
#pragma unroll
    for (int j = 0; j < 4; ++j) { const int n = (lane >> 3) + 8 * j; const LAS float* s = scr + (8 * c) * 33 + n;
        u32x4 o; o.x = pk2(s[0 * 33], s[1 * 33]); o.y = pk2(s[2 * 33], s[3 * 33]); o.z = pk2(s[4 * 33], s[5 * 33]); o.w = pk2(s[6 * 33], s[7 * 33]);
        *(u32x4*)(WT + (size_t)(drow0 + n) * ldt + k0 + 8 * c) = o; }
    LDS_WAIT(); asm volatile("" ::: "memory");
}

__device__ __forceinline__ void ph_prep(Frame& F) {
    const float* c = F.in[I_C]; const float* wada = F.in[I_WADA];
    float* modp = (float*)(F.ws + WS_MODP);
    for (int it = blockIdx.x; it < 192; it += F.G) {
        const int kc = it / 12, cg = it % 12, j = cg * 512 + F.tid;
        float a0 = 0.f, a1 = 0.f, a2 = 0.f, a3 = 0.f;
#pragma unroll 16
        for (int kk = 0; kk < 64; ++kk) { const int k = kc * 64 + kk; const float w = wada[(size_t)k * 6144 + j];
            const float c0 = c[k], c1 = c[1024 + k], c2 = c[2048 + k], c3 = c[3072 + k];
            a0 += c0 * sigmoidf_(c0) * w; a1 += c1 * sigmoidf_(c1) * w; a2 += c2 * sigmoidf_(c2) * w; a3 += c3 * sigmoidf_(c3) * w; }
        modp[(size_t)(kc * 4 + 0) * 6144 + j] = a0; modp[(size_t)(kc * 4 + 1) * 6144 + j] = a1; modp[(size_t)(kc * 4 + 2) * 6144 + j] = a2; modp[(size_t)(kc * 4 + 3) * 6144 + j] = a3;
    }
    LAS float* scr = (LAS float*)(F.lds + F.wave * 16384);
    const int gw = F.vcu * NWAVES + F.wave, NGW = F.G * NWAVES;
    constexpr int I_IN = 16 * 136, I_A = 8 * 32, I_H = 8 * 32, I_O = 16 * 32;
    for (int it = gw; it < I_IN + I_A + I_H + I_O; it += NGW) {
        int r = it;
        if (r < I_IN) { const int kb = r / 136, nb = r % 136, n0 = nb * 32;
            int drow;
            if (n0 < 768) drow = n0; else if (n0 < 2304) drow = N1A + (n0 - 768);
            else if (n0 < 3328) { const int d = n0 - 2304; drow = 768 + (d >> 5) * 64; }
            else { const int d = n0 - 3328; drow = 768 + (d >> 5) * 64 + 32; }
            transpose_item(F.in[I_WIN], DM, INW, (bf16_t*)(F.ws + WS_WIN), DM, drow, scr, kb, nb, F.lane); continue; } r -= I_IN;
        if (r < I_A) { transpose_item(F.in[I_WATT], AW, DM, (bf16_t*)(F.ws + WS_WAH), DM, (r % 32) * 32, scr, r / 32, r % 32, F.lane); continue; } r -= I_A;
        if (r < I_H) { transpose_item(F.in[I_WHY], HW, DM, (bf16_t*)(F.ws + WS_WAH) + AW, DM, (r % 32) * 32, scr, r / 32, r % 32, F.lane); continue; } r -= I_H;
        transpose_item(F.in[I_WOUT], DM, DM, (bf16_t*)(F.ws + WS_WO), DM, (r % 32) * 32, scr, r / 32, r % 32, F.lane);
    }
    {
        const float* w1 = F.in[I_FW1]; const float* b1 = F.in[I_FB1]; const float* f1 = F.in[I_FF1];
        const float* w2 = F.in[I_FW2]; const float* b2 = F.in[I_FB2]; const float* f2 = F.in[I_FF2];
        const int j = F.lane;
        for (int t = gw; t < SEQ; t += NGW) {
            const float tl = (float)t / (float)(SEQ - 1);
            const float w = 6.283185307179586f * (float)t / (float)SEQ;
            float zi = 0.f;
            if (j == 0) zi = tl;
            else if (j <= 16) { const float band = 1e-4f + (float)(j - 1) * ((15.0f - 1e-4f) / 15.0f); zi = cosf(band * w); }
            else if (j <= 32) { const float band = 1e-4f + (float)(j - 17) * ((15.0f - 1e-4f) / 15.0f); zi = -sinf(band * w); }
            float a = b1[j];
#pragma unroll
            for (int i = 0; i < FEMB; ++i) a += __shfl(zi, i) * w1[i * FH + j];
            const float h1 = sinf(f1[j] * a);
            float a2 = b2[j];
#pragma unroll
            for (int i = 0; i < FH; ++i) a2 += __shfl(h1, i) * w2[i * FH + j];
            ((bf16_t*)(F.ws + WS_HDNB))[(size_t)t * FH + j] = (bf16_t)f2bf(sinf(f2[j] * a2));
        }
    }
    {
        bf16_t* ftab = (bf16_t*)(F.ws + WS_FTAB); unsigned* twt = (unsigned*)(F.ws + WS_TWT);
        for (int i = blockIdx.x * NTHREADS + F.tid; i < 2 * 128 * 128; i += F.G * NTHREADS) {
            const int t = i >> 14, row = (i >> 7) & 127, q = i & 127;
            const int q15 = q & 15, h = q15 >> 3, j = q15 & 7; const int nat = (q & ~15) + 8 * (j >> 2) + 4 * h + (j & 3);
            const int e = (row * nat) & 127; const float x = (float)e * (2.0f / 128.0f);
            const float v = t == 0 ? cospif(x) : -sinpif(x);
            ftab[(size_t)t * (128 * 136) + row * 136 + q] = (bf16_t)f2bf(v);
        }
        for (int i = blockIdx.x * NTHREADS + F.tid; i < 16 * 64 * 16; i += F.G * NTHREADS) {
            const int r = i & 15, l = (i >> 4) & 63, ab = i >> 10, al = ab >> 2, be = ab & 3;
            const int e = ((32 * al + ((r & 3) + 8 * (r >> 2) + 4 * (l >> 5))) * (32 * be + (l & 31))) & 16383; const float x = (float)e * (2.0f / 16384.0f);
            twt[i] = pk2(cospif(x), -sinpif(x));
        }
    }
    {
        bf16_t* wr = (bf16_t*)(F.ws + WS_WRT); const float* wg = F.in[I_RGW]; const float* we = F.in[I_REW];
        for (int i = blockIdx.x * NTHREADS + F.tid; i < 80 * DM; i += F.G * NTHREADS) { const int o = i / DM, k = i % DM;
            const float w = o < 8 ? wg[k * 8 + o] : (o < 72 ? we[k * 64 + (o - 8)] : 0.f);
            const unsigned hi = f2bf(w); const float lo = w - bf2f((unsigned short)hi);
            wr[i] = (bf16_t)hi; wr[80 * DM + i] = (bf16_t)f2bf(lo); }
    }
}

__device__ __forceinline__ void ph_taps(Frame& F) {
    typedef float f32x16 __attribute__((ext_vector_type(16)));
    const bf16_t* hb = (const bf16_t*)(F.ws + WS_HDNB); const float* w3 = F.in[I_FW3]; const float* decay = F.in[I_DECAY];
    bf16_t* kraw = (bf16_t*)(F.ws + WS_KRAW); float* kpart = (float*)(F.ws + WS_KPART);
    const int lane = F.lane, lr = lane & 31, lh = lane >> 5;
    for (int it = blockIdx.x; it < 256; it += F.G) {
        const int g = it & 63, tq = it >> 6;
        bf16x8 aW[4];
#pragma unroll
        for (int s = 0; s < 4; ++s) { unsigned pk[4];
#pragma unroll
            for (int j2 = 0; j2 < 4; ++j2) { const int k = 16 * s + 8 * lh + 2 * j2; pk[j2] = pk2(w3[(size_t)k * NFILT + 32 * g + lr], w3[(size_t)(k + 1) * NFILT + 32 * g + lr]); }
            aW[s] = __builtin_bit_cast(bf16x8, (u32x4){pk[0], pk[1], pk[2], pk[3]}); }
        float dcy[16], asum[16];
#pragma unroll
        for (int r = 0; r < 16; ++r) { dcy[r] = fabsf(decay[32 * g + (r & 3) + 8 * (r >> 2) + 4 * lh]); asum[r] = 0.f; }
#pragma unroll 1
        for (int tt = 0; tt < 8; ++tt) {
            const int t = 2048 * tq + 32 * (F.wave * 8 + tt) + lr;
            f32x16 acc;
#pragma unroll
            for (int r = 0; r < 16; ++r) acc[r] = 0.f;
#pragma unroll
            for (int s = 0; s < 4; ++s) { const bf16x8 bH = *(const bf16x8*)(hb + (size_t)t * FH + 16 * s + 8 * lh); acc = __builtin_amdgcn_mfma_f32_32x32x16_bf16(aW[s], bH, acc, 0, 0, 0); }
            const float tl = (float)t / (float)(SEQ - 1);
#pragma unroll
            for (int r = 0; r < 16; ++r) { const float v = acc[r] * (__expf(-tl * dcy[r]) + 0.05f); asum[r] += fabsf(v);
                kraw[(size_t)(32 * g + (r & 3) + 8 * (r >> 2) + 4 * lh) * SEQ + t] = (bf16_t)f2bf(v); }
        }
#pragma unroll
        for (int r = 0; r < 16; ++r) { float v = asum[r];
#pragma unroll
            for (int o = 1; o < 32; o <<= 1) v += __shfl_xor(v, o);
            if (lr == 0) kpart[(size_t)(32 * g + (r & 3) + 8 * (r >> 2) + 4 * lh) * 32 + tq * 8 + F.wave] = v; }
    }
}

__device__ __forceinline__ void ph_hb(Frame& F) {
    const float* modp = (const float*)(F.ws + WS_MODP); const float* bada = F.in[I_BADA];
    float* mod = (float*)(F.ws + WS_MOD);
    for (int i = blockIdx.x * NTHREADS + F.tid; i < NB * 6144; i += F.G * NTHREADS) { const int b = i / 6144, j = i % 6144; float s = bada[j];
#pragma unroll
        for (int kc = 0; kc < 16; ++kc) s += modp[(size_t)(kc * 4 + b) * 6144 + j];
        mod[i] = s; }
    LAS float* sc = (LAS float*)F.lds; LAS float* sh = sc + DM;
    const float* x = F.in[I_X]; bf16_t* hb = (bf16_t*)(F.ws + WS_HB);
    for (int ch = blockIdx.x; ch < T / 128; ch += F.G) {
        const int b = (ch * 128) / SEQ;
        __syncthreads();
#pragma unroll
        for (int j = F.tid; j < 2 * DM; j += NTHREADS) { float s = bada[j];
#pragma unroll
            for (int kc = 0; kc < 16; ++kc) s += modp[(size_t)(kc * 4 + b) * 6144 + j];
            if (j < DM) sh[j] = s; else sc[j - DM] = 1.0f + s; }
        __syncthreads();
        for (int r0 = F.wave * 4; r0 < 128; r0 += NWAVES * 4) {
            f32x4 xv[4][4];
#pragma unroll
            for (int r = 0; r < 4; ++r) { const f32x4* xr = (const f32x4*)(x + ((size_t)ch * 128 + r0 + r) * DM) + F.lane;
#pragma unroll
                for (int j = 0; j < 4; ++j) xv[r][j] = xr[64 * j]; }
#pragma unroll
            for (int r = 0; r < 4; ++r) { unsigned long long* o8 = (unsigned long long*)(hb + ((size_t)ch * 128 + r0 + r) * DM) + F.lane;
#pragma unroll
                for (int j = 0; j < 4; ++j) { const f32x4 v = xv[r][j]; const int k = 4 * F.lane + 256 * j;
                    const float h0 = v[0] * sc[k] + sh[k], h1 = v[1] * sc[k + 1] + sh[k + 1], h2 = v[2] * sc[k + 2] + sh[k + 2], h3 = v[3] * sc[k + 3] + sh[k + 3];
                    o8[64 * j] = (unsigned long long)pk2(h0, h1) | ((unsigned long long)pk2(h2, h3) << 32); } }
        }
    }
    __syncthreads();
}

namespace at {
typedef float f32x16 __attribute__((ext_vector_type(16)));
typedef __bf16 bf16x2_t __attribute__((ext_vector_type(2)));
constexpr int KROWB = 144, VROWB = 784, K_OFF = 0, V_OFF = 384 * KROWB;
__device__ __forceinline__ unsigned cvtpk(float lo, float hi) { f32x2 v = {lo, hi}; bf16x2_t b = __builtin_convertvector(v, bf16x2_t); return __builtin_bit_cast(unsigned, b); }
template <int S> __device__ __forceinline__ bf16x8 pack_step(const f32x16& x) {
    u32x4 p; p.x = cvtpk(x[8 * S], x[8 * S + 1]); p.y = cvtpk(x[8 * S + 2], x[8 * S + 3]); p.z = cvtpk(x[8 * S + 4], x[8 * S + 5]); p.w = cvtpk(x[8 * S + 6], x[8 * S + 7]);
    return __builtin_bit_cast(bf16x8, p);
}
__device__ __forceinline__ int kst(int k) { const int c = k & 15; return (k & ~15) + 8 * ((c >> 2) & 1) + 4 * (c >> 3) + (c & 3); }
}
__device__ __forceinline__ void ph_attn(Frame& F) {
    using namespace at;
    const bf16_t* Q = (const bf16_t*)(F.ws + WS_Q); const bf16_t* Kb = (const bf16_t*)(F.ws + WS_K); const bf16_t* Vb = (const bf16_t*)(F.ws + WS_V);
    bf16_t* O = (bf16_t*)(F.ws + WS_AH); const float* sink = F.in[I_SINK];
    LAS unsigned char* Ks = F.lds + K_OFF; LAS unsigned char* Vs = F.lds + V_OFF;
    const int wid = F.wave;
    constexpr float LOG2E = 1.4426950408889634f;
    for (int unit = blockIdx.x; unit < NB * 2 * 64; unit += F.G) {
        const int qb = unit & 63, kvh = (unit >> 6) & 1, b = unit >> 7;
        int tid = F.tid; asm volatile("" : "+v"(tid));
        const int lane = tid & 63, lr = lane & 31, lh = lane >> 5;
        __syncthreads();
        {
            u32x4 kv[6], vv[6];
#pragma unroll
            for (int i = 0; i < 6; ++i) { const int ci = tid + 512 * i, j = ci >> 3, p = ci & 7; const int kpos = qb * 128 - 128 + j;
                kv[i] = (u32x4){0u, 0u, 0u, 0u}; vv[i] = kv[i];
                if (kpos >= 0 && kpos < SEQ) { const size_t off = ((size_t)b * SEQ + kpos) * KVW + kvh * 64 + p * 8; kv[i] = *(const u32x4*)(Kb + off); vv[i] = *(const u32x4*)(Vb + off); } }
#pragma unroll
            for (int i = 0; i < 6; ++i) { const int ci = tid + 512 * i, j = ci >> 3, p = ci & 7;
                *(LAS u32x4*)(Ks + j * KROWB + p * 16) = kv[i];
                LAS unsigned char* vp = Vs + (p * 8) * VROWB + kst(j) * 2;
                *(LAS bf16_t*)(vp) = (bf16_t)vv[i].x; *(LAS bf16_t*)(vp + VROWB) = (bf16_t)(vv[i].x >> 16);
                *(LAS bf16_t*)(vp + 2 * VROWB) = (bf16_t)vv[i].y; *(LAS bf16_t*)(vp + 3 * VROWB) = (bf16_t)(vv[i].y >> 16);
                *(LAS bf16_t*)(vp + 4 * VROWB) = (bf16_t)vv[i].z; *(LAS bf16_t*)(vp + 5 * VROWB) = (bf16_t)(vv[i].z >> 16);
                *(LAS bf16_t*)(vp + 6 * VROWB) = (bf16_t)vv[i].w; *(LAS bf16_t*)(vp + 7 * VROWB) = (bf16_t)(vv[i].w >> 16); }
        }
        __syncthreads();
        const int g = wid >> 1, h = kvh * 4 + g, uh = wid & 1;
        const float slope2 = exp2f(-(float)(h + 1)) * LOG2E, c1 = 0.125f * LOG2E, m0 = sink[h] * LOG2E;
        const float d0 = (float)(4 * lh - lr);
#pragma unroll 1
        for (int ut = 0; ut < 2; ++ut) {
            const int u = 2 * uh + ut; const size_t trow = (size_t)b * SEQ + qb * 128 + 32 * u + lr;
            bf16x8 qf[4];
#pragma unroll
            for (int s4 = 0; s4 < 4; ++s4) qf[s4] = *(const bf16x8*)(Q + trow * AW + h * 64 + 16 * s4 + 8 * lh);
            f32x16 Ot[2];
#pragma unroll
            for (int r = 0; r < 16; ++r) { Ot[0][r] = 0.f; Ot[1][r] = 0.f; }
            float m = m0, l = lh == 0 ? 1.0f : 0.0f;
            int kt0 = u, kt1 = u + 8; if (qb == 0 && kt0 < 4) kt0 = 4; if (qb == 63 && kt1 > 7) kt1 = 7;
#pragma unroll 1
            for (int kt = kt0; kt <= kt1; ++kt) {
                f32x16 St;
#pragma unroll
                for (int r = 0; r < 16; ++r) St[r] = 0.f;
                LAS const unsigned char* kp = Ks + (32 * kt + lr) * KROWB + lh * 16;
#pragma unroll
                for (int s4 = 0; s4 < 4; ++s4) St = __builtin_amdgcn_mfma_f32_32x32x16_bf16(*(LAS const bf16x8*)(kp + 32 * s4), qf[s4], St, 0, 0, 0);
                const float base = (float)(32 * (kt - u) - 128) + d0; const bool edge = (kt == u) || (kt == u + 8);
                float tmax = -INFINITY;
#pragma unroll
                for (int r = 0; r < 16; ++r) { const float rel = fabsf(base + (float)((r & 3) + 8 * (r >> 2)));
                    float sv = St[r] * c1 - slope2 * rel; if (edge && rel > 128.0f) sv = -INFINITY; St[r] = sv; tmax = fmaxf(tmax, sv); }
                tmax = fmaxf(tmax, __shfl_xor(tmax, 32));
                const float mn = fmaxf(m, tmax), scl = __builtin_amdgcn_exp2f(m - mn); m = mn; l *= scl;
#pragma unroll
                for (int r = 0; r < 16; ++r) { Ot[0][r] *= scl; Ot[1][r] *= scl; }
#pragma unroll
                for (int r = 0; r < 16; ++r) { const float p = __builtin_amdgcn_exp2f(St[r] - mn); l += p; St[r] = p; }
                const bf16x8 pf0 = pack_step<0>(St), pf1 = pack_step<1>(St);
                LAS const unsigned char* vp = Vs + lr * VROWB + (32 * kt + 8 * lh) * 2;
#pragma unroll
                for (int dt = 0; dt < 2; ++dt) {
                    Ot[dt] = __builtin_amdgcn_mfma_f32_32x32x16_bf16(*(LAS const bf16x8*)(vp + dt * 32 * VROWB), pf0, Ot[dt], 0, 0, 0);
                    Ot[dt] = __builtin_amdgcn_mfma_f32_32x32x16_bf16(*(LAS const bf16x8*)(vp + dt * 32 * VROWB + 32), pf1, Ot[dt], 0, 0, 0);
                }
            }
            l += __shfl_xor(l, 32);
            const float il = 1.0f / l;
            bf16_t* op = O + trow * DM + h * 64 + 4 * lh;
#pragma unroll
            for (int dt = 0; dt < 2; ++dt)
#pragma unroll
                for (int gq = 0; gq < 4; ++gq)
                    *(u32x2*)(op + 32 * dt + 8 * gq) = (u32x2){cvtpk(Ot[dt][4 * gq] * il, Ot[dt][4 * gq + 1] * il), cvtpk(Ot[dt][4 * gq + 2] * il, Ot[dt][4 * gq + 3] * il)};
        }
    }
    __syncthreads();
}

__device__ __forceinline__ float block_sum(Frame& F, float v, LAS float* red) {
    v = wave_sum(v);
    __syncthreads();
    if (F.lane == 0) red[F.wave] = v;
    __syncthreads();
    float s = 0.f;
#pragma unroll
    for (int i = 0; i < NWAVES; ++i) s += red[i];
    return s;
}

typedef short v4i16_t __attribute__((ext_vector_type(4)));
__device__ __forceinline__ u32x2 lds_tr4(LAS const unsigned char* p) { return __builtin_bit_cast(u32x2, __builtin_amdgcn_ds_read_tr16_b64_v4i16((LAS v4i16_t*)p)); }
namespace hy {
typedef float f32x16 __attribute__((ext_vector_type(16)));
typedef __bf16 bf16x2_t __attribute__((ext_vector_type(2)));
constexpr int ROWB = 272, TABB = 128 * ROWB, DROWB = 528, FT_OFF = 0, X_OFF = 2 * TABB, SP_OFF = 4 * TABB;
#define HY_SBAR() do { asm volatile("" ::: "memory"); __builtin_amdgcn_sched_barrier(0); } while (0)
#define MFMA32(a, b, c) __builtin_amdgcn_mfma_f32_32x32x16_bf16((a), (b), (c), 0, 0, 0)
__device__ __forceinline__ int crow(int r, int h) { return (r & 3) + 8 * (r >> 2) + 4 * h; }
__device__ __forceinline__ int q16(int c) { return 8 * ((c >> 2) & 1) + 4 * (c >> 3) + (c & 3); }
__device__ __forceinline__ int kstore(int k) { return (k & ~15) + q16(k & 15); }
__device__ __forceinline__ unsigned cvtpk(float lo, float hi) { f32x2 v = {lo, hi}; bf16x2_t b = __builtin_convertvector(v, bf16x2_t); return __builtin_bit_cast(unsigned, b); }
__device__ __forceinline__ bf16x8 neg8(bf16x8 v) { u32x4 u = __builtin_bit_cast(u32x4, v); u.x ^= 0x80008000u; u.y ^= 0x80008000u; u.z ^= 0x80008000u; u.w ^= 0x80008000u; return __builtin_bit_cast(bf16x8, u); }
template <int S> __device__ __forceinline__ bf16x8 pack_step(const f32x16& x) {
    u32x4 p; p.x = cvtpk(x[8 * S], x[8 * S + 1]); p.y = cvtpk(x[8 * S + 2], x[8 * S + 3]); p.z = cvtpk(x[8 * S + 4], x[8 * S + 5]); p.w = cvtpk(x[8 * S + 6], x[8 * S + 7]);
    return __builtin_bit_cast(bf16x8, p);
}
__device__ __forceinline__ bf16x8 ffrag(LAS const unsigned char* ft, int t, int rb, int s, int lr, int lh) {
    return *(LAS const bf16x8*)(ft + (lr * ROWB + lh * 16) + (t * TABB + rb * 32 * ROWB + 32 * s)); }
__device__ __forceinline__ bf16x8 xfrag(LAS const unsigned char* img, int rb, int cs, int lr, int lh) {
    return *(LAS const bf16x8*)(img + (lr * ROWB + lh * 16) + (rb * 32 * ROWB + 16 * cs)); }
__device__ __forceinline__ bf16x8 dfrag(LAS const unsigned char* img, int rb, int cs, int lr, int lh) {
    return *(LAS const bf16x8*)(img + (lr * DROWB + lh * 16) + (rb * 32 * DROWB + 16 * cs)); }
__device__ __forceinline__ void zero16(f32x16& x) {
#pragma unroll
    for (int r = 0; r < 16; ++r) x[r] = 0.f; }
struct ctile { u32x4 q[4]; };
__device__ __forceinline__ ctile load_ctile(const unsigned* w  ) { ctile t;
#pragma unroll
    for (int i = 0; i < 4; ++i) t.q[i] = *(const u32x4*)(w + 4 * i);
    return t; }
template <bool CONJ> __device__ __forceinline__ void cmul_tile(f32x16& xr, f32x16& xi, const ctile& t) {
#pragma unroll
    for (int i = 0; i < 4; ++i) { const unsigned w[4] = {t.q[i].x, t.q[i].y, t.q[i].z, t.q[i].w};
#pragma unroll
        for (int u = 0; u < 4; ++u) { const int r = 4 * i + u; const float wr = bflo(w[u]), wi = CONJ ? -bfhi(w[u]) : bfhi(w[u]);
            const float a = xr[r], b = xi[r]; xr[r] = a * wr - b * wi; xi[r] = a * wi + b * wr; } }
}
template <bool CPLX, int NK>
__device__ __forceinline__ void s1_tw(LAS const unsigned char* ft, LAS const unsigned char* img, const unsigned* twt, int J, int lane, bf16x8 (&bAr)[8], bf16x8 (&bAi)[8]) {
    const int lr = lane & 31, lh = lane >> 5;
#pragma unroll
    for (int hf = 0; hf < 2; ++hf) {
        const ctile tw0 = load_ctile(twt + ((size_t)(((2 * hf) * 4 + J) * 64 + lane)) * 16), tw1 = load_ctile(twt + ((size_t)(((2 * hf + 1) * 4 + J) * 64 + lane)) * 16);
        f32x16 Ar[2], Ai[2];
#pragma unroll
        for (int i = 0; i < 2; ++i) { zero16(Ar[i]); zero16(Ai[i]); }
#pragma unroll
        for (int s = 0; s < NK; ++s) {
            const bf16x8 bFr = ffrag(ft, 0, J, s, lr, lh), bFi = ffrag(ft, 1, J, s, lr, lh), bnFi = neg8(bFi);
#pragma unroll
            for (int i = 0; i < 2; ++i) {
                const bf16x8 aXr = xfrag(img, 2 * hf + i, 2 * s, lr, lh);
                Ar[i] = MFMA32(aXr, bFr, Ar[i]); Ai[i] = MFMA32(aXr, bFi, Ai[i]);
                if (CPLX) { const bf16x8 aXi = xfrag(img, 2 * hf + i, 8 + 2 * s, lr, lh); Ar[i] = MFMA32(aXi, bnFi, Ar[i]); Ai[i] = MFMA32(aXi, bFr, Ai[i]); }
            }
            HY_SBAR();
        }
#pragma unroll
        for (int i = 0; i < 2; ++i) { const int ig = 2 * hf + i;
            cmul_tile<false>(Ar[i], Ai[i], i == 0 ? tw0 : tw1);
            bAr[2 * ig] = pack_step<0>(Ar[i]); bAr[2 * ig + 1] = pack_step<1>(Ar[i]); bAi[2 * ig] = pack_step<0>(Ai[i]); bAi[2 * ig + 1] = pack_step<1>(Ai[i]);
            HY_SBAR();
        }
    }
}
__device__ __forceinline__ void s3_half(LAS const unsigned char* ft, const bf16x8 (&bAr)[8], const bf16x8 (&bAi)[8], int Ih, int lane, f32x16 (&Zr)[2], f32x16 (&Zi)[2]) {
    const int lr = lane & 31, lh = lane >> 5;
#pragma unroll
    for (int I = 0; I < 2; ++I) { zero16(Zr[I]); zero16(Zi[I]); }
#pragma unroll
    for (int s = 0; s < 8; ++s) {
        const bf16x8 bnAi = neg8(bAi[s]);
#pragma unroll
        for (int I = 0; I < 2; ++I) {
            const bf16x8 aFr = ffrag(ft, 0, 2 * Ih + I, s, lr, lh), aFi = ffrag(ft, 1, 2 * Ih + I, s, lr, lh);
            Zr[I] = MFMA32(aFr, bAr[s], Zr[I]); Zr[I] = MFMA32(aFi, bnAi, Zr[I]);
            Zi[I] = MFMA32(aFi, bAr[s], Zi[I]); Zi[I] = MFMA32(aFr, bAi[s], Zi[I]);
        }
        HY_SBAR();
    }
}
__device__ __forceinline__ void fwd_filter(LAS const unsigned char* ft, LAS const unsigned char* img, const unsigned* twt, int J, int lane, float scl, float sk, unsigned* kh  ) {
    bf16x8 bAr[8], bAi[8];
    s1_tw<false, 8>(ft, img, twt, J, lane, bAr, bAi);
#pragma unroll
    for (int Ih = 0; Ih < 2; ++Ih) {
        f32x16 Zr[2], Zi[2];
        s3_half(ft, bAr, bAi, Ih, lane, Zr, Zi);
#pragma unroll
        for (int I = 0; I < 2; ++I) { unsigned* dst = kh + ((size_t)((2 * Ih + I) * 64 + lane)) * 16;
#pragma unroll
            for (int r4 = 0; r4 < 4; ++r4) *(u32x4*)(dst + 4 * r4) = (u32x4){cvtpk(Zr[I][4 * r4] * scl + sk, Zi[I][4 * r4] * scl), cvtpk(Zr[I][4 * r4 + 1] * scl + sk, Zi[I][4 * r4 + 1] * scl),
                                                                              cvtpk(Zr[I][4 * r4 + 2] * scl + sk, Zi[I][4 * r4 + 2] * scl), cvtpk(Zr[I][4 * r4 + 3] * scl + sk, Zi[I][4 * r4 + 3] * scl)}; }
        HY_SBAR();
    }
}
__device__ __forceinline__ void s3_filt_i1(LAS const unsigned char* ft, const unsigned* khat  , const unsigned* twt, int J, int lane, const bf16x8 (&bAr)[8], const bf16x8 (&bAi)[8], u32x2 (&dpk)[4][2][4]) {
    const int lr = lane & 31, lh = lane >> 5;
    bf16x8 aYr[8], aYi[8];
#pragma unroll
    for (int Ih = 0; Ih < 2; ++Ih) {
        const ctile k0 = load_ctile(khat + ((size_t)((2 * Ih) * 64 + lane)) * 16);
        f32x16 Zr[2], Zi[2];
        s3_half(ft, bAr, bAi, Ih, lane, Zr, Zi);
        const ctile k1 = load_ctile(khat + ((size_t)((2 * Ih + 1) * 64 + lane)) * 16);
#pragma unroll
        for (int I = 0; I < 2; ++I) { const int Ig = 2 * Ih + I;
            cmul_tile<false>(Zr[I], Zi[I], I == 0 ? k0 : k1);
            aYr[2 * Ig] = pack_step<0>(Zr[I]); aYr[2 * Ig + 1] = pack_step<1>(Zr[I]); aYi[2 * Ig] = pack_step<0>(Zi[I]); aYi[2 * Ig + 1] = pack_step<1>(Zi[I]);
            HY_SBAR();
        }
    }
#pragma unroll
    for (int ch = 0; ch < 2; ++ch) {
        const ctile tw0 = load_ctile(twt + ((size_t)((J * 4 + 2 * ch) * 64 + lane)) * 16);
        f32x16 Cr[2], Ci[2];
#pragma unroll
        for (int c = 0; c < 2; ++c) { zero16(Cr[c]); zero16(Ci[c]); }
#pragma unroll
        for (int s = 0; s < 8; ++s) {
            const bf16x8 anYr = neg8(aYr[s]);
#pragma unroll
            for (int c = 0; c < 2; ++c) {
                const bf16x8 bFr = ffrag(ft, 0, 2 * ch + c, s, lr, lh), bFi = ffrag(ft, 1, 2 * ch + c, s, lr, lh);
                Cr[c] = MFMA32(aYr[s], bFr, Cr[c]); Cr[c] = MFMA32(aYi[s], bFi, Cr[c]);
                Ci[c] = MFMA32(anYr, bFi, Ci[c]); Ci[c] = MFMA32(aYi[s], bFr, Ci[c]);
            }
            HY_SBAR();
        }
        const ctile tw1 = load_ctile(twt + ((size_t)((J * 4 + 2 * ch + 1) * 64 + lane)) * 16);
#pragma unroll
        for (int c = 0; c < 2; ++c) { const int cg = 2 * ch + c;
            cmul_tile<true>(Cr[c], Ci[c], c == 0 ? tw0 : tw1);
#pragma unroll
            for (int g = 0; g < 4; ++g) {
                dpk[cg][0][g] = (u32x2){cvtpk(Cr[c][4 * g], Cr[c][4 * g + 1]), cvtpk(Cr[c][4 * g + 2], Cr[c][4 * g + 3])};
                dpk[cg][1][g] = (u32x2){cvtpk(Ci[c][4 * g], Ci[c][4 * g + 1]), cvtpk(Ci[c][4 * g + 2], Ci[c][4 * g + 3])};
            }
            HY_SBAR();
        }
    }
}
__device__ __forceinline__ void write_D(LAS unsigned char* dimg, const u32x2 (&dpk)[4][2][4], int J, int lane) {
    const int lr = lane & 31, lh = lane >> 5;
    LAS unsigned char* base = dimg + lr * DROWB + lh * 16 + J * 64;
#pragma unroll
    for (int c = 0; c < 4; ++c)
#pragma unroll
        for (int g = 0; g < 4; ++g) {
            *(LAS u32x2*)(base + c * 32 * DROWB + 32 * (g >> 1) + 8 * (g & 1)) = dpk[c][0][g];
            *(LAS u32x2*)(base + c * 32 * DROWB + 256 + 32 * (g >> 1) + 8 * (g & 1)) = dpk[c][1][g]; }
}
__device__ __forceinline__ void i3_wave(LAS const unsigned char* ft, LAS const unsigned char* dimg, int a, int c, int lane, f32x16& yr, f32x16& yi) {
    const int lr = lane & 31, lh = lane >> 5;
    zero16(yr); zero16(yi);
#pragma unroll
    for (int s = 0; s < 8; ++s) {
        const bf16x8 aFr = ffrag(ft, 0, a, s, lr, lh), aFi = ffrag(ft, 1, a, s, lr, lh), anFi = neg8(aFi);
        const bf16x8 bDr = dfrag(dimg, c, 2 * s, lr, lh), bDi = dfrag(dimg, c, 16 + 2 * s, lr, lh);
        yr = MFMA32(aFr, bDr, yr); yr = MFMA32(aFi, bDi, yr);
        yi = MFMA32(aFr, bDi, yi); yi = MFMA32(anFi, bDr, yi);
        HY_SBAR();
    }
}
__device__ __forceinline__ int img_off(int n2, int ks) { return n2 * ROWB + ks * 2; }
}

__device__ __forceinline__ void ph_hyena_fft(Frame& F) {
    using namespace hy;
    const bf16_t* UT = (const bf16_t*)(F.ws + WS_UT); bf16_t* HYT = (bf16_t*)(F.ws + WS_HYT);
    const float* hdn = (const float*)(F.ws + WS_HDN); const float* w3 = F.in[I_FW3]; const float* decay = F.in[I_DECAY];
    const float* convw = F.in[I_CONVW]; const float* convb = F.in[I_CONVB]; const float* skip = F.in[I_SKIP];
    const unsigned* twt = (const unsigned*)(F.ws + WS_TWT);
    unsigned* khat = (unsigned*)(F.ws + WS_KHAT + (size_t)blockIdx.x * 131072);
    bf16_t* gt = (bf16_t*)(F.ws + WS_GT + (size_t)blockIdx.x * 131072);
    LAS unsigned char* ft = F.lds + FT_OFF; LAS unsigned char* xr = F.lds + X_OFF;
    LAS float* w3s = (LAS float*)(F.lds + SP_OFF);
    LAS float* red = w3s + 256;
    const int wid = F.wave;
#define HY_IDS int tid = F.tid; asm volatile("" : "+v"(tid)); const int lane = tid & 63, lr = lane & 31, lh = lane >> 5; (void)lr; (void)lh; (void)lane;
    __syncthreads();
    { const u32x4* src = (const u32x4*)(F.ws + WS_FTAB);
      for (int i = F.tid; i < 2 * TABB / 16; i += NTHREADS) *(LAS u32x4*)(ft + i * 16) = src[i]; }
    for (int c = blockIdx.x; c < HW; c += F.G) {
        __syncthreads();
        for (int repA = 0; repA < ((PROBE_HY & 1u) ? 2 : 1); ++repA) {
        if (repA) __syncthreads();
        { HY_IDS
        u32x4 kw[8];
#pragma unroll
        for (int i = 0; i < 8; ++i) { const int ci = tid + 512 * i; const int od = ci >> 10, t0 = (ci & 1023) * 8;
            kw[i] = *(const u32x4*)((const bf16_t*)(F.ws + WS_KRAW) + (size_t)((od >> 1) * 1024 + (od & 1) * 512 + c) * SEQ + t0); }
#pragma unroll
        for (int i = 0; i < 8; ++i) {
            const int ci = tid + 512 * i; const int od = ci >> 10, t0 = (ci & 1023) * 8, o = od >> 1, dir = od & 1;
            const u32x4 w = kw[i];
            const unsigned short e[8] = {(unsigned short)w.x, (unsigned short)(w.x >> 16), (unsigned short)w.y, (unsigned short)(w.y >> 16), (unsigned short)w.z, (unsigned short)(w.z >> 16), (unsigned short)w.w, (unsigned short)(w.w >> 16)};
            LAS unsigned char* img = xr + o * TABB;
#pragma unroll
            for (int j = 0; j < 8; ++j) { const int t = t0 + j; int n = dir ? 2 * SEQ - t : t; unsigned short v = e[j];
                if (dir && t == 0) { n = SEQ; v = 0; }
                *(LAS bf16_t*)(img + img_off(n & 127, kstore(n >> 7))) = v; }
        }
        }
        __syncthreads();
        { HY_IDS
            const int o = wid >> 2, J = wid & 3;
            float nsum = 0.f;
            { const float* kp = (const float*)(F.ws + WS_KPART);
              for (int i = 0; i < 32; ++i) nsum += kp[(size_t)(o * 1024 + c) * 32 + i] + kp[(size_t)(o * 1024 + 512 + c) * 32 + i]; }
            const float scl = 1.0f / (nsum * (float)(2 * SEQ)), sk = skip[o * HW + c] * (1.0f / (float)(2 * SEQ));
            fwd_filter(ft, xr + o * TABB, twt, J, lane, scl, sk, khat + (size_t)((o * 4 + J) * 4) * 64 * 16);
        }
        __syncthreads();
        }
        for (int repB = 0; repB < ((PROBE_HY & 2u) ? 2 : 1); ++repB) {
#pragma unroll 1
        for (int rd = 0; rd < 2; ++rd) { HY_IDS
            {
                u32x4 uw[8]; float ul[8], uh[8];
#pragma unroll
                for (int i = 0; i < 8; ++i) { const int blk = 8 * rd + i, g = blk >> 3, b = (blk >> 1) & 3, a = blk & 1;
                    const bf16_t* row = UT + (size_t)((g + 1) * HW + c) * T + (size_t)b * SEQ; const int t0 = 4096 * a + 8 * tid;
                    uw[i] = *(const u32x4*)(row + t0); ul[i] = t0 > 0 ? bf2f(row[t0 - 1]) : 0.f; uh[i] = t0 + 8 < SEQ ? bf2f(row[t0 + 8]) : 0.f; }
#pragma unroll
                for (int i = 0; i < 8; ++i) { const int blk = 8 * rd + i, g = blk >> 3; const int chg = (g + 1) * HW + c;
                    const float w0 = convw[chg], w1 = convw[NHY + chg], w2 = convw[2 * NHY + chg], bb = convb[chg];
                    const u32x4 w = uw[i];
                    const float u[10] = {ul[i], bflo(w.x), bfhi(w.x), bflo(w.y), bfhi(w.y), bflo(w.z), bfhi(w.z), bflo(w.w), bfhi(w.w), uh[i]};
                    float v[8];
#pragma unroll
                    for (int j = 0; j < 8; ++j) v[j] = w0 * u[j] + w1 * u[j + 1] + w2 * u[j + 2] + bb;
                    *(LAS u32x4*)(xr + i * (32 * ROWB) + (tid >> 4) * ROWB + (tid & 15) * 16) = (u32x4){pk2(v[0], v[1]), pk2(v[2], v[3]), pk2(v[4], v[5]), pk2(v[6], v[7])}; }
            }
            __syncthreads();
#pragma unroll
            for (int k = 0; k < 4; ++k) {
                const int item = tid + 512 * k, i = item >> 8, c4 = (item >> 6) & 3; const int blk = 8 * rd + i;
                LAS const unsigned char* a = xr + i * (32 * ROWB) + (4 * lh + ((lane & 15) >> 2)) * ROWB + (32 * c4 + 16 * ((lane >> 4) & 1) + 4 * (lane & 3)) * 2;
                const u32x2 q0 = lds_tr4(a), q1 = lds_tr4(a + 8 * ROWB), q2 = lds_tr4(a + 16 * ROWB), q3 = lds_tr4(a + 24 * ROWB);
                bf16_t* dst = gt + ((size_t)((blk * 4 + c4) * 64 + lane)) * 16;
                *(u32x4*)dst = (u32x4){q0.x, q0.y, q1.x, q1.y}; *(u32x4*)(dst + 8) = (u32x4){q2.x, q2.y, q3.x, q3.y};
            }
            __syncthreads();
        }
        }
        for (int repC = 0; repC < ((PROBE_HY & 4u) ? 2 : 1); ++repC) {
        u32x2 z1p[2][2][4];
        const int p = wid >> 2, J = wid & 3, ta = wid >> 2, tc = wid & 3;
        for (int o = 0; o < 2; ++o) {
            { HY_IDS
            if (o == 0) {
                const float w0 = convw[c], w1 = convw[NHY + c], w2 = convw[2 * NHY + c], bb = convb[c];
                u32x4 uw[8]; float ul[8], uh[8];
#pragma unroll
                for (int i = 0; i < 8; ++i) { const int ci = tid + 512 * i; const int b = ci >> 10, t0 = (ci & 1023) * 8;
                    const bf16_t* row = UT + (size_t)c * T + (size_t)b * SEQ;
                    uw[i] = *(const u32x4*)(row + t0); ul[i] = t0 > 0 ? bf2f(row[t0 - 1]) : 0.f; uh[i] = t0 + 8 < SEQ ? bf2f(row[t0 + 8]) : 0.f; }
#pragma unroll
                for (int i = 0; i < 8; ++i) {
                    const int ci = tid + 512 * i; const int b = ci >> 10, t0 = (ci & 1023) * 8;
                    const u32x4 w = uw[i];
                    const float u[10] = {ul[i], bflo(w.x), bfhi(w.x), bflo(w.y), bfhi(w.y), bflo(w.z), bfhi(w.z), bflo(w.w), bfhi(w.w), uh[i]};
                    const int n1 = t0 >> 7, n2 = t0 & 127; const int ks = kstore(n1) + 64 * (b & 1);
                    LAS unsigned char* img = xr + (b >> 1) * TABB;
#pragma unroll
                    for (int j = 0; j < 8; ++j) *(LAS bf16_t*)(img + img_off(n2 + j, ks)) = (bf16_t)f2bf(w0 * u[j] + w1 * u[j + 1] + w2 * u[j + 2] + bb);
                }
            } else {
#pragma unroll
                for (int q = 0; q < 2; ++q) { LAS unsigned char* img = xr + q * TABB + (32 * tc + lr) * ROWB + lh * 16 + ta * 64;
#pragma unroll
                    for (int g = 0; g < 4; ++g) {
                        *(LAS u32x2*)(img + 32 * (g >> 1) + 8 * (g & 1)) = z1p[q][0][g];
                        *(LAS u32x2*)(img + 128 + 32 * (g >> 1) + 8 * (g & 1)) = z1p[q][1][g]; } }
            }
            }
            __syncthreads();
            u32x2 dpk[4][2][4];
            { HY_IDS
                bf16x8 bAr[8], bAi[8];
                s1_tw<true, 4>(ft, xr + p * TABB, twt, J, lane, bAr, bAi);
                __syncthreads();
                s3_filt_i1(ft, khat + (size_t)((o * 4 + J) * 4) * 64 * 16, twt, J, lane, bAr, bAi, dpk);
            }
#pragma unroll 1
            for (int q = 0; q < 2; ++q) { HY_IDS
                if (p == q) write_D(xr, dpk, J, lane);
                __syncthreads();
                const bf16_t* g0 = gt + ((size_t)((((o * 4 + 2 * q) * 2 + ta) * 4 + tc) * 64 + lane)) * 16;
                const bf16_t* g1 = gt + ((size_t)((((o * 4 + 2 * q + 1) * 2 + ta) * 4 + tc) * 64 + lane)) * 16;
                const u32x4 ga = *(const u32x4*)g0, gb = *(const u32x4*)(g0 + 8), gc = *(const u32x4*)g1, gd = *(const u32x4*)(g1 + 8);
                f32x16 yr, yi;
                i3_wave(ft, xr, ta, tc, lane, yr, yi);
                const unsigned gre[8] = {ga.x, ga.y, ga.z, ga.w, gb.x, gb.y, gb.z, gb.w}, gim[8] = {gc.x, gc.y, gc.z, gc.w, gd.x, gd.y, gd.z, gd.w};
#pragma unroll
                for (int r2 = 0; r2 < 8; ++r2) { yr[2 * r2] *= bflo(gre[r2]); yr[2 * r2 + 1] *= bfhi(gre[r2]); yi[2 * r2] *= bflo(gim[r2]); yi[2 * r2 + 1] *= bfhi(gim[r2]); }
                {
#pragma unroll
                    for (int g = 0; g < 4; ++g) { z1p[q][0][g] = (u32x2){cvtpk(yr[4 * g], yr[4 * g + 1]), cvtpk(yr[4 * g + 2], yr[4 * g + 3])};
                                                  z1p[q][1][g] = (u32x2){cvtpk(yi[4 * g], yi[4 * g + 1]), cvtpk(yi[4 * g + 2], yi[4 * g + 3])}; }
                }
                if (o == 1) {
                    bf16_t* o0 = HYT + (size_t)c * T + (size_t)(2 * q) * SEQ + 32 * tc + lr; bf16_t* o1 = o0 + SEQ;
#pragma unroll
                    for (int r = 0; r < 16; ++r) { const int n1 = 32 * ta + crow(r, lh); o0[128 * n1] = (bf16_t)f2bf(yr[r]); o1[128 * n1] = (bf16_t)f2bf(yi[r]); }
                }
                __syncthreads();
            }
        }
        }
    }
    __syncthreads();
#undef HY_IDS
}

__device__ __forceinline__ void ph_hyT(Frame& F) {
    const bf16_t* HYT = (const bf16_t*)(F.ws + WS_HYT); bf16_t* HY = (bf16_t*)(F.ws + WS_AH) + AW;
    constexpr int TROW = 144;
    LAS unsigned char* tl = F.lds + F.wave * (64 * TROW);
    const int gw = F.vcu * NWAVES + F.wave, NGW = F.G * NWAVES;
    int lane = F.lane; asm volatile("" : "+v"(lane));
    for (int it = gw; it < 8 * (T / 64); it += NGW) {
        const int cb = it & 7, tb = it >> 3; const int c0 = cb * 64, t0 = tb * 64;
        u32x4 v[8];
#pragma unroll
        for (int j = 0; j < 8; ++j) v[j] = *(const u32x4*)(HYT + (size_t)(c0 + 8 * j + (lane >> 3)) * T + t0 + 8 * (lane & 7));
#pragma unroll
        for (int j = 0; j < 8; ++j) *(LAS u32x4*)(tl + (8 * j + (lane >> 3)) * TROW + (lane & 7) * 16) = v[j];
        const int q = (lane & 15) >> 2, p = lane & 3, g = lane >> 4;
#pragma unroll
        for (int ps = 0; ps < 4; ++ps)
#pragma unroll
            for (int hf = 0; hf < 2; ++hf) {
                LAS const unsigned char* a = tl + (32 * hf + 8 * g + q) * TROW + (16 * ps + 4 * p) * 2;
                const u32x2 lo = lds_tr4(a), hi = lds_tr4(a + 4 * TROW);
                *(u32x4*)(HY + (size_t)(t0 + 16 * ps + (lane & 15)) * DM + c0 + 32 * hf + 8 * g) = (u32x4){lo.x, lo.y, hi.x, hi.y};
            }
    }
}

__device__ __forceinline__ void ph_expert_cvt(Frame& F) {
    LAS float* scr = (LAS float*)(F.lds + F.wave * 16384);
    const int gw = F.vcu * NWAVES + F.wave, NGW = F.G * NWAVES;
    bf16_t* W13 = (bf16_t*)(F.ws + WS_W13); bf16_t* W2 = (bf16_t*)(F.ws + WS_W2);
    for (int it = gw; it < NE * 768; it += NGW) {
        const int e = it / 768; int r = it % 768;
        if (r < 512) { const bool is3 = r >= 256; r &= 255; const int kb = r / 16, nb = r % 16, n0 = nb * 32;
            const int drow = (n0 >> 7) * 256 + (is3 ? 128 : 0) + (n0 & 127);
            transpose_item(F.in[is3 ? I_EW3 : I_EW1] + (size_t)e * DM * DE, DM, DE, W13 + (size_t)e * DM * DM, DM, drow, scr, kb, nb, F.lane); }
        else { r -= 512; const int kb = r / 32, nb = r % 32;
            transpose_item(F.in[I_EW2] + (size_t)e * DE * DM, DE, DM, W2 + (size_t)e * DM * DE, DE, nb * 32, scr, kb, nb, F.lane); }
    }
}

__device__ __forceinline__ void ph_ln1_route(Frame& F) {
    int tid = threadIdx.x; asm volatile("" : "+v"(tid));
    const float* xin = F.in[I_X]; bf16_t* y1 = (bf16_t*)(F.ws + WS_Y1); bf16_t* h2b = (bf16_t*)(F.ws + WS_HB); bf16_t* h2l = (bf16_t*)(F.ws + WS_H2LO);
    const float* mod = (const float*)(F.ws + WS_MOD); const float* g1 = F.in[I_LN1G]; const float* b1 = F.in[I_LN1B];
    const bf16_t* wr = (const bf16_t*)(F.ws + WS_WRT); const float* bg = F.in[I_RGB]; const float* be = F.in[I_REB];
    unsigned* cnt = F.ctl + CW_CNT; int* btok = (int*)(F.ws + WS_BTOK); float* bw = (float*)(F.ws + WS_BW);
    constexpr int WROW = 272, WCH = 80 * WROW;
    LAS unsigned char* wl = F.lds;
    LAS float* lg = (LAS float*)(F.lds + 65536);
    for (int ch = blockIdx.x; ch < T / 128; ch += F.G) {
        const int b = (ch * 128) / SEQ;
        f32x4 pgg[4], pbb[4], psh[4], psc[4];
#pragma unroll
        for (int j = 0; j < 4; ++j) { const int k = 4 * F.lane + 256 * j;
            pgg[j] = *(const f32x4*)(g1 + k); pbb[j] = *(const f32x4*)(b1 + k);
            psh[j] = *(const f32x4*)(mod + (size_t)b * 6144 + 3072 + k); psc[j] = *(const f32x4*)(mod + (size_t)b * 6144 + 4096 + k) + 1.0f; }
        for (int rr0 = F.wave * 4; rr0 < 128; rr0 += NWAVES * 4) {
            f32x4 xin4[4][4]; unsigned long long yin4[4][4];
#pragma unroll
            for (int r = 0; r < 4; ++r) { const size_t row = (size_t)ch * 128 + rr0 + r;
                const f32x4* xi = (const f32x4*)(xin + row * DM) + F.lane; const unsigned long long* yi = (const unsigned long long*)(y1 + row * DM) + F.lane;
#pragma unroll
                for (int j = 0; j < 4; ++j) { xin4[r][j] = xi[64 * j]; yin4[r][j] = yi[64 * j]; } }
#pragma unroll
            for (int r = 0; r < 4; ++r) {
            const size_t row = (size_t)ch * 128 + rr0 + r;
            unsigned long long* x1o = (unsigned long long*)(y1 + row * DM) + F.lane;
            f32x4 x[4]; float s = 0.f;
#pragma unroll
            for (int j = 0; j < 4; ++j) { const unsigned long long yw = yin4[r][j]; const f32x4 yv = {bflo((unsigned)yw), bfhi((unsigned)yw), bflo((unsigned)(yw >> 32)), bfhi((unsigned)(yw >> 32))};
                x[j] = xin4[r][j] * DN_ALPHA + yv; s += (x[j][0] + x[j][1]) + (x[j][2] + x[j][3]); }
            const float mean = wave_sum(s) * (1.f / DM); float s2 = 0.f;
#pragma unroll
            for (int j = 0; j < 4; ++j) { x[j] = x[j] - mean; s2 += (x[j][0] * x[j][0] + x[j][1] * x[j][1]) + (x[j][2] * x[j][2] + x[j][3] * x[j][3]); }
            const float rstd = 1.f / sqrtf(wave_sum(s2) * (1.f / DM) + LN_EPS);
            unsigned long long* o8 = (unsigned long long*)(h2b + row * DM) + F.lane; unsigned long long* l8 = (unsigned long long*)(h2l + row * DM) + F.lane;
#pragma unroll
            for (int j = 0; j < 4; ++j) {
                x[j] = x[j] * rstd * pgg[j] + pbb[j]; x1o[64 * j] = (unsigned long long)pk2(x[j][0], x[j][1]) | ((unsigned long long)pk2(x[j][2], x[j][3]) << 32);
                const f32x4 h = x[j] * psc[j] + psh[j];
                const unsigned h01 = pk2(h[0], h[1]), h23 = pk2(h[2], h[3]);
                o8[64 * j] = (unsigned long long)h01 | ((unsigned long long)h23 << 32);
                l8[64 * j] = (unsigned long long)pk2(h[0] - bflo(h01), h[1] - bfhi(h01)) | ((unsigned long long)pk2(h[2] - bflo(h23), h[3] - bfhi(h23)) << 32); }
            }
        }
        FSTAMP(36);
        __syncthreads();
        {
            const int lane = F.lane, l15 = lane & 15, l4 = lane >> 4;
            f32x4 acc[5];
#pragma unroll
            for (int n = 0; n < 5; ++n) acc[n] = (f32x4){0.f, 0.f, 0.f, 0.f};
            const size_t arow = ((size_t)ch * 128 + 16 * F.wave + l15) * DM + 8 * l4;
            u32x4 wv[3][5]; bf16x8 ah[3][4], al[3][4];
#define RT_LOAD(set, kc_) do { _Pragma("unroll") for (int ii = 0; ii < 5; ++ii) { const int i = tid + 512 * ii, part = i / 1280, r = (i % 1280) >> 4, pc = i & 15; \
        wv[set][ii] = *(const u32x4*)(wr + (size_t)part * 80 * DM + (size_t)r * DM + (kc_) * 128 + pc * 8); } \
    _Pragma("unroll") for (int s4 = 0; s4 < 4; ++s4) { ah[set][s4] = *(const bf16x8*)(h2b + arow + (kc_) * 128 + 32 * s4); al[set][s4] = *(const bf16x8*)(h2l + arow + (kc_) * 128 + 32 * s4); } } while (0)
            RT_LOAD(0, 0); RT_LOAD(1, 1);
#pragma unroll
            for (int kc = 0; kc < 8; ++kc) {
                const int cs = kc % 3;
#pragma unroll
                for (int ii = 0; ii < 5; ++ii) { const int i = tid + 512 * ii, part = i / 1280, r = (i % 1280) >> 4, pc = i & 15; *(LAS u32x4*)(wl + part * WCH + r * WROW + pc * 16) = wv[cs][ii]; }
                asm volatile("s_waitcnt lgkmcnt(0)" ::: "memory"); __builtin_amdgcn_s_barrier(); asm volatile("" ::: "memory");
                if (kc + 2 < 8) RT_LOAD((kc + 2) % 3, kc + 2);
#pragma unroll
                for (int s4 = 0; s4 < 4; ++s4) {
#pragma unroll
                    for (int n = 0; n < 5; ++n) {
                        const bf16x8 bh = *(LAS const bf16x8*)(wl + (16 * n + l15) * WROW + (32 * s4 + 8 * l4) * 2), bl = *(LAS const bf16x8*)(wl + WCH + (16 * n + l15) * WROW + (32 * s4 + 8 * l4) * 2);
                        acc[n] = __builtin_amdgcn_mfma_f32_16x16x32_bf16(ah[cs][s4], bh, acc[n], 0, 0, 0);
                        acc[n] = __builtin_amdgcn_mfma_f32_16x16x32_bf16(al[cs][s4], bh, acc[n], 0, 0, 0);
                        acc[n] = __builtin_amdgcn_mfma_f32_16x16x32_bf16(ah[cs][s4], bl, acc[n], 0, 0, 0);
                    }
                }
                asm volatile("s_waitcnt lgkmcnt(0)" ::: "memory"); __builtin_amdgcn_s_barrier(); asm volatile("" ::: "memory");
            }
#undef RT_LOAD
#pragma unroll
            for (int n = 0; n < 5; ++n)
#pragma unroll
                for (int r = 0; r < 4; ++r) lg[(16 * F.wave + 4 * l4 + r) * 81 + 16 * n + l15] = acc[n][r];
        }
        __syncthreads();
        FSTAMP(37);
        LAS int* hist = (LAS int*)(F.lds + 110592); LAS int* hbase = hist + 64; LAS int* aexp = hist + 128; LAS int* arank = aexp + 256; LAS float* aw = (LAS float*)(arank + 256);
        if (tid < 64) hist[tid] = 0;
        __syncthreads();
        if (tid < 128) {
            LAS const float* lr_ = lg + tid * 81;
            float gl[8]; float gmax; int g = 0;
#pragma unroll
            for (int i = 0; i < 8; ++i) gl[i] = lr_[i] + bg[i];
            gmax = gl[0];
#pragma unroll
            for (int i = 1; i < 8; ++i) if (gl[i] > gmax) { gmax = gl[i]; g = i; }
            float den = 0.f;
#pragma unroll
            for (int i = 0; i < 8; ++i) den += __expf(gl[i] - gmax);
            const float pg = 1.0f / den;
            float el[8];
#pragma unroll
            for (int j = 0; j < 8; ++j) el[j] = lr_[8 + g * 8 + j] + be[g * 8 + j];
            int i1 = 0; float e1 = el[0];
#pragma unroll
            for (int j = 1; j < 8; ++j) if (el[j] > e1) { e1 = el[j]; i1 = j; }
            int i2 = -1; float e2 = -INFINITY;
#pragma unroll
            for (int j = 0; j < 8; ++j) if (j != i1 && (i2 < 0 || el[j] > e2)) { e2 = el[j]; i2 = j; }
            const float r = __expf(e2 - e1); const float wa = pg / (1.0f + r), wb = pg * r / (1.0f + r);
            const int ea = g * 8 + i1, eb = g * 8 + i2;
            aexp[2 * tid] = ea; aw[2 * tid] = wa; arank[2 * tid] = __hip_atomic_fetch_add(&hist[ea], 1, __ATOMIC_RELAXED, __HIP_MEMORY_SCOPE_WORKGROUP);
            aexp[2 * tid + 1] = eb; aw[2 * tid + 1] = wb; arank[2 * tid + 1] = __hip_atomic_fetch_add(&hist[eb], 1, __ATOMIC_RELAXED, __HIP_MEMORY_SCOPE_WORKGROUP);
        }
        __syncthreads();
        if (tid < 64) { const int n = hist[tid]; hbase[tid] = n > 0 ? (int)atomicAdd(&cnt[32 * tid], (unsigned)n) : 0; }
        __syncthreads();
        if (tid < 256) { const int e = aexp[tid]; const size_t pos = (size_t)e * ECAP + hbase[e] + arank[tid];
            btok[pos] = (ch * 128 + (tid >> 1)) * 2 + (tid & 1); bw[pos] = aw[tid]; }
        __syncthreads();
    }
}

constexpr int MOE_UL_OFF = TAB_OFF + 576, MOE_RT_OFF = 149504, MOE_WT_OFF = MOE_RT_OFF + pg8::MOE_MAXU * 1024;
static_assert(MOE_WT_OFF + pg8::MOE_MAXU * 1024 <= LDSCTL_OFF && MOE_UL_OFF + pg8::MOE_MAXU * 16 <= LDS_BYTES, "MoE LDS tables");
template <bool DOWN> __device__ __forceinline__ void build_moe_tab(Frame& F, LAS int* tab) {
    LAS int* ulist = (LAS int*)(F.lds + MOE_UL_OFF); LAS int* rowtab = (LAS int*)(F.lds + MOE_RT_OFF); LAS float* wtab = (LAS float*)(F.lds + MOE_WT_OFF);
    const int* btok = (const int*)(F.ws + WS_BTOK); const float* bw = (const float*)(F.ws + WS_BW);
    int tid = threadIdx.x; asm volatile("" : "+v"(tid));
    __syncthreads();
    if (tid < 64) tab[72 + tid] = (int)__hip_atomic_load(F.ctl + CW_CNT + 32 * tid, __ATOMIC_RELAXED, __HIP_MEMORY_SCOPE_AGENT);
    __syncthreads();
    if (tid == 0) { int s = 0; for (int e = 0; e < 64; ++e) { tab[e] = s; s += (tab[72 + e] + 255) >> 8; } tab[64] = s; }
    __syncthreads();
    if (tid < pg8::MOE_MAXU) {
        const int L = tid * F.G + F.vcu, tile = L >> 2; const bool valid = tile < tab[64];
        int e = 0;
        for (int j = 1; j < 64; ++j) e += (tab[j] <= tile) ? 1 : 0;
        ulist[4 * tid] = e; ulist[4 * tid + 1] = tile - tab[e]; ulist[4 * tid + 2] = tile; ulist[4 * tid + 3] = valid ? (L & 3) + 1 : 0;
    }
    __syncthreads();
    for (int i = tid; i < pg8::MOE_MAXU * 256; i += NTHREADS) {
        const int ui = i >> 8, r = i & 255;
        if (ulist[4 * ui + 3] != 0) {
            const int e = ulist[4 * ui], idx = ulist[4 * ui + 1] * 256 + r; const bool in = idx < tab[72 + e];
            const int bt = in ? btok[(size_t)e * ECAP + idx] : -1;
            if (DOWN) { rowtab[i] = bt; wtab[i] = in ? bw[(size_t)e * ECAP + idx] : 0.f; }
            else rowtab[i] = in ? (bt >> 1) : 0;
        }
    }
    __syncthreads();
}

__device__ __forceinline__ void ph_final(Frame& F) {
    float* out = F.out; const bf16_t* y2 = (const bf16_t*)(F.ws + WS_Y2); const bf16_t* x1b = (const bf16_t*)(F.ws + WS_Y1);
    const float* mod = (const float*)(F.ws + WS_MOD); const float* g2 = F.in[I_LN2G]; const float* b2 = F.in[I_LN2B];
    const int gw = F.vcu * NWAVES + F.wave, NGW = F.G * NWAVES;
    constexpr int RB = 4;
    f32x4 pg2[4], pb2[4];
#pragma unroll
    for (int j = 0; j < 4; ++j) { pg2[j] = *(const f32x4*)(g2 + 4 * F.lane + 256 * j); pb2[j] = *(const f32x4*)(b2 + 4 * F.lane + 256 * j); }
    for (int row0 = gw * RB; row0 < T; row0 += NGW * RB) {
        const int b = row0 / SEQ;
        unsigned long long xa[RB][4], ya[RB][4], yb[RB][4];
#pragma unroll
        for (int r = 0; r < RB; ++r) { const size_t row = (size_t)row0 + r;
            const unsigned long long* xb = (const unsigned long long*)(x1b + row * DM) + F.lane;
            const unsigned long long* pa = (const unsigned long long*)(y2 + (2 * row) * DM) + F.lane; const unsigned long long* pb = (const unsigned long long*)(y2 + (2 * row + 1) * DM) + F.lane;
#pragma unroll
            for (int j = 0; j < 4; ++j) { xa[r][j] = xb[64 * j]; ya[r][j] = pa[64 * j]; yb[r][j] = pb[64 * j]; } }
#pragma unroll
        for (int r = 0; r < RB; ++r) {
            f32x4* xr = (f32x4*)(out + ((size_t)row0 + r) * DM) + F.lane;
            f32x4 x[4]; float s = 0.f;
#pragma unroll
            for (int j = 0; j < 4; ++j) { const int k = 4 * F.lane + 256 * j;
                const f32x4 gt = *(const f32x4*)(mod + (size_t)b * 6144 + 5120 + k);
                const unsigned long long a = ya[r][j], c = yb[r][j], xw = xa[r][j];
                f32x4 y; y[0] = bflo((unsigned)a) + bflo((unsigned)c); y[1] = bfhi((unsigned)a) + bfhi((unsigned)c);
                y[2] = bflo((unsigned)(a >> 32)) + bflo((unsigned)(c >> 32)); y[3] = bfhi((unsigned)(a >> 32)) + bfhi((unsigned)(c >> 32));
                const f32x4 x1 = {bflo((unsigned)xw), bfhi((unsigned)xw), bflo((unsigned)(xw >> 32)), bfhi((unsigned)(xw >> 32))};
                x[j] = x1 * DN_ALPHA + gt * y; s += (x[j][0] + x[j][1]) + (x[j][2] + x[j][3]); }
            const float mean = wave_sum(s) * (1.f / DM); float s2 = 0.f;
#pragma unroll
            for (int j = 0; j < 4; ++j) { x[j] = x[j] - mean; s2 += (x[j][0] * x[j][0] + x[j][1] * x[j][1]) + (x[j][2] * x[j][2] + x[j][3] * x[j][3]); }
            const float rstd = 1.f / sqrtf(wave_sum(s2) * (1.f / DM) + LN_EPS);
#pragma unroll
            for (int j = 0; j < 4; ++j) xr[64 * j] = x[j] * rstd * pg2[j] + pb2[j];
        }
    }
}

constexpr int N_PHASES = 12;
__device__ __forceinline__ Frame make_frame(const Args& args, unsigned char* lds) {
    Frame F;
    F.lds = (LAS unsigned char*)lds; F.ws = args.ws; F.ctl = (unsigned*)(args.ws + WS_CTL);
    F.tid = threadIdx.x; F.lane = F.tid & 63; F.wave = __builtin_amdgcn_readfirstlane(F.tid >> 6);
    F.G = gridDim.x; { const int bx = blockIdx.x; F.vcu = (F.G % 8 == 0) ? (bx % 8) * (F.G / 8) + bx / 8 : bx; }
    F.in = args.in; F.out = args.out;
    return F;
}
template <unsigned PH_MASK> __global__ void __launch_bounds__(NTHREADS, 2) mk_fwd(Args args) {
    extern __shared__ __attribute__((aligned(16))) unsigned char lds[];
    for (int u = threadIdx.x; u < (LDS_BYTES - LDSCTL_OFF) / 4; u += NTHREADS) ((LAS unsigned*)((LAS unsigned char*)lds + LDSCTL_OFF))[u] = 0u;
    __syncthreads();
    constexpr bool multi = (PH_MASK & (PH_MASK - 1u)) != 0u;
    if (multi) xcd_barrier_post((unsigned*)(args.ws + WS_CTL) + CW_BAR);
#define IN(k) ((PH_MASK >> (k)) & 1u)
#define GBAR() xcd_barrier((unsigned*)(args.ws + WS_CTL) + CW_BAR, (volatile LAS unsigned*)((LAS unsigned char*)lds + MISC_OFF) + 8)
#define STAMP(i) do { if (PROBE_T >= 0 && blockIdx.x == 0 && threadIdx.x == 0) ((volatile LAS unsigned*)((LAS unsigned char*)lds + LDSCTL_OFF))[(i)] = (unsigned)__builtin_amdgcn_s_memrealtime(); } while (0)
#define PH(k, ...) if (IN(k)) { STAMP(2 * (k)); { __VA_ARGS__ } STAMP(2 * (k) + 1); } if (IN(k) && ((PROBE_DBL >> (k)) & 1u)) { GBAR(); __VA_ARGS__ } if (IN(k) && (k) + 1 < N_PHASES && IN((k) + 1)) GBAR();
#define SEAM(k) do { if (IN(k) && IN((k) + 1)) xcd_barrier((unsigned*)(args.ws + WS_CTL) + CW_BAR, (volatile LAS unsigned*)((LAS unsigned char*)lds + MISC_OFF) + 8); } while (0)
#define RING ((LAS unsigned char*)lds)
#define TAB ((LAS int*)((LAS unsigned char*)lds + TAB_OFF))

    PH(0, Frame F = make_frame(args, lds); ph_prep(F);
    )
    PH(1, Frame F = make_frame(args, lds); ph_taps(F); if (PROBE_SUB & 16u) ph_taps(F); ph_hb(F); if (PROBE_SUB & 32u) ph_hb(F);
    )
    PH(2,
        { pg8::DenseSched S; S.init(T, N1A, DM, gridDim.x, (int)blockIdx.x, args.ws + WS_WIN);
          pg8::EpiInA E{(bf16_t*)(args.ws + WS_Q), (bf16_t*)(args.ws + WS_K), (bf16_t*)(args.ws + WS_V), (bf16_t*)(args.ws + WS_GA)};
          pg8::gemm_phase<pg8::EpiInA, pg8::DenseSched, true>(RING, args.ws + WS_HB, DM, S, E); }
        { pg8::DenseSched S; S.init(NHY, T, DM, gridDim.x, (int)blockIdx.x, args.ws + WS_HB);
          pg8::EpiBf16 E{(bf16_t*)(args.ws + WS_UT), T};
          pg8::gemm_phase<pg8::EpiBf16, pg8::DenseSched, true>(RING, args.ws + WS_WIN + (size_t)N1A * DM * 2, DM, S, E); }
    )
    PH(3, Frame F = make_frame(args, lds); ph_attn(F); FSTAMP(24); if (PROBE_SUB & 1u) ph_attn(F); ph_hyena_fft(F); if (PROBE_SUB & 2u) ph_hyena_fft(F);
    )
    PH(4, Frame F = make_frame(args, lds); ph_hyT(F);
    )
    PH(5,
        pg8::DenseSched S; S.init(T, DM, DM, gridDim.x, (int)blockIdx.x, args.ws + WS_WAH);
        pg8::EpiMerge E{(const bf16_t*)(args.ws + WS_GA), (bf16_t*)(args.ws + WS_HB)};
        pg8::gemm_phase<pg8::EpiMerge, pg8::DenseSched, true>(RING, args.ws + WS_AH, DM, S, E);
    )
    PH(7,
        { pg8::DenseSched S; S.init(T, DM, DM, gridDim.x, (int)blockIdx.x, args.ws + WS_WO);
          pg8::EpiY E{(const float*)(args.ws + WS_MOD) + 2048, (bf16_t*)(args.ws + WS_Y1)};
          pg8::gemm_phase<pg8::EpiY, pg8::DenseSched, true>(RING, args.ws + WS_HB, DM, S, E);
          if (PROBE_SUB & 4u) pg8::gemm_phase<pg8::EpiY, pg8::DenseSched, true>(RING, args.ws + WS_HB, DM, S, E);
          if (PROBE_SUB & 64u) { pg8::EpiNull EN; pg8::gemm_phase<pg8::EpiNull, pg8::DenseSched, true>(RING, args.ws + WS_HB, DM, S, EN); } }
        { Frame F = make_frame(args, lds); FSTAMP(35); ph_expert_cvt(F); if (PROBE_SUB & 8u) ph_expert_cvt(F); }
    )
    PH(8, Frame F = make_frame(args, lds); ph_ln1_route(F);
    )
    PH(9,
        { Frame F = make_frame(args, lds); build_moe_tab<false>(F, TAB); }
        pg8::MoeSched<true> S{TAB, (const LAS int*)((LAS unsigned char*)lds + MOE_UL_OFF), (const LAS int*)((LAS unsigned char*)lds + MOE_RT_OFF), (const char*)(args.ws + WS_W13), (size_t)DM * DM * 2, DM};
        pg8::EpiSwiGLU E{(bf16_t*)(args.ws + WS_HACT)};
        pg8::gemm_phase<pg8::EpiSwiGLU, pg8::MoeSched<true>, true>(RING, args.ws + WS_HB, DM, S, E);
    )
    PH(10,
        { Frame F = make_frame(args, lds); build_moe_tab<true>(F, TAB); }
        pg8::MoeSched<false> S{TAB, (const LAS int*)((LAS unsigned char*)lds + MOE_UL_OFF), (const LAS int*)((LAS unsigned char*)lds + MOE_RT_OFF), (const char*)(args.ws + WS_W2), (size_t)DM * DE * 2, DE};
        pg8::EpiScatter E{(bf16_t*)(args.ws + WS_Y2), (const LAS int*)((LAS unsigned char*)lds + MOE_RT_OFF), (const LAS float*)((LAS unsigned char*)lds + MOE_WT_OFF)};
        pg8::gemm_phase<pg8::EpiScatter, pg8::MoeSched<false>, true>(RING, args.ws + WS_HACT, DE, S, E);
    )
    PH(11, Frame F = make_frame(args, lds); ph_final(F);
    )
    if (PROBE_T >= 0 && blockIdx.x == 0 && threadIdx.x == 0) {
        volatile LAS unsigned* st = (volatile LAS unsigned*)((LAS unsigned char*)lds + LDSCTL_OFF);
        const unsigned d = st[PROBE_TJ] - st[PROBE_T]; const unsigned t0 = (unsigned)__builtin_amdgcn_s_memrealtime();
        while ((unsigned)__builtin_amdgcn_s_memrealtime() - t0 < 16u * d) __builtin_amdgcn_s_sleep(8);
    }
#undef IN
#undef SEAM
#undef GBAR
#undef PH
#undef RING
#undef TAB
}

extern "C" void kernel_launch(void* const* d_in, const int* in_sizes, int n_in, void* d_out, int out_size, void* d_ws, size_t ws_size, hipStream_t stream) {
    static int grid = 0;
    if (grid == 0) {
        if (n_in != 31 || out_size != T * DM || ws_size < WS_END) { fprintf(stderr, "kernel_launch: unexpected shapes: n_in %d out %d ws %zu (need %zu)\n", n_in, out_size, ws_size, (size_t)WS_END); grid = -1; return; }
        int dev = 0, cus = 0;
        if (hipGetDevice(&dev) != hipSuccess || hipDeviceGetAttribute(&cus, hipDeviceAttributeMultiprocessorCount, dev) != hipSuccess) { grid = -1; return; }
        bool ok = true;
#define SET_ATTR(m) ok = ok && (hipFuncSetAttribute((const void*)mk_fwd<(m)>, hipFuncAttributeMaxDynamicSharedMemorySize, LDS_BYTES) == hipSuccess)
#if MK_N_LAUNCHES == 1
        SET_ATTR(FUSED_MASK);
#else
        { SET_ATTR(1u << 0); SET_ATTR(1u << 1); SET_ATTR(1u << 2); SET_ATTR(1u << 3); SET_ATTR(1u << 4); SET_ATTR(1u << 5); SET_ATTR(1u << 6); SET_ATTR(1u << 7); SET_ATTR(1u << 8); SET_ATTR(1u << 9); SET_ATTR(1u << 10); SET_ATTR(1u << 11); }
#endif
#undef SET_ATTR
        if (!ok) { fprintf(stderr, "kernel_launch: hipFuncSetAttribute failed\n"); grid = -1; return; }
        (void)hipGetLastError();
        grid = cus;
    }
    if (grid < 0) return;
    if (hipMemsetAsync((char*)d_ws + WS_CTL, 0, CTL_ZERO_BYTES, stream) != hipSuccess) return;
    Args a{};
    for (int i = 0; i < 31; ++i) a.in[i] = (const float*)d_in[i];
    a.out = (float*)d_out; a.ws = (unsigned char*)d_ws;
#if MK_N_LAUNCHES == 1
    a.ph_lo = 0; a.ph_hi = N_PHASES; hipLaunchKernelGGL(mk_fwd<FUSED_MASK>, dim3(grid), dim3(NTHREADS), LDS_BYTES, stream, a);
#else
    {
#define LAUNCH_PH(p) do { a.ph_lo = (p); a.ph_hi = (p) + 1; for (int rep_ = 0; rep_ < (((PROBE_DBL >> (p)) & 1u) ? 2 : 1); ++rep_) hipLaunchKernelGGL(mk_fwd<(1u << (p))>, dim3(grid), dim3(NTHREADS), LDS_BYTES, stream, a); } while (0)
        LAUNCH_PH(0); LAUNCH_PH(1); LAUNCH_PH(2); LAUNCH_PH(3); LAUNCH_PH(4); LAUNCH_PH(5); LAUNCH_PH(6); LAUNCH_PH(7); LAUNCH_PH(8); LAUNCH_PH(9); LAUNCH_PH(10); LAUNCH_PH(11);
#undef LAUNCH_PH
    }
#endif
}
```
